# Optimizing an MI355X kernel written in HIP

```python
import math
import jax
import jax.numpy as jnp
from jax import lax
import numpy as np

D_MODEL = 1024
BATCH = 16
SEQ = 2048
DEPTH = 2

CTX_LEN = 256
GRID_W = 64
N_BRANCHES = 4
BRANCH_WIDTH = 512
POOL_WIDTH = 512
POOL_GROUP = 128
POOL_WINDOWS = (2, 4, 8, 16)
SSD_HEADS = 8
SSD_HEADDIM = 64
SSD_INNER = SSD_HEADS * SSD_HEADDIM
SSD_GROUPS = 2
SSD_STATE = 64
SSD_XBC = SSD_INNER + 2 * SSD_GROUPS * SSD_STATE
SSD_CONV = 5
SSD_CHUNK = 128
DIFF_HEADS = 4
DIFF_DK = 64
DIFF_DV = 2 * DIFF_DK
DIFF_QK_WIDTH = DIFF_HEADS * 2 * DIFF_DK
DIFF_V_WIDTH = DIFF_HEADS * DIFF_DV
ATTN_BLOCK = 128
ROPE_BASE = 10000.0
SGU_WIDTH = 512
SGU_GROUPS = 4
SGU_GROUP_W = SGU_WIDTH // SGU_GROUPS
SGU_CHUNK = 128
N_EXPERTS = 16
EXPERT_FF = 512
EC_CAPACITY_FACTOR = 2
LN_EPS = 1e-5
ALPHA = (2 * DEPTH) ** 0.25
BETA = (8 * DEPTH) ** -0.25
PROJ_WIDTHS = (POOL_WIDTH, SSD_INNER, SSD_XBC, 2 * SSD_HEADS, DIFF_QK_WIDTH, DIFF_QK_WIDTH, DIFF_V_WIDTH, 2 * SGU_WIDTH)
IN_COLS = sum(PROJ_WIDTHS)

kernel_name = 'hybrid_parallel_mixer_ec_moe_diffusion'


def layer_norm(x, g, b):
    xf = x.astype(jnp.float32)
    mu = jnp.mean(xf, axis=-1, keepdims=True)
    var = jnp.mean(jnp.square(xf - mu), axis=-1, keepdims=True)
    return ((xf - mu) * lax.rsqrt(var + LN_EPS) * g + b).astype(x.dtype)


def rms_norm(xf, g):
    return xf * lax.rsqrt(jnp.mean(jnp.square(xf), axis=-1, keepdims=True) + LN_EPS) * g


def modulate(x, shift, scale):
    return x * (1 + scale) + shift


def flip(t):
    return jnp.flip(t, axis=1)


def pool_mix(xp, pool_w, pool_scale):
    bsz, n, _ = xp.shape
    xf = xp.astype(jnp.float32)
    cs = jnp.concatenate([jnp.zeros((bsz, 1, POOL_WIDTH), jnp.float32), jnp.cumsum(xf, axis=1)], axis=1)
    t = jnp.arange(n)
    outs = []
    for g, w in enumerate(POOL_WINDOWS):
        lo = jnp.clip(t - w // 2, 0, n)
        hi = jnp.clip(t + w // 2, 0, n)
        csg = cs[:, :, g * POOL_GROUP:(g + 1) * POOL_GROUP]
        mean = (csg[:, hi] - csg[:, lo]) / (hi - lo).astype(jnp.float32)[None, :, None]
        outs.append(mean - xf[:, :, g * POOL_GROUP:(g + 1) * POOL_GROUP])
    pooled = jnp.stack(outs, axis=2).astype(xp.dtype)
    mixed = jnp.einsum('bngc,gcd->bngd', pooled, pool_w).reshape(bsz, n, POOL_WIDTH)
    return mixed * pool_scale


def depthwise_conv(x, w, b):
    ch = x.shape[-1]
    y = lax.conv_general_dilated(x, w[:, None, :].astype(x.dtype), window_strides=(1,),
                                 padding=[(SSD_CONV // 2, SSD_CONV // 2)],
                                 dimension_numbers=('NWC', 'WIO', 'NWC'), feature_group_count=ch)
    return y + b


def ssd_prep(xbc, dt_raw, conv_w, conv_b, dt_bias):
    bsz, n, _ = xbc.shape
    xbc = jax.nn.silu(depthwise_conv(xbc, conv_w, conv_b))
    xs, bm, cm = jnp.split(xbc, [SSD_INNER, SSD_INNER + SSD_GROUPS * SSD_STATE], axis=-1)
    dt = jax.nn.softplus(dt_raw.astype(jnp.float32).reshape(bsz, n, 2, SSD_HEADS) + dt_bias.astype(jnp.float32))
    return (xs.reshape(bsz, n, SSD_HEADS, SSD_HEADDIM),
            bm.reshape(bsz, n, SSD_GROUPS, SSD_STATE),
            cm.reshape(bsz, n, SSD_GROUPS, SSD_STATE),
            dt[:, :, 0], dt[:, :, 1])


def ssd_chunked(x, dt, a_neg, bmat, cmat, init_state, with_output):
    f32 = jnp.float32
    bsz, n, nh, hp = x.shape
    nc = n // SSD_CHUNK
    rep = nh // SSD_GROUPS
    xdt = (x.astype(f32) * dt[..., None]).reshape(bsz, nc, SSD_CHUNK, nh, hp)
    a_cs = jnp.cumsum((dt * a_neg).reshape(bsz, nc, SSD_CHUNK, nh).transpose(0, 3, 1, 2), axis=-1)
    bh = jnp.repeat(bmat.astype(f32), rep, axis=2).reshape(bsz, nc, SSD_CHUNK, nh, SSD_STATE)
    ch = jnp.repeat(cmat.astype(f32), rep, axis=2).reshape(bsz, nc, SSD_CHUNK, nh, SSD_STATE)
    decay_to_end = jnp.exp(a_cs[..., -1:] - a_cs)
    chunk_states = jnp.einsum('bclhn,bhcl,bclhp->bchpn', bh, decay_to_end, xdt)
    chunk_decay = jnp.exp(a_cs[..., -1])

    def carry_step(state, inp):
        s_k, d_k = inp
        return state * d_k[:, :, None, None] + s_k, state

    final, entering = lax.scan(carry_step, init_state,
                               (jnp.moveaxis(chunk_states, 1, 0), jnp.moveaxis(chunk_decay, 2, 0)))
    if not with_output:
        return None, final
    entering = jnp.moveaxis(entering, 0, 1)
    seg = a_cs[..., :, None] - a_cs[..., None, :]
    lower = jnp.tril(jnp.ones((SSD_CHUNK, SSD_CHUNK), dtype=bool))
    lmat = jnp.exp(jnp.where(lower, seg, -jnp.inf))
    scores = jnp.einsum('bclhn,bcshn->bhcls', ch, bh) * lmat
    y = (jnp.einsum('bhcls,bcshp->bclhp', scores, xdt)
         + jnp.einsum('bclhn,bchpn,bhcl->bclhp', ch, entering, jnp.exp(a_cs)))
    return y.reshape(bsz, n, nh, hp), final


def ssd_finish(y_f, y_b, xs, z, d_skip, g):
    bsz, n = z.shape[:2]
    y = y_f + y_b + d_skip.astype(jnp.float32)[:, None] * xs.astype(jnp.float32)
    y = y.reshape(bsz, n, SSD_INNER) * jax.nn.silu(z.astype(jnp.float32))
    return rms_norm(y, g.astype(jnp.float32)).astype(z.dtype)


def rotate(x, pos):
    half = x.shape[-1] // 2
    inv = ROPE_BASE ** (-jnp.arange(half, dtype=jnp.float32) / half)
    ang = pos.astype(jnp.float32)[:, None] * inv
    cos = jnp.cos(ang)[None, :, None, :]
    sin = jnp.sin(ang)[None, :, None, :]
    xf = x.astype(jnp.float32)
    x1, x2 = xf[..., :half], xf[..., half:]
    return jnp.concatenate([x1 * cos - x2 * sin, x1 * sin + x2 * cos], axis=-1).astype(x.dtype)


def axial_rope(x, rows, cols):
    half = x.shape[-1] // 2
    return jnp.concatenate([rotate(x[..., :half], rows), rotate(x[..., half:], cols)], axis=-1)


def diff_heads(q, rows, cols, use_rope):
    bsz, n, _ = q.shape
    q = q.reshape(bsz, n, DIFF_HEADS * 2, DIFF_DK)
    if use_rope:
        q = axial_rope(q, rows, cols)
    q = q.reshape(bsz, n, DIFF_HEADS, 2, DIFF_DK).transpose(0, 2, 3, 1, 4)
    return q[:, :, 0], q[:, :, 1]


def value_heads(v):
    bsz, n, _ = v.shape
    return v.reshape(bsz, n, DIFF_HEADS, DIFF_DV).transpose(0, 2, 1, 3)


def diff_attend(q1, q2, k1, k2, v, lam):
    scale = DIFF_DK ** -0.5
    s1 = jnp.einsum('bhqd,bhkd->bhqk', q1, k1).astype(jnp.float32) * scale
    s2 = jnp.einsum('bhqd,bhkd->bhqk', q2, k2).astype(jnp.float32) * scale
    a = jax.nn.softmax(s1, axis=-1) - lam * jax.nn.softmax(s2, axis=-1)
    return jnp.einsum('bhqk,bhkd->bhqd', a.astype(v.dtype), v)


def blocked_diff_attention(q1, q2, k1, k2, v, lam):
    bsz, nh, n, dk = q1.shape
    nb = n // ATTN_BLOCK

    def blocks(q):
        return q.reshape(bsz, nh, nb, ATTN_BLOCK, dk).transpose(2, 0, 1, 3, 4)

    out = lax.map(lambda qq: diff_attend(qq[0], qq[1], k1, k2, v, lam), (blocks(q1), blocks(q2)))
    return out.transpose(1, 2, 0, 3, 4).reshape(bsz, nh, n, DIFF_DV)


def diff_head_norm(o, g, lam_init):
    bsz, nh, n, dv = o.shape
    of = rms_norm(o.astype(jnp.float32), g.astype(jnp.float32)) * (1.0 - lam_init)
    return of.transpose(0, 2, 1, 3).reshape(bsz, n, nh * dv).astype(o.dtype)


def spatial_gating(uv, ln_g, ln_b, w_s, b_s):
    bsz, n, _ = uv.shape
    u, v = jnp.split(jax.nn.gelu(uv), 2, axis=-1)
    v = layer_norm(v, ln_g, ln_b)
    vg = v.reshape(bsz, n // SGU_CHUNK, SGU_CHUNK, SGU_GROUPS, SGU_GROUP_W)
    vm = jnp.einsum('gpq,bcqgd->bcpgd', w_s, vg) + b_s.T[None, None, :, :, None]
    return u * vm.reshape(bsz, n, SGU_WIDTH)


def merge_branches(h, branches, w_gate, w_branch, w_out):
    acc = jax.nn.sigmoid(h @ w_gate[0]) * (branches[0] @ w_branch[0])
    for k in range(1, N_BRANCHES):
        acc = acc + jax.nn.sigmoid(h @ w_gate[k]) * (branches[k] @ w_branch[k])
    return acc @ w_out


def token_mixer(h_lat, h_ctx, rows, cols, layer_idx, need_ctx, w_in, conv_w, conv_b, a_log, dt_bias,
                ssd_d, ssd_norm_g, diff_lambda, diff_norm_g, pool_w, pool_scale, sgu_ln_g, sgu_ln_b,
                sgu_w, sgu_b, w_gate, w_branch, w_out):
    offsets = np.cumsum(PROJ_WIDTHS)[:-1].tolist()
    pool_l, z_l, xbc_l, dt_l, q_l, k_l, v_l, uv_l = jnp.split(h_lat @ w_in, offsets, axis=-1)
    pool_c, z_c, xbc_c, dt_c, q_c, k_c, v_c, uv_c = jnp.split(h_ctx @ w_in, offsets, axis=-1)

    y_pool_l = pool_mix(pool_l, pool_w, pool_scale)

    a_neg = -jnp.exp(a_log.astype(jnp.float32))
    xs_c, bm_c, cm_c, dtf_c, dtb_c = ssd_prep(xbc_c, dt_c, conv_w, conv_b, dt_bias)
    zero = jnp.zeros((h_ctx.shape[0], SSD_HEADS, SSD_HEADDIM, SSD_STATE), jnp.float32)
    yf_c, sf_c = ssd_chunked(xs_c, dtf_c, a_neg[0], bm_c, cm_c, zero, need_ctx)
    yb_c, sb_c = ssd_chunked(flip(xs_c), flip(dtb_c), a_neg[1], flip(bm_c), flip(cm_c), zero, need_ctx)
    xs_l, bm_l, cm_l, dtf_l, dtb_l = ssd_prep(xbc_l, dt_l, conv_w, conv_b, dt_bias)
    yf_l, _ = ssd_chunked(xs_l, dtf_l, a_neg[0], bm_l, cm_l, sf_c, True)
    yb_l, _ = ssd_chunked(flip(xs_l), flip(dtb_l), a_neg[1], flip(bm_l), flip(cm_l), sb_c, True)
    y_ssd_l = ssd_finish(yf_l, flip(yb_l), xs_l, z_l, ssd_d, ssd_norm_g)

    lam_init = 0.8 - 0.6 * math.exp(-0.3 * layer_idx)
    dl = diff_lambda.astype(jnp.float32)
    lam = jnp.exp(jnp.sum(dl[0] * dl[1])) - jnp.exp(jnp.sum(dl[2] * dl[3])) + lam_init
    q1_l, q2_l = diff_heads(q_l, rows, cols, True)
    k1_l, k2_l = diff_heads(k_l, rows, cols, True)
    k1_c, k2_c = diff_heads(k_c, rows, cols, False)
    vh_l, vh_c = value_heads(v_l), value_heads(v_c)
    k1_all = jnp.concatenate([k1_l, k1_c], axis=2)
    k2_all = jnp.concatenate([k2_l, k2_c], axis=2)
    v_all = jnp.concatenate([vh_l, vh_c], axis=2)
    y_diff_l = diff_head_norm(blocked_diff_attention(q1_l, q2_l, k1_all, k2_all, v_all, lam), diff_norm_g, lam_init)

    y_sgu_l = spatial_gating(uv_l, sgu_ln_g, sgu_ln_b, sgu_w, sgu_b)

    y_lat = merge_branches(h_lat, (y_pool_l, y_ssd_l, y_diff_l, y_sgu_l), w_gate, w_branch, w_out)
    if not need_ctx:
        return y_lat, None

    y_pool_c = pool_mix(pool_c, pool_w, pool_scale)
    y_ssd_c = ssd_finish(yf_c, flip(yb_c), xs_c, z_c, ssd_d, ssd_norm_g)
    q1_c, q2_c = diff_heads(q_c, rows, cols, False)
    y_diff_c = diff_head_norm(diff_attend(q1_c, q2_c, k1_c, k2_c, vh_c, lam), diff_norm_g, lam_init)
    y_sgu_c = spatial_gating(uv_c, sgu_ln_g, sgu_ln_b, sgu_w, sgu_b)
    y_ctx = merge_branches(h_ctx, (y_pool_c, y_ssd_c, y_diff_c, y_sgu_c), w_gate, w_branch, w_out)
    return y_lat, y_ctx


def expert_choice_ffn(h, w_router, w1, w3, w2):
    bsz, n, d = h.shape
    cap = EC_CAPACITY_FACTOR * n // N_EXPERTS
    aff = jax.nn.softmax((h @ w_router).astype(jnp.float32), axis=-1)
    gate, idx = lax.top_k(jnp.swapaxes(aff, 1, 2), cap)
    xe = jax.vmap(lambda hb, ib: hb[ib])(h, idx)
    hid = jax.nn.silu(jnp.einsum('becd,edf->becf', xe, w1)) * jnp.einsum('becd,edf->becf', xe, w3)
    ye = jnp.einsum('becf,efd->becd', hid, w2) * gate[..., None].astype(h.dtype)
    return jax.vmap(lambda ib, yb: jnp.zeros((n, d), yb.dtype).at[ib.reshape(-1)].add(yb.reshape(-1, d)))(idx, ye)


def setup_inputs(seed: int = 0) -> dict:
    key = jax.random.key(seed)
    keys = jax.random.split(key, 40)
    counter = [0]

    def nxt():
        k = keys[counter[0]]
        counter[0] += 1
        return k

    f32 = jnp.float32

    def nrm(shape, scale):
        return jax.random.normal(nxt(), shape, f32) * scale

    L, D = DEPTH, D_MODEL
    dt0 = jnp.exp(jax.random.uniform(nxt(), (L, 2, SSD_HEADS), f32, math.log(1e-3), math.log(1e-1)))
    return {
        'x': nrm((BATCH, SEQ, D), 1.0),
        'c': nrm((BATCH, D), 1.0),
        'ctx': nrm((BATCH, CTX_LEN, D), 1.0),
        'c_ctx': nrm((D,), 1.0),
        'w_mod': nrm((L, D, 6 * D), 0.5 * D ** -0.5),
        'b_mod': nrm((L, 6 * D), 0.01),
        'w_in': nrm((L, D, IN_COLS), D ** -0.5),
        'conv_w': nrm((L, SSD_CONV, SSD_XBC), SSD_CONV ** -0.5),
        'conv_b': nrm((L, SSD_XBC), 0.01),
        'a_log': jnp.log(jax.random.uniform(nxt(), (L, 2, SSD_HEADS), f32, 1.0, 16.0)),
        'dt_bias': dt0 + jnp.log(-jnp.expm1(-dt0)),
        'ssd_d': 1.0 + nrm((L, SSD_HEADS), 0.1),
        'ssd_norm_g': 1.0 + nrm((L, SSD_INNER), 0.02),
        'diff_lambda': nrm((L, 4, DIFF_DK), 0.1),
        'diff_norm_g': 1.0 + nrm((L, DIFF_DV), 0.02),
        'pool_w': nrm((L, len(POOL_WINDOWS), POOL_GROUP, POOL_GROUP), POOL_GROUP ** -0.5),
        'pool_scale': 1.0 + nrm((L, POOL_WIDTH), 0.1),
        'sgu_ln_g': 1.0 + nrm((L, SGU_WIDTH), 0.02),
        'sgu_ln_b': nrm((L, SGU_WIDTH), 0.01),
        'sgu_w': nrm((L, SGU_GROUPS, SGU_CHUNK, SGU_CHUNK), SGU_CHUNK ** -0.5),
        'sgu_b': 1.0 + nrm((L, SGU_GROUPS, SGU_CHUNK), 0.1),
        'w_gate': nrm((L, N_BRANCHES, D, D), D ** -0.5),
        'w_branch': nrm((L, N_BRANCHES, BRANCH_WIDTH, D), BRANCH_WIDTH ** -0.5 * BETA),
        'w_out': nrm((L, D, D), D ** -0.5 * BETA),
        'ln1_g': 1.0 + nrm((L, D), 0.02),
        'ln1_b': nrm((L, D), 0.01),
        'w_router': nrm((L, D, N_EXPERTS), D ** -0.5),
        'w1': nrm((L, N_EXPERTS, D, EXPERT_FF), D ** -0.5),
        'w3': nrm((L, N_EXPERTS, D, EXPERT_FF), D ** -0.5),
        'w2': nrm((L, N_EXPERTS, EXPERT_FF, D), EXPERT_FF ** -0.5 * BETA),
        'ln2_g': 1.0 + nrm((L, D), 0.02),
        'ln2_b': nrm((L, D), 0.01),
    }


def reference(x, c, ctx, c_ctx, w_mod, b_mod, w_in, conv_w, conv_b, a_log, dt_bias, ssd_d, ssd_norm_g,
              diff_lambda, diff_norm_g, pool_w, pool_scale, sgu_ln_g, sgu_ln_b, sgu_w, sgu_b, w_gate,
              w_branch, w_out, ln1_g, ln1_b, w_router, w1, w3, w2, ln2_g, ln2_b):
    n_lat = x.shape[1]
    n_rows = n_lat // GRID_W
    rows = jnp.broadcast_to(jnp.arange(n_rows, dtype=jnp.int32)[:, None], (n_rows, GRID_W)).reshape(-1)
    cols = jnp.broadcast_to(jnp.arange(GRID_W, dtype=jnp.int32)[None, :], (n_rows, GRID_W)).reshape(-1)
    for l in range(DEPTH):
        last = l == DEPTH - 1
        m_lat = jnp.split((jax.nn.silu(c) @ w_mod[l] + b_mod[l])[:, None, :], 6, axis=-1)
        m_ctx = jnp.split((jax.nn.silu(c_ctx) @ w_mod[l] + b_mod[l]).reshape(1, 1, -1), 6, axis=-1)
        h_lat = modulate(x, m_lat[0], m_lat[1])
        h_ctx = modulate(ctx, m_ctx[0], m_ctx[1])
        y_lat, y_ctx = token_mixer(h_lat, h_ctx, rows, cols, l, not last, w_in[l], conv_w[l], conv_b[l],
                                   a_log[l], dt_bias[l], ssd_d[l], ssd_norm_g[l], diff_lambda[l],
                                   diff_norm_g[l], pool_w[l], pool_scale[l], sgu_ln_g[l], sgu_ln_b[l],
                                   sgu_w[l], sgu_b[l], w_gate[l], w_branch[l], w_out[l])
        x = layer_norm(ALPHA * x + m_lat[2] * y_lat, ln1_g[l], ln1_b[l])
        y_ffn = expert_choice_ffn(modulate(x, m_lat[3], m_lat[4]), w_router[l], w1[l], w3[l], w2[l])
        x = layer_norm(ALPHA * x + m_lat[5] * y_ffn, ln2_g[l], ln2_b[l])
        if not last:
            ctx = layer_norm(ALPHA * ctx + m_ctx[2] * y_ctx, ln1_g[l], ln1_b[l])
            y_ffn_c = expert_choice_ffn(modulate(ctx, m_ctx[3], m_ctx[4]), w_router[l], w1[l], w3[l], w2[l])
            ctx = layer_norm(ALPHA * ctx + m_ctx[5] * y_ffn_c, ln2_g[l], ln2_b[l])
    return x
```

```cpp
#include <hip/hip_runtime.h>
#include <hip/hip_cooperative_groups.h>
#include <cstdio>
#include <cstdint>
namespace cg = cooperative_groups;

typedef unsigned short u16;
using bf16x8 = __attribute__((ext_vector_type(8))) short;
using bf16x4 = __attribute__((ext_vector_type(4))) short;
using f32x4 = __attribute__((ext_vector_type(4))) float;
using u32x4 = __attribute__((ext_vector_type(4))) unsigned;

#define DI __device__ __forceinline__
#define MFMA16(a, b, c) __builtin_amdgcn_mfma_f32_16x16x32_bf16((a), (b), (c), 0, 0, 0)

constexpr int NB = 16, SEQ = 2048, CTXL = 256, SP = 2304, NTOK = NB * SP, DM = 1024;
constexpr int HROWS = 8 * SP;
constexpr int INC = 4368, INP = 4480;
constexpr int NFFN_LAT = 65536, NFFN_ALL = 73728;
constexpr float LN_EPS = 1e-5f;
constexpr float ALPHA = 1.41421356237309515f;
constexpr int SMEM_BYTES = 81920;
constexpr int NPHASE = 2 + 2 * (2 * 4 + 7);


constexpr size_t al256(size_t x) { return (x + 255) & ~(size_t)255; }
constexpr size_t U_ = (size_t)NTOK * 512 * 2;
constexpr size_t OFF_WinT = 0;
constexpr size_t OFF_WgT = OFF_WinT + al256((size_t)2 * INP * 1024 * 2);
constexpr size_t OFF_WbT = OFF_WgT + al256((size_t)2 * 4 * 1024 * 1024 * 2);
constexpr size_t OFF_WoT = OFF_WbT + al256((size_t)2 * 4 * 1024 * 512 * 2);
constexpr size_t OFF_poolT = OFF_WoT + al256((size_t)2 * 1024 * 1024 * 2);
constexpr size_t OFF_sguW = OFF_poolT + al256((size_t)2 * 4 * 128 * 128 * 2);
constexpr size_t OFF_mod = OFF_sguW + al256((size_t)2 * 4 * 128 * 128 * 2);
constexpr size_t OFF_rope = OFF_mod + al256((size_t)2 * 17 * 6144 * 4);
constexpr size_t OFF_lamv = OFF_rope + al256(64 * 16 * 2 * 4);
constexpr size_t OFF_aff = OFF_lamv + 256;
constexpr size_t OFF_rank = OFF_aff + al256((size_t)NTOK * 16 * 4);
constexpr size_t OFF_ssq = OFF_rank + al256((size_t)NTOK * 16 * 4);
constexpr size_t OFF_tokidx = OFF_ssq + al256((size_t)NTOK * 8 * 4);
constexpr size_t OFF_gatev = OFF_tokidx + al256((size_t)NFFN_ALL * 4);
constexpr size_t OFF_dtbuf = OFF_gatev + al256((size_t)NFFN_ALL * 4);
constexpr size_t OFF_decay = OFF_dtbuf + al256((size_t)HROWS * 16 * 4);
constexpr size_t OFF_H = OFF_decay + al256((size_t)8 * 2 * 8 * 18 * 4);
constexpr size_t OFF_Y = OFF_H + 2 * U_;
constexpr size_t OFF_o1 = OFF_Y;
constexpr size_t OFF_cstate = OFF_Y + U_ / 2;
constexpr size_t OFF_enter = OFF_Y + U_ / 2 + U_;
constexpr size_t OFF_RM = OFF_Y + 2 * U_;
constexpr size_t OFF_xp = OFF_RM;
constexpr size_t OFF_z = OFF_xp + U_ / 2;
constexpr size_t OFF_xbc = OFF_z + U_ / 2;
constexpr size_t OFF_q = OFF_xbc + (U_ / 4) * 3;
constexpr size_t OFF_k = OFF_q + U_ / 2;
constexpr size_t OFF_vT = OFF_k + U_ / 2;
constexpr size_t OFF_gvT = OFF_vT + U_ / 2;
constexpr size_t OFF_br0 = OFF_gvT + U_ / 2;
constexpr size_t OFF_br1 = OFF_br0 + U_;
constexpr size_t OFF_br2 = OFF_br1 + U_;
constexpr size_t OFF_br3 = OFF_br2 + U_;
constexpr size_t OFF_acc = OFF_RM;
constexpr size_t OFF_W13T = OFF_RM;
constexpr size_t OFF_W2T = OFF_W13T + (size_t)16 * 1024 * 1024 * 2;
constexpr size_t OFF_hid = OFF_W2T + (size_t)16 * 1024 * 512 * 2;
constexpr size_t OFF_ye = OFF_hid + (size_t)NFFN_ALL * 512 * 2;
constexpr size_t WS_MIX_END = OFF_br3 + U_;
constexpr size_t WS_FFN_END = OFF_ye + (size_t)NFFN_ALL * 1024 * 2;
constexpr size_t WS_NEED = WS_MIX_END > WS_FFN_END ? WS_MIX_END : WS_FFN_END;

struct Params {
  const float *x, *c, *ctx, *c_ctx, *w_mod, *b_mod, *w_in, *conv_w, *conv_b, *a_log, *dt_bias, *ssd_d, *ssd_norm_g,
      *diff_lambda, *diff_norm_g, *pool_w, *pool_scale, *sgu_ln_g, *sgu_ln_b, *sgu_w, *sgu_b, *w_gate, *w_branch, *w_out,
      *ln1_g, *ln1_b, *w_router, *w1, *w3, *w2, *ln2_g, *ln2_b;
  float* out;
  char* ws;
};

DI int TID() { int t = (int)__builtin_amdgcn_workitem_id_x(); asm volatile("" : "+v"(t)); return t; }
DI u16 f2bf(float x) { unsigned u = __float_as_uint(x); u += 0x7fffu + ((u >> 16) & 1u); return (u16)(u >> 16); }
DI float bf2f(u16 v) { return __uint_as_float(((unsigned)v) << 16); }
DI float sigmoidf_(float x) { return 1.f / (1.f + __expf(-x)); }
DI float siluf_(float x) { return x / (1.f + __expf(-x)); }
DI float geluf_(float x) { float y = 0.7978845608028654f * (x + 0.044715f * x * x * x); float t = 1.f - 2.f / (__expf(2.f * y) + 1.f); return 0.5f * x * (1.f + t); }
DI float softplusf_(float x) { return x > 20.f ? x : log1pf(__expf(x)); }
DI bf16x4 pack4(float a, float b, float c, float d) { bf16x4 r; r[0] = (short)f2bf(a); r[1] = (short)f2bf(b); r[2] = (short)f2bf(c); r[3] = (short)f2bf(d); return r; }
DI bf16x4 pack4v(f32x4 v) { return pack4(v[0], v[1], v[2], v[3]); }
DI float wave_sum(float v) { for (int o = 32; o > 0; o >>= 1) v += __shfl_xor(v, o); return v; }

template <int MI, int NI, bool SWAP>
DI void mma_lds(const u16* As, int lda, const u16* Bs, int ldb, int ksteps, f32x4 (&acc)[MI][NI], int fr, int fq) {
  for (int ks = 0; ks < ksteps; ++ks) {
    bf16x8 a[MI], b[NI];
#pragma unroll
    for (int m = 0; m < MI; ++m) a[m] = *(const bf16x8*)(As + (m * 16 + fr) * lda + ks * 32 + fq * 8);
#pragma unroll
    for (int n = 0; n < NI; ++n) b[n] = *(const bf16x8*)(Bs + (n * 16 + fr) * ldb + ks * 32 + fq * 8);
#pragma unroll
    for (int m = 0; m < MI; ++m)
#pragma unroll
      for (int n = 0; n < NI; ++n) acc[m][n] = SWAP ? MFMA16(b[n], a[m], acc[m][n]) : MFMA16(a[m], b[n], acc[m][n]);
  }
}

constexpr int LDT = 72;
template <int NI, bool SWAP, bool GATHER>
DI void gemm_main(const u16* __restrict__ A, int lda, const int* __restrict__ aidx, int arow0, const u16* __restrict__ Bt, int ldb, int brow0,
                  int K, f32x4 (&acc)[4][NI], u16* smem) {
  constexpr int BN = NI * 32;
  constexpr int NBL = BN / 32;
  const int tid = TID(), wave = tid >> 6, lane = tid & 63, fr = lane & 15, fq = lane >> 4;
  const int wr = wave >> 1, wc = wave & 1;
  u16* As = smem;
  u16* Bs = smem + 2 * 128 * LDT;
  const int lr = tid >> 3, lc = (tid & 7) * 8;
  const u16* ap[4];
#pragma unroll
  for (int i = 0; i < 4; ++i) {
    int r = arow0 + lr + 32 * i;
    size_t rr = GATHER ? (size_t)aidx[r] : (size_t)r;
    ap[i] = A + rr * lda + lc;
  }
  const u16* bp = Bt + (size_t)(brow0 + lr) * ldb + lc;
  u32x4 ra[4], rb[NBL];
  const int nk = K / 64;
#pragma unroll
  for (int i = 0; i < 4; ++i) ra[i] = *(const u32x4*)(ap[i]);
#pragma unroll
  for (int i = 0; i < NBL; ++i) rb[i] = *(const u32x4*)(bp + (size_t)(32 * i) * ldb);
  __syncthreads();
#pragma unroll
  for (int i = 0; i < 4; ++i) *(u32x4*)(As + (lr + 32 * i) * LDT + lc) = ra[i];
#pragma unroll
  for (int i = 0; i < NBL; ++i) *(u32x4*)(Bs + (lr + 32 * i) * LDT + lc) = rb[i];
  __syncthreads();
  for (int kt = 0; kt < nk; ++kt) {
    const int cur = kt & 1;
    if (kt + 1 < nk) {
      const int ko = (kt + 1) * 64;
#pragma unroll
      for (int i = 0; i < 4; ++i) ra[i] = *(const u32x4*)(ap[i] + ko);
#pragma unroll
      for (int i = 0; i < NBL; ++i) rb[i] = *(const u32x4*)(bp + (size_t)(32 * i) * ldb + ko);
    }
    mma_lds<4, NI, SWAP>(As + cur * 128 * LDT + wr * 64 * LDT, LDT, Bs + cur * BN * LDT + wc * (NI * 16) * LDT, LDT, 2, acc, fr, fq);
    if (kt + 1 < nk) {
      const int nx = cur ^ 1;
#pragma unroll
      for (int i = 0; i < 4; ++i) *(u32x4*)(As + nx * 128 * LDT + (lr + 32 * i) * LDT + lc) = ra[i];
#pragma unroll
      for (int i = 0; i < NBL; ++i) *(u32x4*)(Bs + nx * BN * LDT + (lr + 32 * i) * LDT + lc) = rb[i];
    }
    __syncthreads();
  }
}

template <int NI> DI void zero_acc(f32x4 (&a)[4][NI]) {
#pragma unroll
  for (int m = 0; m < 4; ++m)
#pragma unroll
    for (int n = 0; n < NI; ++n) a[m][n] = f32x4{0.f, 0.f, 0.f, 0.f};
}

DI void cvt_tile(const float* __restrict__ src0, const float* __restrict__ src1, int ld, u16* __restrict__ dst, int K, int n0, int k0, int mode, u16* lds) {
  const int tid = TID();
  __syncthreads();
  if (mode == 3) {
    for (int idx = tid; idx < 4096; idx += 256) {
      int n = idx >> 6, kk = idx & 63;
      lds[n * LDT + kk] = f2bf(src0[(size_t)(n0 + n) * ld + k0 + kk]);
    }
  } else {
    for (int idx = tid; idx < 4096; idx += 256) {
      int kk = idx >> 6, n = idx & 63;
      int nn = n0 + n;
      float v = 0.f;
      if (mode == 0) v = src0[(size_t)(k0 + kk) * ld + nn];
      else if (mode == 1) {
        int col = nn < 1792 ? nn : (nn < 4352 ? nn + 16 : (nn < 4368 ? nn - 4352 + 1792 : -1));
        if (col >= 0) v = src0[(size_t)(k0 + kk) * ld + col];
        if (nn >= 1792 && nn < 2304) v *= 0.125f;
      } else {
        int g = nn >> 5, r = nn & 31;
        v = (r < 16) ? src0[(size_t)(k0 + kk) * ld + g * 16 + r] : src1[(size_t)(k0 + kk) * ld + g * 16 + r - 16];
      }
      lds[n * LDT + kk] = f2bf(v);
    }
  }
  __syncthreads();
  for (int c = tid; c < 512; c += 256) {
    int n = c >> 3, kc = (c & 7) * 8;
    *(u32x4*)(dst + (size_t)(n0 + n) * K + k0 + kc) = *(const u32x4*)(lds + n * LDT + kc);
  }
}

DI void mod_item(const Params& P, int item, char* smem) {
  const int l = item / 96, n0 = (item % 96) * 64;
  float* sc = (float*)smem;
  const int tid = TID();
  __syncthreads();
  for (int i = tid; i < 17 * 1024; i += 256) {
    int s = i >> 10, kk = i & 1023;
    float v = s < 16 ? P.c[s * 1024 + kk] : P.c_ctx[kk];
    sc[i] = siluf_(v);
  }
  __syncthreads();
  const int col = tid & 63, kp = tid >> 6;
  float a[17];
#pragma unroll
  for (int s = 0; s < 17; ++s) a[s] = 0.f;
  const float* w = P.w_mod + (size_t)l * 1024 * 6144 + n0 + col;
  for (int kk = kp * 256; kk < kp * 256 + 256; ++kk) {
    float wv = w[(size_t)kk * 6144];
#pragma unroll
    for (int s = 0; s < 17; ++s) a[s] += sc[s * 1024 + kk] * wv;
  }
  __syncthreads();
  float* red = (float*)smem;
#pragma unroll
  for (int s = 0; s < 17; ++s) red[(kp * 17 + s) * 64 + col] = a[s];
  __syncthreads();
  for (int i = tid; i < 17 * 64; i += 256) {
    int s = i >> 6, cc = i & 63;
    float v = red[(0 * 17 + s) * 64 + cc] + red[(1 * 17 + s) * 64 + cc] + red[(2 * 17 + s) * 64 + cc] + red[(3 * 17 + s) * 64 + cc];
    ((float*)(P.ws + OFF_mod))[((size_t)l * 17 + s) * 6144 + n0 + cc] = v + P.b_mod[l * 6144 + n0 + cc];
  }
}

DI void misc_item(const Params& P) {
  const int tid = TID();
  for (int i = tid; i < 1024; i += 256) {
    int pos = i >> 4, f = i & 15;
    float inv = powf(10000.f, -(float)f / 16.f);
    float ang = (float)pos * inv;
    ((float*)(P.ws + OFF_rope))[i * 2] = cosf(ang);
    ((float*)(P.ws + OFF_rope))[i * 2 + 1] = sinf(ang);
  }
  if (tid < 2) {
    const float* dl = P.diff_lambda + tid * 256;
    float s1 = 0.f, s2 = 0.f;
    for (int i = 0; i < 64; ++i) { s1 += dl[i] * dl[64 + i]; s2 += dl[128 + i] * dl[192 + i]; }
    float lam_init = 0.8f - 0.6f * expf(-0.3f * (float)tid);
    ((float*)(P.ws + OFF_lamv))[tid * 2] = expf(s1) - expf(s2) + lam_init;
    ((float*)(P.ws + OFF_lamv))[tid * 2 + 1] = lam_init;
  }
}

DI void phase_prologue(const Params& P, char* smem) {
  const int per_layer = 1120 + 4 * 256 + 4 * 128 + 256 + 16 + 16;
  const int ncvt = 2 * per_layer;
  const int total = ncvt + 192 + 1;
  for (int it = blockIdx.x; it < total; it += gridDim.x) {
    if (it < ncvt) {
      const int l = it / per_layer;
      int t = it % per_layer;
      const float* s0; u16* dst; int ld, K, ntk, mode;
      if (t < 1120) { s0 = P.w_in + (size_t)l * 1024 * INC; ld = INC; dst = ((u16*)(P.ws + OFF_WinT)) + (size_t)l * INP * 1024; K = 1024; ntk = 16; mode = 1; }
      else if (t < 2144) { t -= 1120; int kq = t >> 8; t &= 255; s0 = P.w_gate + ((size_t)l * 4 + kq) * 1024 * 1024; ld = 1024; dst = ((u16*)(P.ws + OFF_WgT)) + ((size_t)l * 4 + kq) * 1024 * 1024; K = 1024; ntk = 16; mode = 0; }
      else if (t < 2656) { t -= 2144; int kq = t >> 7; t &= 127; s0 = P.w_branch + ((size_t)l * 4 + kq) * 512 * 1024; ld = 1024; dst = ((u16*)(P.ws + OFF_WbT)) + ((size_t)l * 4 + kq) * 1024 * 512; K = 512; ntk = 8; mode = 0; }
      else if (t < 2912) { t -= 2656; s0 = P.w_out + (size_t)l * 1024 * 1024; ld = 1024; dst = ((u16*)(P.ws + OFF_WoT)) + (size_t)l * 1024 * 1024; K = 1024; ntk = 16; mode = 0; }
      else if (t < 2928) { t -= 2912; int g = t >> 2; t &= 3; s0 = P.pool_w + ((size_t)l * 4 + g) * 128 * 128; ld = 128; dst = ((u16*)(P.ws + OFF_poolT)) + ((size_t)l * 4 + g) * 128 * 128; K = 128; ntk = 2; mode = 0; }
      else { t -= 2928; int g = t >> 2; t &= 3; s0 = P.sgu_w + ((size_t)l * 4 + g) * 128 * 128; ld = 128; dst = ((u16*)(P.ws + OFF_sguW)) + ((size_t)l * 4 + g) * 128 * 128; K = 128; ntk = 2; mode = 3; }
      const int tn = t / ntk, tk = t % ntk;
      cvt_tile(s0, s0, ld, dst, K, tn * 64, tk * 64, mode, (u16*)smem);
    } else if (it < ncvt + 192) {
      mod_item(P, it - ncvt, smem);
    } else {
      misc_item(P);
    }
  }
}

DI void ffn_cvt_item(const Params& P, int l, int it, char* smem) {
  const int e = it / 384;
  int t = it % 384;
  if (t < 256) {
    cvt_tile(P.w1 + ((size_t)l * 16 + e) * 1024 * 512, P.w3 + ((size_t)l * 16 + e) * 1024 * 512, 512, ((u16*)(P.ws + OFF_W13T)) + (size_t)e * 1024 * 1024, 1024, (t >> 4) * 64, (t & 15) * 64, 2, (u16*)smem);
  } else {
    t -= 256;
    const float* s = P.w2 + ((size_t)l * 16 + e) * 512 * 1024;
    cvt_tile(s, s, 1024, ((u16*)(P.ws + OFF_W2T)) + (size_t)e * 1024 * 512, 512, (t >> 3) * 64, (t & 7) * 64, 0, (u16*)smem);
  }
}

DI void load_row_f32(const float* p, int lane, float (&v)[16]) {
#pragma unroll
  for (int k = 0; k < 4; ++k) { float4 t = *(const float4*)(p + lane * 4 + 256 * k); v[4 * k] = t.x; v[4 * k + 1] = t.y; v[4 * k + 2] = t.z; v[4 * k + 3] = t.w; }
}
DI void load_row_bf16(const u16* p, int lane, float (&v)[16]) {
#pragma unroll
  for (int k = 0; k < 4; ++k) { bf16x4 t = *(const bf16x4*)(p + lane * 4 + 256 * k); for (int i = 0; i < 4; ++i) v[4 * k + i] = bf2f((u16)t[i]); }
}
DI void store_row_f32(float* p, int lane, const float (&v)[16]) {
#pragma unroll
  for (int k = 0; k < 4; ++k) *(float4*)(p + lane * 4 + 256 * k) = make_float4(v[4 * k], v[4 * k + 1], v[4 * k + 2], v[4 * k + 3]);
}
DI void store_row_bf16(u16* p, int lane, const float (&v)[16]) {
#pragma unroll
  for (int k = 0; k < 4; ++k) *(bf16x4*)(p + lane * 4 + 256 * k) = pack4(v[4 * k], v[4 * k + 1], v[4 * k + 2], v[4 * k + 3]);
}
DI void ln_row(float (&v)[16], const float* g, const float* b, int lane) {
  float s = 0.f;
#pragma unroll
  for (int i = 0; i < 16; ++i) s += v[i];
  float mu = wave_sum(s) * (1.f / 1024.f);
  float q = 0.f;
#pragma unroll
  for (int i = 0; i < 16; ++i) { float d = v[i] - mu; q += d * d; }
  float rstd = rsqrtf(wave_sum(q) * (1.f / 1024.f) + LN_EPS);
  float gg[16], bb[16];
  load_row_f32(g, lane, gg); load_row_f32(b, lane, bb);
#pragma unroll
  for (int i = 0; i < 16; ++i) v[i] = (v[i] - mu) * rstd * gg[i] + bb[i];
}

DI void phase_h0(const Params& P) {
  const int lane = TID() & 63;
  const int gw = blockIdx.x * 4 + (TID() >> 6), nw = gridDim.x * 4;
  for (int row = gw; row < NTOK; row += nw) {
    int s = row / SP, p = row % SP;
    bool lat = p < SEQ;
    const float* xs = lat ? P.x + ((size_t)s * SEQ + p) * DM : P.ctx + ((size_t)s * CTXL + (p - SEQ)) * DM;
    const float* md = ((float*)(P.ws + OFF_mod)) + (size_t)(lat ? s : 16) * 6144;
    float v[16], sh[16], scl[16];
    load_row_f32(xs, lane, v); load_row_f32(md, lane, sh); load_row_f32(md + 1024, lane, scl);
#pragma unroll
    for (int i = 0; i < 16; ++i) v[i] = v[i] * (1.f + scl[i]) + sh[i];
    store_row_bf16(((u16*)(P.ws + OFF_H)) + (size_t)row * DM, lane, v);
  }
}

DI void compute_x1(const Params& P, int l, int row, int lane, float (&v)[16]) {
  int s = row / SP, p = row % SP;
  bool lat = p < SEQ;
  const float* xs;
  if (l == 0) xs = lat ? P.x + ((size_t)s * SEQ + p) * DM : P.ctx + ((size_t)s * CTXL + (p - SEQ)) * DM;
  else xs = P.out + ((size_t)s * SEQ + p) * DM;
  const float* md = ((float*)(P.ws + OFF_mod)) + ((size_t)l * 17 + (lat ? s : 16)) * 6144;
  float y[16], m2[16];
  load_row_f32(xs, lane, v); load_row_bf16(((u16*)(P.ws + OFF_Y)) + (size_t)row * DM, lane, y); load_row_f32(md + 2 * 1024, lane, m2);
#pragma unroll
  for (int i = 0; i < 16; ++i) v[i] = ALPHA * v[i] + m2[i] * y[i];
  ln_row(v, P.ln1_g + l * 1024, P.ln1_b + l * 1024, lane);
}

DI void phase_ln1(const Params& P, int l, char* smem) {
  const bool last = (l == 1);
  const int lane = TID() & 63;
  const int gw = blockIdx.x * 4 + (TID() >> 6), nw = gridDim.x * 4;
  for (int row = gw; row < NTOK; row += nw) {
    int s = row / SP, p = row % SP;
    bool lat = p < SEQ;
    if (last && !lat) continue;
    float v[16];
    compute_x1(P, l, row, lane, v);
    const float* md = ((float*)(P.ws + OFF_mod)) + ((size_t)l * 17 + (lat ? s : 16)) * 6144;
    float m3[16], m4[16];
    load_row_f32(md + 3 * 1024, lane, m3); load_row_f32(md + 4 * 1024, lane, m4);
#pragma unroll
    for (int i = 0; i < 16; ++i) v[i] = v[i] * (1.f + m4[i]) + m3[i];
    store_row_bf16(((u16*)(P.ws + OFF_H)) + (size_t)row * DM, lane, v);
    float lg[16];
#pragma unroll
    for (int e = 0; e < 16; ++e) lg[e] = 0.f;
    const float* wr = P.w_router + (size_t)l * 1024 * 16;
#pragma unroll
    for (int k = 0; k < 4; ++k)
#pragma unroll
      for (int i = 0; i < 4; ++i) {
        int cidx = lane * 4 + 256 * k + i;
        float hv = v[4 * k + i];
        const float4* w4 = (const float4*)(wr + (size_t)cidx * 16);
#pragma unroll
        for (int e4 = 0; e4 < 4; ++e4) { float4 w = w4[e4]; lg[4 * e4] += hv * w.x; lg[4 * e4 + 1] += hv * w.y; lg[4 * e4 + 2] += hv * w.z; lg[4 * e4 + 3] += hv * w.w; }
      }
#pragma unroll
    for (int e = 0; e < 16; ++e) lg[e] = wave_sum(lg[e]);
    float mx = lg[0];
#pragma unroll
    for (int e = 1; e < 16; ++e) mx = fmaxf(mx, lg[e]);
    float sum = 0.f;
#pragma unroll
    for (int e = 0; e < 16; ++e) { lg[e] = expf(lg[e] - mx); sum += lg[e]; }
    float inv = 1.f / sum;
    if (lane < 16) {
      float mine = 0.f;
#pragma unroll
      for (int e = 0; e < 16; ++e) if (lane == e) mine = lg[e];
      ((float*)(P.ws + OFF_aff))[(size_t)row * 16 + lane] = mine * inv;
    }
  }
  for (int it = blockIdx.x; it < 16 * 384; it += gridDim.x) ffn_cvt_item(P, l, it, smem);
}

DI void phase_topk(const Params& P, int l, char* smem) {
  const bool last = (l == 1);
  const int tid = TID();
  float* vals = (float*)smem;
  const int nitems = last ? 256 : 512;
  for (int it = blockIdx.x; it < nitems; it += gridDim.x) {
    bool isctx = it >= 256;
    int se = it & 255, s = se >> 4, e = se & 15;
    int n = isctx ? CTXL : SEQ, cap = isctx ? 32 : 256;
    int row0 = s * SP + (isctx ? SEQ : 0);
    __syncthreads();
    for (int i = tid; i < n; i += 256) vals[i] = ((float*)(P.ws + OFF_aff))[(size_t)(row0 + i) * 16 + e];
    __syncthreads();
    for (int t = tid; t < n; t += 256) {
      float a = vals[t];
      int rk = 0;
      for (int u = 0; u < n; u += 4) {
        float4 w = *(const float4*)(vals + u);
        rk += (w.x > a || (w.x == a && u < t)) ? 1 : 0;
        rk += (w.y > a || (w.y == a && u + 1 < t)) ? 1 : 0;
        rk += (w.z > a || (w.z == a && u + 2 < t)) ? 1 : 0;
        rk += (w.w > a || (w.w == a && u + 3 < t)) ? 1 : 0;
      }
      ((int*)(P.ws + OFF_rank))[(size_t)(row0 + t) * 16 + e] = rk;
      if (rk < cap) {
        int R = isctx ? NFFN_LAT + (e * 16 + s) * 32 + rk : (s * 16 + e) * 256 + rk;
        ((int*)(P.ws + OFF_tokidx))[R] = row0 + t;
        ((float*)(P.ws + OFF_gatev))[R] = a;
      }
    }
  }
}

DI void phase_ln2(const Params& P, int l) {
  const bool last = (l == 1);
  const int lane = TID() & 63;
  const int gw = blockIdx.x * 4 + (TID() >> 6), nw = gridDim.x * 4;
  for (int row = gw; row < NTOK; row += nw) {
    int s = row / SP, p = row % SP;
    bool lat = p < SEQ;
    if (last && !lat) continue;
    float v[16];
    compute_x1(P, l, row, lane, v);
    float yf[16];
#pragma unroll
    for (int i = 0; i < 16; ++i) yf[i] = 0.f;
    const int cap = lat ? 256 : 32;
    for (int e = 0; e < 16; ++e) {
      int rk = ((int*)(P.ws + OFF_rank))[(size_t)row * 16 + e];
      if (rk < cap) {
        int R = lat ? (s * 16 + e) * 256 + rk : NFFN_LAT + (e * 16 + s) * 32 + rk;
        float t[16];
        load_row_bf16(((u16*)(P.ws + OFF_ye)) + (size_t)R * DM, lane, t);
#pragma unroll
        for (int i = 0; i < 16; ++i) yf[i] += t[i];
      }
    }
    const float* md = ((float*)(P.ws + OFF_mod)) + ((size_t)l * 17 + (lat ? s : 16)) * 6144;
    float m5[16];
    load_row_f32(md + 5 * 1024, lane, m5);
#pragma unroll
    for (int i = 0; i < 16; ++i) v[i] = ALPHA * v[i] + m5[i] * yf[i];
    ln_row(v, P.ln2_g + l * 1024, P.ln2_b + l * 1024, lane);
    if (lat) store_row_f32(P.out + ((size_t)s * SEQ + p) * DM, lane, v);
    if (!last) {
      const float* md2 = ((float*)(P.ws + OFF_mod)) + ((size_t)(l + 1) * 17 + (lat ? s : 16)) * 6144;
      float sh[16], scl[16];
      load_row_f32(md2, lane, sh); load_row_f32(md2 + 1024, lane, scl);
#pragma unroll
      for (int i = 0; i < 16; ++i) v[i] = v[i] * (1.f + scl[i]) + sh[i];
      store_row_bf16(((u16*)(P.ws + OFF_H)) + (size_t)row * DM, lane, v);
    }
  }
}

template <bool SWAP>
DI void proj_tile(const Params& P, int l, int hb, int mt, int nt, char* smem) {
  const int tid = TID(), wave = tid >> 6, lane = tid & 63, fr = lane & 15, fq = lane >> 4;
  const int wr = wave >> 1, wc = wave & 1;
  const int hrow0 = mt * 128, grow0 = hb * HROWS + hrow0;
  f32x4 acc[4][4];
  zero_acc<4>(acc);
  gemm_main<4, SWAP, false>(((u16*)(P.ws + OFF_H)), DM, nullptr, grow0, ((u16*)(P.ws + OFF_WinT)) + (size_t)l * INP * 1024, 1024, nt * 128, 1024, acc, (u16*)smem);
  const int jp = mt % 18;
  const int bl = mt / 18;
  const bool lat = jp < 16;
  if (SWAP) {
    u16* dst; int ldd, c0;
    if (nt < 4) { dst = ((u16*)(P.ws + OFF_xp)); ldd = 512; c0 = nt * 128; }
    else if (nt < 8) { dst = ((u16*)(P.ws + OFF_z)); ldd = 512; c0 = (nt - 4) * 128; }
    else if (nt < 14) { dst = ((u16*)(P.ws + OFF_xbc)); ldd = 768; c0 = (nt - 8) * 128; }
    else if (nt < 18) { dst = ((u16*)(P.ws + OFF_q)); ldd = 512; c0 = (nt - 14) * 128; }
    else if (nt < 22) { dst = ((u16*)(P.ws + OFF_k)); ldd = 512; c0 = (nt - 18) * 128; }
    else { dst = ((u16*)(P.ws + OFF_br3)); ldd = 512; c0 = (nt - 26) * 128; }
    const bool isu = nt >= 26;
    const bool rope = (nt >= 14 && nt < 22) && lat;
#pragma unroll
    for (int m = 0; m < 4; ++m) {
      int r = wr * 64 + m * 16 + fr;
      size_t orow = isu ? (size_t)(grow0 + r) : (size_t)(hrow0 + r);
      if (rope) {
        int t = jp * 128 + r;
        int prow = t >> 6, pcol = t & 63;
#pragma unroll
        for (int j = 0; j < 4; ++j) {
          int f = fq * 4 + j;
          float c1 = ((float*)(P.ws + OFF_rope))[(prow * 16 + f) * 2], s1 = ((float*)(P.ws + OFF_rope))[(prow * 16 + f) * 2 + 1];
          float c2 = ((float*)(P.ws + OFF_rope))[(pcol * 16 + f) * 2], s2 = ((float*)(P.ws + OFF_rope))[(pcol * 16 + f) * 2 + 1];
          float a = acc[m][0][j], b = acc[m][1][j];
          acc[m][0][j] = a * c1 - b * s1; acc[m][1][j] = a * s1 + b * c1;
          a = acc[m][2][j]; b = acc[m][3][j];
          acc[m][2][j] = a * c2 - b * s2; acc[m][3][j] = a * s2 + b * c2;
        }
      }
#pragma unroll
      for (int n = 0; n < 4; ++n) {
        f32x4 v = acc[m][n];
        if (isu) { v[0] = geluf_(v[0]); v[1] = geluf_(v[1]); v[2] = geluf_(v[2]); v[3] = geluf_(v[3]); }
        int col = c0 + wc * 64 + n * 16 + fq * 4;
        *(bf16x4*)(dst + orow * ldd + col) = pack4v(v);
      }
    }
  } else {
    if (nt == 34) {
      if (wc == 0) {
#pragma unroll
        for (int m = 0; m < 4; ++m)
#pragma unroll
          for (int j = 0; j < 4; ++j) ((float*)(P.ws + OFF_dtbuf))[(size_t)(hrow0 + wr * 64 + m * 16 + fq * 4 + j) * 16 + fr] = acc[m][0][j];
      }
    } else if (nt < 26) {
      int cb = (nt - 22) * 128 + wc * 64;
#pragma unroll
      for (int m = 0; m < 4; ++m)
#pragma unroll
        for (int n = 0; n < 4; ++n) {
          int c = cb + n * 16 + fr;
          int pos = jp * 128 + wr * 64 + m * 16 + fq * 4;
          *(bf16x4*)(((u16*)(P.ws + OFF_vT)) + ((size_t)bl * 512 + c) * SP + pos) = pack4v(acc[m][n]);
        }
    } else {
      int cb = (nt - 30) * 128 + wc * 64;
#pragma unroll
      for (int m = 0; m < 4; ++m)
#pragma unroll
        for (int n = 0; n < 4; ++n) {
          int c = cb + n * 16 + fr;
          int i0 = wr * 64 + m * 16 + fq * 4;
          f32x4 v = acc[m][n];
          *(bf16x4*)(((u16*)(P.ws + OFF_gvT)) + ((size_t)mt * 512 + c) * 128 + i0) = pack4(geluf_(v[0]), geluf_(v[1]), geluf_(v[2]), geluf_(v[3]));
        }
    }
  }
}

DI void phase_proj(const Params& P, int l, int hb, char* smem) {
  const bool last = (l == 1);
  for (int it = blockIdx.x; it < 144 * 35; it += gridDim.x) {
    int mt = it / 35, nt = it % 35;
    bool isctx = (mt % 18) >= 16;
    if (last && isctx) {
      bool need = (nt >= 8 && nt < 14) || (nt >= 18 && nt < 26) || nt == 34;
      if (!need) continue;
    }
    bool transposed = (nt >= 22 && nt < 26) || nt >= 30;
    if (transposed) proj_tile<false>(P, l, hb, mt, nt, smem);
    else proj_tile<true>(P, l, hb, mt, nt, smem);
  }
}

constexpr int LDK = 136;
DI void pool_item(const Params& P, int l, int hb, int mt, int g, char* smem) {
  const int tid = TID(), wave = tid >> 6, lane = tid & 63, fr = lane & 15, fq = lane >> 4;
  const int wr = wave >> 1, wc = wave & 1;
  u16* As = (u16*)smem;
  u16* Bs = As + 128 * LDK;
  const int jp = mt % 18, bl = mt / 18;
  const bool lat = jp < 16;
  const int n = lat ? SEQ : CTXL;
  const int p0 = lat ? jp * 128 : (jp - 16) * 128;
  const int seqbase = bl * SP + (lat ? 0 : SEQ);
  const int half = 1 << g;
  __syncthreads();
  {
    const int cch = tid & 15;
    const u16* src = ((u16*)(P.ws + OFF_xp)) + (size_t)seqbase * 512 + g * 128 + cch * 8;
    for (int ii = 0; ii < 8; ++ii) {
      int i = (tid >> 4) + 16 * ii;
      int p = p0 + i;
      int lo = max(p - half, 0), hi = min(p + half, n);
      float s[8];
#pragma unroll
      for (int e = 0; e < 8; ++e) s[e] = 0.f;
      for (int r = lo; r < hi; ++r) {
        bf16x8 t = *(const bf16x8*)(src + (size_t)r * 512);
#pragma unroll
        for (int e = 0; e < 8; ++e) s[e] += bf2f((u16)t[e]);
      }
      bf16x8 self = *(const bf16x8*)(src + (size_t)p * 512);
      float inv = 1.f / (float)(hi - lo);
      bf16x8 o;
#pragma unroll
      for (int e = 0; e < 8; ++e) o[e] = (short)f2bf(s[e] * inv - bf2f((u16)self[e]));
      *(bf16x8*)(As + i * LDK + cch * 8) = o;
    }
    const u16* wsrc = ((u16*)(P.ws + OFF_poolT)) + ((size_t)l * 4 + g) * 128 * 128;
    for (int cid = tid; cid < 2048; cid += 256) {
      int r = cid >> 4, c8 = (cid & 15) * 8;
      *(u32x4*)(Bs + r * LDK + c8) = *(const u32x4*)(wsrc + r * 128 + c8);
    }
  }
  __syncthreads();
  f32x4 acc[4][4];
  zero_acc<4>(acc);
  mma_lds<4, 4, true>(As + wr * 64 * LDK, LDK, Bs + wc * 64 * LDK, LDK, 4, acc, fr, fq);
  const float* psc = P.pool_scale + l * 512 + g * 128;
#pragma unroll
  for (int m = 0; m < 4; ++m)
#pragma unroll
    for (int nn = 0; nn < 4; ++nn) {
      int r = wr * 64 + m * 16 + fr, c = wc * 64 + nn * 16 + fq * 4;
      float4 sc = *(const float4*)(psc + c);
      f32x4 v = acc[m][nn];
      *(bf16x4*)(((u16*)(P.ws + OFF_br0)) + (size_t)(hb * HROWS + mt * 128 + r) * 512 + g * 128 + c) = pack4(v[0] * sc.x, v[1] * sc.y, v[2] * sc.z, v[3] * sc.w);
    }
}

DI void sgu_item(const Params& P, int l, int hb, int mt, char* smem) {
  const int tid = TID(), wave = tid >> 6, lane = tid & 63, fr = lane & 15, fq = lane >> 4;
  const int wr = wave >> 1, wc = wave & 1;
  u16* As = (u16*)smem;
  u16* Bs = As + 128 * LDK;
  float* st = (float*)(Bs + 128 * LDK);
  const u16* gv = ((u16*)(P.ws + OFF_gvT)) + (size_t)mt * 512 * 128;
  __syncthreads();
  {
    int i = tid & 127, part = tid >> 7;
    float s = 0.f;
    for (int c = part * 256; c < part * 256 + 256; ++c) s += bf2f(gv[c * 128 + i]);
    st[part * 128 + i] = s;
    __syncthreads();
    float mu = (st[i] + st[128 + i]) * (1.f / 512.f);
    __syncthreads();
    float qv = 0.f;
    for (int c = part * 256; c < part * 256 + 256; ++c) { float d = bf2f(gv[c * 128 + i]) - mu; qv += d * d; }
    st[part * 128 + i] = qv;
    __syncthreads();
    float var = (st[i] + st[128 + i]) * (1.f / 512.f);
    __syncthreads();
    if (part == 0) { st[256 + i] = mu; st[384 + i] = rsqrtf(var + LN_EPS); }
  }
  const float* mu = st + 256;
  const float* rs = st + 384;
  for (int g = 0; g < 4; ++g) {
    __syncthreads();
    const u16* wsrc = ((u16*)(P.ws + OFF_sguW)) + ((size_t)l * 4 + g) * 128 * 128;
    for (int cid = tid; cid < 2048; cid += 256) {
      int r = cid >> 4, c8 = (cid & 15) * 8;
      *(u32x4*)(As + r * LDK + c8) = *(const u32x4*)(wsrc + r * 128 + c8);
      bf16x8 t = *(const bf16x8*)(gv + (size_t)(g * 128 + r) * 128 + c8);
      float lg = P.sgu_ln_g[l * 512 + g * 128 + r], lb = P.sgu_ln_b[l * 512 + g * 128 + r];
      bf16x8 o;
#pragma unroll
      for (int e = 0; e < 8; ++e) o[e] = (short)f2bf((bf2f((u16)t[e]) - mu[c8 + e]) * rs[c8 + e] * lg + lb);
      *(bf16x8*)(Bs + r * LDK + c8) = o;
    }
    __syncthreads();
    f32x4 acc[4][4];
    zero_acc<4>(acc);
    mma_lds<4, 4, true>(As + wr * 64 * LDK, LDK, Bs + wc * 64 * LDK, LDK, 4, acc, fr, fq);
    const float* bs = P.sgu_b + ((size_t)l * 4 + g) * 128;
#pragma unroll
    for (int m = 0; m < 4; ++m) {
      int pp = wr * 64 + m * 16 + fr;
      float bias = bs[pp];
#pragma unroll
      for (int nn = 0; nn < 4; ++nn) {
        int d = wc * 64 + nn * 16 + fq * 4;
        u16* up = ((u16*)(P.ws + OFF_br3)) + (size_t)(hb * HROWS + mt * 128 + pp) * 512 + g * 128 + d;
        bf16x4 uu = *(const bf16x4*)up;
        f32x4 v = acc[m][nn];
        *(bf16x4*)up = pack4((v[0] + bias) * bf2f((u16)uu[0]), (v[1] + bias) * bf2f((u16)uu[1]), (v[2] + bias) * bf2f((u16)uu[2]), (v[3] + bias) * bf2f((u16)uu[3]));
      }
    }
  }
}

DI void attn_item(const Params& P, int l, int hb, int item, char* smem) {
  const int tid = TID(), wave = tid >> 6, lane = tid & 63, fr = lane & 15, fq = lane >> 4;
  const int qt = item % 18, h = (item / 18) & 3, bl = item / 72;
  const bool ctxq = qt >= 16;
  const int key0 = ctxq ? SEQ : 0, nkt = ctxq ? 4 : 36;
  const int hrow_q0 = bl * SP + qt * 128 + wave * 32;
  constexpr int KT = 64 * LDT, VT = 128 * LDT;
  u16* Ks = (u16*)smem;
  u16* Vs = Ks + 2 * KT;
  const float lam = ((float*)(P.ws + OFF_lamv))[l * 2], lam_init = ((float*)(P.ws + OFF_lamv))[l * 2 + 1];
  constexpr float LOG2E = 1.4426950408889634f;
  for (int sub = 0; sub < 2; ++sub) {
    const int hs = 2 * h + sub;
    bf16x8 qf[2][2];
#pragma unroll
    for (int qb = 0; qb < 2; ++qb)
#pragma unroll
      for (int ks = 0; ks < 2; ++ks) qf[qb][ks] = *(const bf16x8*)(((u16*)(P.ws + OFF_q)) + (size_t)(hrow_q0 + qb * 16 + fr) * 512 + hs * 64 + ks * 32 + fq * 8);
    f32x4 ot[8][2];
#pragma unroll
    for (int d = 0; d < 8; ++d) { ot[d][0] = f32x4{0.f, 0.f, 0.f, 0.f}; ot[d][1] = f32x4{0.f, 0.f, 0.f, 0.f}; }
    float mrow[2] = {-INFINITY, -INFINITY}, lrow[2] = {0.f, 0.f};
    const u16* Kg = ((u16*)(P.ws + OFF_k)) + ((size_t)bl * SP + key0) * 512 + hs * 64;
    const u16* Vg = ((u16*)(P.ws + OFF_vT)) + ((size_t)bl * 512 + h * 128) * SP + key0;
    u32x4 rk[2], rv[4];
    const u16* kgp = Kg + (size_t)(tid >> 2) * 512 + (tid & 3) * 16;
    const u16* vgp = Vg + (size_t)(tid >> 1) * SP + (tid & 1) * 32;
    u16* ksp = Ks + (tid >> 2) * LDT + (tid & 3) * 16;
    u16* vsp = Vs + (tid >> 1) * LDT + (tid & 1) * 32;
    auto gload = [&](int t) {
      const u16* kp = kgp + (size_t)t * 64 * 512;
      rk[0] = *(const u32x4*)(kp); rk[1] = *(const u32x4*)(kp + 8);
      const u16* vp = vgp + t * 64;
      rv[0] = *(const u32x4*)(vp); rv[1] = *(const u32x4*)(vp + 8); rv[2] = *(const u32x4*)(vp + 16); rv[3] = *(const u32x4*)(vp + 24);
    };
    auto sstore = [&](int buf) {
      u16* kp = ksp + buf * KT;
      *(u32x4*)(kp) = rk[0]; *(u32x4*)(kp + 8) = rk[1];
      u16* vp = vsp + buf * VT;
      *(u32x4*)(vp) = rv[0]; *(u32x4*)(vp + 8) = rv[1]; *(u32x4*)(vp + 16) = rv[2]; *(u32x4*)(vp + 24) = rv[3];
    };
    gload(0);
    __syncthreads();
    sstore(0);
    __syncthreads();
    for (int t = 0; t < nkt; ++t) {
      const int cur = t & 1;
      if (t + 1 < nkt) gload(t + 1);
      const u16* Kc = Ks + cur * KT;
      const u16* Vc = Vs + cur * VT;
      f32x4 st[4][2];
#pragma unroll
      for (int k4 = 0; k4 < 4; ++k4) { st[k4][0] = f32x4{0.f, 0.f, 0.f, 0.f}; st[k4][1] = f32x4{0.f, 0.f, 0.f, 0.f}; }
#pragma unroll
      for (int k4 = 0; k4 < 4; ++k4)
#pragma unroll
        for (int ks = 0; ks < 2; ++ks) {
          bf16x8 a = *(const bf16x8*)(Kc + (k4 * 16 + fr) * LDT + ks * 32 + fq * 8);
          st[k4][0] = MFMA16(a, qf[0][ks], st[k4][0]);
          st[k4][1] = MFMA16(a, qf[1][ks], st[k4][1]);
          if (ks == 1 && (k4 & 1)) __builtin_amdgcn_sched_barrier(0);
        }
      __builtin_amdgcn_sched_barrier(0);
#pragma unroll
      for (int qb = 0; qb < 2; ++qb) {
        float mx = -INFINITY;
#pragma unroll
        for (int k4 = 0; k4 < 4; ++k4)
#pragma unroll
          for (int j = 0; j < 4; ++j) mx = fmaxf(mx, st[k4][qb][j]);
        mx = fmaxf(mx, __shfl_xor(mx, 16));
        mx = fmaxf(mx, __shfl_xor(mx, 32));
        float mnew = fmaxf(mrow[qb], mx);
        float alpha = __builtin_amdgcn_exp2f((mrow[qb] - mnew) * LOG2E);
        mrow[qb] = mnew;
        float moff = mnew * LOG2E;
        float ps = 0.f;
#pragma unroll
        for (int k4 = 0; k4 < 4; ++k4)
#pragma unroll
          for (int j = 0; j < 4; ++j) { float pv = __builtin_amdgcn_exp2f(st[k4][qb][j] * LOG2E - moff); st[k4][qb][j] = pv; ps += pv; }
        lrow[qb] = lrow[qb] * alpha + ps;
#pragma unroll
        for (int d = 0; d < 8; ++d) { ot[d][qb][0] *= alpha; ot[d][qb][1] *= alpha; ot[d][qb][2] *= alpha; ot[d][qb][3] *= alpha; }
      }
      __builtin_amdgcn_sched_barrier(0);
#pragma unroll
      for (int ks2 = 0; ks2 < 2; ++ks2) {
        bf16x8 pf[2];
#pragma unroll
        for (int qb = 0; qb < 2; ++qb) {
          bf16x4 lo = pack4v(st[2 * ks2][qb]), hi = pack4v(st[2 * ks2 + 1][qb]);
          pf[qb] = __builtin_shufflevector(lo, hi, 0, 1, 2, 3, 4, 5, 6, 7);
        }
#pragma unroll
        for (int d = 0; d < 8; ++d) {
          const u16* vp = Vc + (d * 16 + fr) * LDT + ks2 * 32 + fq * 4;
          bf16x4 lo = *(const bf16x4*)vp, hi = *(const bf16x4*)(vp + 16);
          bf16x8 a = __builtin_shufflevector(lo, hi, 0, 1, 2, 3, 4, 5, 6, 7);
          ot[d][0] = MFMA16(a, pf[0], ot[d][0]);
          ot[d][1] = MFMA16(a, pf[1], ot[d][1]);
          if ((d & 3) == 3) __builtin_amdgcn_sched_barrier(0);
        }
      }
      if (t + 1 < nkt) sstore(cur ^ 1);
      __syncthreads();
    }
#pragma unroll
    for (int qb = 0; qb < 2; ++qb) {
      float lt = lrow[qb];
      lt += __shfl_xor(lt, 16);
      lt += __shfl_xor(lt, 32);
      float inv = 1.f / lt;
      size_t hrow = (size_t)(hrow_q0 + qb * 16 + fr);
      if (sub == 0) {
#pragma unroll
        for (int d = 0; d < 8; ++d) {
          f32x4 v = ot[d][qb];
          *(bf16x4*)(((u16*)(P.ws + OFF_o1)) + hrow * 512 + h * 128 + d * 16 + fq * 4) = pack4(v[0] * inv, v[1] * inv, v[2] * inv, v[3] * inv);
        }
      } else {
        float ss = 0.f;
#pragma unroll
        for (int d = 0; d < 8; ++d) {
          bf16x4 o1v = *(const bf16x4*)(((u16*)(P.ws + OFF_o1)) + hrow * 512 + h * 128 + d * 16 + fq * 4);
#pragma unroll
          for (int j = 0; j < 4; ++j) { float dd = bf2f((u16)o1v[j]) - lam * ot[d][qb][j] * inv; ot[d][qb][j] = dd; ss += dd * dd; }
        }
        ss += __shfl_xor(ss, 16);
        ss += __shfl_xor(ss, 32);
        float rr = rsqrtf(ss * (1.f / 128.f) + LN_EPS) * (1.f - lam_init);
        const float* gn = P.diff_norm_g + l * 128;
#pragma unroll
        for (int d = 0; d < 8; ++d) {
          int dv = d * 16 + fq * 4;
          float4 g4 = *(const float4*)(gn + dv);
          f32x4 v = ot[d][qb];
          *(bf16x4*)(((u16*)(P.ws + OFF_br2)) + ((size_t)hb * HROWS + hrow) * 512 + h * 128 + dv) = pack4(v[0] * rr * g4.x, v[1] * rr * g4.y, v[2] * rr * g4.z, v[3] * rr * g4.w);
        }
      }
    }
  }
}

template <bool TRANS>
DI void conv_stage(const Params& P, int l, const u16* xbase  , int chan0, int n, int p0, u16* dst, int ld, const float* scale) {
  const int tid = TID(), cl = tid & 63, ig = tid >> 6;
  const int ch = chan0 + cl;
  const float* cw = P.conv_w + (size_t)l * 5 * 768 + ch;
  const float w0 = cw[0], w1 = cw[768], w2 = cw[2 * 768], w3 = cw[3 * 768], w4 = cw[4 * 768];
  const float cb = P.conv_b[l * 768 + ch];
  const u16* xc = xbase + ch;
  auto ld1 = [&](int pos) -> float { return (pos >= 0 && pos < n) ? bf2f(xc[(size_t)pos * 768]) : 0.f; };
  int pos = p0 + ig * 32;
  float a = ld1(pos - 2), b = ld1(pos - 1), c = ld1(pos), d = ld1(pos + 1), e = ld1(pos + 2);
  for (int ii = 0; ii < 32; ++ii) {
    float v = w0 * a + w1 * b + w2 * c + w3 * d + w4 * e + cb;
    v = siluf_(v);
    int tok = ig * 32 + ii;
    if (scale) v *= scale[tok];
    if (TRANS) dst[cl * ld + tok] = f2bf(v); else dst[tok * ld + cl] = f2bf(v);
    a = b; b = c; c = d; d = e; e = ld1(pos + ii + 3);
  }
}

DI void ssd_scalars(const Params& P, int l, int hrow0, int h, int dir, float* dts, float* S, float* tmp) {
  const int tid = TID();
  const float aneg = -expf(P.a_log[l * 16 + dir * 8 + h]);
  if (tid < 128) {
    float raw = ((float*)(P.ws + OFF_dtbuf))[(size_t)(hrow0 + tid) * 16 + dir * 8 + h] + P.dt_bias[l * 16 + dir * 8 + h];
    float dt = softplusf_(raw);
    dts[tid] = dt;
    tmp[tid] = dt * aneg;
  }
  __syncthreads();
  if (tid < 128) {
    float s = 0.f;
    if (dir == 0) { for (int i = 0; i <= tid; ++i) s += tmp[i]; }
    else { for (int i = 127; i >= tid; --i) s += tmp[i]; }
    S[tid] = s;
  }
  __syncthreads();
}

constexpr int SSD_STATE_STRIDE = 18 * 4096;
DI void ssd_state_item(const Params& P, int l, int hb, int item, char* smem) {
  const int tid = TID(), wave = tid >> 6, lane = tid & 63, fr = lane & 15, fq = lane >> 4;
  const int dir = item & 1, h = (item >> 1) & 7, jp = (item >> 4) % 18, bl = (item >> 4) / 18;
  const bool lat = jp < 16;
  const int n = lat ? SEQ : CTXL;
  const int p0 = lat ? jp * 128 : (jp - 16) * 128;
  const int seqbase = bl * SP + (lat ? 0 : SEQ);
  const int hrow0 = bl * SP + jp * 128;
  u16* At = (u16*)smem;
  u16* Bt = At + 64 * LDK;
  float* dts = (float*)(Bt + 64 * LDK);
  float* S = dts + 128;
  float* wgt = S + 128;
  __syncthreads();
  ssd_scalars(P, l, hrow0, h, dir, dts, S, wgt);
  const float total = (dir == 0) ? S[127] : S[0];
  __syncthreads();
  if (tid < 128) wgt[tid] = dts[tid] * __expf(total - S[tid]);
  __syncthreads();
  const u16* xb = ((u16*)(P.ws + OFF_xbc)) + (size_t)seqbase * 768;
  conv_stage<true>(P, l, xb, h * 64, n, p0, At, LDK, wgt);
  conv_stage<true>(P, l, xb, 512 + (h >> 2) * 64, n, p0, Bt, LDK, nullptr);
  __syncthreads();
  const int wr = wave >> 1, wc = wave & 1;
  f32x4 acc[2][2];
#pragma unroll
  for (int m = 0; m < 2; ++m) { acc[m][0] = f32x4{0.f, 0.f, 0.f, 0.f}; acc[m][1] = f32x4{0.f, 0.f, 0.f, 0.f}; }
  mma_lds<2, 2, false>(At + wr * 32 * LDK, LDK, Bt + wc * 32 * LDK, LDK, 4, acc, fr, fq);
  float* cs = ((float*)(P.ws + OFF_cstate)) + (((size_t)(bl * 2 + dir) * 8 + h) * 18 + jp) * 4096;
#pragma unroll
  for (int m = 0; m < 2; ++m)
#pragma unroll
    for (int nn = 0; nn < 2; ++nn)
#pragma unroll
      for (int j = 0; j < 4; ++j) cs[(wr * 32 + m * 16 + fq * 4 + j) * 64 + wc * 32 + nn * 16 + fr] = acc[m][nn][j];
  if (tid == 0) ((float*)(P.ws + OFF_decay))[((bl * 2 + dir) * 8 + h) * 18 + jp] = __expf(total);
}

DI void phase_carry(const Params& P) {
  const int total = 8 * 2 * 8 * 4096;
  for (int idx = blockIdx.x * 256 + TID(); idx < total; idx += gridDim.x * 256) {
    int pn = idx & 4095, bdh = idx >> 12;
    int dir = (bdh >> 3) & 1;
    const float* cs = ((float*)(P.ws + OFF_cstate)) + (size_t)bdh * SSD_STATE_STRIDE + pn;
    u16* en = ((u16*)(P.ws + OFF_enter)) + (size_t)bdh * SSD_STATE_STRIDE + pn;
    const float* dc = ((float*)(P.ws + OFF_decay)) + bdh * 18;
    float state = 0.f;
    for (int st = 0; st < 18; ++st) {
      int jp;
      if (dir == 0) jp = st < 2 ? 16 + st : st - 2;
      else jp = st < 2 ? 17 - st : 17 - st;
      en[(size_t)jp * 4096] = f2bf(state);
      state = state * dc[jp] + cs[(size_t)jp * 4096];
    }
  }
}

DI void ssd_out_item(const Params& P, int l, int hb, int item, char* smem) {
  const int tid = TID(), wave = tid >> 6, lane = tid & 63, fr = lane & 15, fq = lane >> 4;
  const int h = item & 7, jp = (item >> 3) % 18, bl = (item >> 3) / 18;
  const bool lat = jp < 16;
  const int n = lat ? SEQ : CTXL;
  const int p0 = lat ? jp * 128 : (jp - 16) * 128;
  const int seqbase = bl * SP + (lat ? 0 : SEQ);
  const int hrow0 = bl * SP + jp * 128;
  u16* Cs = (u16*)smem;
  u16* xT = Cs + 128 * LDT;
  u16* Et = xT + 64 * LDK;
  u16* Un = Et + 64 * LDT;
  float* fs = (float*)(Un + 128 * LDK);
  float* dts = fs;
  float* S = fs + 128;
  float* tmp = fs + 256;
  const int grp = h >> 2;
  __syncthreads();
  const u16* xb = ((u16*)(P.ws + OFF_xbc)) + (size_t)seqbase * 768;
  conv_stage<false>(P, l, xb, 640 + grp * 64, n, p0, Cs, LDT, nullptr);
  conv_stage<false>(P, l, xb, 512 + grp * 64, n, p0, Un, LDT, nullptr);
  conv_stage<true>(P, l, xb, h * 64, n, p0, xT, LDK, nullptr);
  __syncthreads();
  f32x4 cb[2][8];
#pragma unroll
  for (int m = 0; m < 2; ++m)
#pragma unroll
    for (int nn = 0; nn < 8; ++nn) cb[m][nn] = f32x4{0.f, 0.f, 0.f, 0.f};
  mma_lds<2, 8, false>(Cs + wave * 32 * LDT, LDT, Un, LDT, 2, cb, fr, fq);
  f32x4 yacc[2][4];
#pragma unroll
  for (int m = 0; m < 2; ++m)
#pragma unroll
    for (int nn = 0; nn < 4; ++nn) yacc[m][nn] = f32x4{0.f, 0.f, 0.f, 0.f};
  for (int dir = 0; dir < 2; ++dir) {
    __syncthreads();
    ssd_scalars(P, l, hrow0, h, dir, dts, S, tmp);
#pragma unroll
    for (int m = 0; m < 2; ++m)
#pragma unroll
      for (int j = 0; j < 4; ++j) {
        int lrow = wave * 32 + m * 16 + fq * 4 + j;
        float Sl = S[lrow];
#pragma unroll
        for (int nn = 0; nn < 8; ++nn) {
          int s = nn * 16 + fr;
          bool ok = dir == 0 ? (s <= lrow) : (s >= lrow);
          float coef = ok ? __expf(Sl - S[s]) * dts[s] : 0.f;
          Un[lrow * LDK + s] = f2bf(cb[m][nn][j] * coef);
        }
      }
    {
      const u16* en = ((u16*)(P.ws + OFF_enter)) + (((size_t)(bl * 2 + dir) * 8 + h) * 18 + jp) * 4096;
      for (int cid = tid; cid < 512; cid += 256) {
        int pr = cid >> 3, c8 = (cid & 7) * 8;
        *(u32x4*)(Et + pr * LDT + c8) = *(const u32x4*)(en + pr * 64 + c8);
      }
    }
    __syncthreads();
    mma_lds<2, 4, true>(Un + wave * 32 * LDK, LDK, xT, LDK, 4, yacc, fr, fq);
    f32x4 yi[2][4];
#pragma unroll
    for (int m = 0; m < 2; ++m)
#pragma unroll
      for (int nn = 0; nn < 4; ++nn) yi[m][nn] = f32x4{0.f, 0.f, 0.f, 0.f};
    mma_lds<2, 4, true>(Cs + wave * 32 * LDT, LDT, Et, LDT, 2, yi, fr, fq);
#pragma unroll
    for (int m = 0; m < 2; ++m) {
      float e = __expf(S[wave * 32 + m * 16 + fr]);
#pragma unroll
      for (int nn = 0; nn < 4; ++nn)
#pragma unroll
        for (int j = 0; j < 4; ++j) yacc[m][nn][j] += e * yi[m][nn][j];
    }
  }
  const float dsk = P.ssd_d[l * 8 + h];
  const float* gn = P.ssd_norm_g + l * 512 + h * 64;
#pragma unroll
  for (int m = 0; m < 2; ++m) {
    int lrow = wave * 32 + m * 16 + fr;
    float ss = 0.f;
#pragma unroll
    for (int nn = 0; nn < 4; ++nn) {
      int pc = nn * 16 + fq * 4;
      bf16x4 zz = *(const bf16x4*)(((u16*)(P.ws + OFF_z)) + (size_t)(hrow0 + lrow) * 512 + h * 64 + pc);
      float4 g4 = *(const float4*)(gn + pc);
      float gg[4] = {g4.x, g4.y, g4.z, g4.w};
      float o[4];
#pragma unroll
      for (int j = 0; j < 4; ++j) {
        float y = yacc[m][nn][j] + dsk * bf2f(xT[(pc + j) * LDK + lrow]);
        y *= siluf_(bf2f((u16)zz[j]));
        ss += y * y;
        o[j] = y * gg[j];
      }
      *(bf16x4*)(((u16*)(P.ws + OFF_br1)) + ((size_t)hb * HROWS + hrow0 + lrow) * 512 + h * 64 + pc) = pack4(o[0], o[1], o[2], o[3]);
    }
    ss += __shfl_xor(ss, 16);
    ss += __shfl_xor(ss, 32);
    if (fq == 0) ((float*)(P.ws + OFF_ssq))[((size_t)hb * HROWS + hrow0 + lrow) * 8 + h] = ss;
  }
}

DI void merge_tile(const Params& P, int l, int mt, int nt, char* smem) {
  const int tid = TID(), wave = tid >> 6, lane = tid & 63, fr = lane & 15, fq = lane >> 4;
  const int wr = wave >> 1, wc = wave & 1;
  const int row0 = mt * 128;
  f32x4 accS[4][2];
  zero_acc<2>(accS);
  const u16* brs[4] = {((u16*)(P.ws + OFF_br0)), ((u16*)(P.ws + OFF_br1)), ((u16*)(P.ws + OFF_br2)), ((u16*)(P.ws + OFF_br3))};
#pragma unroll 1
  for (int kq = 0; kq < 4; ++kq) {
    f32x4 g[4][2];
    zero_acc<2>(g);
    gemm_main<2, true, false>(((u16*)(P.ws + OFF_H)), DM, nullptr, row0, ((u16*)(P.ws + OFF_WgT)) + ((size_t)l * 4 + kq) * 1024 * 1024, 1024, nt * 64, 1024, g, (u16*)smem);
#pragma unroll
    for (int m = 0; m < 4; ++m)
#pragma unroll
      for (int n = 0; n < 2; ++n)
#pragma unroll
        for (int j = 0; j < 4; ++j) g[m][n][j] = sigmoidf_(g[m][n][j]);
    f32x4 bb[4][2];
    zero_acc<2>(bb);
    const u16* br = kq == 0 ? ((u16*)(P.ws + OFF_br0)) : (kq == 1 ? ((u16*)(P.ws + OFF_br1)) : (kq == 2 ? ((u16*)(P.ws + OFF_br2)) : ((u16*)(P.ws + OFF_br3))));
    gemm_main<2, true, false>(br, 512, nullptr, row0, ((u16*)(P.ws + OFF_WbT)) + ((size_t)l * 4 + kq) * 1024 * 512, 512, nt * 64, 512, bb, (u16*)smem);
#pragma unroll
    for (int m = 0; m < 4; ++m) {
      float rs = 1.f;
      if (kq == 1) {
        const float* sq = ((float*)(P.ws + OFF_ssq)) + (size_t)(row0 + wr * 64 + m * 16 + fr) * 8;
        float4 a = *(const float4*)sq, b = *(const float4*)(sq + 4);
        rs = rsqrtf((a.x + a.y + a.z + a.w + b.x + b.y + b.z + b.w) * (1.f / 512.f) + LN_EPS);
      }
#pragma unroll
      for (int n = 0; n < 2; ++n)
#pragma unroll
        for (int j = 0; j < 4; ++j) accS[m][n][j] += g[m][n][j] * bb[m][n][j] * rs;
    }
  }
  (void)brs;
#pragma unroll
  for (int m = 0; m < 4; ++m)
#pragma unroll
    for (int n = 0; n < 2; ++n) {
      int r = row0 + wr * 64 + m * 16 + fr, c = nt * 64 + wc * 32 + n * 16 + fq * 4;
      *(bf16x4*)(((u16*)(P.ws + OFF_acc)) + (size_t)r * DM + c) = pack4v(accS[m][n]);
    }
}

DI void phase_merge(const Params& P, int l, char* smem) {
  const bool last = (l == 1);
  for (int it = blockIdx.x; it < 288 * 16; it += gridDim.x) {
    int mt = it / 16, nt = it % 16;
    if (last && (mt % 18) >= 16) continue;
    merge_tile(P, l, mt, nt, smem);
  }
}

DI void phase_outproj(const Params& P, int l, char* smem) {
  const bool last = (l == 1);
  const int tid = TID(), wave = tid >> 6, lane = tid & 63, fr = lane & 15, fq = lane >> 4;
  const int wr = wave >> 1, wc = wave & 1;
  for (int it = blockIdx.x; it < 288 * 8; it += gridDim.x) {
    int mt = it / 8, nt = it % 8;
    if (last && (mt % 18) >= 16) continue;
    f32x4 acc[4][4];
    zero_acc<4>(acc);
    gemm_main<4, true, false>(((u16*)(P.ws + OFF_acc)), DM, nullptr, mt * 128, ((u16*)(P.ws + OFF_WoT)) + (size_t)l * 1024 * 1024, 1024, nt * 128, 1024, acc, (u16*)smem);
#pragma unroll
    for (int m = 0; m < 4; ++m)
#pragma unroll
      for (int n = 0; n < 4; ++n) {
        int r = mt * 128 + wr * 64 + m * 16 + fr, c = nt * 128 + wc * 64 + n * 16 + fq * 4;
        *(bf16x4*)(((u16*)(P.ws + OFF_Y)) + (size_t)r * DM + c) = pack4v(acc[m][n]);
      }
  }
}

DI void phase_ffn1(const Params& P, int l, char* smem) {
  const bool last = (l == 1);
  const int tid = TID(), wave = tid >> 6, lane = tid & 63, fr = lane & 15, fq = lane >> 4;
  const int wr = wave >> 1, wc = wave & 1;
  const int nmt = last ? 512 : 576;
  for (int it = blockIdx.x; it < nmt * 8; it += gridDim.x) {
    int mt = it / 8, nt = it % 8;
    int R0 = mt * 128;
    int e = R0 < NFFN_LAT ? (R0 >> 8) & 15 : (R0 - NFFN_LAT) >> 9;
    f32x4 acc[4][4];
    zero_acc<4>(acc);
    gemm_main<4, true, true>(((u16*)(P.ws + OFF_H)), DM, ((int*)(P.ws + OFF_tokidx)), R0, ((u16*)(P.ws + OFF_W13T)) + (size_t)e * 1024 * 1024, 1024, nt * 128, 1024, acc, (u16*)smem);
#pragma unroll
    for (int m = 0; m < 4; ++m)
#pragma unroll
      for (int n2 = 0; n2 < 2; ++n2) {
        int r = R0 + wr * 64 + m * 16 + fr;
        int hc = (nt * 4 + wc * 2 + n2) * 16 + fq * 4;
        f32x4 a = acc[m][2 * n2], b = acc[m][2 * n2 + 1];
        *(bf16x4*)(((u16*)(P.ws + OFF_hid)) + (size_t)r * 512 + hc) = pack4(siluf_(a[0]) * b[0], siluf_(a[1]) * b[1], siluf_(a[2]) * b[2], siluf_(a[3]) * b[3]);
      }
  }
}

DI void phase_ffn2(const Params& P, int l, char* smem) {
  const bool last = (l == 1);
  const int tid = TID(), wave = tid >> 6, lane = tid & 63, fr = lane & 15, fq = lane >> 4;
  const int wr = wave >> 1, wc = wave & 1;
  const int nmt = last ? 512 : 576;
  for (int it = blockIdx.x; it < nmt * 8; it += gridDim.x) {
    int mt = it / 8, nt = it % 8;
    int R0 = mt * 128;
    int e = R0 < NFFN_LAT ? (R0 >> 8) & 15 : (R0 - NFFN_LAT) >> 9;
    f32x4 acc[4][4];
    zero_acc<4>(acc);
    gemm_main<4, true, false>(((u16*)(P.ws + OFF_hid)), 512, nullptr, R0, ((u16*)(P.ws + OFF_W2T)) + (size_t)e * 1024 * 512, 512, nt * 128, 512, acc, (u16*)smem);
#pragma unroll
    for (int m = 0; m < 4; ++m) {
      int r = R0 + wr * 64 + m * 16 + fr;
      float gt = ((float*)(P.ws + OFF_gatev))[r];
#pragma unroll
      for (int n = 0; n < 4; ++n) {
        int c = nt * 128 + wc * 64 + n * 16 + fq * 4;
        f32x4 v = acc[m][n];
        *(bf16x4*)(((u16*)(P.ws + OFF_ye)) + (size_t)r * DM + c) = pack4(v[0] * gt, v[1] * gt, v[2] * gt, v[3] * gt);
      }
    }
  }
}

DI void phase_mix2(const Params& P, int l, int hb, char* smem) {
  const bool last = (l == 1);
  const int G = gridDim.x;
  for (int it = blockIdx.x; it < 576; it += G) {
    if (last && (it % 18) >= 16) continue;
    attn_item(P, l, hb, it, smem);
  }
  const int b2 = G - 1 - blockIdx.x;
  for (int it = b2; it < 2304; it += G) ssd_state_item(P, l, hb, it, smem);
  for (int it = b2; it < 576; it += G) {
    int mt = it >> 2, g = it & 3;
    if (last && (mt % 18) >= 16) continue;
    pool_item(P, l, hb, mt, g, smem);
  }
  for (int mt = b2; mt < 144; mt += G) {
    if (last && (mt % 18) >= 16) continue;
    sgu_item(P, l, hb, mt, smem);
  }
}

DI void phase_ssd_out(const Params& P, int l, int hb, char* smem) {
  const bool last = (l == 1);
  for (int it = blockIdx.x; it < 8 * 18 * 8; it += gridDim.x) {
    int jp = (it >> 3) % 18;
    if (last && jp >= 16) continue;
    ssd_out_item(P, l, hb, it, smem);
  }
}

template <bool COOP>
__global__ void __launch_bounds__(256, 2) mk_forward(Params P, int ph_begin, int ph_end) {
  __shared__ __attribute__((aligned(16))) char smem[SMEM_BYTES];
  int ph = 0;
#define PHASE(code)                                         \
  {                                                         \
    if (ph >= ph_begin && ph < ph_end) { code; }            \
    ++ph;                                                   \
    if (COOP && ph > ph_begin && ph < ph_end) cg::this_grid().sync(); \
  }
  PHASE(phase_prologue(P, smem));
  PHASE(phase_h0(P));
  for (int l = 0; l < 2; ++l) {
    for (int hb = 0; hb < 2; ++hb) {
      PHASE(phase_proj(P, l, hb, smem));
      PHASE(phase_mix2(P, l, hb, smem));
      PHASE(phase_carry(P));
      PHASE(phase_ssd_out(P, l, hb, smem));
    }
    PHASE(phase_merge(P, l, smem));
    PHASE(phase_outproj(P, l, smem));
    PHASE(phase_ln1(P, l, smem));
    PHASE(phase_topk(P, l, smem));
    PHASE(phase_ffn1(P, l, smem));
    PHASE(phase_ffn2(P, l, smem));
    PHASE(phase_ln2(P, l));
  }
#undef PHASE
}

#ifndef MK_COOP
#define MK_COOP 1
#endif

extern "C" void kernel_launch(void* const* d_in, const int* in_sizes, int n_in, void* d_out, int out_size, void* d_ws, size_t ws_size,
                              hipStream_t stream) {
  Params p{};
  const float* const* in = (const float* const*)d_in;
  p.x = in[0]; p.c = in[1]; p.ctx = in[2]; p.c_ctx = in[3]; p.w_mod = in[4]; p.b_mod = in[5]; p.w_in = in[6]; p.conv_w = in[7];
  p.conv_b = in[8]; p.a_log = in[9]; p.dt_bias = in[10]; p.ssd_d = in[11]; p.ssd_norm_g = in[12]; p.diff_lambda = in[13];
  p.diff_norm_g = in[14]; p.pool_w = in[15]; p.pool_scale = in[16]; p.sgu_ln_g = in[17]; p.sgu_ln_b = in[18]; p.sgu_w = in[19];
  p.sgu_b = in[20]; p.w_gate = in[21]; p.w_branch = in[22]; p.w_out = in[23]; p.ln1_g = in[24]; p.ln1_b = in[25]; p.w_router = in[26];
  p.w1 = in[27]; p.w3 = in[28]; p.w2 = in[29]; p.ln2_g = in[30]; p.ln2_b = in[31];
  p.out = (float*)d_out;
  p.ws = (char*)d_ws;
  if (WS_NEED > ws_size) { fprintf(stderr, "workspace too small: need %zu have %zu\n", (size_t)WS_NEED, ws_size); return; }

  static int grid_blocks = 0;
  if (!grid_blocks) {
    int dev = 0, cus = 0, per_cu = 0;
    hipGetDevice(&dev);
    hipDeviceGetAttribute(&cus, hipDeviceAttributeMultiprocessorCount, dev);
    if (MK_COOP) hipOccupancyMaxActiveBlocksPerMultiprocessor(&per_cu, mk_forward<true>, 256, 0);
    else hipOccupancyMaxActiveBlocksPerMultiprocessor(&per_cu, mk_forward<false>, 256, 0);
    if (per_cu < 1) per_cu = 1;
    if (per_cu > 2) per_cu = 2;
    grid_blocks = cus * per_cu;
  }
#if MK_COOP
  int b = 0, e = NPHASE;
  void* args[] = {&p, &b, &e};
  hipError_t err = hipLaunchCooperativeKernel((void*)mk_forward<true>, dim3(grid_blocks), dim3(256), args, 0, stream);
  if (err != hipSuccess) fprintf(stderr, "cooperative launch failed: %s (grid %d)\n", hipGetErrorString(err), grid_blocks);
#else
  for (int ph = 0; ph < NPHASE; ++ph) hipLaunchKernelGGL(mk_forward<false>, dim3(grid_blocks), dim3(256), 0, stream, p, ph, ph + 1);
#endif
}
```

```cpp
#include <hip/hip_runtime.h>
#include <hip/hip_cooperative_groups.h>
#include <cstdio>
#include <cstdint>
namespace cg = cooperative_groups;

typedef unsigned short u16;
using bf16x8 = __attribute__((ext_vector_type(8))) short;
using bf16x4 = __attribute__((ext_vector_type(4))) short;
using f32x4 = __attribute__((ext_vector_type(4))) float;
using u32x4 = __attribute__((ext_vector_type(4))) unsigned;

#define DI __device__ __forceinline__
#define MFMA16(a, b, c) __builtin_amdgcn_mfma_f32_16x16x32_bf16((a), (b), (c), 0, 0, 0)

constexpr int NB = 16, SEQ = 2048, CTXL = 256, SP = 2304, NTOK = NB * SP, DM = 1024;
constexpr int HROWS = 8 * SP;
constexpr int INC = 4368, INP = 4480;
constexpr int NFFN_LAT = 65536, NFFN_ALL = 73728;
constexpr float LN_EPS = 1e-5f;
constexpr float ALPHA = 1.41421356237309515f;
constexpr int SMEM_BYTES = 81920;
constexpr int NPHASE = 2 + 2 * (2 * 4 + 7);


constexpr size_t al256(size_t x) { return (x + 255) & ~(size_t)255; }
constexpr size_t U_ = (size_t)NTOK * 512 * 2;
constexpr size_t OFF_WinT = 0;
constexpr size_t OFF_WgT = OFF_WinT + al256((size_t)2 * INP * 1024 * 2);
constexpr size_t OFF_WbT = OFF_WgT + al256((size_t)2 * 4 * 1024 * 1024 * 2);
constexpr size_t OFF_WoT = OFF_WbT + al256((size_t)2 * 4 * 1024 * 512 * 2);
constexpr size_t OFF_poolT = OFF_WoT + al256((size_t)2 * 1024 * 1024 * 2);
constexpr size_t OFF_sguW = OFF_poolT + al256((size_t)2 * 4 * 128 * 128 * 2);
constexpr size_t OFF_mod = OFF_sguW + al256((size_t)2 * 4 * 128 * 128 * 2);
constexpr size_t OFF_rope = OFF_mod + al256((size_t)2 * 17 * 6144 * 4);
constexpr size_t OFF_lamv = OFF_rope + al256(64 * 16 * 2 * 4);
constexpr size_t OFF_bar = OFF_lamv + 256;
constexpr size_t OFF_aff = OFF_bar + 16384;
constexpr size_t OFF_rank = OFF_aff + al256((size_t)NTOK * 16 * 4);
constexpr size_t OFF_ssq = OFF_rank + al256((size_t)NTOK * 16 * 4);
constexpr size_t OFF_tokidx = OFF_ssq + al256((size_t)NTOK * 8 * 4);
constexpr size_t OFF_gatev = OFF_tokidx + al256((size_t)NFFN_ALL * 4);
constexpr size_t OFF_dtbuf = OFF_gatev + al256((size_t)NFFN_ALL * 4);
constexpr size_t OFF_decay = OFF_dtbuf + al256((size_t)HROWS * 16 * 4);
constexpr size_t OFF_H = OFF_decay + al256((size_t)8 * 2 * 8 * 18 * 4);
constexpr size_t OFF_Y = OFF_H + 2 * U_;
constexpr size_t OFF_o1 = OFF_Y;
constexpr size_t OFF_cstate = OFF_Y + U_ / 2;
constexpr size_t OFF_enter = OFF_Y + U_ / 2 + U_;
constexpr size_t OFF_RM = OFF_Y + 2 * U_;
constexpr size_t OFF_xp = OFF_RM;
constexpr size_t OFF_z = OFF_xp + U_ / 2;
constexpr size_t OFF_xbc = OFF_z + U_ / 2;
constexpr size_t OFF_q = OFF_xbc + (U_ / 4) * 3;
constexpr size_t OFF_k = OFF_q + U_ / 2;
constexpr size_t OFF_vT = OFF_k + U_ / 2;
constexpr size_t OFF_gvT = OFF_vT + U_ / 2;
constexpr size_t OFF_br0 = OFF_gvT + U_ / 2;
constexpr size_t OFF_br1 = OFF_br0 + U_;
constexpr size_t OFF_br2 = OFF_br1 + U_;
constexpr size_t OFF_br3 = OFF_br2 + U_;
constexpr size_t OFF_acc = OFF_RM;
constexpr size_t OFF_W13T = OFF_RM;
constexpr size_t OFF_W2T = OFF_W13T + (size_t)16 * 1024 * 1024 * 2;
constexpr size_t OFF_hid = OFF_W2T + (size_t)16 * 1024 * 512 * 2;
constexpr size_t OFF_ye = OFF_hid + (size_t)NFFN_ALL * 512 * 2;
constexpr size_t WS_MIX_END = OFF_br3 + U_;
constexpr size_t WS_FFN_END = OFF_ye + (size_t)NFFN_ALL * 1024 * 2;
constexpr size_t WS_NEED = WS_MIX_END > WS_FFN_END ? WS_MIX_END : WS_FFN_END;

struct Params {
  const float *x, *c, *ctx, *c_ctx, *w_mod, *b_mod, *w_in, *conv_w, *conv_b, *a_log, *dt_bias, *ssd_d, *ssd_norm_g,
      *diff_lambda, *diff_norm_g, *pool_w, *pool_scale, *sgu_ln_g, *sgu_ln_b, *sgu_w, *sgu_b, *w_gate, *w_branch, *w_out,
      *ln1_g, *ln1_b, *w_router, *w1, *w3, *w2, *ln2_g, *ln2_b;
  float* out;
  char* ws;
};

DI int TID() { int t = (int)__builtin_amdgcn_workitem_id_x(); asm volatile("" : "+v"(t)); return t; }
DI u16 f2bf(float x) { unsigned u = __float_as_uint(x); u += 0x7fffu + ((u >> 16) & 1u); return (u16)(u >> 16); }
DI float bf2f(u16 v) { return __uint_as_float(((unsigned)v) << 16); }
DI float sigmoidf_(float x) { return 1.f / (1.f + __expf(-x)); }
DI float siluf_(float x) { return x / (1.f + __expf(-x)); }
DI float geluf_(float x) { float y = 0.7978845608028654f * (x + 0.044715f * x * x * x); float t = 1.f - 2.f / (__expf(2.f * y) + 1.f); return 0.5f * x * (1.f + t); }
DI float softplusf_(float x) { return x > 20.f ? x : log1pf(__expf(x)); }
DI bf16x4 pack4(float a, float b, float c, float d) { bf16x4 r; r[0] = (short)f2bf(a); r[1] = (short)f2bf(b); r[2] = (short)f2bf(c); r[3] = (short)f2bf(d); return r; }
DI bf16x4 pack4v(f32x4 v) { return pack4(v[0], v[1], v[2], v[3]); }
DI float wave_sum(float v) { for (int o = 32; o > 0; o >>= 1) v += __shfl_xor(v, o); return v; }

template <int MI, int NI, bool SWAP>
DI void mma_lds(const u16* As, int lda, const u16* Bs, int ldb, int ksteps, f32x4 (&acc)[MI][NI], int fr, int fq) {
  for (int ks = 0; ks < ksteps; ++ks) {
    bf16x8 a[MI], b[NI];
#pragma unroll
    for (int m = 0; m < MI; ++m) a[m] = *(const bf16x8*)(As + (m * 16 + fr) * lda + ks * 32 + fq * 8);
#pragma unroll
    for (int n = 0; n < NI; ++n) b[n] = *(const bf16x8*)(Bs + (n * 16 + fr) * ldb + ks * 32 + fq * 8);
#pragma unroll
    for (int m = 0; m < MI; ++m)
#pragma unroll
      for (int n = 0; n < NI; ++n) acc[m][n] = SWAP ? MFMA16(b[n], a[m], acc[m][n]) : MFMA16(a[m], b[n], acc[m][n]);
  }
}

constexpr int LDT = 72;
template <int NI, bool SWAP, bool GATHER>
DI void gemm_main(const u16* __restrict__ A, int lda, const int* __restrict__ aidx, int arow0, const u16* __restrict__ Bt, int ldb, int brow0,
                  int K, f32x4 (&acc)[4][NI], u16* smem) {
  constexpr int BN = NI * 32;
  constexpr int NBL = BN / 32;
  const int tid = TID(), wave = tid >> 6, lane = tid & 63, fr = lane & 15, fq = lane >> 4;
  const int wr = wave >> 1, wc = wave & 1;
  u16* As = smem;
  u16* Bs = smem + 2 * 128 * LDT;
  const int lr = tid >> 3, lc = (tid & 7) * 8;
  const u16* ap[4];
#pragma unroll
  for (int i = 0; i < 4; ++i) {
    int r = arow0 + lr + 32 * i;
    size_t rr = GATHER ? (size_t)aidx[r] : (size_t)r;
    ap[i] = A + rr * lda + lc;
  }
  const u16* bp = Bt + (size_t)(brow0 + lr) * ldb + lc;
  u32x4 ra[4], rb[NBL];
  const int nk = K / 64;
#pragma unroll
  for (int i = 0; i < 4; ++i) ra[i] = *(const u32x4*)(ap[i]);
#pragma unroll
  for (int i = 0; i < NBL; ++i) rb[i] = *(const u32x4*)(bp + (size_t)(32 * i) * ldb);
  __syncthreads();
#pragma unroll
  for (int i = 0; i < 4; ++i) *(u32x4*)(As + (lr + 32 * i) * LDT + lc) = ra[i];
#pragma unroll
  for (int i = 0; i < NBL; ++i) *(u32x4*)(Bs + (lr + 32 * i) * LDT + lc) = rb[i];
  __syncthreads();
  for (int kt = 0; kt < nk; ++kt) {
    const int cur = kt & 1;
    if (kt + 1 < nk) {
      const int ko = (kt + 1) * 64;
#pragma unroll
      for (int i = 0; i < 4; ++i) ra[i] = *(const u32x4*)(ap[i] + ko);
#pragma unroll
      for (int i = 0; i < NBL; ++i) rb[i] = *(const u32x4*)(bp + (size_t)(32 * i) * ldb + ko);
    }
    mma_lds<4, NI, SWAP>(As + cur * 128 * LDT + wr * 64 * LDT, LDT, Bs + cur * BN * LDT + wc * (NI * 16) * LDT, LDT, 2, acc, fr, fq);
    if (kt + 1 < nk) {
      const int nx = cur ^ 1;
#pragma unroll
      for (int i = 0; i < 4; ++i) *(u32x4*)(As + nx * 128 * LDT + (lr + 32 * i) * LDT + lc) = ra[i];
#pragma unroll
      for (int i = 0; i < NBL; ++i) *(u32x4*)(Bs + nx * BN * LDT + (lr + 32 * i) * LDT + lc) = rb[i];
    }
    __syncthreads();
  }
}

template <int NI> DI void zero_acc(f32x4 (&a)[4][NI]) {
#pragma unroll
  for (int m = 0; m < 4; ++m)
#pragma unroll
    for (int n = 0; n < NI; ++n) a[m][n] = f32x4{0.f, 0.f, 0.f, 0.f};
}

DI void cvt_tile(const float* __restrict__ src0, const float* __restrict__ src1, int ld, u16* __restrict__ dst, int K, int n0, int k0, int mode, u16* lds) {
  const int tid = TID();
  __syncthreads();
  if (mode == 3) {
    for (int idx = tid; idx < 4096; idx += 256) {
      int n = idx >> 6, kk = idx & 63;
      lds[n * LDT + kk] = f2bf(src0[(size_t)(n0 + n) * ld + k0 + kk]);
    }
  } else {
    for (int idx = tid; idx < 4096; idx += 256) {
      int kk = idx >> 6, n = idx & 63;
      int nn = n0 + n;
      float v = 0.f;
      if (mode == 0) v = src0[(size_t)(k0 + kk) * ld + nn];
      else if (mode == 1) {
        int col = nn < 1792 ? nn : (nn < 4352 ? nn + 16 : (nn < 4368 ? nn - 4352 + 1792 : -1));
        if (col >= 0) v = src0[(size_t)(k0 + kk) * ld + col];
        if (nn >= 1792 && nn < 2304) v *= 0.125f;
      } else {
        int g = nn >> 5, r = nn & 31;
        v = (r < 16) ? src0[(size_t)(k0 + kk) * ld + g * 16 + r] : src1[(size_t)(k0 + kk) * ld + g * 16 + r - 16];
      }
      lds[n * LDT + kk] = f2bf(v);
    }
  }
  __syncthreads();
  for (int c = tid; c < 512; c += 256) {
    int n = c >> 3, kc = (c & 7) * 8;
    *(u32x4*)(dst + (size_t)(n0 + n) * K + k0 + kc) = *(const u32x4*)(lds + n * LDT + kc);
  }
}

DI void mod_item(const Params& P, int item, char* smem) {
  const int l = item / 96, n0 = (item % 96) * 64;
  float* sc = (float*)smem;
  const int tid = TID();
  __syncthreads();
  for (int i = tid; i < 17 * 1024; i += 256) {
    int s = i >> 10, kk = i & 1023;
    float v = s < 16 ? P.c[s * 1024 + kk] : P.c_ctx[kk];
    sc[i] = siluf_(v);
  }
  __syncthreads();
  const int col = tid & 63, kp = tid >> 6;
  float a[17];
#pragma unroll
  for (int s = 0; s < 17; ++s) a[s] = 0.f;
  const float* w = P.w_mod + (size_t)l * 1024 * 6144 + n0 + col;
  for (int kk = kp * 256; kk < kp * 256 + 256; ++kk) {
    float wv = w[(size_t)kk * 6144];
#pragma unroll
    for (int s = 0; s < 17; ++s) a[s] += sc[s * 1024 + kk] * wv;
  }
  __syncthreads();
  float* red = (float*)smem;
#pragma unroll
  for (int s = 0; s < 17; ++s) red[(kp * 17 + s) * 64 + col] = a[s];
  __syncthreads();
  for (int i = tid; i < 17 * 64; i += 256) {
    int s = i >> 6, cc = i & 63;
    float v = red[(0 * 17 + s) * 64 + cc] + red[(1 * 17 + s) * 64 + cc] + red[(2 * 17 + s) * 64 + cc] + red[(3 * 17 + s) * 64 + cc];
    ((float*)(P.ws + OFF_mod))[((size_t)l * 17 + s) * 6144 + n0 + cc] = v + P.b_mod[l * 6144 + n0 + cc];
  }
}

DI void misc_item(const Params& P) {
  const int tid = TID();
  for (int i = tid; i < 1024; i += 256) {
    int pos = i >> 4, f = i & 15;
    float inv = powf(10000.f, -(float)f / 16.f);
    float ang = (float)pos * inv;
    ((float*)(P.ws + OFF_rope))[i * 2] = cosf(ang);
    ((float*)(P.ws + OFF_rope))[i * 2 + 1] = sinf(ang);
  }
  if (tid < 2) {
    const float* dl = P.diff_lambda + tid * 256;
    float s1 = 0.f, s2 = 0.f;
    for (int i = 0; i < 64; ++i) { s1 += dl[i] * dl[64 + i]; s2 += dl[128 + i] * dl[192 + i]; }
    float lam_init = 0.8f - 0.6f * expf(-0.3f * (float)tid);
    ((float*)(P.ws + OFF_lamv))[tid * 2] = expf(s1) - expf(s2) + lam_init;
    ((float*)(P.ws + OFF_lamv))[tid * 2 + 1] = lam_init;
  }
}

DI void phase_prologue(const Params& P, char* smem) {
  const int per_layer = 1120 + 4 * 256 + 4 * 128 + 256 + 16 + 16;
  const int ncvt = 2 * per_layer;
  const int total = ncvt + 192 + 1;
  for (int it = blockIdx.x; it < total; it += gridDim.x) {
    if (it < ncvt) {
      const int l = it / per_layer;
      int t = it % per_layer;
      const float* s0; u16* dst; int ld, K, ntk, mode;
      if (t < 1120) { s0 = P.w_in + (size_t)l * 1024 * INC; ld = INC; dst = ((u16*)(P.ws + OFF_WinT)) + (size_t)l * INP * 1024; K = 1024; ntk = 16; mode = 1; }
      else if (t < 2144) { t -= 1120; int kq = t >> 8; t &= 255; s0 = P.w_gate + ((size_t)l * 4 + kq) * 1024 * 1024; ld = 1024; dst = ((u16*)(P.ws + OFF_WgT)) + ((size_t)l * 4 + kq) * 1024 * 1024; K = 1024; ntk = 16; mode = 0; }
      else if (t < 2656) { t -= 2144; int kq = t >> 7; t &= 127; s0 = P.w_branch + ((size_t)l * 4 + kq) * 512 * 1024; ld = 1024; dst = ((u16*)(P.ws + OFF_WbT)) + ((size_t)l * 4 + kq) * 1024 * 512; K = 512; ntk = 8; mode = 0; }
      else if (t < 2912) { t -= 2656; s0 = P.w_out + (size_t)l * 1024 * 1024; ld = 1024; dst = ((u16*)(P.ws + OFF_WoT)) + (size_t)l * 1024 * 1024; K = 1024; ntk = 16; mode = 0; }
      else if (t < 2928) { t -= 2912; int g = t >> 2; t &= 3; s0 = P.pool_w + ((size_t)l * 4 + g) * 128 * 128; ld = 128; dst = ((u16*)(P.ws + OFF_poolT)) + ((size_t)l * 4 + g) * 128 * 128; K = 128; ntk = 2; mode = 0; }
      else { t -= 2928; int g = t >> 2; t &= 3; s0 = P.sgu_w + ((size_t)l * 4 + g) * 128 * 128; ld = 128; dst = ((u16*)(P.ws + OFF_sguW)) + ((size_t)l * 4 + g) * 128 * 128; K = 128; ntk = 2; mode = 3; }
      const int tn = t / ntk, tk = t % ntk;
      cvt_tile(s0, s0, ld, dst, K, tn * 64, tk * 64, mode, (u16*)smem);
    } else if (it < ncvt + 192) {
      mod_item(P, it - ncvt, smem);
    } else {
      misc_item(P);
    }
  }
}

DI void ffn_cvt_item(const Params& P, int l, int it, char* smem) {
  const int e = it / 384;
  int t = it % 384;
  if (t < 256) {
    cvt_tile(P.w1 + ((size_t)l * 16 + e) * 1024 * 512, P.w3 + ((size_t)l * 16 + e) * 1024 * 512, 512, ((u16*)(P.ws + OFF_W13T)) + (size_t)e * 1024 * 1024, 1024, (t >> 4) * 64, (t & 15) * 64, 2, (u16*)smem);
  } else {
    t -= 256;
    const float* s = P.w2 + ((size_t)l * 16 + e) * 512 * 1024;
    cvt_tile(s, s, 1024, ((u16*)(P.ws + OFF_W2T)) + (size_t)e * 1024 * 512, 512, (t >> 3) * 64, (t & 7) * 64, 0, (u16*)smem);
  }
}

DI void load_row_f32(const float* p, int lane, float (&v)[16]) {
#pragma unroll
  for (int k = 0; k < 4; ++k) { float4 t = *(const float4*)(p + lane * 4 + 256 * k); v[4 * k] = t.x; v[4 * k + 1] = t.y; v[4 * k + 2] = t.z; v[4 * k + 3] = t.w; }
}
DI void load_row_bf16(const u16* p, int lane, float (&v)[16]) {
#pragma unroll
  for (int k = 0; k < 4; ++k) { bf16x4 t = *(const bf16x4*)(p + lane * 4 + 256 * k); for (int i = 0; i < 4; ++i) v[4 * k + i] = bf2f((u16)t[i]); }
}
DI void store_row_f32(float* p, int lane, const float (&v)[16]) {
#pragma unroll
  for (int k = 0; k < 4; ++k) *(float4*)(p + lane * 4 + 256 * k) = make_float4(v[4 * k], v[4 * k + 1], v[4 * k + 2], v[4 * k + 3]);
}
DI void store_row_bf16(u16* p, int lane, const float (&v)[16]) {
#pragma unroll
  for (int k = 0; k < 4; ++k) *(bf16x4*)(p + lane * 4 + 256 * k) = pack4(v[4 * k], v[4 * k + 1], v[4 * k + 2], v[4 * k + 3]);
}
DI void ln_row(float (&v)[16], const float* g, const float* b, int lane) {
  float s = 0.f;
#pragma unroll
  for (int i = 0; i < 16; ++i) s += v[i];
  float mu = wave_sum(s) * (1.f / 1024.f);
  float q = 0.f;
#pragma unroll
  for (int i = 0; i < 16; ++i) { float d = v[i] - mu; q += d * d; }
  float rstd = rsqrtf(wave_sum(q) * (1.f / 1024.f) + LN_EPS);
  float gg[16], bb[16];
  load_row_f32(g, lane, gg); load_row_f32(b, lane, bb);
#pragma unroll
  for (int i = 0; i < 16; ++i) v[i] = (v[i] - mu) * rstd * gg[i] + bb[i];
}

DI void phase_h0(const Params& P) {
  const int lane = TID() & 63;
  const int gw = blockIdx.x * 4 + (TID() >> 6), nw = gridDim.x * 4;
  for (int row = gw; row < NTOK; row += nw) {
    int s = row / SP, p = row % SP;
    bool lat = p < SEQ;
    const float* xs = lat ? P.x + ((size_t)s * SEQ + p) * DM : P.ctx + ((size_t)s * CTXL + (p - SEQ)) * DM;
    const float* md = ((float*)(P.ws + OFF_mod)) + (size_t)(lat ? s : 16) * 6144;
    float v[16], sh[16], scl[16];
    load_row_f32(xs, lane, v); load_row_f32(md, lane, sh); load_row_f32(md + 1024, lane, scl);
#pragma unroll
    for (int i = 0; i < 16; ++i) v[i] = v[i] * (1.f + scl[i]) + sh[i];
    store_row_bf16(((u16*)(P.ws + OFF_H)) + (size_t)row * DM, lane, v);
  }
}

DI void compute_x1(const Params& P, int l, int row, int lane, float (&v)[16]) {
  int s = row / SP, p = row % SP;
  bool lat = p < SEQ;
  const float* xs;
  if (l == 0) xs = lat ? P.x + ((size_t)s * SEQ + p) * DM : P.ctx + ((size_t)s * CTXL + (p - SEQ)) * DM;
  else xs = P.out + ((size_t)s * SEQ + p) * DM;
  const float* md = ((float*)(P.ws + OFF_mod)) + ((size_t)l * 17 + (lat ? s : 16)) * 6144;
  float y[16], m2[16];
  load_row_f32(xs, lane, v); load_row_bf16(((u16*)(P.ws + OFF_Y)) + (size_t)row * DM, lane, y); load_row_f32(md + 2 * 1024, lane, m2);
#pragma unroll
  for (int i = 0; i < 16; ++i) v[i] = ALPHA * v[i] + m2[i] * y[i];
  ln_row(v, P.ln1_g + l * 1024, P.ln1_b + l * 1024, lane);
}

DI void phase_ln1(const Params& P, int l, char* smem) {
  const bool last = (l == 1);
  const int lane = TID() & 63;
  const int gw = blockIdx.x * 4 + (TID() >> 6), nw = gridDim.x * 4;
  for (int row = gw; row < NTOK; row += nw) {
    int s = row / SP, p = row % SP;
    bool lat = p < SEQ;
    if (last && !lat) continue;
    float v[16];
    compute_x1(P, l, row, lane, v);
    const float* md = ((float*)(P.ws + OFF_mod)) + ((size_t)l * 17 + (lat ? s : 16)) * 6144;
    float m3[16], m4[16];
    load_row_f32(md + 3 * 1024, lane, m3); load_row_f32(md + 4 * 1024, lane, m4);
#pragma unroll
    for (int i = 0; i < 16; ++i) v[i] = v[i] * (1.f + m4[i]) + m3[i];
    store_row_bf16(((u16*)(P.ws + OFF_H)) + (size_t)row * DM, lane, v);
    float lg[16];
#pragma unroll
    for (int e = 0; e < 16; ++e) lg[e] = 0.f;
    const float* wr = P.w_router + (size_t)l * 1024 * 16;
#pragma unroll
    for (int k = 0; k < 4; ++k)
#pragma unroll
      for (int i = 0; i < 4; ++i) {
        int cidx = lane * 4 + 256 * k + i;
        float hv = v[4 * k + i];
        const float4* w4 = (const float4*)(wr + (size_t)cidx * 16);
#pragma unroll
        for (int e4 = 0; e4 < 4; ++e4) { float4 w = w4[e4]; lg[4 * e4] += hv * w.x; lg[4 * e4 + 1] += hv * w.y; lg[4 * e4 + 2] += hv * w.z; lg[4 * e4 + 3] += hv * w.w; }
      }
#pragma unroll
    for (int e = 0; e < 16; ++e) lg[e] = wave_sum(lg[e]);
    float mx = lg[0];
#pragma unroll
    for (int e = 1; e < 16; ++e) mx = fmaxf(mx, lg[e]);
    float sum = 0.f;
#pragma unroll
    for (int e = 0; e < 16; ++e) { lg[e] = expf(lg[e] - mx); sum += lg[e]; }
    float inv = 1.f / sum;
    if (lane < 16) {
      float mine = 0.f;
#pragma unroll
      for (int e = 0; e < 16; ++e) if (lane == e) mine = lg[e];
      ((float*)(P.ws + OFF_aff))[(size_t)row * 16 + lane] = mine * inv;
    }
  }
  for (int it = blockIdx.x; it < 16 * 384; it += gridDim.x) ffn_cvt_item(P, l, it, smem);
}

DI void phase_topk(const Params& P, int l, char* smem) {
  const bool last = (l == 1);
  const int tid = TID();
  float* vals = (float*)smem;
  const int nitems = last ? 256 : 512;
  for (int it = blockIdx.x; it < nitems; it += gridDim.x) {
    bool isctx = it >= 256;
    int se = it & 255, s = se >> 4, e = se & 15;
    int n = isctx ? CTXL : SEQ, cap = isctx ? 32 : 256;
    int row0 = s * SP + (isctx ? SEQ : 0);
    __syncthreads();
    for (int i = tid; i < n; i += 256) vals[i] = ((float*)(P.ws + OFF_aff))[(size_t)(row0 + i) * 16 + e];
    __syncthreads();
    for (int t = tid; t < n; t += 256) {
      float a = vals[t];
      int rk = 0;
      for (int u = 0; u < n; u += 4) {
        float4 w = *(const float4*)(vals + u);
        rk += (w.x > a || (w.x == a && u < t)) ? 1 : 0;
        rk += (w.y > a || (w.y == a && u + 1 < t)) ? 1 : 0;
        rk += (w.z > a || (w.z == a && u + 2 < t)) ? 1 : 0;
        rk += (w.w > a || (w.w == a && u + 3 < t)) ? 1 : 0;
      }
      ((int*)(P.ws + OFF_rank))[(size_t)(row0 + t) * 16 + e] = rk;
      if (rk < cap) {
        int R = isctx ? NFFN_LAT + (e * 16 + s) * 32 + rk : (s * 16 + e) * 256 + rk;
        ((int*)(P.ws + OFF_tokidx))[R] = row0 + t;
        ((float*)(P.ws + OFF_gatev))[R] = a;
      }
    }
  }
}

DI void phase_ln2(const Params& P, int l) {
  const bool last = (l == 1);
  const int lane = TID() & 63;
  const int gw = blockIdx.x * 4 + (TID() >> 6), nw = gridDim.x * 4;
  for (int row = gw; row < NTOK; row += nw) {
    int s = row / SP, p = row % SP;
    bool lat = p < SEQ;
    if (last && !lat) continue;
    float v[16];
    compute_x1(P, l, row, lane, v);
    float yf[16];
#pragma unroll
    for (int i = 0; i < 16; ++i) yf[i] = 0.f;
    const int cap = lat ? 256 : 32;
    for (int e = 0; e < 16; ++e) {
      int rk = ((int*)(P.ws + OFF_rank))[(size_t)row * 16 + e];
      if (rk < cap) {
        int R = lat ? (s * 16 + e) * 256 + rk : NFFN_LAT + (e * 16 + s) * 32 + rk;
        float t[16];
        load_row_bf16(((u16*)(P.ws + OFF_ye)) + (size_t)R * DM, lane, t);
#pragma unroll
        for (int i = 0; i < 16; ++i) yf[i] += t[i];
      }
    }
    const float* md = ((float*)(P.ws + OFF_mod)) + ((size_t)l * 17 + (lat ? s : 16)) * 6144;
    float m5[16];
    load_row_f32(md + 5 * 1024, lane, m5);
#pragma unroll
    for (int i = 0; i < 16; ++i) v[i] = ALPHA * v[i] + m5[i] * yf[i];
    ln_row(v, P.ln2_g + l * 1024, P.ln2_b + l * 1024, lane);
    if (lat) store_row_f32(P.out + ((size_t)s * SEQ + p) * DM, lane, v);
    if (!last) {
      const float* md2 = ((float*)(P.ws + OFF_mod)) + ((size_t)(l + 1) * 17 + (lat ? s : 16)) * 6144;
      float sh[16], scl[16];
      load_row_f32(md2, lane, sh); load_row_f32(md2 + 1024, lane, scl);
#pragma unroll
      for (int i = 0; i < 16; ++i) v[i] = v[i] * (1.f + scl[i]) + sh[i];
      store_row_bf16(((u16*)(P.ws + OFF_H)) + (size_t)row * DM, lane, v);
    }
  }
}

template <bool SWAP>
DI void proj_tile(const Params& P, int l, int hb, int mt, int nt, char* smem) {
  const int tid = TID(), wave = tid >> 6, lane = tid & 63, fr = lane & 15, fq = lane >> 4;
  const int wr = wave >> 1, wc = wave & 1;
  const int hrow0 = mt * 128, grow0 = hb * HROWS + hrow0;
  f32x4 acc[4][4];
  zero_acc<4>(acc);
  gemm_main<4, SWAP, false>(((u16*)(P.ws + OFF_H)), DM, nullptr, grow0, ((u16*)(P.ws + OFF_WinT)) + (size_t)l * INP * 1024, 1024, nt * 128, 1024, acc, (u16*)smem);
  const int jp = mt % 18;
  const int bl = mt / 18;
  const bool lat = jp < 16;
  if (SWAP) {
    u16* dst; int ldd, c0;
    if (nt < 4) { dst = ((u16*)(P.ws + OFF_xp)); ldd = 512; c0 = nt * 128; }
    else if (nt < 8) { dst = ((u16*)(P.ws + OFF_z)); ldd = 512; c0 = (nt - 4) * 128; }
    else if (nt < 14) { dst = ((u16*)(P.ws + OFF_xbc)); ldd = 768; c0 = (nt - 8) * 128; }
    else if (nt < 18) { dst = ((u16*)(P.ws + OFF_q)); ldd = 512; c0 = (nt - 14) * 128; }
    else if (nt < 22) { dst = ((u16*)(P.ws + OFF_k)); ldd = 512; c0 = (nt - 18) * 128; }
    else { dst = ((u16*)(P.ws + OFF_br3)); ldd = 512; c0 = (nt - 26) * 128; }
    const bool isu = nt >= 26;
    const bool rope = (nt >= 14 && nt < 22) && lat;
#pragma unroll
    for (int m = 0; m < 4; ++m) {
      int r = wr * 64 + m * 16 + fr;
      size_t orow = isu ? (size_t)(grow0 + r) : (size_t)(hrow0 + r);
      if (rope) {
        int t = jp * 128 + r;
        int prow = t >> 6, pcol = t & 63;
#pragma unroll
        for (int j = 0; j < 4; ++j) {
          int f = fq * 4 + j;
          float c1 = ((float*)(P.ws + OFF_rope))[(prow * 16 + f) * 2], s1 = ((float*)(P.ws + OFF_rope))[(prow * 16 + f) * 2 + 1];
          float c2 = ((float*)(P.ws + OFF_rope))[(pcol * 16 + f) * 2], s2 = ((float*)(P.ws + OFF_rope))[(pcol * 16 + f) * 2 + 1];
          float a = acc[m][0][j], b = acc[m][1][j];
          acc[m][0][j] = a * c1 - b * s1; acc[m][1][j] = a * s1 + b * c1;
          a = acc[m][2][j]; b = acc[m][3][j];
          acc[m][2][j] = a * c2 - b * s2; acc[m][3][j] = a * s2 + b * c2;
        }
      }
#pragma unroll
      for (int n = 0; n < 4; ++n) {
        f32x4 v = acc[m][n];
        if (isu) { v[0] = geluf_(v[0]); v[1] = geluf_(v[1]); v[2] = geluf_(v[2]); v[3] = geluf_(v[3]); }
        int col = c0 + wc * 64 + n * 16 + fq * 4;
        *(bf16x4*)(dst + orow * ldd + col) = pack4v(v);
      }
    }
  } else {
    if (nt == 34) {
      if (wc == 0) {
#pragma unroll
        for (int m = 0; m < 4; ++m)
#pragma unroll
          for (int j = 0; j < 4; ++j) ((float*)(P.ws + OFF_dtbuf))[(size_t)(hrow0 + wr * 64 + m * 16 + fq * 4 + j) * 16 + fr] = acc[m][0][j];
      }
    } else if (nt < 26) {
      int cb = (nt - 22) * 128 + wc * 64;
#pragma unroll
      for (int m = 0; m < 4; ++m)
#pragma unroll
        for (int n = 0; n < 4; ++n) {
          int c = cb + n * 16 + fr;
          int pos = jp * 128 + wr * 64 + m * 16 + fq * 4;
          *(bf16x4*)(((u16*)(P.ws + OFF_vT)) + ((size_t)bl * 512 + c) * SP + pos) = pack4v(acc[m][n]);
        }
    } else {
      int cb = (nt - 30) * 128 + wc * 64;
#pragma unroll
      for (int m = 0; m < 4; ++m)
#pragma unroll
        for (int n = 0; n < 4; ++n) {
          int c = cb + n * 16 + fr;
          int i0 = wr * 64 + m * 16 + fq * 4;
          f32x4 v = acc[m][n];
          *(bf16x4*)(((u16*)(P.ws + OFF_gvT)) + ((size_t)mt * 512 + c) * 128 + i0) = pack4(geluf_(v[0]), geluf_(v[1]), geluf_(v[2]), geluf_(v[3]));
        }
    }
  }
}

DI void phase_proj(const Params& P, int l, int hb, char* smem) {
  const bool last = (l == 1);
  for (int it = blockIdx.x; it < 144 * 35; it += gridDim.x) {
    int mt = it / 35, nt = it % 35;
    bool isctx = (mt % 18) >= 16;
    if (last && isctx) {
      bool need = (nt >= 8 && nt < 14) || (nt >= 18 && nt < 26) || nt == 34;
      if (!need) continue;
    }
    bool transposed = (nt >= 22 && nt < 26) || nt >= 30;
    if (transposed) proj_tile<false>(P, l, hb, mt, nt, smem);
    else proj_tile<true>(P, l, hb, mt, nt, smem);
  }
}

constexpr int LDK = 136;
DI void pool_item(const Params& P, int l, int hb, int mt, int g, char* smem) {
  const int tid = TID(), wave = tid >> 6, lane = tid & 63, fr = lane & 15, fq = lane >> 4;
  const int wr = wave >> 1, wc = wave & 1;
  u16* As = (u16*)smem;
  u16* Bs = As + 128 * LDK;
  const int jp = mt % 18, bl = mt / 18;
  const bool lat = jp < 16;
  const int n = lat ? SEQ : CTXL;
  const int p0 = lat ? jp * 128 : (jp - 16) * 128;
  const int seqbase = bl * SP + (lat ? 0 : SEQ);
  const int half = 1 << g;
  __syncthreads();
  {
    const int cch = tid & 15;
    const u16* src = ((u16*)(P.ws + OFF_xp)) + (size_t)seqbase * 512 + g * 128 + cch * 8;
    for (int ii = 0; ii < 8; ++ii) {
      int i = (tid >> 4) + 16 * ii;
      int p = p0 + i;
      int lo = max(p - half, 0), hi = min(p + half, n);
      float s[8];
#pragma unroll
      for (int e = 0; e < 8; ++e) s[e] = 0.f;
      for (int r = lo; r < hi; ++r) {
        bf16x8 t = *(const bf16x8*)(src + (size_t)r * 512);
#pragma unroll
        for (int e = 0; e < 8; ++e) s[e] += bf2f((u16)t[e]);
      }
      bf16x8 self = *(const bf16x8*)(src + (size_t)p * 512);
      float inv = 1.f / (float)(hi - lo);
      bf16x8 o;
#pragma unroll
      for (int e = 0; e < 8; ++e) o[e] = (short)f2bf(s[e] * inv - bf2f((u16)self[e]));
      *(bf16x8*)(As + i * LDK + cch * 8) = o;
    }
    const u16* wsrc = ((u16*)(P.ws + OFF_poolT)) + ((size_t)l * 4 + g) * 128 * 128;
    for (int cid = tid; cid < 2048; cid += 256) {
      int r = cid >> 4, c8 = (cid & 15) * 8;
      *(u32x4*)(Bs + r * LDK + c8) = *(const u32x4*)(wsrc + r * 128 + c8);
    }
  }
  __syncthreads();
  f32x4 acc[4][4];
  zero_acc<4>(acc);
  mma_lds<4, 4, true>(As + wr * 64 * LDK, LDK, Bs + wc * 64 * LDK, LDK, 4, acc, fr, fq);
  const float* psc = P.pool_scale + l * 512 + g * 128;
#pragma unroll
  for (int m = 0; m < 4; ++m)
#pragma unroll
    for (int nn = 0; nn < 4; ++nn) {
      int r = wr * 64 + m * 16 + fr, c = wc * 64 + nn * 16 + fq * 4;
      float4 sc = *(const float4*)(psc + c);
      f32x4 v = acc[m][nn];
      *(bf16x4*)(((u16*)(P.ws + OFF_br0)) + (size_t)(hb * HROWS + mt * 128 + r) * 512 + g * 128 + c) = pack4(v[0] * sc.x, v[1] * sc.y, v[2] * sc.z, v[3] * sc.w);
    }
}

DI void sgu_item(const Params& P, int l, int hb, int mt, char* smem) {
  const int tid = TID(), wave = tid >> 6, lane = tid & 63, fr = lane & 15, fq = lane >> 4;
  const int wr = wave >> 1, wc = wave & 1;
  u16* As = (u16*)smem;
  u16* Bs = As + 128 * LDK;
  float* st = (float*)(Bs + 128 * LDK);
  const u16* gv = ((u16*)(P.ws + OFF_gvT)) + (size_t)mt * 512 * 128;
  __syncthreads();
  {
    int i = tid & 127, part = tid >> 7;
    float s = 0.f;
    for (int c = part * 256; c < part * 256 + 256; ++c) s += bf2f(gv[c * 128 + i]);
    st[part * 128 + i] = s;
    __syncthreads();
    float mu = (st[i] + st[128 + i]) * (1.f / 512.f);
    __syncthreads();
    float qv = 0.f;
    for (int c = part * 256; c < part * 256 + 256; ++c) { float d = bf2f(gv[c * 128 + i]) - mu; qv += d * d; }
    st[part * 128 + i] = qv;
    __syncthreads();
    float var = (st[i] + st[128 + i]) * (1.f / 512.f);
    __syncthreads();
    if (part == 0) { st[256 + i] = mu; st[384 + i] = rsqrtf(var + LN_EPS); }
  }
  const float* mu = st + 256;
  const float* rs = st + 384;
  for (int g = 0; g < 4; ++g) {
    __syncthreads();
    const u16* wsrc = ((u16*)(P.ws + OFF_sguW)) + ((size_t)l * 4 + g) * 128 * 128;
    for (int cid = tid; cid < 2048; cid += 256) {
      int r = cid >> 4, c8 = (cid & 15) * 8;
      *(u32x4*)(As + r * LDK + c8) = *(const u32x4*)(wsrc + r * 128 + c8);
      bf16x8 t = *(const bf16x8*)(gv + (size_t)(g * 128 + r) * 128 + c8);
      float lg = P.sgu_ln_g[l * 512 + g * 128 + r], lb = P.sgu_ln_b[l * 512 + g * 128 + r];
      bf16x8 o;
#pragma unroll
      for (int e = 0; e < 8; ++e) o[e] = (short)f2bf((bf2f((u16)t[e]) - mu[c8 + e]) * rs[c8 + e] * lg + lb);
      *(bf16x8*)(Bs + r * LDK + c8) = o;
    }
    __syncthreads();
    f32x4 acc[4][4];
    zero_acc<4>(acc);
    mma_lds<4, 4, true>(As + wr * 64 * LDK, LDK, Bs + wc * 64 * LDK, LDK, 4, acc, fr, fq);
    const float* bs = P.sgu_b + ((size_t)l * 4 + g) * 128;
#pragma unroll
    for (int m = 0; m < 4; ++m) {
      int pp = wr * 64 + m * 16 + fr;
      float bias = bs[pp];
#pragma unroll
      for (int nn = 0; nn < 4; ++nn) {
        int d = wc * 64 + nn * 16 + fq * 4;
        u16* up = ((u16*)(P.ws + OFF_br3)) + (size_t)(hb * HROWS + mt * 128 + pp) * 512 + g * 128 + d;
        bf16x4 uu = *(const bf16x4*)up;
        f32x4 v = acc[m][nn];
        *(bf16x4*)up = pack4((v[0] + bias) * bf2f((u16)uu[0]), (v[1] + bias) * bf2f((u16)uu[1]), (v[2] + bias) * bf2f((u16)uu[2]), (v[3] + bias) * bf2f((u16)uu[3]));
      }
    }
  }
}

DI void attn_item(const Params& P, int l, int hb, int item, char* smem) {
  const int tid = TID(), wave = tid >> 6, lane = tid & 63, fr = lane & 15, fq = lane >> 4;
  const int qt = item % 18, h = (item / 18) & 3, bl = item / 72;
  const bool ctxq = qt >= 16;
  const int key0 = ctxq ? SEQ : 0, nkt = ctxq ? 4 : 36;
  const int hrow_q0 = bl * SP + qt * 128 + wave * 32;
  constexpr int KT = 64 * LDT, VT = 128 * LDT;
  u16* Ks = (u16*)smem;
  u16* Vs = Ks + 2 * KT;
  const float lam = ((float*)(P.ws + OFF_lamv))[l * 2], lam_init = ((float*)(P.ws + OFF_lamv))[l * 2 + 1];
  constexpr float LOG2E = 1.4426950408889634f;
  for (int sub = 0; sub < 2; ++sub) {
    const int hs = 2 * h + sub;
    bf16x8 qf[2][2];
#pragma unroll
    for (int qb = 0; qb < 2; ++qb)
#pragma unroll
      for (int ks = 0; ks < 2; ++ks) qf[qb][ks] = *(const bf16x8*)(((u16*)(P.ws + OFF_q)) + (size_t)(hrow_q0 + qb * 16 + fr) * 512 + hs * 64 + ks * 32 + fq * 8);
    f32x4 ot[8][2];
#pragma unroll
    for (int d = 0; d < 8; ++d) { ot[d][0] = f32x4{0.f, 0.f, 0.f, 0.f}; ot[d][1] = f32x4{0.f, 0.f, 0.f, 0.f}; }
    float mrow[2] = {-INFINITY, -INFINITY}, lrow[2] = {0.f, 0.f};
    const u16* Kg = ((u16*)(P.ws + OFF_k)) + ((size_t)bl * SP + key0) * 512 + hs * 64;
    const u16* Vg = ((u16*)(P.ws + OFF_vT)) + ((size_t)bl * 512 + h * 128) * SP + key0;
    u32x4 rk[2], rv[4];
    const u16* kgp = Kg + (size_t)(tid >> 2) * 512 + (tid & 3) * 16;
    const u16* vgp = Vg + (size_t)(tid >> 1) * SP + (tid & 1) * 32;
    u16* ksp = Ks + (tid >> 2) * LDT + (tid & 3) * 16;
    u16* vsp = Vs + (tid >> 1) * LDT + (tid & 1) * 32;
    auto gload = [&](int t) {
      const u16* kp = kgp + (size_t)t * 64 * 512;
      rk[0] = *(const u32x4*)(kp); rk[1] = *(const u32x4*)(kp + 8);
      const u16* vp = vgp + t * 64;
      rv[0] = *(const u32x4*)(vp); rv[1] = *(const u32x4*)(vp + 8); rv[2] = *(const u32x4*)(vp + 16); rv[3] = *(const u32x4*)(vp + 24);
    };
    auto sstore = [&](int buf) {
      u16* kp = ksp + buf * KT;
      *(u32x4*)(kp) = rk[0]; *(u32x4*)(kp + 8) = rk[1];
      u16* vp = vsp + buf * VT;
      *(u32x4*)(vp) = rv[0]; *(u32x4*)(vp + 8) = rv[1]; *(u32x4*)(vp + 16) = rv[2]; *(u32x4*)(vp + 24) = rv[3];
    };
    gload(0);
    __syncthreads();
    sstore(0);
    __syncthreads();
    for (int t = 0; t < nkt; ++t) {
      const int cur = t & 1;
      if (t + 1 < nkt) gload(t + 1);
      const u16* Kc = Ks + cur * KT;
      const u16* Vc = Vs + cur * VT;
      f32x4 st[4][2];
#pragma unroll
      for (int k4 = 0; k4 < 4; ++k4) { st[k4][0] = f32x4{0.f, 0.f, 0.f, 0.f}; st[k4][1] = f32x4{0.f, 0.f, 0.f, 0.f}; }
#pragma unroll
      for (int k4 = 0; k4 < 4; ++k4)
#pragma unroll
        for (int ks = 0; ks < 2; ++ks) {
          bf16x8 a = *(const bf16x8*)(Kc + (k4 * 16 + fr) * LDT + ks * 32 + fq * 8);
          st[k4][0] = MFMA16(a, qf[0][ks], st[k4][0]);
          st[k4][1] = MFMA16(a, qf[1][ks], st[k4][1]);
          if (ks == 1 && (k4 & 1)) __builtin_amdgcn_sched_barrier(0);
        }
      __builtin_amdgcn_sched_barrier(0);
#pragma unroll
      for (int qb = 0; qb < 2; ++qb) {
        float mx = -INFINITY;
#pragma unroll
        for (int k4 = 0; k4 < 4; ++k4)
#pragma unroll
          for (int j = 0; j < 4; ++j) mx = fmaxf(mx, st[k4][qb][j]);
        mx = fmaxf(mx, __shfl_xor(mx, 16));
        mx = fmaxf(mx, __shfl_xor(mx, 32));
        float mnew = fmaxf(mrow[qb], mx);
        float alpha = __builtin_amdgcn_exp2f((mrow[qb] - mnew) * LOG2E);
        mrow[qb] = mnew;
        float moff = mnew * LOG2E;
        float ps = 0.f;
#pragma unroll
        for (int k4 = 0; k4 < 4; ++k4)
#pragma unroll
          for (int j = 0; j < 4; ++j) { float pv = __builtin_amdgcn_exp2f(st[k4][qb][j] * LOG2E - moff); st[k4][qb][j] = pv; ps += pv; }
        lrow[qb] = lrow[qb] * alpha + ps;
#pragma unroll
        for (int d = 0; d < 8; ++d) { ot[d][qb][0] *= alpha; ot[d][qb][1] *= alpha; ot[d][qb][2] *= alpha; ot[d][qb][3] *= alpha; }
      }
      __builtin_amdgcn_sched_barrier(0);
#pragma unroll
      for (int ks2 = 0; ks2 < 2; ++ks2) {
        bf16x8 pf[2];
#pragma unroll
        for (int qb = 0; qb < 2; ++qb) {
          bf16x4 lo = pack4v(st[2 * ks2][qb]), hi = pack4v(st[2 * ks2 + 1][qb]);
          pf[qb] = __builtin_shufflevector(lo, hi, 0, 1, 2, 3, 4, 5, 6, 7);
        }
#pragma unroll
        for (int d = 0; d < 8; ++d) {
          const u16* vp = Vc + (d * 16 + fr) * LDT + ks2 * 32 + fq * 4;
          bf16x4 lo = *(const bf16x4*)vp, hi = *(const bf16x4*)(vp + 16);
          bf16x8 a = __builtin_shufflevector(lo, hi, 0, 1, 2, 3, 4, 5, 6, 7);
          ot[d][0] = MFMA16(a, pf[0], ot[d][0]);
          ot[d][1] = MFMA16(a, pf[1], ot[d][1]);
          if ((d & 3) == 3) __builtin_amdgcn_sched_barrier(0);
        }
      }
      if (t + 1 < nkt) sstore(cur ^ 1);
      __syncthreads();
    }
#pragma unroll
    for (int qb = 0; qb < 2; ++qb) {
      float lt = lrow[qb];
      lt += __shfl_xor(lt, 16);
      lt += __shfl_xor(lt, 32);
      float inv = 1.f / lt;
      size_t hrow = (size_t)(hrow_q0 + qb * 16 + fr);
      if (sub == 0) {
#pragma unroll
        for (int d = 0; d < 8; ++d) {
          f32x4 v = ot[d][qb];
          *(bf16x4*)(((u16*)(P.ws + OFF_o1)) + hrow * 512 + h * 128 + d * 16 + fq * 4) = pack4(v[0] * inv, v[1] * inv, v[2] * inv, v[3] * inv);
        }
      } else {
        float ss = 0.f;
#pragma unroll
        for (int d = 0; d < 8; ++d) {
          bf16x4 o1v = *(const bf16x4*)(((u16*)(P.ws + OFF_o1)) + hrow * 512 + h * 128 + d * 16 + fq * 4);
#pragma unroll
          for (int j = 0; j < 4; ++j) { float dd = bf2f((u16)o1v[j]) - lam * ot[d][qb][j] * inv; ot[d][qb][j] = dd; ss += dd * dd; }
        }
        ss += __shfl_xor(ss, 16);
        ss += __shfl_xor(ss, 32);
        float rr = rsqrtf(ss * (1.f / 128.f) + LN_EPS) * (1.f - lam_init);
        const float* gn = P.diff_norm_g + l * 128;
#pragma unroll
        for (int d = 0; d < 8; ++d) {
          int dv = d * 16 + fq * 4;
          float4 g4 = *(const float4*)(gn + dv);
          f32x4 v = ot[d][qb];
          *(bf16x4*)(((u16*)(P.ws + OFF_br2)) + ((size_t)hb * HROWS + hrow) * 512 + h * 128 + dv) = pack4(v[0] * rr * g4.x, v[1] * rr * g4.y, v[2] * rr * g4.z, v[3] * rr * g4.w);
        }
      }
    }
  }
}

template <bool TRANS>
DI void conv_stage(const Params& P, int l, const u16* xbase  , int chan0, int n, int p0, u16* dst, int ld, const float* scale) {
  const int tid = TID(), cl = tid & 63, ig = tid >> 6;
  const int ch = chan0 + cl;
  const float* cw = P.conv_w + (size_t)l * 5 * 768 + ch;
  const float w0 = cw[0], w1 = cw[768], w2 = cw[2 * 768], w3 = cw[3 * 768], w4 = cw[4 * 768];
  const float cb = P.conv_b[l * 768 + ch];
  const u16* xc = xbase + ch;
  auto ld1 = [&](int pos) -> float { return (pos >= 0 && pos < n) ? bf2f(xc[(size_t)pos * 768]) : 0.f; };
  int pos = p0 + ig * 32;
  float a = ld1(pos - 2), b = ld1(pos - 1), c = ld1(pos), d = ld1(pos + 1), e = ld1(pos + 2);
  for (int ii = 0; ii < 32; ++ii) {
    float v = w0 * a + w1 * b + w2 * c + w3 * d + w4 * e + cb;
    v = siluf_(v);
    int tok = ig * 32 + ii;
    if (scale) v *= scale[tok];
    if (TRANS) dst[cl * ld + tok] = f2bf(v); else dst[tok * ld + cl] = f2bf(v);
    a = b; b = c; c = d; d = e; e = ld1(pos + ii + 3);
  }
}

DI void ssd_scalars(const Params& P, int l, int hrow0, int h, int dir, float* dts, float* S, float* tmp) {
  const int tid = TID();
  const float aneg = -expf(P.a_log[l * 16 + dir * 8 + h]);
  if (tid < 128) {
    float raw = ((float*)(P.ws + OFF_dtbuf))[(size_t)(hrow0 + tid) * 16 + dir * 8 + h] + P.dt_bias[l * 16 + dir * 8 + h];
    float dt = softplusf_(raw);
    dts[tid] = dt;
    tmp[tid] = dt * aneg;
  }
  __syncthreads();
  if (tid < 128) {
    float s = 0.f;
    if (dir == 0) { for (int i = 0; i <= tid; ++i) s += tmp[i]; }
    else { for (int i = 127; i >= tid; --i) s += tmp[i]; }
    S[tid] = s;
  }
  __syncthreads();
}

constexpr int SSD_STATE_STRIDE = 18 * 4096;
DI void ssd_state_item(const Params& P, int l, int hb, int item, char* smem) {
  const int tid = TID(), wave = tid >> 6, lane = tid & 63, fr = lane & 15, fq = lane >> 4;
  const int dir = item & 1, h = (item >> 1) & 7, jp = (item >> 4) % 18, bl = (item >> 4) / 18;
  const bool lat = jp < 16;
  const int n = lat ? SEQ : CTXL;
  const int p0 = lat ? jp * 128 : (jp - 16) * 128;
  const int seqbase = bl * SP + (lat ? 0 : SEQ);
  const int hrow0 = bl * SP + jp * 128;
  u16* At = (u16*)smem;
  u16* Bt = At + 64 * LDK;
  float* dts = (float*)(Bt + 64 * LDK);
  float* S = dts + 128;
  float* wgt = S + 128;
  __syncthreads();
  ssd_scalars(P, l, hrow0, h, dir, dts, S, wgt);
  const float total = (dir == 0) ? S[127] : S[0];
  __syncthreads();
  if (tid < 128) wgt[tid] = dts[tid] * __expf(total - S[tid]);
  __syncthreads();
  const u16* xb = ((u16*)(P.ws + OFF_xbc)) + (size_t)seqbase * 768;
  conv_stage<true>(P, l, xb, h * 64, n, p0, At, LDK, wgt);
  conv_stage<true>(P, l, xb, 512 + (h >> 2) * 64, n, p0, Bt, LDK, nullptr);
  __syncthreads();
  const int wr = wave >> 1, wc = wave & 1;
  f32x4 acc[2][2];
#pragma unroll
  for (int m = 0; m < 2; ++m) { acc[m][0] = f32x4{0.f, 0.f, 0.f, 0.f}; acc[m][1] = f32x4{0.f, 0.f, 0.f, 0.f}; }
  mma_lds<2, 2, false>(At + wr * 32 * LDK, LDK, Bt + wc * 32 * LDK, LDK, 4, acc, fr, fq);
  float* cs = ((float*)(P.ws + OFF_cstate)) + (((size_t)(bl * 2 + dir) * 8 + h) * 18 + jp) * 4096;
#pragma unroll
  for (int m = 0; m < 2; ++m)
#pragma unroll
    for (int nn = 0; nn < 2; ++nn)
#pragma unroll
      for (int j = 0; j < 4; ++j) cs[(wr * 32 + m * 16 + fq * 4 + j) * 64 + wc * 32 + nn * 16 + fr] = acc[m][nn][j];
  if (tid == 0) ((float*)(P.ws + OFF_decay))[((bl * 2 + dir) * 8 + h) * 18 + jp] = __expf(total);
}

DI void phase_carry(const Params& P) {
  const int total = 8 * 2 * 8 * 4096;
  for (int idx = blockIdx.x * 256 + TID(); idx < total; idx += gridDim.x * 256) {
    int pn = idx & 4095, bdh = idx >> 12;
    int dir = (bdh >> 3) & 1;
    const float* cs = ((float*)(P.ws + OFF_cstate)) + (size_t)bdh * SSD_STATE_STRIDE + pn;
    u16* en = ((u16*)(P.ws + OFF_enter)) + (size_t)bdh * SSD_STATE_STRIDE + pn;
    const float* dc = ((float*)(P.ws + OFF_decay)) + bdh * 18;
    float state = 0.f;
    for (int st = 0; st < 18; ++st) {
      int jp;
      if (dir == 0) jp = st < 2 ? 16 + st : st - 2;
      else jp = st < 2 ? 17 - st : 17 - st;
      en[(size_t)jp * 4096] = f2bf(state);
      state = state * dc[jp] + cs[(size_t)jp * 4096];
    }
  }
}

DI void ssd_out_item(const Params& P, int l, int hb, int item, char* smem) {
  const int tid = TID(), wave = tid >> 6, lane = tid & 63, fr = lane & 15, fq = lane >> 4;
  const int h = item & 7, jp = (item >> 3) % 18, bl = (item >> 3) / 18;
  const bool lat = jp < 16;
  const int n = lat ? SEQ : CTXL;
  const int p0 = lat ? jp * 128 : (jp - 16) * 128;
  const int seqbase = bl * SP + (lat ? 0 : SEQ);
  const int hrow0 = bl * SP + jp * 128;
  u16* Cs = (u16*)smem;
  u16* xT = Cs + 128 * LDT;
  u16* Et = xT + 64 * LDK;
  u16* Un = Et + 64 * LDT;
  float* fs = (float*)(Un + 128 * LDK);
  float* dts = fs;
  float* S = fs + 128;
  float* tmp = fs + 256;
  const int grp = h >> 2;
  __syncthreads();
  const u16* xb = ((u16*)(P.ws + OFF_xbc)) + (size_t)seqbase * 768;
  conv_stage<false>(P, l, xb, 640 + grp * 64, n, p0, Cs, LDT, nullptr);
  conv_stage<false>(P, l, xb, 512 + grp * 64, n, p0, Un, LDT, nullptr);
  conv_stage<true>(P, l, xb, h * 64, n, p0, xT, LDK, nullptr);
  __syncthreads();
  f32x4 cb[2][8];
#pragma unroll
  for (int m = 0; m < 2; ++m)
#pragma unroll
    for (int nn = 0; nn < 8; ++nn) cb[m][nn] = f32x4{0.f, 0.f, 0.f, 0.f};
  mma_lds<2, 8, false>(Cs + wave * 32 * LDT, LDT, Un, LDT, 2, cb, fr, fq);
  f32x4 yacc[2][4];
#pragma unroll
  for (int m = 0; m < 2; ++m)
#pragma unroll
    for (int nn = 0; nn < 4; ++nn) yacc[m][nn] = f32x4{0.f, 0.f, 0.f, 0.f};
  for (int dir = 0; dir < 2; ++dir) {
    __syncthreads();
    ssd_scalars(P, l, hrow0, h, dir, dts, S, tmp);
#pragma unroll
    for (int m = 0; m < 2; ++m)
#pragma unroll
      for (int j = 0; j < 4; ++j) {
        int lrow = wave * 32 + m * 16 + fq * 4 + j;
        float Sl = S[lrow];
#pragma unroll
        for (int nn = 0; nn < 8; ++nn) {
          int s = nn * 16 + fr;
          bool ok = dir == 0 ? (s <= lrow) : (s >= lrow);
          float coef = ok ? __expf(Sl - S[s]) * dts[s] : 0.f;
          Un[lrow * LDK + s] = f2bf(cb[m][nn][j] * coef);
        }
      }
    {
      const u16* en = ((u16*)(P.ws + OFF_enter)) + (((size_t)(bl * 2 + dir) * 8 + h) * 18 + jp) * 4096;
      for (int cid = tid; cid < 512; cid += 256) {
        int pr = cid >> 3, c8 = (cid & 7) * 8;
        *(u32x4*)(Et + pr * LDT + c8) = *(const u32x4*)(en + pr * 64 + c8);
      }
    }
    __syncthreads();
    mma_lds<2, 4, true>(Un + wave * 32 * LDK, LDK, xT, LDK, 4, yacc, fr, fq);
    f32x4 yi[2][4];
#pragma unroll
    for (int m = 0; m < 2; ++m)
#pragma unroll
      for (int nn = 0; nn < 4; ++nn) yi[m][nn] = f32x4{0.f, 0.f, 0.f, 0.f};
    mma_lds<2, 4, true>(Cs + wave * 32 * LDT, LDT, Et, LDT, 2, yi, fr, fq);
#pragma unroll
    for (int m = 0; m < 2; ++m) {
      float e = __expf(S[wave * 32 + m * 16 + fr]);
#pragma unroll
      for (int nn = 0; nn < 4; ++nn)
#pragma unroll
        for (int j = 0; j < 4; ++j) yacc[m][nn][j] += e * yi[m][nn][j];
    }
  }
  const float dsk = P.ssd_d[l * 8 + h];
  const float* gn = P.ssd_norm_g + l * 512 + h * 64;
#pragma unroll
  for (int m = 0; m < 2; ++m) {
    int lrow = wave * 32 + m * 16 + fr;
    float ss = 0.f;
#pragma unroll
    for (int nn = 0; nn < 4; ++nn) {
      int pc = nn * 16 + fq * 4;
      bf16x4 zz = *(const bf16x4*)(((u16*)(P.ws + OFF_z)) + (size_t)(hrow0 + lrow) * 512 + h * 64 + pc);
      float4 g4 = *(const float4*)(gn + pc);
      float gg[4] = {g4.x, g4.y, g4.z, g4.w};
      float o[4];
#pragma unroll
      for (int j = 0; j < 4; ++j) {
        float y = yacc[m][nn][j] + dsk * bf2f(xT[(pc + j) * LDK + lrow]);
        y *= siluf_(bf2f((u16)zz[j]));
        ss += y * y;
        o[j] = y * gg[j];
      }
      *(bf16x4*)(((u16*)(P.ws + OFF_br1)) + ((size_t)hb * HROWS + hrow0 + lrow) * 512 + h * 64 + pc) = pack4(o[0], o[1], o[2], o[3]);
    }
    ss += __shfl_xor(ss, 16);
    ss += __shfl_xor(ss, 32);
    if (fq == 0) ((float*)(P.ws + OFF_ssq))[((size_t)hb * HROWS + hrow0 + lrow) * 8 + h] = ss;
  }
}

DI void merge_tile(const Params& P, int l, int mt, int nt, char* smem) {
  const int tid = TID(), wave = tid >> 6, lane = tid & 63, fr = lane & 15, fq = lane >> 4;
  const int wr = wave >> 1, wc = wave & 1;
  const int row0 = mt * 128;
  f32x4 accS[4][2];
  zero_acc<2>(accS);
  const u16* brs[4] = {((u16*)(P.ws + OFF_br0)), ((u16*)(P.ws + OFF_br1)), ((u16*)(P.ws + OFF_br2)), ((u16*)(P.ws + OFF_br3))};
#pragma unroll 1
  for (int kq = 0; kq < 4; ++kq) {
    f32x4 g[4][2];
    zero_acc<2>(g);
    gemm_main<2, true, false>(((u16*)(P.ws + OFF_H)), DM, nullptr, row0, ((u16*)(P.ws + OFF_WgT)) + ((size_t)l * 4 + kq) * 1024 * 1024, 1024, nt * 64, 1024, g, (u16*)smem);
#pragma unroll
    for (int m = 0; m < 4; ++m)
#pragma unroll
      for (int n = 0; n < 2; ++n)
#pragma unroll
        for (int j = 0; j < 4; ++j) g[m][n][j] = sigmoidf_(g[m][n][j]);
    f32x4 bb[4][2];
    zero_acc<2>(bb);
    const u16* br = kq == 0 ? ((u16*)(P.ws + OFF_br0)) : (kq == 1 ? ((u16*)(P.ws + OFF_br1)) : (kq == 2 ? ((u16*)(P.ws + OFF_br2)) : ((u16*)(P.ws + OFF_br3))));
    gemm_main<2, true, false>(br, 512, nullptr, row0, ((u16*)(P.ws + OFF_WbT)) + ((size_t)l * 4 + kq) * 1024 * 512, 512, nt * 64, 512, bb, (u16*)smem);
#pragma unroll
    for (int m = 0; m < 4; ++m) {
      float rs = 1.f;
      if (kq == 1) {
        const float* sq = ((float*)(P.ws + OFF_ssq)) + (size_t)(row0 + wr * 64 + m * 16 + fr) * 8;
        float4 a = *(const float4*)sq, b = *(const float4*)(sq + 4);
        rs = rsqrtf((a.x + a.y + a.z + a.w + b.x + b.y + b.z + b.w) * (1.f / 512.f) + LN_EPS);
      }
#pragma unroll
      for (int n = 0; n < 2; ++n)
#pragma unroll
        for (int j = 0; j < 4; ++j) accS[m][n][j] += g[m][n][j] * bb[m][n][j] * rs;
    }
  }
  (void)brs;
#pragma unroll
  for (int m = 0; m < 4; ++m)
#pragma unroll
    for (int n = 0; n < 2; ++n) {
      int r = row0 + wr * 64 + m * 16 + fr, c = nt * 64 + wc * 32 + n * 16 + fq * 4;
      *(bf16x4*)(((u16*)(P.ws + OFF_acc)) + (size_t)r * DM + c) = pack4v(accS[m][n]);
    }
}

DI void phase_merge(const Params& P, int l, char* smem) {
  const bool last = (l == 1);
  for (int it = blockIdx.x; it < 288 * 16; it += gridDim.x) {
    int mt = it / 16, nt = it % 16;
    if (last && (mt % 18) >= 16) continue;
    merge_tile(P, l, mt, nt, smem);
  }
}

DI void phase_outproj(const Params& P, int l, char* smem) {
  const bool last = (l == 1);
  const int tid = TID(), wave = tid >> 6, lane = tid & 63, fr = lane & 15, fq = lane >> 4;
  const int wr = wave >> 1, wc = wave & 1;
  for (int it = blockIdx.x; it < 288 * 8; it += gridDim.x) {
    int mt = it / 8, nt = it % 8;
    if (last && (mt % 18) >= 16) continue;
    f32x4 acc[4][4];
    zero_acc<4>(acc);
    gemm_main<4, true, false>(((u16*)(P.ws + OFF_acc)), DM, nullptr, mt * 128, ((u16*)(P.ws + OFF_WoT)) + (size_t)l * 1024 * 1024, 1024, nt * 128, 1024, acc, (u16*)smem);
#pragma unroll
    for (int m = 0; m < 4; ++m)
#pragma unroll
      for (int n = 0; n < 4; ++n) {
        int r = mt * 128 + wr * 64 + m * 16 + fr, c = nt * 128 + wc * 64 + n * 16 + fq * 4;
        *(bf16x4*)(((u16*)(P.ws + OFF_Y)) + (size_t)r * DM + c) = pack4v(acc[m][n]);
      }
  }
}

DI void phase_ffn1(const Params& P, int l, char* smem) {
  const bool last = (l == 1);
  const int tid = TID(), wave = tid >> 6, lane = tid & 63, fr = lane & 15, fq = lane >> 4;
  const int wr = wave >> 1, wc = wave & 1;
  const int nmt = last ? 512 : 576;
  for (int it = blockIdx.x; it < nmt * 8; it += gridDim.x) {
    int mt = it / 8, nt = it % 8;
    int R0 = mt * 128;
    int e = R0 < NFFN_LAT ? (R0 >> 8) & 15 : (R0 - NFFN_LAT) >> 9;
    f32x4 acc[4][4];
    zero_acc<4>(acc);
    gemm_main<4, true, true>(((u16*)(P.ws + OFF_H)), DM, ((int*)(P.ws + OFF_tokidx)), R0, ((u16*)(P.ws + OFF_W13T)) + (size_t)e * 1024 * 1024, 1024, nt * 128, 1024, acc, (u16*)smem);
#pragma unroll
    for (int m = 0; m < 4; ++m)
#pragma unroll
      for (int n2 = 0; n2 < 2; ++n2) {
        int r = R0 + wr * 64 + m * 16 + fr;
        int hc = (nt * 4 + wc * 2 + n2) * 16 + fq * 4;
        f32x4 a = acc[m][2 * n2], b = acc[m][2 * n2 + 1];
        *(bf16x4*)(((u16*)(P.ws + OFF_hid)) + (size_t)r * 512 + hc) = pack4(siluf_(a[0]) * b[0], siluf_(a[1]) * b[1], siluf_(a[2]) * b[2], siluf_(a[3]) * b[3]);
      }
  }
}

DI void phase_ffn2(const Params& P, int l, char* smem) {
  const bool last = (l == 1);
  const int tid = TID(), wave = tid >> 6, lane = tid & 63, fr = lane & 15, fq = lane >> 4;
  const int wr = wave >> 1, wc = wave & 1;
  const int nmt = last ? 512 : 576;
  for (int it = blockIdx.x; it < nmt * 8; it += gridDim.x) {
    int mt = it / 8, nt = it % 8;
    int R0 = mt * 128;
    int e = R0 < NFFN_LAT ? (R0 >> 8) & 15 : (R0 - NFFN_LAT) >> 9;
    f32x4 acc[4][4];
    zero_acc<4>(acc);
    gemm_main<4, true, false>(((u16*)(P.ws + OFF_hid)), 512, nullptr, R0, ((u16*)(P.ws + OFF_W2T)) + (size_t)e * 1024 * 512, 512, nt * 128, 512, acc, (u16*)smem);
#pragma unroll
    for (int m = 0; m < 4; ++m) {
      int r = R0 + wr * 64 + m * 16 + fr;
      float gt = ((float*)(P.ws + OFF_gatev))[r];
#pragma unroll
      for (int n = 0; n < 4; ++n) {
        int c = nt * 128 + wc * 64 + n * 16 + fq * 4;
        f32x4 v = acc[m][n];
        *(bf16x4*)(((u16*)(P.ws + OFF_ye)) + (size_t)r * DM + c) = pack4(v[0] * gt, v[1] * gt, v[2] * gt, v[3] * gt);
      }
    }
  }
}

DI void phase_mix2(const Params& P, int l, int hb, char* smem) {
  const bool last = (l == 1);
  const int G = gridDim.x;
  for (int it = blockIdx.x; it < 576; it += G) {
    if (last && (it % 18) >= 16) continue;
    attn_item(P, l, hb, it, smem);
  }
  const int b2 = G - 1 - blockIdx.x;
  for (int it = b2; it < 2304; it += G) ssd_state_item(P, l, hb, it, smem);
  for (int it = b2; it < 576; it += G) {
    int mt = it >> 2, g = it & 3;
    if (last && (mt % 18) >= 16) continue;
    pool_item(P, l, hb, mt, g, smem);
  }
  for (int mt = b2; mt < 144; mt += G) {
    if (last && (mt % 18) >= 16) continue;
    sgu_item(P, l, hb, mt, smem);
  }
}

DI void phase_ssd_out(const Params& P, int l, int hb, char* smem) {
  const bool last = (l == 1);
  for (int it = blockIdx.x; it < 8 * 18 * 8; it += gridDim.x) {
    int jp = (it >> 3) % 18;
    if (last && jp >= 16) continue;
    ssd_out_item(P, l, hb, it, smem);
  }
}

#define XB_TMO      128
#define XB_XCNT(j)  (256  + 64 * (j))
#define XB_XSUB(j)  (1280 + 64 * (j))
#define XB_XGEN(j)  (2304 + 64 * (j))
#define XB_TOP      3328
#define XB_TOPGEN   3392
#define XCD_BAR_WORDS 3456
#define XB_SPIN_CAP (1u << 18)
#define LAS __attribute__((address_space(3)))

__device__ __forceinline__ unsigned xb_ld(unsigned* p)              { return __hip_atomic_load(p, __ATOMIC_RELAXED, __HIP_MEMORY_SCOPE_AGENT); }
__device__ __forceinline__ unsigned xb_add(unsigned* p, unsigned v) { return __hip_atomic_fetch_add(p, v, __ATOMIC_RELAXED, __HIP_MEMORY_SCOPE_AGENT); }
__device__ __forceinline__ unsigned xb_xcc_id() { return (unsigned)__builtin_amdgcn_s_getreg((3 << 11) | 20) & 0xFu; }
#define XB_SPIN(cond, bar) do { unsigned _sp = 0; while (cond) { __builtin_amdgcn_s_sleep(1); \
    if ((++_sp & 255u) == 0u) { if (xb_ld(&(bar)[XB_TMO])) break; if (_sp > XB_SPIN_CAP) { atomicAdd(&(bar)[XB_TMO], 1u); break; } } } } while (0)

struct XcdBarrier {
    unsigned* bar; unsigned x;
    volatile LAS unsigned* st;
};

__device__ __forceinline__ XcdBarrier xcd_barrier_post(unsigned* bar, volatile LAS unsigned* st) {
    XcdBarrier b; b.bar = bar; b.x = xb_xcc_id(); b.st = st;
    if (threadIdx.x == 0) (void)xb_add(&bar[XB_XCNT(b.x)], 1u);
    return b;
}
__device__ __forceinline__ void xcd_barrier_complete(unsigned* bar, unsigned x, unsigned& nloc, unsigned& nx) {
    const unsigned G = gridDim.x * gridDim.y * gridDim.z;
    unsigned sum, cnt, mine, sp = 0u;
    for (;;) {
        sum = 0u; cnt = 0u; mine = 0u;
#pragma unroll
        for (unsigned j = 0; j < 16; ++j) { const unsigned c = xb_ld(&bar[XB_XCNT(j)]); sum += c; cnt += (c > 0u) ? 1u : 0u; mine = (j == x) ? c : mine; }
        if (sum == G) break;
        __builtin_amdgcn_s_sleep(1);
        if ((++sp & 255u) == 0u) { if (xb_ld(&bar[XB_TMO])) break; if (sp > XB_SPIN_CAP) { atomicAdd(&bar[XB_TMO], 1u); break; } }
    }
    nloc = mine > 0u ? mine : 1u; nx = cnt > 0u ? cnt : 1u;
}

__device__ __forceinline__ void xcd_barrier(const XcdBarrier& b) {
    asm volatile("s_waitcnt vmcnt(0)" ::: "memory");
    __syncthreads();
    if (threadIdx.x == 0) {
        unsigned* bar = b.bar;
        __builtin_amdgcn_s_waitcnt(0);
        unsigned nloc = b.st[0], nx = b.st[1];
        if (nloc == 0u) { xcd_barrier_complete(bar, b.x, nloc, nx); b.st[0] = nloc; b.st[1] = nx; }
        const unsigned old = xb_add(&bar[XB_XSUB(b.x)], 1u);
        const unsigned gen = old / nloc;
        if (old + 1u == (gen + 1u) * nloc) {
            __builtin_amdgcn_fence(__ATOMIC_RELEASE, "agent");
            asm volatile("s_waitcnt vmcnt(0)" ::: "memory");
            const unsigned og = xb_add(&bar[XB_TOP], 1u);
            const unsigned tg = og / nx;
            if (og + 1u == (tg + 1u) * nx) xb_add(&bar[XB_TOPGEN], 1u);
            else XB_SPIN(xb_ld(&bar[XB_TOPGEN]) == tg, bar);
            __builtin_amdgcn_fence(__ATOMIC_ACQUIRE, "agent");
            xb_add(&bar[XB_XGEN(b.x)], 1u);
            asm volatile("s_waitcnt vmcnt(0)" ::: "memory");
        } else {
            XB_SPIN(xb_ld(&bar[XB_XGEN(b.x)]) == gen, bar);
            __builtin_amdgcn_fence(__ATOMIC_ACQUIRE, "agent");
            asm volatile("s_waitcnt vmcnt(0)" ::: "memory");
        }
    }
    __syncthreads();
}


template <bool COOP>
__global__ void __launch_bounds__(256, 2) mk_forward(Params P, int ph_begin, int ph_end) {
  __shared__ __attribute__((aligned(16))) char smem[SMEM_BYTES];
  int ph = 0;
  volatile LAS unsigned* xbst = (volatile LAS unsigned*)(smem + SMEM_BYTES - 16);
  XcdBarrier xb;
  if (COOP) {
    if (__builtin_amdgcn_workitem_id_x() == 0) { xbst[0] = 0u; xbst[1] = 0u; xbst[2] = 0u; xbst[3] = 0u; }
    __syncthreads();
    xb = xcd_barrier_post((unsigned*)(P.ws + OFF_bar), xbst);
  }
#define PHASE(code)                                         \
  {                                                         \
    if (ph >= ph_begin && ph < ph_end) { code; }            \
    ++ph;                                                   \
    if (COOP && ph > ph_begin && ph < ph_end) {             \
      if (ph == 1) cg::this_grid().sync();                  \
      else xcd_barrier(xb);                                 \
    }                                                       \
  }
  PHASE(phase_prologue(P, smem));
  PHASE(phase_h0(P));
  for (int l = 0; l < 2; ++l) {
    for (int hb = 0; hb < 2; ++hb) {
      PHASE(phase_proj(P, l, hb, smem));
      PHASE(phase_mix2(P, l, hb, smem));
      PHASE(phase_carry(P));
      PHASE(phase_ssd_out(P, l, hb, smem));
    }
    PHASE(phase_merge(P, l, smem));
    PHASE(phase_outproj(P, l, smem));
    PHASE(phase_ln1(P, l, smem));
    PHASE(phase_topk(P, l, smem));
    PHASE(phase_ffn1(P, l, smem));
    PHASE(phase_ffn2(P, l, smem));
    PHASE(phase_ln2(P, l));
  }
#undef PHASE
}

#ifndef MK_COOP
#define MK_COOP 1
#endif

extern "C" void kernel_launch(void* const* d_in, const int* in_sizes, int n_in, void* d_out, int out_size, void* d_ws, size_t ws_size,
                              hipStream_t stream) {
  Params p{};
  const float* const* in = (const float* const*)d_in;
  p.x = in[0]; p.c = in[1]; p.ctx = in[2]; p.c_ctx = in[3]; p.w_mod = in[4]; p.b_mod = in[5]; p.w_in = in[6]; p.conv_w = in[7];
  p.conv_b = in[8]; p.a_log = in[9]; p.dt_bias = in[10]; p.ssd_d = in[11]; p.ssd_norm_g = in[12]; p.diff_lambda = in[13];
  p.diff_norm_g = in[14]; p.pool_w = in[15]; p.pool_scale = in[16]; p.sgu_ln_g = in[17]; p.sgu_ln_b = in[18]; p.sgu_w = in[19];
  p.sgu_b = in[20]; p.w_gate = in[21]; p.w_branch = in[22]; p.w_out = in[23]; p.ln1_g = in[24]; p.ln1_b = in[25]; p.w_router = in[26];
  p.w1 = in[27]; p.w3 = in[28]; p.w2 = in[29]; p.ln2_g = in[30]; p.ln2_b = in[31];
  p.out = (float*)d_out;
  p.ws = (char*)d_ws;
  if (WS_NEED > ws_size) { fprintf(stderr, "workspace too small: need %zu have %zu\n", (size_t)WS_NEED, ws_size); return; }

  static int grid_blocks = 0;
  if (!grid_blocks) {
    int dev = 0, cus = 0, per_cu = 0;
    hipGetDevice(&dev);
    hipDeviceGetAttribute(&cus, hipDeviceAttributeMultiprocessorCount, dev);
    if (MK_COOP) hipOccupancyMaxActiveBlocksPerMultiprocessor(&per_cu, mk_forward<true>, 256, 0);
    else hipOccupancyMaxActiveBlocksPerMultiprocessor(&per_cu, mk_forward<false>, 256, 0);
    if (per_cu < 1) per_cu = 1;
    if (per_cu > 2) per_cu = 2;
    grid_blocks = cus * per_cu;
  }
#if MK_COOP
  hipMemsetAsync((char*)d_ws + OFF_bar, 0, 16384, stream);
  int b = 0, e = NPHASE;
  void* args[] = {&p, &b, &e};
  hipError_t err = hipLaunchCooperativeKernel((void*)mk_forward<true>, dim3(grid_blocks), dim3(256), args, 0, stream);
  if (err != hipSuccess) fprintf(stderr, "cooperative launch failed: %s (grid %d)\n", hipGetErrorString(err), grid_blocks);
#else
  for (int ph = 0; ph < NPHASE; ++ph) hipLaunchKernelGGL(mk_forward<false>, dim3(grid_blocks), dim3(256), 0, stream, p, ph, ph + 1);
#endif
}
```

```cpp
#include <hip/hip_runtime.h>
#include <hip/hip_cooperative_groups.h>
#include <cstdio>
#include <cstdint>
namespace cg = cooperative_groups;

typedef unsigned short u16;
using bf16x8 = __attribute__((ext_vector_type(8))) short;
using bf16x4 = __attribute__((ext_vector_type(4))) short;
using f32x4 = __attribute__((ext_vector_type(4))) float;
using u32x4 = __attribute__((ext_vector_type(4))) unsigned;

#define DI __device__ __forceinline__
#define MFMA16(a, b, c) __builtin_amdgcn_mfma_f32_16x16x32_bf16((a), (b), (c), 0, 0, 0)

constexpr int NB = 16, SEQ = 2048, CTXL = 256, SP = 2304, NTOK = NB * SP, DM = 1024;
constexpr int HROWS = 8 * SP;
constexpr int INC = 4368, INP = 4480;
constexpr int NFFN_LAT = 65536, NFFN_ALL = 73728;
constexpr float LN_EPS = 1e-5f;
constexpr float ALPHA = 1.41421356237309515f;
constexpr int SMEM_BYTES = 81920;
constexpr int NPHASE = 2 + 2 * (2 * 4 + 7);


constexpr size_t al256(size_t x) { return (x + 255) & ~(size_t)255; }
constexpr size_t U_ = (size_t)NTOK * 512 * 2;
constexpr size_t OFF_WinT = 0;
constexpr size_t OFF_WgT = OFF_WinT + al256((size_t)2 * INP * 1024 * 2);
constexpr size_t OFF_WbT = OFF_WgT + al256((size_t)2 * 4 * 1024 * 1024 * 2);
constexpr size_t OFF_WoT = OFF_WbT + al256((size_t)2 * 4 * 1024 * 512 * 2);
constexpr size_t OFF_poolT = OFF_WoT + al256((size_t)2 * 1024 * 1024 * 2);
constexpr size_t OFF_sguW = OFF_poolT + al256((size_t)2 * 4 * 128 * 128 * 2);
constexpr size_t OFF_mod = OFF_sguW + al256((size_t)2 * 4 * 128 * 128 * 2);
constexpr size_t OFF_rope = OFF_mod + al256((size_t)2 * 17 * 6144 * 4);
constexpr size_t OFF_lamv = OFF_rope + al256(64 * 16 * 2 * 4);
constexpr size_t OFF_bar = OFF_lamv + 256;
constexpr size_t OFF_aff = OFF_bar + 16384;
constexpr size_t OFF_rank = OFF_aff + al256((size_t)NTOK * 16 * 4);
constexpr size_t OFF_ssq = OFF_rank + al256((size_t)NTOK * 16 * 4);
constexpr size_t OFF_tokidx = OFF_ssq + al256((size_t)NTOK * 8 * 4);
constexpr size_t OFF_gatev = OFF_tokidx + al256((size_t)NFFN_ALL * 4);
constexpr size_t OFF_dtbuf = OFF_gatev + al256((size_t)NFFN_ALL * 4);
constexpr size_t OFF_decay = OFF_dtbuf + al256((size_t)HROWS * 16 * 4);
constexpr size_t OFF_H = OFF_decay + al256((size_t)8 * 2 * 8 * 18 * 4);
constexpr size_t OFF_Y = OFF_H + 2 * U_;
constexpr size_t OFF_o1 = OFF_Y;
constexpr size_t OFF_cstate = OFF_Y + U_ / 2;
constexpr size_t OFF_enter = OFF_Y + U_ / 2 + U_;
constexpr size_t OFF_RM = OFF_Y + 2 * U_;
constexpr size_t OFF_xp = OFF_RM;
constexpr size_t OFF_z = OFF_xp + U_ / 2;
constexpr size_t OFF_xbc = OFF_z + U_ / 2;
constexpr size_t OFF_q = OFF_xbc + (U_ / 4) * 3;
constexpr size_t OFF_k = OFF_q + U_ / 2;
constexpr size_t OFF_vT = OFF_k + U_ / 2;
constexpr size_t OFF_gvT = OFF_vT + U_ / 2;
constexpr size_t OFF_br0 = OFF_gvT + U_ / 2;
constexpr size_t OFF_br1 = OFF_br0 + U_;
constexpr size_t OFF_br2 = OFF_br1 + U_;
constexpr size_t OFF_br3 = OFF_br2 + U_;
constexpr size_t OFF_acc = OFF_RM;
constexpr size_t OFF_W13T = OFF_RM;
constexpr size_t OFF_W2T = OFF_W13T + (size_t)16 * 1024 * 1024 * 2;
constexpr size_t OFF_hid = OFF_W2T + (size_t)16 * 1024 * 512 * 2;
constexpr size_t OFF_ye = OFF_hid + (size_t)NFFN_ALL * 512 * 2;
constexpr size_t WS_MIX_END = OFF_br3 + U_;
constexpr size_t WS_FFN_END = OFF_ye + (size_t)NFFN_ALL * 1024 * 2;
constexpr size_t WS_NEED = WS_MIX_END > WS_FFN_END ? WS_MIX_END : WS_FFN_END;

struct Params {
  const float *x, *c, *ctx, *c_ctx, *w_mod, *b_mod, *w_in, *conv_w, *conv_b, *a_log, *dt_bias, *ssd_d, *ssd_norm_g,
      *diff_lambda, *diff_norm_g, *pool_w, *pool_scale, *sgu_ln_g, *sgu_ln_b, *sgu_w, *sgu_b, *w_gate, *w_branch, *w_out,
      *ln1_g, *ln1_b, *w_router, *w1, *w3, *w2, *ln2_g, *ln2_b;
  float* out;
  char* ws;
};

DI int TID() { int t = (int)__builtin_amdgcn_workitem_id_x(); asm volatile("" : "+v"(t)); return t; }
DI u16 f2bf(float x) { unsigned u = __float_as_uint(x); u += 0x7fffu + ((u >> 16) & 1u); return (u16)(u >> 16); }
DI float bf2f(u16 v) { return __uint_as_float(((unsigned)v) << 16); }
DI float sigmoidf_(float x) { return 1.f / (1.f + __expf(-x)); }
DI float siluf_(float x) { return x / (1.f + __expf(-x)); }
DI float geluf_(float x) { float y = 0.7978845608028654f * (x + 0.044715f * x * x * x); float t = 1.f - 2.f / (__expf(2.f * y) + 1.f); return 0.5f * x * (1.f + t); }
DI float softplusf_(float x) { return x > 20.f ? x : log1pf(__expf(x)); }
DI bf16x4 pack4(float a, float b, float c, float d) { bf16x4 r; r[0] = (short)f2bf(a); r[1] = (short)f2bf(b); r[2] = (short)f2bf(c); r[3] = (short)f2bf(d); return r; }
DI bf16x4 pack4v(f32x4 v) { return pack4(v[0], v[1], v[2], v[3]); }
DI float wave_sum(float v) { for (int o = 32; o > 0; o >>= 1) v += __shfl_xor(v, o); return v; }

template <int MI, int NI, bool SWAP>
DI void mma_lds(const u16* As, int lda, const u16* Bs, int ldb, int ksteps, f32x4 (&acc)[MI][NI], int fr, int fq) {
  for (int ks = 0; ks < ksteps; ++ks) {
    bf16x8 a[MI], b[NI];
#pragma unroll
    for (int m = 0; m < MI; ++m) a[m] = *(const bf16x8*)(As + (m * 16 + fr) * lda + ks * 32 + fq * 8);
#pragma unroll
    for (int n = 0; n < NI; ++n) b[n] = *(const bf16x8*)(Bs + (n * 16 + fr) * ldb + ks * 32 + fq * 8);
#pragma unroll
    for (int m = 0; m < MI; ++m)
#pragma unroll
      for (int n = 0; n < NI; ++n) acc[m][n] = SWAP ? MFMA16(b[n], a[m], acc[m][n]) : MFMA16(a[m], b[n], acc[m][n]);
  }
}

constexpr int LDT = 72;
template <int NI, bool SWAP, bool GATHER>
DI void gemm_main(const u16* __restrict__ A, int lda, const int* __restrict__ aidx, int arow0, const u16* __restrict__ Bt, int ldb, int brow0,
                  int K, f32x4 (&acc)[4][NI], u16* smem) {
  constexpr int BN = NI * 32;
  constexpr int NBL = BN / 32;
  const int tid = TID(), wave = tid >> 6, lane = tid & 63, fr = lane & 15, fq = lane >> 4;
  const int wr = wave >> 1, wc = wave & 1;
  u16* As = smem;
  u16* Bs = smem + 2 * 128 * LDT;
  const int lr = tid >> 3, lc = (tid & 7) * 8;
  const u16* ap[4];
#pragma unroll
  for (int i = 0; i < 4; ++i) {
    int r = arow0 + lr + 32 * i;
    size_t rr = GATHER ? (size_t)aidx[r] : (size_t)r;
    ap[i] = A + rr * lda + lc;
  }
  const u16* bp = Bt + (size_t)(brow0 + lr) * ldb + lc;
  u32x4 ra[4], rb[NBL];
  const int nk = K / 64;
#pragma unroll
  for (int i = 0; i < 4; ++i) ra[i] = *(const u32x4*)(ap[i]);
#pragma unroll
  for (int i = 0; i < NBL; ++i) rb[i] = *(const u32x4*)(bp + (size_t)(32 * i) * ldb);
  __syncthreads();
#pragma unroll
  for (int i = 0; i < 4; ++i) *(u32x4*)(As + (lr + 32 * i) * LDT + lc) = ra[i];
#pragma unroll
  for (int i = 0; i < NBL; ++i) *(u32x4*)(Bs + (lr + 32 * i) * LDT + lc) = rb[i];
  __syncthreads();
  for (int kt = 0; kt < nk; ++kt) {
    const int cur = kt & 1;
    if (kt + 1 < nk) {
      const int ko = (kt + 1) * 64;
#pragma unroll
      for (int i = 0; i < 4; ++i) ra[i] = *(const u32x4*)(ap[i] + ko);
#pragma unroll
      for (int i = 0; i < NBL; ++i) rb[i] = *(const u32x4*)(bp + (size_t)(32 * i) * ldb + ko);
    }
    mma_lds<4, NI, SWAP>(As + cur * 128 * LDT + wr * 64 * LDT, LDT, Bs + cur * BN * LDT + wc * (NI * 16) * LDT, LDT, 2, acc, fr, fq);
    if (kt + 1 < nk) {
      const int nx = cur ^ 1;
#pragma unroll
      for (int i = 0; i < 4; ++i) *(u32x4*)(As + nx * 128 * LDT + (lr + 32 * i) * LDT + lc) = ra[i];
#pragma unroll
      for (int i = 0; i < NBL; ++i) *(u32x4*)(Bs + nx * BN * LDT + (lr + 32 * i) * LDT + lc) = rb[i];
    }
    __syncthreads();
  }
}

template <int NI> DI void zero_acc(f32x4 (&a)[4][NI]) {
#pragma unroll
  for (int m = 0; m < 4; ++m)
#pragma unroll
    for (int n = 0; n < NI; ++n) a[m][n] = f32x4{0.f, 0.f, 0.f, 0.f};
}

DI void cvt_tile(const float* __restrict__ src0, const float* __restrict__ src1, int ld, u16* __restrict__ dst, int K, int n0, int k0, int mode, u16* lds) {
  const int tid = TID();
  constexpr int LC = 66;
  __syncthreads();
  if (mode == 3) {
    for (int idx = tid; idx < 4096; idx += 256) {
      int n = idx >> 6, kk = idx & 63;
      lds[kk * LC + n] = f2bf(src0[(size_t)(n0 + n) * ld + k0 + kk]);
    }
  } else {
    for (int idx = tid; idx < 4096; idx += 256) {
      int kk = idx >> 6, n = idx & 63;
      int nn = n0 + n;
      float v = 0.f;
      if (mode == 0) v = src0[(size_t)(k0 + kk) * ld + nn];
      else if (mode == 1) {
        int col = nn < 1792 ? nn : (nn < 4352 ? nn + 16 : (nn < 4368 ? nn - 4352 + 1792 : -1));
        if (col >= 0) v = src0[(size_t)(k0 + kk) * ld + col];
        if (nn >= 1792 && nn < 2304) v *= 0.125f;
      } else {
        int g = nn >> 5, r = nn & 31;
        v = (r < 16) ? src0[(size_t)(k0 + kk) * ld + g * 16 + r] : src1[(size_t)(k0 + kk) * ld + g * 16 + r - 16];
      }
      lds[kk * LC + n] = f2bf(v);
    }
  }
  __syncthreads();
  for (int c = tid; c < 512; c += 256) {
    int n = c & 63, kc = (c >> 6) * 8;
    bf16x8 o;
#pragma unroll
    for (int j = 0; j < 8; ++j) o[j] = (short)lds[(kc + j) * LC + n];
    *(bf16x8*)(dst + (size_t)(n0 + n) * K + k0 + kc) = o;
  }
}

DI void mod_item(const Params& P, int item, char* smem) {
  const int l = item / 96, n0 = (item % 96) * 64;
  float* sc = (float*)smem;
  const int tid = TID();
  __syncthreads();
  for (int i = tid; i < 17 * 1024; i += 256) {
    int s = i >> 10, kk = i & 1023;
    float v = s < 16 ? P.c[s * 1024 + kk] : P.c_ctx[kk];
    sc[i] = siluf_(v);
  }
  __syncthreads();
  const int col = tid & 63, kp = tid >> 6;
  float a[17];
#pragma unroll
  for (int s = 0; s < 17; ++s) a[s] = 0.f;
  const float* w = P.w_mod + (size_t)l * 1024 * 6144 + n0 + col;
  for (int kk = kp * 256; kk < kp * 256 + 256; ++kk) {
    float wv = w[(size_t)kk * 6144];
#pragma unroll
    for (int s = 0; s < 17; ++s) a[s] += sc[s * 1024 + kk] * wv;
  }
  __syncthreads();
  float* red = (float*)smem;
#pragma unroll
  for (int s = 0; s < 17; ++s) red[(kp * 17 + s) * 64 + col] = a[s];
  __syncthreads();
  for (int i = tid; i < 17 * 64; i += 256) {
    int s = i >> 6, cc = i & 63;
    float v = red[(0 * 17 + s) * 64 + cc] + red[(1 * 17 + s) * 64 + cc] + red[(2 * 17 + s) * 64 + cc] + red[(3 * 17 + s) * 64 + cc];
    ((float*)(P.ws + OFF_mod))[((size_t)l * 17 + s) * 6144 + n0 + cc] = v + P.b_mod[l * 6144 + n0 + cc];
  }
}

DI void misc_item(const Params& P) {
  const int tid = TID();
  for (int i = tid; i < 1024; i += 256) {
    int pos = i >> 4, f = i & 15;
    float inv = powf(10000.f, -(float)f / 16.f);
    float ang = (float)pos * inv;
    ((float*)(P.ws + OFF_rope))[i * 2] = cosf(ang);
    ((float*)(P.ws + OFF_rope))[i * 2 + 1] = sinf(ang);
  }
  if (tid < 2) {
    const float* dl = P.diff_lambda + tid * 256;
    float s1 = 0.f, s2 = 0.f;
    for (int i = 0; i < 64; ++i) { s1 += dl[i] * dl[64 + i]; s2 += dl[128 + i] * dl[192 + i]; }
    float lam_init = 0.8f - 0.6f * expf(-0.3f * (float)tid);
    ((float*)(P.ws + OFF_lamv))[tid * 2] = expf(s1) - expf(s2) + lam_init;
    ((float*)(P.ws + OFF_lamv))[tid * 2 + 1] = lam_init;
  }
}

DI void phase_prologue(const Params& P, char* smem) {
  const int per_layer = 1120 + 4 * 256 + 4 * 128 + 256 + 16 + 16;
  const int ncvt = 2 * per_layer;
  const int total = ncvt + 192 + 1;
  for (int it = blockIdx.x; it < total; it += gridDim.x) {
    if (it < ncvt) {
      const int l = it / per_layer;
      int t = it % per_layer;
      const float* s0; u16* dst; int ld, K, ntk, mode;
      if (t < 1120) { s0 = P.w_in + (size_t)l * 1024 * INC; ld = INC; dst = ((u16*)(P.ws + OFF_WinT)) + (size_t)l * INP * 1024; K = 1024; ntk = 16; mode = 1; }
      else if (t < 2144) { t -= 1120; int kq = t >> 8; t &= 255; s0 = P.w_gate + ((size_t)l * 4 + kq) * 1024 * 1024; ld = 1024; dst = ((u16*)(P.ws + OFF_WgT)) + ((size_t)l * 4 + kq) * 1024 * 1024; K = 1024; ntk = 16; mode = 0; }
      else if (t < 2656) { t -= 2144; int kq = t >> 7; t &= 127; s0 = P.w_branch + ((size_t)l * 4 + kq) * 512 * 1024; ld = 1024; dst = ((u16*)(P.ws + OFF_WbT)) + ((size_t)l * 4 + kq) * 1024 * 512; K = 512; ntk = 8; mode = 0; }
      else if (t < 2912) { t -= 2656; s0 = P.w_out + (size_t)l * 1024 * 1024; ld = 1024; dst = ((u16*)(P.ws + OFF_WoT)) + (size_t)l * 1024 * 1024; K = 1024; ntk = 16; mode = 0; }
      else if (t < 2928) { t -= 2912; int g = t >> 2; t &= 3; s0 = P.pool_w + ((size_t)l * 4 + g) * 128 * 128; ld = 128; dst = ((u16*)(P.ws + OFF_poolT)) + ((size_t)l * 4 + g) * 128 * 128; K = 128; ntk = 2; mode = 0; }
      else { t -= 2928; int g = t >> 2; t &= 3; s0 = P.sgu_w + ((size_t)l * 4 + g) * 128 * 128; ld = 128; dst = ((u16*)(P.ws + OFF_sguW)) + ((size_t)l * 4 + g) * 128 * 128; K = 128; ntk = 2; mode = 3; }
      const int tn = t / ntk, tk = t % ntk;
      cvt_tile(s0, s0, ld, dst, K, tn * 64, tk * 64, mode, (u16*)smem);
    } else if (it < ncvt + 192) {
      mod_item(P, it - ncvt, smem);
    } else {
      misc_item(P);
    }
  }
}

DI void ffn_cvt_item(const Params& P, int l, int it, char* smem) {
  const int e = it / 384;
  int t = it % 384;
  if (t < 256) {
    cvt_tile(P.w1 + ((size_t)l * 16 + e) * 1024 * 512, P.w3 + ((size_t)l * 16 + e) * 1024 * 512, 512, ((u16*)(P.ws + OFF_W13T)) + (size_t)e * 1024 * 1024, 1024, (t >> 4) * 64, (t & 15) * 64, 2, (u16*)smem);
  } else {
    t -= 256;
    const float* s = P.w2 + ((size_t)l * 16 + e) * 512 * 1024;
    cvt_tile(s, s, 1024, ((u16*)(P.ws + OFF_W2T)) + (size_t)e * 1024 * 512, 512, (t >> 3) * 64, (t & 7) * 64, 0, (u16*)smem);
  }
}

DI void load_row_f32(const float* p, int lane, float (&v)[16]) {
#pragma unroll
  for (int k = 0; k < 4; ++k) { float4 t = *(const float4*)(p + lane * 4 + 256 * k); v[4 * k] = t.x; v[4 * k + 1] = t.y; v[4 * k + 2] = t.z; v[4 * k + 3] = t.w; }
}
DI void load_row_bf16(const u16* p, int lane, float (&v)[16]) {
#pragma unroll
  for (int k = 0; k < 4; ++k) { bf16x4 t = *(const bf16x4*)(p + lane * 4 + 256 * k); for (int i = 0; i < 4; ++i) v[4 * k + i] = bf2f((u16)t[i]); }
}
DI void store_row_f32(float* p, int lane, const float (&v)[16]) {
#pragma unroll
  for (int k = 0; k < 4; ++k) *(float4*)(p + lane * 4 + 256 * k) = make_float4(v[4 * k], v[4 * k + 1], v[4 * k + 2], v[4 * k + 3]);
}
DI void store_row_bf16(u16* p, int lane, const float (&v)[16]) {
#pragma unroll
  for (int k = 0; k < 4; ++k) *(bf16x4*)(p + lane * 4 + 256 * k) = pack4(v[4 * k], v[4 * k + 1], v[4 * k + 2], v[4 * k + 3]);
}
DI void ln_row(float (&v)[16], const float* g, const float* b, int lane) {
  float s = 0.f;
#pragma unroll
  for (int i = 0; i < 16; ++i) s += v[i];
  float mu = wave_sum(s) * (1.f / 1024.f);
  float q = 0.f;
#pragma unroll
  for (int i = 0; i < 16; ++i) { float d = v[i] - mu; q += d * d; }
  float rstd = rsqrtf(wave_sum(q) * (1.f / 1024.f) + LN_EPS);
  float gg[16], bb[16];
  load_row_f32(g, lane, gg); load_row_f32(b, lane, bb);
#pragma unroll
  for (int i = 0; i < 16; ++i) v[i] = (v[i] - mu) * rstd * gg[i] + bb[i];
}

DI void phase_h0(const Params& P) {
  const int lane = TID() & 63;
  const int gw = blockIdx.x * 4 + (TID() >> 6), nw = gridDim.x * 4;
  for (int row = gw; row < NTOK; row += nw) {
    int s = row / SP, p = row % SP;
    bool lat = p < SEQ;
    const float* xs = lat ? P.x + ((size_t)s * SEQ + p) * DM : P.ctx + ((size_t)s * CTXL + (p - SEQ)) * DM;
    const float* md = ((float*)(P.ws + OFF_mod)) + (size_t)(lat ? s : 16) * 6144;
    float v[16], sh[16], scl[16];
    load_row_f32(xs, lane, v); load_row_f32(md, lane, sh); load_row_f32(md + 1024, lane, scl);
#pragma unroll
    for (int i = 0; i < 16; ++i) v[i] = v[i] * (1.f + scl[i]) + sh[i];
    store_row_bf16(((u16*)(P.ws + OFF_H)) + (size_t)row * DM, lane, v);
  }
}

DI void compute_x1(const Params& P, int l, int row, int lane, float (&v)[16]) {
  int s = row / SP, p = row % SP;
  bool lat = p < SEQ;
  const float* xs;
  if (l == 0) xs = lat ? P.x + ((size_t)s * SEQ + p) * DM : P.ctx + ((size_t)s * CTXL + (p - SEQ)) * DM;
  else xs = P.out + ((size_t)s * SEQ + p) * DM;
  const float* md = ((float*)(P.ws + OFF_mod)) + ((size_t)l * 17 + (lat ? s : 16)) * 6144;
  float y[16], m2[16];
  load_row_f32(xs, lane, v); load_row_bf16(((u16*)(P.ws + OFF_Y)) + (size_t)row * DM, lane, y); load_row_f32(md + 2 * 1024, lane, m2);
#pragma unroll
  for (int i = 0; i < 16; ++i) v[i] = ALPHA * v[i] + m2[i] * y[i];
  ln_row(v, P.ln1_g + l * 1024, P.ln1_b + l * 1024, lane);
}

DI void phase_ln1(const Params& P, int l, char* smem) {
  const bool last = (l == 1);
  const int tid = TID();
  const int lane = tid & 63;
  const int gw = blockIdx.x * 4 + (tid >> 6), nw = gridDim.x * 4;
  float* wT = (float*)smem;
  __syncthreads();
  {
    const float* wr = P.w_router + (size_t)l * 1024 * 16;
    for (int i = tid; i < 4096; i += 256) {
      int c = i >> 2, e4 = (i & 3) * 4;
      float4 w = *(const float4*)(wr + (size_t)c * 16 + e4);
      wT[(e4 + 0) * 1024 + c] = w.x; wT[(e4 + 1) * 1024 + c] = w.y; wT[(e4 + 2) * 1024 + c] = w.z; wT[(e4 + 3) * 1024 + c] = w.w;
    }
  }
  __syncthreads();
  for (int row = gw; row < NTOK; row += nw) {
    int s = row / SP, p = row % SP;
    bool lat = p < SEQ;
    if (last && !lat) continue;
    float v[16];
    compute_x1(P, l, row, lane, v);
    const float* md = ((float*)(P.ws + OFF_mod)) + ((size_t)l * 17 + (lat ? s : 16)) * 6144;
    float m3[16], m4[16];
    load_row_f32(md + 3 * 1024, lane, m3); load_row_f32(md + 4 * 1024, lane, m4);
#pragma unroll
    for (int i = 0; i < 16; ++i) v[i] = v[i] * (1.f + m4[i]) + m3[i];
    store_row_bf16(((u16*)(P.ws + OFF_H)) + (size_t)row * DM, lane, v);
    float lg[16];
#pragma unroll
    for (int e = 0; e < 16; ++e) {
      float a = 0.f;
#pragma unroll
      for (int k = 0; k < 4; ++k) {
        float4 w = *(const float4*)(wT + e * 1024 + lane * 4 + 256 * k);
        a += v[4 * k] * w.x + v[4 * k + 1] * w.y + v[4 * k + 2] * w.z + v[4 * k + 3] * w.w;
      }
      lg[e] = a;
    }
#pragma unroll
    for (int e = 0; e < 16; ++e) lg[e] = wave_sum(lg[e]);
    float mx = lg[0];
#pragma unroll
    for (int e = 1; e < 16; ++e) mx = fmaxf(mx, lg[e]);
    float sum = 0.f;
#pragma unroll
    for (int e = 0; e < 16; ++e) { lg[e] = expf(lg[e] - mx); sum += lg[e]; }
    float inv = 1.f / sum;
    if (lane < 16) {
      float mine = 0.f;
#pragma unroll
      for (int e = 0; e < 16; ++e) if (lane == e) mine = lg[e];
      ((float*)(P.ws + OFF_aff))[(size_t)row * 16 + lane] = mine * inv;
    }
  }
  for (int it = blockIdx.x; it < 16 * 384; it += gridDim.x) ffn_cvt_item(P, l, it, smem);
}

DI int block_excl_scan(int v, int* red, int tid, int& total) {
  const int lane = tid & 63, wave = tid >> 6;
  int inc = v;
#pragma unroll
  for (int o = 1; o < 64; o <<= 1) { int t = __shfl_up(inc, o); if (lane >= o) inc += t; }
  __syncthreads();
  if (lane == 63) red[wave] = inc;
  __syncthreads();
  int base = 0;
#pragma unroll
  for (int w = 0; w < 4; ++w) { int t = red[w]; if (w < wave) base += t; }
  total = red[0] + red[1] + red[2] + red[3];
  return base + inc - v;
}

DI void phase_topk(const Params& P, int l, char* smem) {
  const bool last = (l == 1);
  const int tid = TID();
  unsigned* keys = (unsigned*)smem;
  int* red = (int*)(smem + 8192);
  const int nitems = last ? 256 : 512;
  for (int it = blockIdx.x; it < nitems; it += gridDim.x) {
    const bool isctx = it >= 256;
    const int se = it & 255, s = se >> 4, e = se & 15;
    const int n = isctx ? CTXL : SEQ, cap = isctx ? 32 : 256;
    const int row0 = s * SP + (isctx ? SEQ : 0);
    const int per = n >> 8;
    __syncthreads();
    for (int i = tid; i < n; i += 256) keys[i] = __float_as_uint(((float*)(P.ws + OFF_aff))[(size_t)(row0 + i) * 16 + e]);
    __syncthreads();
    unsigned kv[8];
#pragma unroll
    for (int j = 0; j < 8; ++j) kv[j] = (j < per) ? keys[tid * per + j] : 0u;
    unsigned prefix = 0u;
    int krem = cap;
    for (int bit = 31; bit >= 0; --bit) {
      const unsigned himask = (bit == 31) ? 0u : (0xFFFFFFFFu << (bit + 1));
      const unsigned want = prefix | (1u << bit);
      int c = 0;
#pragma unroll
      for (int j = 0; j < 8; ++j) c += (j < per && ((kv[j] & (himask | (1u << bit))) == want)) ? 1 : 0;
      c = (int)wave_sum((float)c);
      __syncthreads();
      if ((tid & 63) == 0) red[tid >> 6] = c;
      __syncthreads();
      const int cnt = red[0] + red[1] + red[2] + red[3];
      if (cnt >= krem) prefix = want; else krem -= cnt;
    }
    const unsigned T = prefix;
    int cgt = 0, ceq = 0;
#pragma unroll
    for (int j = 0; j < 8; ++j) if (j < per) { cgt += kv[j] > T ? 1 : 0; ceq += kv[j] == T ? 1 : 0; }
    int tot_gt, tot_eq, tot_sel;
    (void)block_excl_scan(cgt, red, tid, tot_gt);
    const int eq_before = block_excl_scan(ceq, red, tid, tot_eq);
    const int need_eq = cap - tot_gt;
    int eqc = eq_before, csel = 0;
    bool sel[8];
#pragma unroll
    for (int j = 0; j < 8; ++j) {
      sel[j] = false;
      if (j < per) {
        if (kv[j] > T) sel[j] = true;
        else if (kv[j] == T) { sel[j] = eqc < need_eq; ++eqc; }
        csel += sel[j] ? 1 : 0;
      }
    }
    int slot = block_excl_scan(csel, red, tid, tot_sel);
#pragma unroll
    for (int j = 0; j < 8; ++j) if (j < per) {
      const int t = tid * per + j;
      int rk = cap;
      if (sel[j]) {
        rk = slot++;
        const int R = isctx ? NFFN_LAT + (e * 16 + s) * 32 + rk : (s * 16 + e) * 256 + rk;
        ((int*)(P.ws + OFF_tokidx))[R] = row0 + t;
        ((float*)(P.ws + OFF_gatev))[R] = __uint_as_float(kv[j]);
      }
      ((int*)(P.ws + OFF_rank))[(size_t)(row0 + t) * 16 + e] = rk;
    }
  }
}

DI void phase_ln2(const Params& P, int l) {
  const bool last = (l == 1);
  const int lane = TID() & 63;
  const int gw = blockIdx.x * 4 + (TID() >> 6), nw = gridDim.x * 4;
  for (int row = gw; row < NTOK; row += nw) {
    int s = row / SP, p = row % SP;
    bool lat = p < SEQ;
    if (last && !lat) continue;
    float v[16];
    compute_x1(P, l, row, lane, v);
    float yf[16];
#pragma unroll
    for (int i = 0; i < 16; ++i) yf[i] = 0.f;
    const int cap = lat ? 256 : 32;
    for (int e = 0; e < 16; ++e) {
      int rk = ((int*)(P.ws + OFF_rank))[(size_t)row * 16 + e];
      if (rk < cap) {
        int R = lat ? (s * 16 + e) * 256 + rk : NFFN_LAT + (e * 16 + s) * 32 + rk;
        float t[16];
        load_row_bf16(((u16*)(P.ws + OFF_ye)) + (size_t)R * DM, lane, t);
#pragma unroll
        for (int i = 0; i < 16; ++i) yf[i] += t[i];
      }
    }
    const float* md = ((float*)(P.ws + OFF_mod)) + ((size_t)l * 17 + (lat ? s : 16)) * 6144;
    float m5[16];
    load_row_f32(md + 5 * 1024, lane, m5);
#pragma unroll
    for (int i = 0; i < 16; ++i) v[i] = ALPHA * v[i] + m5[i] * yf[i];
    ln_row(v, P.ln2_g + l * 1024, P.ln2_b + l * 1024, lane);
    if (lat) store_row_f32(P.out + ((size_t)s * SEQ + p) * DM, lane, v);
    if (!last) {
      const float* md2 = ((float*)(P.ws + OFF_mod)) + ((size_t)(l + 1) * 17 + (lat ? s : 16)) * 6144;
      float sh[16], scl[16];
      load_row_f32(md2, lane, sh); load_row_f32(md2 + 1024, lane, scl);
#pragma unroll
      for (int i = 0; i < 16; ++i) v[i] = v[i] * (1.f + scl[i]) + sh[i];
      store_row_bf16(((u16*)(P.ws + OFF_H)) + (size_t)row * DM, lane, v);
    }
  }
}

template <bool SWAP>
DI void proj_tile(const Params& P, int l, int hb, int mt, int nt, char* smem) {
  const int tid = TID(), wave = tid >> 6, lane = tid & 63, fr = lane & 15, fq = lane >> 4;
  const int wr = wave >> 1, wc = wave & 1;
  const int hrow0 = mt * 128, grow0 = hb * HROWS + hrow0;
  f32x4 acc[4][4];
  zero_acc<4>(acc);
  gemm_main<4, SWAP, false>(((u16*)(P.ws + OFF_H)), DM, nullptr, grow0, ((u16*)(P.ws + OFF_WinT)) + (size_t)l * INP * 1024, 1024, nt * 128, 1024, acc, (u16*)smem);
  const int jp = mt % 18;
  const int bl = mt / 18;
  const bool lat = jp < 16;
  if (SWAP) {
    u16* dst; int ldd, c0;
    if (nt < 4) { dst = ((u16*)(P.ws + OFF_xp)); ldd = 512; c0 = nt * 128; }
    else if (nt < 8) { dst = ((u16*)(P.ws + OFF_z)); ldd = 512; c0 = (nt - 4) * 128; }
    else if (nt < 14) { dst = ((u16*)(P.ws + OFF_xbc)); ldd = 768; c0 = (nt - 8) * 128; }
    else if (nt < 18) { dst = ((u16*)(P.ws + OFF_q)); ldd = 512; c0 = (nt - 14) * 128; }
    else if (nt < 22) { dst = ((u16*)(P.ws + OFF_k)); ldd = 512; c0 = (nt - 18) * 128; }
    else { dst = ((u16*)(P.ws + OFF_br3)); ldd = 512; c0 = (nt - 26) * 128; }
    const bool isu = nt >= 26;
    const bool rope = (nt >= 14 && nt < 22) && lat;
#pragma unroll
    for (int m = 0; m < 4; ++m) {
      int r = wr * 64 + m * 16 + fr;
      size_t orow = isu ? (size_t)(grow0 + r) : (size_t)(hrow0 + r);
      if (rope) {
        int t = jp * 128 + r;
        int prow = t >> 6, pcol = t & 63;
#pragma unroll
        for (int j = 0; j < 4; ++j) {
          int f = fq * 4 + j;
          float c1 = ((float*)(P.ws + OFF_rope))[(prow * 16 + f) * 2], s1 = ((float*)(P.ws + OFF_rope))[(prow * 16 + f) * 2 + 1];
          float c2 = ((float*)(P.ws + OFF_rope))[(pcol * 16 + f) * 2], s2 = ((float*)(P.ws + OFF_rope))[(pcol * 16 + f) * 2 + 1];
          float a = acc[m][0][j], b = acc[m][1][j];
          acc[m][0][j] = a * c1 - b * s1; acc[m][1][j] = a * s1 + b * c1;
          a = acc[m][2][j]; b = acc[m][3][j];
          acc[m][2][j] = a * c2 - b * s2; acc[m][3][j] = a * s2 + b * c2;
        }
      }
#pragma unroll
      for (int n = 0; n < 4; ++n) {
        f32x4 v = acc[m][n];
        if (isu) { v[0] = geluf_(v[0]); v[1] = geluf_(v[1]); v[2] = geluf_(v[2]); v[3] = geluf_(v[3]); }
        int col = c0 + wc * 64 + n * 16 + fq * 4;
        *(bf16x4*)(dst + orow * ldd + col) = pack4v(v);
      }
    }
  } else {
    if (nt == 34) {
      if (wc == 0) {
#pragma unroll
        for (int m = 0; m < 4; ++m)
#pragma unroll
          for (int j = 0; j < 4; ++j) ((float*)(P.ws + OFF_dtbuf))[(size_t)(hrow0 + wr * 64 + m * 16 + fq * 4 + j) * 16 + fr] = acc[m][0][j];
      }
    } else if (nt < 26) {
      int cb = (nt - 22) * 128 + wc * 64;
#pragma unroll
      for (int m = 0; m < 4; ++m)
#pragma unroll
        for (int n = 0; n < 4; ++n) {
          int c = cb + n * 16 + fr;
          int pos = jp * 128 + wr * 64 + m * 16 + fq * 4;
          *(bf16x4*)(((u16*)(P.ws + OFF_vT)) + ((size_t)bl * 512 + c) * SP + pos) = pack4v(acc[m][n]);
        }
    } else {
      int cb = (nt - 30) * 128 + wc * 64;
#pragma unroll
      for (int m = 0; m < 4; ++m)
#pragma unroll
        for (int n = 0; n < 4; ++n) {
          int c = cb + n * 16 + fr;
          int i0 = wr * 64 + m * 16 + fq * 4;
          f32x4 v = acc[m][n];
          *(bf16x4*)(((u16*)(P.ws + OFF_gvT)) + ((size_t)mt * 512 + c) * 128 + i0) = pack4(geluf_(v[0]), geluf_(v[1]), geluf_(v[2]), geluf_(v[3]));
        }
    }
  }
}

DI void phase_proj(const Params& P, int l, int hb, char* smem) {
  const bool last = (l == 1);
  for (int it = blockIdx.x; it < 144 * 35; it += gridDim.x) {
    int mt = it / 35, nt = it % 35;
    bool isctx = (mt % 18) >= 16;
    if (last && isctx) {
      bool need = (nt >= 8 && nt < 14) || (nt >= 18 && nt < 26) || nt == 34;
      if (!need) continue;
    }
    bool transposed = (nt >= 22 && nt < 26) || nt >= 30;
    if (transposed) proj_tile<false>(P, l, hb, mt, nt, smem);
    else proj_tile<true>(P, l, hb, mt, nt, smem);
  }
}

constexpr int LDK = 136;
DI void pool_item(const Params& P, int l, int hb, int mt, int g, char* smem) {
  const int tid = TID(), wave = tid >> 6, lane = tid & 63, fr = lane & 15, fq = lane >> 4;
  const int wr = wave >> 1, wc = wave & 1;
  u16* As = (u16*)smem;
  u16* Bs = As + 128 * LDK;
  const int jp = mt % 18, bl = mt / 18;
  const bool lat = jp < 16;
  const int n = lat ? SEQ : CTXL;
  const int p0 = lat ? jp * 128 : (jp - 16) * 128;
  const int seqbase = bl * SP + (lat ? 0 : SEQ);
  const int half = 1 << g;
  __syncthreads();
  {
    const int cch = tid & 15;
    const u16* src = ((u16*)(P.ws + OFF_xp)) + (size_t)seqbase * 512 + g * 128 + cch * 8;
    for (int ii = 0; ii < 8; ++ii) {
      int i = (tid >> 4) + 16 * ii;
      int p = p0 + i;
      int lo = max(p - half, 0), hi = min(p + half, n);
      float s[8];
#pragma unroll
      for (int e = 0; e < 8; ++e) s[e] = 0.f;
      for (int r = lo; r < hi; ++r) {
        bf16x8 t = *(const bf16x8*)(src + (size_t)r * 512);
#pragma unroll
        for (int e = 0; e < 8; ++e) s[e] += bf2f((u16)t[e]);
      }
      bf16x8 self = *(const bf16x8*)(src + (size_t)p * 512);
      float inv = 1.f / (float)(hi - lo);
      bf16x8 o;
#pragma unroll
      for (int e = 0; e < 8; ++e) o[e] = (short)f2bf(s[e] * inv - bf2f((u16)self[e]));
      *(bf16x8*)(As + i * LDK + cch * 8) = o;
    }
    const u16* wsrc = ((u16*)(P.ws + OFF_poolT)) + ((size_t)l * 4 + g) * 128 * 128;
    for (int cid = tid; cid < 2048; cid += 256) {
      int r = cid >> 4, c8 = (cid & 15) * 8;
      *(u32x4*)(Bs + r * LDK + c8) = *(const u32x4*)(wsrc + r * 128 + c8);
    }
  }
  __syncthreads();
  f32x4 acc[4][4];
  zero_acc<4>(acc);
  mma_lds<4, 4, true>(As + wr * 64 * LDK, LDK, Bs + wc * 64 * LDK, LDK, 4, acc, fr, fq);
  const float* psc = P.pool_scale + l * 512 + g * 128;
#pragma unroll
  for (int m = 0; m < 4; ++m)
#pragma unroll
    for (int nn = 0; nn < 4; ++nn) {
      int r = wr * 64 + m * 16 + fr, c = wc * 64 + nn * 16 + fq * 4;
      float4 sc = *(const float4*)(psc + c);
      f32x4 v = acc[m][nn];
      *(bf16x4*)(((u16*)(P.ws + OFF_br0)) + (size_t)(hb * HROWS + mt * 128 + r) * 512 + g * 128 + c) = pack4(v[0] * sc.x, v[1] * sc.y, v[2] * sc.z, v[3] * sc.w);
    }
}

DI void sgu_item(const Params& P, int l, int hb, int mt, char* smem) {
  const int tid = TID(), wave = tid >> 6, lane = tid & 63, fr = lane & 15, fq = lane >> 4;
  const int wr = wave >> 1, wc = wave & 1;
  u16* As = (u16*)smem;
  u16* Bs = As + 128 * LDK;
  float* st = (float*)(Bs + 128 * LDK);
  const u16* gv = ((u16*)(P.ws + OFF_gvT)) + (size_t)mt * 512 * 128;
  __syncthreads();
  {
    int i = tid & 127, part = tid >> 7;
    float s = 0.f;
#pragma unroll 16
    for (int c = part * 256; c < part * 256 + 256; ++c) s += bf2f(gv[c * 128 + i]);
    st[part * 128 + i] = s;
    __syncthreads();
    float mu = (st[i] + st[128 + i]) * (1.f / 512.f);
    __syncthreads();
    float qv = 0.f;
#pragma unroll 16
    for (int c = part * 256; c < part * 256 + 256; ++c) { float d = bf2f(gv[c * 128 + i]) - mu; qv += d * d; }
    st[part * 128 + i] = qv;
    __syncthreads();
    float var = (st[i] + st[128 + i]) * (1.f / 512.f);
    __syncthreads();
    if (part == 0) { st[256 + i] = mu; st[384 + i] = rsqrtf(var + LN_EPS); }
  }
  const float* mu = st + 256;
  const float* rs = st + 384;
  for (int g = 0; g < 4; ++g) {
    __syncthreads();
    const u16* wsrc = ((u16*)(P.ws + OFF_sguW)) + ((size_t)l * 4 + g) * 128 * 128;
    for (int cid = tid; cid < 2048; cid += 256) {
      int r = cid >> 4, c8 = (cid & 15) * 8;
      *(u32x4*)(As + r * LDK + c8) = *(const u32x4*)(wsrc + r * 128 + c8);
      bf16x8 t = *(const bf16x8*)(gv + (size_t)(g * 128 + r) * 128 + c8);
      float lg = P.sgu_ln_g[l * 512 + g * 128 + r], lb = P.sgu_ln_b[l * 512 + g * 128 + r];
      bf16x8 o;
#pragma unroll
      for (int e = 0; e < 8; ++e) o[e] = (short)f2bf((bf2f((u16)t[e]) - mu[c8 + e]) * rs[c8 + e] * lg + lb);
      *(bf16x8*)(Bs + r * LDK + c8) = o;
    }
    __syncthreads();
    f32x4 acc[4][4];
    zero_acc<4>(acc);
    mma_lds<4, 4, true>(As + wr * 64 * LDK, LDK, Bs + wc * 64 * LDK, LDK, 4, acc, fr, fq);
    const float* bs = P.sgu_b + ((size_t)l * 4 + g) * 128;
#pragma unroll
    for (int m = 0; m < 4; ++m) {
      int pp = wr * 64 + m * 16 + fr;
      float bias = bs[pp];
#pragma unroll
      for (int nn = 0; nn < 4; ++nn) {
        int d = wc * 64 + nn * 16 + fq * 4;
        u16* up = ((u16*)(P.ws + OFF_br3)) + (size_t)(hb * HROWS + mt * 128 + pp) * 512 + g * 128 + d;
        bf16x4 uu = *(const bf16x4*)up;
        f32x4 v = acc[m][nn];
        *(bf16x4*)up = pack4((v[0] + bias) * bf2f((u16)uu[0]), (v[1] + bias) * bf2f((u16)uu[1]), (v[2] + bias) * bf2f((u16)uu[2]), (v[3] + bias) * bf2f((u16)uu[3]));
      }
    }
  }
}

DI void attn_item(const Params& P, int l, int hb, int item, char* smem) {
  const int tid = TID(), wave = tid >> 6, lane = tid & 63, fr = lane & 15, fq = lane >> 4;
  const int qt = item % 18, h = (item / 18) & 3, bl = item / 72;
  const bool ctxq = qt >= 16;
  const int key0 = ctxq ? SEQ : 0, nkt = ctxq ? 4 : 36;
  const int hrow_q0 = bl * SP + qt * 128 + wave * 32;
  constexpr int KT = 64 * LDT, VT = 128 * LDT;
  u16* Ks = (u16*)smem;
  u16* Vs = Ks + 2 * KT;
  constexpr float LOG2E = 1.4426950408889634f;
  for (int sub = 0; sub < 2; ++sub) {
    const int hs = 2 * h + sub;
    bf16x8 qf[2][2];
#pragma unroll
    for (int qb = 0; qb < 2; ++qb)
#pragma unroll
      for (int ks = 0; ks < 2; ++ks) qf[qb][ks] = *(const bf16x8*)(((u16*)(P.ws + OFF_q)) + (size_t)(hrow_q0 + qb * 16 + fr) * 512 + hs * 64 + ks * 32 + fq * 8);
    f32x4 ot[8][2];
#pragma unroll
    for (int d = 0; d < 8; ++d) { ot[d][0] = f32x4{0.f, 0.f, 0.f, 0.f}; ot[d][1] = f32x4{0.f, 0.f, 0.f, 0.f}; }
    float mrow[2] = {-INFINITY, -INFINITY}, lrow[2] = {0.f, 0.f};
    const u16* Kg = ((u16*)(P.ws + OFF_k)) + ((size_t)bl * SP + key0) * 512 + hs * 64;
    const u16* Vg = ((u16*)(P.ws + OFF_vT)) + ((size_t)bl * 512 + h * 128) * SP + key0;
    u32x4 rk[2], rv[4];
    const u16* kgp = Kg + (size_t)(tid >> 2) * 512 + (tid & 3) * 16;
    const u16* vgp = Vg + (size_t)(tid >> 1) * SP + (tid & 1) * 32;
    u16* ksp = Ks + (tid >> 2) * LDT + (tid & 3) * 16;
    u16* vsp = Vs + (tid >> 1) * LDT + (tid & 1) * 32;
    auto gloadK = [&](int t) {
      const u16* kp = kgp + (size_t)t * 64 * 512;
      rk[0] = *(const u32x4*)(kp); rk[1] = *(const u32x4*)(kp + 8);
    };
    auto gloadV = [&](int t) {
      const u16* vp = vgp + t * 64;
      rv[0] = *(const u32x4*)(vp); rv[1] = *(const u32x4*)(vp + 8); rv[2] = *(const u32x4*)(vp + 16); rv[3] = *(const u32x4*)(vp + 24);
    };
    auto sstore = [&](int buf) {
      u16* kp = ksp + buf * KT;
      *(u32x4*)(kp) = rk[0]; *(u32x4*)(kp + 8) = rk[1];
      u16* vp = vsp + buf * VT;
      *(u32x4*)(vp) = rv[0]; *(u32x4*)(vp + 8) = rv[1]; *(u32x4*)(vp + 16) = rv[2]; *(u32x4*)(vp + 24) = rv[3];
    };
    gloadK(0); gloadV(0);
    __syncthreads();
    sstore(0);
    __syncthreads();
    for (int t = 0; t < nkt; ++t) {
      const int cur = t & 1;
      if (t + 1 < nkt) gloadK(t + 1);
      const u16* Kc = Ks + cur * KT;
      const u16* Vc = Vs + cur * VT;
      f32x4 st[4][2];
#pragma unroll
      for (int k4 = 0; k4 < 4; ++k4) { st[k4][0] = f32x4{0.f, 0.f, 0.f, 0.f}; st[k4][1] = f32x4{0.f, 0.f, 0.f, 0.f}; }
#pragma unroll
      for (int k4 = 0; k4 < 4; ++k4)
#pragma unroll
        for (int ks = 0; ks < 2; ++ks) {
          bf16x8 a = *(const bf16x8*)(Kc + (k4 * 16 + fr) * LDT + ks * 32 + fq * 8);
          st[k4][0] = MFMA16(a, qf[0][ks], st[k4][0]);
          st[k4][1] = MFMA16(a, qf[1][ks], st[k4][1]);
          if (ks == 1 && (k4 & 1)) __builtin_amdgcn_sched_barrier(0);
        }
      __builtin_amdgcn_sched_barrier(0);
#pragma unroll
      for (int qb = 0; qb < 2; ++qb) {
        float mx = -INFINITY;
#pragma unroll
        for (int k4 = 0; k4 < 4; ++k4)
#pragma unroll
          for (int j = 0; j < 4; ++j) mx = fmaxf(mx, st[k4][qb][j]);
        mx = fmaxf(mx, __shfl_xor(mx, 16));
        mx = fmaxf(mx, __shfl_xor(mx, 32));
        float mnew = fmaxf(mrow[qb], mx);
        float alpha = __builtin_amdgcn_exp2f((mrow[qb] - mnew) * LOG2E);
        mrow[qb] = mnew;
        float moff = mnew * LOG2E;
        float ps = 0.f;
#pragma unroll
        for (int k4 = 0; k4 < 4; ++k4)
#pragma unroll
          for (int j = 0; j < 4; ++j) { float pv = __builtin_amdgcn_exp2f(st[k4][qb][j] * LOG2E - moff); st[k4][qb][j] = pv; ps += pv; }
        lrow[qb] = lrow[qb] * alpha + ps;
#pragma unroll
        for (int d = 0; d < 8; ++d) { ot[d][qb][0] *= alpha; ot[d][qb][1] *= alpha; ot[d][qb][2] *= alpha; ot[d][qb][3] *= alpha; }
      }
      __builtin_amdgcn_sched_barrier(0);
      if (t + 1 < nkt) gloadV(t + 1);
#pragma unroll
      for (int ks2 = 0; ks2 < 2; ++ks2) {
        bf16x8 pf[2];
#pragma unroll
        for (int qb = 0; qb < 2; ++qb) {
          bf16x4 lo = pack4v(st[2 * ks2][qb]), hi = pack4v(st[2 * ks2 + 1][qb]);
          pf[qb] = __builtin_shufflevector(lo, hi, 0, 1, 2, 3, 4, 5, 6, 7);
        }
#pragma unroll
        for (int d = 0; d < 8; ++d) {
          const u16* vp = Vc + (d * 16 + fr) * LDT + ks2 * 32 + fq * 4;
          bf16x4 lo = *(const bf16x4*)vp, hi = *(const bf16x4*)(vp + 16);
          bf16x8 a = __builtin_shufflevector(lo, hi, 0, 1, 2, 3, 4, 5, 6, 7);
          ot[d][0] = MFMA16(a, pf[0], ot[d][0]);
          ot[d][1] = MFMA16(a, pf[1], ot[d][1]);
          if ((d & 3) == 3) __builtin_amdgcn_sched_barrier(0);
        }
      }
      if (t + 1 < nkt) sstore(cur ^ 1);
      __syncthreads();
    }
#pragma unroll
    for (int qb = 0; qb < 2; ++qb) {
      float lt = lrow[qb];
      lt += __shfl_xor(lt, 16);
      lt += __shfl_xor(lt, 32);
      float inv = 1.f / lt;
      size_t hrow = (size_t)(hrow_q0 + qb * 16 + fr);
      if (sub == 0) {
#pragma unroll
        for (int d = 0; d < 8; ++d) {
          f32x4 v = ot[d][qb];
          *(bf16x4*)(((u16*)(P.ws + OFF_o1)) + hrow * 512 + h * 128 + d * 16 + fq * 4) = pack4(v[0] * inv, v[1] * inv, v[2] * inv, v[3] * inv);
        }
      } else {
        const float lam = ((float*)(P.ws + OFF_lamv))[l * 2], lam_init = ((float*)(P.ws + OFF_lamv))[l * 2 + 1];
        float ss = 0.f;
#pragma unroll
        for (int d = 0; d < 8; ++d) {
          bf16x4 o1v = *(const bf16x4*)(((u16*)(P.ws + OFF_o1)) + hrow * 512 + h * 128 + d * 16 + fq * 4);
#pragma unroll
          for (int j = 0; j < 4; ++j) { float dd = bf2f((u16)o1v[j]) - lam * ot[d][qb][j] * inv; ot[d][qb][j] = dd; ss += dd * dd; }
        }
        ss += __shfl_xor(ss, 16);
        ss += __shfl_xor(ss, 32);
        float rr = rsqrtf(ss * (1.f / 128.f) + LN_EPS) * (1.f - lam_init);
        const float* gn = P.diff_norm_g + l * 128;
#pragma unroll
        for (int d = 0; d < 8; ++d) {
          int dv = d * 16 + fq * 4;
          float4 g4 = *(const float4*)(gn + dv);
          f32x4 v = ot[d][qb];
          *(bf16x4*)(((u16*)(P.ws + OFF_br2)) + ((size_t)hb * HROWS + hrow) * 512 + h * 128 + dv) = pack4(v[0] * rr * g4.x, v[1] * rr * g4.y, v[2] * rr * g4.z, v[3] * rr * g4.w);
        }
      }
    }
  }
}

template <bool TRANS>
DI void conv_stage(const Params& P, int l, const u16* xbase  , int chan0, int n, int p0, u16* dst, int ld, const float* scale) {
  const int tid = TID(), cl = tid & 63, ig = tid >> 6;
  const int ch = chan0 + cl;
  const float* cw = P.conv_w + (size_t)l * 5 * 768 + ch;
  const float w0 = cw[0], w1 = cw[768], w2 = cw[2 * 768], w3 = cw[3 * 768], w4 = cw[4 * 768];
  const float cb = P.conv_b[l * 768 + ch];
  const u16* xc = xbase + ch;
  const int pos0 = p0 + ig * 32 - 2;
  float xv[36];
#pragma unroll
  for (int i = 0; i < 36; ++i) { int pos = pos0 + i; xv[i] = (pos >= 0 && pos < n) ? bf2f(xc[(size_t)pos * 768]) : 0.f; }
#pragma unroll
  for (int ii = 0; ii < 32; ++ii) {
    float v = w0 * xv[ii] + w1 * xv[ii + 1] + w2 * xv[ii + 2] + w3 * xv[ii + 3] + w4 * xv[ii + 4] + cb;
    v = siluf_(v);
    int tok = ig * 32 + ii;
    if (scale) v *= scale[tok];
    if (TRANS) dst[cl * ld + tok] = f2bf(v); else dst[tok * ld + cl] = f2bf(v);
  }
}

DI void ssd_scalars(const Params& P, int l, int hrow0, int h, int dir, float* dts, float* S, float* tmp) {
  const int tid = TID();
  const float aneg = -expf(P.a_log[l * 16 + dir * 8 + h]);
  if (tid < 128) {
    float raw = ((float*)(P.ws + OFF_dtbuf))[(size_t)(hrow0 + tid) * 16 + dir * 8 + h] + P.dt_bias[l * 16 + dir * 8 + h];
    float dt = softplusf_(raw);
    dts[tid] = dt;
    tmp[tid] = dt * aneg;
  }
  __syncthreads();
  if (tid < 128) {
    float s = 0.f;
    if (dir == 0) { for (int i = 0; i <= tid; ++i) s += tmp[i]; }
    else { for (int i = 127; i >= tid; --i) s += tmp[i]; }
    S[tid] = s;
  }
  __syncthreads();
}

constexpr int SSD_STATE_STRIDE = 18 * 4096;
DI void ssd_state_item(const Params& P, int l, int hb, int item, char* smem) {
  const int tid = TID(), wave = tid >> 6, lane = tid & 63, fr = lane & 15, fq = lane >> 4;
  const int dir = item & 1, h = (item >> 1) & 7, jp = (item >> 4) % 18, bl = (item >> 4) / 18;
  const bool lat = jp < 16;
  const int n = lat ? SEQ : CTXL;
  const int p0 = lat ? jp * 128 : (jp - 16) * 128;
  const int seqbase = bl * SP + (lat ? 0 : SEQ);
  const int hrow0 = bl * SP + jp * 128;
  u16* At = (u16*)smem;
  u16* Bt = At + 64 * LDK;
  float* dts = (float*)(Bt + 64 * LDK);
  float* S = dts + 128;
  float* wgt = S + 128;
  __syncthreads();
  ssd_scalars(P, l, hrow0, h, dir, dts, S, wgt);
  const float total = (dir == 0) ? S[127] : S[0];
  __syncthreads();
  if (tid < 128) wgt[tid] = dts[tid] * __expf(total - S[tid]);
  __syncthreads();
  const u16* xb = ((u16*)(P.ws + OFF_xbc)) + (size_t)seqbase * 768;
  conv_stage<true>(P, l, xb, h * 64, n, p0, At, LDK, wgt);
  conv_stage<true>(P, l, xb, 512 + (h >> 2) * 64, n, p0, Bt, LDK, nullptr);
  __syncthreads();
  const int wr = wave >> 1, wc = wave & 1;
  f32x4 acc[2][2];
#pragma unroll
  for (int m = 0; m < 2; ++m) { acc[m][0] = f32x4{0.f, 0.f, 0.f, 0.f}; acc[m][1] = f32x4{0.f, 0.f, 0.f, 0.f}; }
  mma_lds<2, 2, false>(At + wr * 32 * LDK, LDK, Bt + wc * 32 * LDK, LDK, 4, acc, fr, fq);
  float* cs = ((float*)(P.ws + OFF_cstate)) + (((size_t)(bl * 2 + dir) * 8 + h) * 18 + jp) * 4096;
#pragma unroll
  for (int m = 0; m < 2; ++m)
#pragma unroll
    for (int nn = 0; nn < 2; ++nn)
#pragma unroll
      for (int j = 0; j < 4; ++j) cs[(wr * 32 + m * 16 + fq * 4 + j) * 64 + wc * 32 + nn * 16 + fr] = acc[m][nn][j];
  if (tid == 0) ((float*)(P.ws + OFF_decay))[((bl * 2 + dir) * 8 + h) * 18 + jp] = __expf(total);
}

DI void phase_carry(const Params& P) {
  const int total = 8 * 2 * 8 * 4096;
  for (int idx = blockIdx.x * 256 + TID(); idx < total; idx += gridDim.x * 256) {
    int pn = idx & 4095, bdh = idx >> 12;
    int dir = (bdh >> 3) & 1;
    const float* __restrict__ cs = ((const float*)(P.ws + OFF_cstate)) + (size_t)bdh * SSD_STATE_STRIDE + pn;
    u16* __restrict__ en = ((u16*)(P.ws + OFF_enter)) + (size_t)bdh * SSD_STATE_STRIDE + pn;
    const float* __restrict__ dc = ((const float*)(P.ws + OFF_decay)) + bdh * 18;
    float cv[18], dv[18];
#pragma unroll
    for (int jp = 0; jp < 18; ++jp) { cv[jp] = cs[(size_t)jp * 4096]; dv[jp] = dc[jp]; }
    float state = 0.f;
    if (dir == 0) {
#pragma unroll
      for (int st = 0; st < 18; ++st) {
        const int jp = st < 2 ? 16 + st : st - 2;
        en[(size_t)jp * 4096] = f2bf(state);
        state = state * dv[jp] + cv[jp];
      }
    } else {
#pragma unroll
      for (int st = 0; st < 18; ++st) {
        const int jp = 17 - st;
        en[(size_t)jp * 4096] = f2bf(state);
        state = state * dv[jp] + cv[jp];
      }
    }
  }
}

DI void ssd_out_item(const Params& P, int l, int hb, int item, char* smem) {
  const int tid = TID(), wave = tid >> 6, lane = tid & 63, fr = lane & 15, fq = lane >> 4;
  const int h = item & 7, jp = (item >> 3) % 18, bl = (item >> 3) / 18;
  const bool lat = jp < 16;
  const int n = lat ? SEQ : CTXL;
  const int p0 = lat ? jp * 128 : (jp - 16) * 128;
  const int seqbase = bl * SP + (lat ? 0 : SEQ);
  const int hrow0 = bl * SP + jp * 128;
  u16* Cs = (u16*)smem;
  u16* xT = Cs + 128 * LDT;
  u16* Et = xT + 64 * LDK;
  u16* Un = Et + 64 * LDT;
  float* fs = (float*)(Un + 128 * LDK);
  float* dts = fs;
  float* S = fs + 128;
  float* tmp = fs + 256;
  const int grp = h >> 2;
  __syncthreads();
  const u16* xb = ((u16*)(P.ws + OFF_xbc)) + (size_t)seqbase * 768;
  conv_stage<false>(P, l, xb, 640 + grp * 64, n, p0, Cs, LDT, nullptr);
  conv_stage<false>(P, l, xb, 512 + grp * 64, n, p0, Un, LDT, nullptr);
  conv_stage<true>(P, l, xb, h * 64, n, p0, xT, LDK, nullptr);
  __syncthreads();
  f32x4 cb[2][8];
#pragma unroll
  for (int m = 0; m < 2; ++m)
#pragma unroll
    for (int nn = 0; nn < 8; ++nn) cb[m][nn] = f32x4{0.f, 0.f, 0.f, 0.f};
  mma_lds<2, 8, false>(Cs + wave * 32 * LDT, LDT, Un, LDT, 2, cb, fr, fq);
  f32x4 yacc[2][4];
#pragma unroll
  for (int m = 0; m < 2; ++m)
#pragma unroll
    for (int nn = 0; nn < 4; ++nn) yacc[m][nn] = f32x4{0.f, 0.f, 0.f, 0.f};
  for (int dir = 0; dir < 2; ++dir) {
    __syncthreads();
    ssd_scalars(P, l, hrow0, h, dir, dts, S, tmp);
#pragma unroll
    for (int m = 0; m < 2; ++m)
#pragma unroll
      for (int j = 0; j < 4; ++j) {
        int lrow = wave * 32 + m * 16 + fq * 4 + j;
        float Sl = S[lrow];
#pragma unroll
        for (int nn = 0; nn < 8; ++nn) {
          int s = nn * 16 + fr;
          bool ok = dir == 0 ? (s <= lrow) : (s >= lrow);
          float coef = ok ? __expf(Sl - S[s]) * dts[s] : 0.f;
          Un[lrow * LDK + s] = f2bf(cb[m][nn][j] * coef);
        }
      }
    {
      const u16* en = ((u16*)(P.ws + OFF_enter)) + (((size_t)(bl * 2 + dir) * 8 + h) * 18 + jp) * 4096;
      for (int cid = tid; cid < 512; cid += 256) {
        int pr = cid >> 3, c8 = (cid & 7) * 8;
        *(u32x4*)(Et + pr * LDT + c8) = *(const u32x4*)(en + pr * 64 + c8);
      }
    }
    __syncthreads();
    mma_lds<2, 4, true>(Un + wave * 32 * LDK, LDK, xT, LDK, 4, yacc, fr, fq);
    f32x4 yi[2][4];
#pragma unroll
    for (int m = 0; m < 2; ++m)
#pragma unroll
      for (int nn = 0; nn < 4; ++nn) yi[m][nn] = f32x4{0.f, 0.f, 0.f, 0.f};
    mma_lds<2, 4, true>(Cs + wave * 32 * LDT, LDT, Et, LDT, 2, yi, fr, fq);
#pragma unroll
    for (int m = 0; m < 2; ++m) {
      float e = __expf(S[wave * 32 + m * 16 + fr]);
#pragma unroll
      for (int nn = 0; nn < 4; ++nn)
#pragma unroll
        for (int j = 0; j < 4; ++j) yacc[m][nn][j] += e * yi[m][nn][j];
    }
  }
  const float dsk = P.ssd_d[l * 8 + h];
  const float* gn = P.ssd_norm_g + l * 512 + h * 64;
#pragma unroll
  for (int m = 0; m < 2; ++m) {
    int lrow = wave * 32 + m * 16 + fr;
    float ss = 0.f;
#pragma unroll
    for (int nn = 0; nn < 4; ++nn) {
      int pc = nn * 16 + fq * 4;
      bf16x4 zz = *(const bf16x4*)(((u16*)(P.ws + OFF_z)) + (size_t)(hrow0 + lrow) * 512 + h * 64 + pc);
      float4 g4 = *(const float4*)(gn + pc);
      float gg[4] = {g4.x, g4.y, g4.z, g4.w};
      float o[4];
#pragma unroll
      for (int j = 0; j < 4; ++j) {
        float y = yacc[m][nn][j] + dsk * bf2f(xT[(pc + j) * LDK + lrow]);
        y *= siluf_(bf2f((u16)zz[j]));
        ss += y * y;
        o[j] = y * gg[j];
      }
      *(bf16x4*)(((u16*)(P.ws + OFF_br1)) + ((size_t)hb * HROWS + hrow0 + lrow) * 512 + h * 64 + pc) = pack4(o[0], o[1], o[2], o[3]);
    }
    ss += __shfl_xor(ss, 16);
    ss += __shfl_xor(ss, 32);
    if (fq == 0) ((float*)(P.ws + OFF_ssq))[((size_t)hb * HROWS + hrow0 + lrow) * 8 + h] = ss;
  }
}

DI void merge_tile(const Params& P, int l, int mt, int nt, char* smem) {
  const int tid = TID(), wave = tid >> 6, lane = tid & 63, fr = lane & 15, fq = lane >> 4;
  const int wr = wave >> 1, wc = wave & 1;
  const int row0 = mt * 128;
  f32x4 accS[4][2];
  zero_acc<2>(accS);
  const u16* brs[4] = {((u16*)(P.ws + OFF_br0)), ((u16*)(P.ws + OFF_br1)), ((u16*)(P.ws + OFF_br2)), ((u16*)(P.ws + OFF_br3))};
#pragma unroll 1
  for (int kq = 0; kq < 4; ++kq) {
    f32x4 g[4][2];
    zero_acc<2>(g);
    gemm_main<2, true, false>(((u16*)(P.ws + OFF_H)), DM, nullptr, row0, ((u16*)(P.ws + OFF_WgT)) + ((size_t)l * 4 + kq) * 1024 * 1024, 1024, nt * 64, 1024, g, (u16*)smem);
#pragma unroll
    for (int m = 0; m < 4; ++m)
#pragma unroll
      for (int n = 0; n < 2; ++n)
#pragma unroll
        for (int j = 0; j < 4; ++j) g[m][n][j] = sigmoidf_(g[m][n][j]);
    f32x4 bb[4][2];
    zero_acc<2>(bb);
    const u16* br = kq == 0 ? ((u16*)(P.ws + OFF_br0)) : (kq == 1 ? ((u16*)(P.ws + OFF_br1)) : (kq == 2 ? ((u16*)(P.ws + OFF_br2)) : ((u16*)(P.ws + OFF_br3))));
    gemm_main<2, true, false>(br, 512, nullptr, row0, ((u16*)(P.ws + OFF_WbT)) + ((size_t)l * 4 + kq) * 1024 * 512, 512, nt * 64, 512, bb, (u16*)smem);
#pragma unroll
    for (int m = 0; m < 4; ++m) {
      float rs = 1.f;
      if (kq == 1) {
        const float* sq = ((float*)(P.ws + OFF_ssq)) + (size_t)(row0 + wr * 64 + m * 16 + fr) * 8;
        float4 a = *(const float4*)sq, b = *(const float4*)(sq + 4);
        rs = rsqrtf((a.x + a.y + a.z + a.w + b.x + b.y + b.z + b.w) * (1.f / 512.f) + LN_EPS);
      }
#pragma unroll
      for (int n = 0; n < 2; ++n)
#pragma unroll
        for (int j = 0; j < 4; ++j) accS[m][n][j] += g[m][n][j] * bb[m][n][j] * rs;
    }
  }
  (void)brs;
#pragma unroll
  for (int m = 0; m < 4; ++m)
#pragma unroll
    for (int n = 0; n < 2; ++n) {
      int r = row0 + wr * 64 + m * 16 + fr, c = nt * 64 + wc * 32 + n * 16 + fq * 4;
      *(bf16x4*)(((u16*)(P.ws + OFF_acc)) + (size_t)r * DM + c) = pack4v(accS[m][n]);
    }
}

DI void phase_merge(const Params& P, int l, char* smem) {
  const bool last = (l == 1);
  for (int it = blockIdx.x; it < 288 * 16; it += gridDim.x) {
    int mt = it / 16, nt = it % 16;
    if (last && (mt % 18) >= 16) continue;
    merge_tile(P, l, mt, nt, smem);
  }
}

DI void phase_outproj(const Params& P, int l, char* smem) {
  const bool last = (l == 1);
  const int tid = TID(), wave = tid >> 6, lane = tid & 63, fr = lane & 15, fq = lane >> 4;
  const int wr = wave >> 1, wc = wave & 1;
  for (int it = blockIdx.x; it < 288 * 8; it += gridDim.x) {
    int mt = it / 8, nt = it % 8;
    if (last && (mt % 18) >= 16) continue;
    f32x4 acc[4][4];
    zero_acc<4>(acc);
    gemm_main<4, true, false>(((u16*)(P.ws + OFF_acc)), DM, nullptr, mt * 128, ((u16*)(P.ws + OFF_WoT)) + (size_t)l * 1024 * 1024, 1024, nt * 128, 1024, acc, (u16*)smem);
#pragma unroll
    for (int m = 0; m < 4; ++m)
#pragma unroll
      for (int n = 0; n < 4; ++n) {
        int r = mt * 128 + wr * 64 + m * 16 + fr, c = nt * 128 + wc * 64 + n * 16 + fq * 4;
        *(bf16x4*)(((u16*)(P.ws + OFF_Y)) + (size_t)r * DM + c) = pack4v(acc[m][n]);
      }
  }
}

DI void phase_ffn1(const Params& P, int l, char* smem) {
  const bool last = (l == 1);
  const int tid = TID(), wave = tid >> 6, lane = tid & 63, fr = lane & 15, fq = lane >> 4;
  const int wr = wave >> 1, wc = wave & 1;
  const int nmt = last ? 512 : 576;
  for (int it = blockIdx.x; it < nmt * 8; it += gridDim.x) {
    int mt = it / 8, nt = it % 8;
    int R0 = mt * 128;
    int e = R0 < NFFN_LAT ? (R0 >> 8) & 15 : (R0 - NFFN_LAT) >> 9;
    f32x4 acc[4][4];
    zero_acc<4>(acc);
    gemm_main<4, true, true>(((u16*)(P.ws + OFF_H)), DM, ((int*)(P.ws + OFF_tokidx)), R0, ((u16*)(P.ws + OFF_W13T)) + (size_t)e * 1024 * 1024, 1024, nt * 128, 1024, acc, (u16*)smem);
#pragma unroll
    for (int m = 0; m < 4; ++m)
#pragma unroll
      for (int n2 = 0; n2 < 2; ++n2) {
        int r = R0 + wr * 64 + m * 16 + fr;
        int hc = (nt * 4 + wc * 2 + n2) * 16 + fq * 4;
        f32x4 a = acc[m][2 * n2], b = acc[m][2 * n2 + 1];
        *(bf16x4*)(((u16*)(P.ws + OFF_hid)) + (size_t)r * 512 + hc) = pack4(siluf_(a[0]) * b[0], siluf_(a[1]) * b[1], siluf_(a[2]) * b[2], siluf_(a[3]) * b[3]);
      }
  }
}

DI void phase_ffn2(const Params& P, int l, char* smem) {
  const bool last = (l == 1);
  const int tid = TID(), wave = tid >> 6, lane = tid & 63, fr = lane & 15, fq = lane >> 4;
  const int wr = wave >> 1, wc = wave & 1;
  const int nmt = last ? 512 : 576;
  for (int it = blockIdx.x; it < nmt * 8; it += gridDim.x) {
    int mt = it / 8, nt = it % 8;
    int R0 = mt * 128;
    int e = R0 < NFFN_LAT ? (R0 >> 8) & 15 : (R0 - NFFN_LAT) >> 9;
    f32x4 acc[4][4];
    zero_acc<4>(acc);
    gemm_main<4, true, false>(((u16*)(P.ws + OFF_hid)), 512, nullptr, R0, ((u16*)(P.ws + OFF_W2T)) + (size_t)e * 1024 * 512, 512, nt * 128, 512, acc, (u16*)smem);
#pragma unroll
    for (int m = 0; m < 4; ++m) {
      int r = R0 + wr * 64 + m * 16 + fr;
      float gt = ((float*)(P.ws + OFF_gatev))[r];
#pragma unroll
      for (int n = 0; n < 4; ++n) {
        int c = nt * 128 + wc * 64 + n * 16 + fq * 4;
        f32x4 v = acc[m][n];
        *(bf16x4*)(((u16*)(P.ws + OFF_ye)) + (size_t)r * DM + c) = pack4(v[0] * gt, v[1] * gt, v[2] * gt, v[3] * gt);
      }
    }
  }
}

DI int wq_next(unsigned* ctr, char* smem) {
  volatile int* slot = (volatile int*)(smem + SMEM_BYTES - 32);
  __syncthreads();
  if (TID() == 0) *slot = (int)__hip_atomic_fetch_add(ctr, 1u, __ATOMIC_RELAXED, __HIP_MEMORY_SCOPE_AGENT);
  __syncthreads();
  return *slot;
}

DI void phase_mix2(const Params& P, int l, int hb, char* smem) {
  const bool last = (l == 1);
  const int nA = 576, nG = 144, nS = 2304, nP = 576;
  for (;;) {
    const int it = wq_next((unsigned*)(P.ws + OFF_bar) + 3600 + 16 * (l * 2 + hb), smem);
    if (it >= nA + nG + nS + nP) break;
    if (it < nA) {
      if (last && (it % 18) >= 16) continue;
      attn_item(P, l, hb, it, smem);
    } else if (it < nA + nG) {
      const int mt = it - nA;
      if (last && (mt % 18) >= 16) continue;
      sgu_item(P, l, hb, mt, smem);
    } else if (it < nA + nG + nS) {
      ssd_state_item(P, l, hb, it - nA - nG, smem);
    } else {
      const int t = it - nA - nG - nS;
      const int mt = t >> 2, g = t & 3;
      if (last && (mt % 18) >= 16) continue;
      pool_item(P, l, hb, mt, g, smem);
    }
  }
}

DI void phase_ssd_out(const Params& P, int l, int hb, char* smem) {
  const bool last = (l == 1);
  for (int it = blockIdx.x; it < 8 * 18 * 8; it += gridDim.x) {
    int jp = (it >> 3) % 18;
    if (last && jp >= 16) continue;
    ssd_out_item(P, l, hb, it, smem);
  }
}

#define XB_TMO      128
#define XB_XCNT(j)  (256  + 64 * (j))
#define XB_XSUB(j)  (1280 + 64 * (j))
#define XB_XGEN(j)  (2304 + 64 * (j))
#define XB_TOP      3328
#define XB_TOPGEN   3392
#define XCD_BAR_WORDS 3456
#define XB_SPIN_CAP (1u << 18)
#define LAS __attribute__((address_space(3)))

__device__ __forceinline__ unsigned xb_ld(unsigned* p)              { return __hip_atomic_load(p, __ATOMIC_RELAXED, __HIP_MEMORY_SCOPE_AGENT); }
__device__ __forceinline__ unsigned xb_add(unsigned* p, unsigned v) { return __hip_atomic_fetch_add(p, v, __ATOMIC_RELAXED, __HIP_MEMORY_SCOPE_AGENT); }
__device__ __forceinline__ unsigned xb_xcc_id() { return (unsigned)__builtin_amdgcn_s_getreg((3 << 11) | 20) & 0xFu; }
#define XB_SPIN(cond, bar) do { unsigned _sp = 0; while (cond) { __builtin_amdgcn_s_sleep(1); \
    if ((++_sp & 255u) == 0u) { if (xb_ld(&(bar)[XB_TMO])) break; if (_sp > XB_SPIN_CAP) { atomicAdd(&(bar)[XB_TMO], 1u); break; } } } } while (0)

struct XcdBarrier {
    unsigned* bar; unsigned x;
    volatile LAS unsigned* st;
};

__device__ __forceinline__ XcdBarrier xcd_barrier_post(unsigned* bar, volatile LAS unsigned* st) {
    XcdBarrier b; b.bar = bar; b.x = xb_xcc_id(); b.st = st;
    if (threadIdx.x == 0) (void)xb_add(&bar[XB_XCNT(b.x)], 1u);
    return b;
}
__device__ __forceinline__ void xcd_barrier_complete(unsigned* bar, unsigned x, unsigned& nloc, unsigned& nx) {
    const unsigned G = gridDim.x * gridDim.y * gridDim.z;
    unsigned sum, cnt, mine, sp = 0u;
    for (;;) {
        sum = 0u; cnt = 0u; mine = 0u;
#pragma unroll
        for (unsigned j = 0; j < 16; ++j) { const unsigned c = xb_ld(&bar[XB_XCNT(j)]); sum += c; cnt += (c > 0u) ? 1u : 0u; mine = (j == x) ? c : mine; }
        if (sum == G) break;
        __builtin_amdgcn_s_sleep(1);
        if ((++sp & 255u) == 0u) { if (xb_ld(&bar[XB_TMO])) break; if (sp > XB_SPIN_CAP) { atomicAdd(&bar[XB_TMO], 1u); break; } }
    }
    nloc = mine > 0u ? mine : 1u; nx = cnt > 0u ? cnt : 1u;
}

__device__ __forceinline__ void xcd_barrier(const XcdBarrier& b) {
    asm volatile("s_waitcnt vmcnt(0)" ::: "memory");
    __syncthreads();
    if (threadIdx.x == 0) {
        unsigned* bar = b.bar;
        __builtin_amdgcn_s_waitcnt(0);
        unsigned nloc = b.st[0], nx = b.st[1];
        if (nloc == 0u) { xcd_barrier_complete(bar, b.x, nloc, nx); b.st[0] = nloc; b.st[1] = nx; }
        const unsigned old = xb_add(&bar[XB_XSUB(b.x)], 1u);
        const unsigned gen = old / nloc;
        if (old + 1u == (gen + 1u) * nloc) {
            __builtin_amdgcn_fence(__ATOMIC_RELEASE, "agent");
            asm volatile("s_waitcnt vmcnt(0)" ::: "memory");
            const unsigned og = xb_add(&bar[XB_TOP], 1u);
            const unsigned tg = og / nx;
            if (og + 1u == (tg + 1u) * nx) xb_add(&bar[XB_TOPGEN], 1u);
            else XB_SPIN(xb_ld(&bar[XB_TOPGEN]) == tg, bar);
            __builtin_amdgcn_fence(__ATOMIC_ACQUIRE, "agent");
            xb_add(&bar[XB_XGEN(b.x)], 1u);
            asm volatile("s_waitcnt vmcnt(0)" ::: "memory");
        } else {
            XB_SPIN(xb_ld(&bar[XB_XGEN(b.x)]) == gen, bar);
            __builtin_amdgcn_fence(__ATOMIC_ACQUIRE, "agent");
            asm volatile("s_waitcnt vmcnt(0)" ::: "memory");
        }
    }
    __syncthreads();
}


template <bool COOP>
__global__ void __launch_bounds__(256, 2) mk_forward(Params P, int ph_begin, int ph_end) {
  __shared__ __attribute__((aligned(16))) char smem[SMEM_BYTES];
  int ph = 0;
  volatile LAS unsigned* xbst = (volatile LAS unsigned*)(smem + SMEM_BYTES - 16);
  XcdBarrier xb;
  if (COOP) {
    if (__builtin_amdgcn_workitem_id_x() == 0) { xbst[0] = 0u; xbst[1] = 0u; xbst[2] = 0u; xbst[3] = 0u; }
    __syncthreads();
    xb = xcd_barrier_post((unsigned*)(P.ws + OFF_bar), xbst);
  }
#define PHASE(code)                                         \
  {                                                         \
    if (ph >= ph_begin && ph < ph_end) { code; }            \
    ++ph;                                                   \
    if (COOP && ph > ph_begin && ph < ph_end) {             \
      if (ph == 1) cg::this_grid().sync();                  \
      else xcd_barrier(xb);                                 \
    }                                                       \
  }
  PHASE(phase_prologue(P, smem));
  PHASE(phase_h0(P));
  for (int l = 0; l < 2; ++l) {
    for (int hb = 0; hb < 2; ++hb) {
      PHASE(phase_proj(P, l, hb, smem));
      PHASE(phase_mix2(P, l, hb, smem));
      PHASE(phase_carry(P));
      PHASE(phase_ssd_out(P, l, hb, smem));
    }
    PHASE(phase_merge(P, l, smem));
    PHASE(phase_outproj(P, l, smem));
    PHASE(phase_ln1(P, l, smem));
    PHASE(phase_topk(P, l, smem));
    PHASE(phase_ffn1(P, l, smem));
    PHASE(phase_ffn2(P, l, smem));
    PHASE(phase_ln2(P, l));
  }
#undef PHASE
}

#ifndef MK_COOP
#define MK_COOP 1
#endif

extern "C" void kernel_launch(void* const* d_in, const int* in_sizes, int n_in, void* d_out, int out_size, void* d_ws, size_t ws_size,
                              hipStream_t stream) {
  Params p{};
  const float* const* in = (const float* const*)d_in;
  p.x = in[0]; p.c = in[1]; p.ctx = in[2]; p.c_ctx = in[3]; p.w_mod = in[4]; p.b_mod = in[5]; p.w_in = in[6]; p.conv_w = in[7];
  p.conv_b = in[8]; p.a_log = in[9]; p.dt_bias = in[10]; p.ssd_d = in[11]; p.ssd_norm_g = in[12]; p.diff_lambda = in[13];
  p.diff_norm_g = in[14]; p.pool_w = in[15]; p.pool_scale = in[16]; p.sgu_ln_g = in[17]; p.sgu_ln_b = in[18]; p.sgu_w = in[19];
  p.sgu_b = in[20]; p.w_gate = in[21]; p.w_branch = in[22]; p.w_out = in[23]; p.ln1_g = in[24]; p.ln1_b = in[25]; p.w_router = in[26];
  p.w1 = in[27]; p.w3 = in[28]; p.w2 = in[29]; p.ln2_g = in[30]; p.ln2_b = in[31];
  p.out = (float*)d_out;
  p.ws = (char*)d_ws;
  if (WS_NEED > ws_size) { fprintf(stderr, "workspace too small: need %zu have %zu\n", (size_t)WS_NEED, ws_size); return; }

  static int grid_blocks = 0;
  if (!grid_blocks) {
    int dev = 0, cus = 0, per_cu = 0;
    hipGetDevice(&dev);
    hipDeviceGetAttribute(&cus, hipDeviceAttributeMultiprocessorCount, dev);
    if (MK_COOP) hipOccupancyMaxActiveBlocksPerMultiprocessor(&per_cu, mk_forward<true>, 256, 0);
    else hipOccupancyMaxActiveBlocksPerMultiprocessor(&per_cu, mk_forward<false>, 256, 0);
    if (per_cu < 1) per_cu = 1;
    if (per_cu > 2) per_cu = 2;
    grid_blocks = cus * per_cu;
  }
#if MK_COOP
  hipMemsetAsync((char*)d_ws + OFF_bar, 0, 16384, stream);
  int b = 0, e = NPHASE;
  void* args[] = {&p, &b, &e};
  hipError_t err = hipLaunchCooperativeKernel((void*)mk_forward<true>, dim3(grid_blocks), dim3(256), args, 0, stream);
  if (err != hipSuccess) fprintf(stderr, "cooperative launch failed: %s (grid %d)\n", hipGetErrorString(err), grid_blocks);
#else
  for (int ph = 0; ph < NPHASE; ++ph) hipLaunchKernelGGL(mk_forward<false>, dim3(grid_blocks), dim3(256), 0, stream, p, ph, ph + 1);
#endif
}
```

```cpp
#include <hip/hip_runtime.h>
#include <hip/hip_cooperative_groups.h>
#include <cstdio>
#include <cstdint>
namespace cg = cooperative_groups;

typedef unsigned short u16;
using bf16x8 = __attribute__((ext_vector_type(8))) short;
using bf16x4 = __attribute__((ext_vector_type(4))) short;
using f32x4 = __attribute__((ext_vector_type(4))) float;
using u32x4 = __attribute__((ext_vector_type(4))) unsigned;

#define DI __device__ __forceinline__
#define MFMA16(a, b, c) __builtin_amdgcn_mfma_f32_16x16x32_bf16((a), (b), (c), 0, 0, 0)

constexpr int NB = 16, SEQ = 2048, CTXL = 256, SP = 2304, NTOK = NB * SP, DM = 1024;
constexpr int HROWS = 8 * SP;
constexpr int INC = 4368, INP = 4480;
constexpr int NFFN_LAT = 65536, NFFN_ALL = 73728;
constexpr float LN_EPS = 1e-5f;
constexpr float ALPHA = 1.41421356237309515f;
constexpr int SMEM_BYTES = 81920;
constexpr int NPHASE = 2 + 2 * (2 * 4 + 7);


constexpr size_t al256(size_t x) { return (x + 255) & ~(size_t)255; }
constexpr size_t U_ = (size_t)NTOK * 512 * 2;
constexpr size_t OFF_WinT = 0;
constexpr size_t OFF_WgT = OFF_WinT + al256((size_t)2 * INP * 1024 * 2);
constexpr size_t OFF_WbT = OFF_WgT + al256((size_t)2 * 4 * 1024 * 1024 * 2);
constexpr size_t OFF_WoT = OFF_WbT + al256((size_t)2 * 4 * 1024 * 512 * 2);
constexpr size_t OFF_poolT = OFF_WoT + al256((size_t)2 * 1024 * 1024 * 2);
constexpr size_t OFF_sguW = OFF_poolT + al256((size_t)2 * 4 * 128 * 128 * 2);
constexpr size_t OFF_mod = OFF_sguW + al256((size_t)2 * 4 * 128 * 128 * 2);
constexpr size_t OFF_rope = OFF_mod + al256((size_t)2 * 17 * 6144 * 4);
constexpr size_t OFF_lamv = OFF_rope + al256(64 * 16 * 2 * 4);
constexpr size_t OFF_bar = OFF_lamv + 256;
constexpr size_t OFF_aff = OFF_bar + 16384;
constexpr size_t OFF_rank = OFF_aff + al256((size_t)NTOK * 16 * 4);
constexpr size_t OFF_ssq = OFF_rank + al256((size_t)NTOK * 16 * 4);
constexpr size_t OFF_tokidx = OFF_ssq + al256((size_t)NTOK * 8 * 4);
constexpr size_t OFF_gatev = OFF_tokidx + al256((size_t)NFFN_ALL * 4);
constexpr size_t OFF_dtbuf = OFF_gatev + al256((size_t)NFFN_ALL * 4);
constexpr size_t OFF_decay = OFF_dtbuf + al256((size_t)HROWS * 16 * 4);
constexpr size_t OFF_H = OFF_decay + al256((size_t)8 * 2 * 8 * 18 * 4);
constexpr size_t OFF_Y = OFF_H + 2 * U_;
constexpr size_t OFF_o1 = OFF_Y;
constexpr size_t OFF_cstate = OFF_Y + U_ / 2;
constexpr size_t OFF_enter = OFF_Y + U_ / 2 + U_;
constexpr size_t OFF_RM = OFF_Y + 2 * U_;
constexpr size_t OFF_xp = OFF_RM;
constexpr size_t OFF_z = OFF_xp + U_ / 2;
constexpr size_t OFF_xbc = OFF_z + U_ / 2;
constexpr size_t OFF_q = OFF_xbc + (U_ / 4) * 3;
constexpr size_t OFF_k = OFF_q + U_ / 2;
constexpr size_t OFF_vT = OFF_k + U_ / 2;
constexpr size_t OFF_gvT = OFF_vT + U_ / 2;
constexpr size_t OFF_br0 = OFF_gvT + U_ / 2;
constexpr size_t OFF_br1 = OFF_br0 + U_;
constexpr size_t OFF_br2 = OFF_br1 + U_;
constexpr size_t OFF_br3 = OFF_br2 + U_;
constexpr size_t OFF_acc = OFF_RM;
constexpr size_t OFF_W13T = OFF_RM;
constexpr size_t OFF_W2T = OFF_W13T + (size_t)16 * 1024 * 1024 * 2;
constexpr size_t OFF_hid = OFF_W2T + (size_t)16 * 1024 * 512 * 2;
constexpr size_t OFF_ye = OFF_hid + (size_t)NFFN_ALL * 512 * 2;
constexpr size_t WS_MIX_END = OFF_br3 + U_;
constexpr size_t WS_FFN_END = OFF_ye + (size_t)NFFN_ALL * 1024 * 2;
constexpr size_t WS_NEED = WS_MIX_END > WS_FFN_END ? WS_MIX_END : WS_FFN_END;

struct Params {
  const float *x, *c, *ctx, *c_ctx, *w_mod, *b_mod, *w_in, *conv_w, *conv_b, *a_log, *dt_bias, *ssd_d, *ssd_norm_g,
      *diff_lambda, *diff_norm_g, *pool_w, *pool_scale, *sgu_ln_g, *sgu_ln_b, *sgu_w, *sgu_b, *w_gate, *w_branch, *w_out,
      *ln1_g, *ln1_b, *w_router, *w1, *w3, *w2, *ln2_g, *ln2_b;
  float* out;
  char* ws;
};

DI int TID() { int t = (int)__builtin_amdgcn_workitem_id_x(); asm volatile("" : "+v"(t)); return t; }
DI u16 f2bf(float x) { unsigned u = __float_as_uint(x); u += 0x7fffu + ((u >> 16) & 1u); return (u16)(u >> 16); }
DI float bf2f(u16 v) { return __uint_as_float(((unsigned)v) << 16); }
DI float sigmoidf_(float x) { return 1.f / (1.f + __expf(-x)); }
DI float siluf_(float x) { return x / (1.f + __expf(-x)); }
DI float geluf_(float x) { float y = 0.7978845608028654f * (x + 0.044715f * x * x * x); float t = 1.f - 2.f / (__expf(2.f * y) + 1.f); return 0.5f * x * (1.f + t); }
DI float softplusf_(float x) { return x > 20.f ? x : log1pf(__expf(x)); }
DI bf16x4 pack4(float a, float b, float c, float d) { bf16x4 r; r[0] = (short)f2bf(a); r[1] = (short)f2bf(b); r[2] = (short)f2bf(c); r[3] = (short)f2bf(d); return r; }
DI bf16x4 pack4v(f32x4 v) { return pack4(v[0], v[1], v[2], v[3]); }
DI float wave_sum(float v) { for (int o = 32; o > 0; o >>= 1) v += __shfl_xor(v, o); return v; }

template <int MI, int NI, bool SWAP>
DI void mma_lds(const u16* As, int lda, const u16* Bs, int ldb, int ksteps, f32x4 (&acc)[MI][NI], int fr, int fq) {
  for (int ks = 0; ks < ksteps; ++ks) {
    bf16x8 a[MI], b[NI];
#pragma unroll
    for (int m = 0; m < MI; ++m) a[m] = *(const bf16x8*)(As + (m * 16 + fr) * lda + ks * 32 + fq * 8);
#pragma unroll
    for (int n = 0; n < NI; ++n) b[n] = *(const bf16x8*)(Bs + (n * 16 + fr) * ldb + ks * 32 + fq * 8);
#pragma unroll
    for (int m = 0; m < MI; ++m)
#pragma unroll
      for (int n = 0; n < NI; ++n) acc[m][n] = SWAP ? MFMA16(b[n], a[m], acc[m][n]) : MFMA16(a[m], b[n], acc[m][n]);
  }
}

constexpr int LDT = 72;
template <int NI, bool SWAP, bool GATHER>
DI void gemm_main(const u16* __restrict__ A, int lda, const int* __restrict__ aidx, int arow0, const u16* __restrict__ Bt, int ldb, int brow0,
                  int K, f32x4 (&acc)[4][NI], u16* smem) {
  constexpr int BN = NI * 32;
  constexpr int NBL = BN / 32;
  const int tid = TID(), wave = tid >> 6, lane = tid & 63, fr = lane & 15, fq = lane >> 4;
  const int wr = wave >> 1, wc = wave & 1;
  u16* As = smem;
  u16* Bs = smem + 2 * 128 * LDT;
  const int lr = tid >> 3, lc = (tid & 7) * 8;
  const u16* ap[4];
#pragma unroll
  for (int i = 0; i < 4; ++i) {
    int r = arow0 + lr + 32 * i;
    size_t rr = GATHER ? (size_t)aidx[r] : (size_t)r;
    ap[i] = A + rr * lda + lc;
  }
  const u16* bp = Bt + (size_t)(brow0 + lr) * ldb + lc;
  u32x4 ra0[4], rb0[NBL], ra1[4], rb1[NBL];
  const int nk = K / 64;
#define GLOAD(RA, RB, KO)                                                                   \
  {                                                                                         \
    _Pragma("unroll") for (int i = 0; i < 4; ++i) RA[i] = *(const u32x4*)(ap[i] + (KO));    \
    _Pragma("unroll") for (int i = 0; i < NBL; ++i) RB[i] = *(const u32x4*)(bp + (size_t)(32 * i) * ldb + (KO)); \
  }
#define SSTORE(RA, RB, BUF)                                                                 \
  {                                                                                         \
    _Pragma("unroll") for (int i = 0; i < 4; ++i) *(u32x4*)(As + (BUF) * 128 * LDT + (lr + 32 * i) * LDT + lc) = RA[i];  \
    _Pragma("unroll") for (int i = 0; i < NBL; ++i) *(u32x4*)(Bs + (BUF) * BN * LDT + (lr + 32 * i) * LDT + lc) = RB[i]; \
  }
#define COMPUTE(BUF) mma_lds<4, NI, SWAP>(As + (BUF) * 128 * LDT + wr * 64 * LDT, LDT, Bs + (BUF) * BN * LDT + wc * (NI * 16) * LDT, LDT, 2, acc, fr, fq)
  GLOAD(ra0, rb0, 0);
  GLOAD(ra1, rb1, 64);
  __syncthreads();
  SSTORE(ra0, rb0, 0);
  __syncthreads();
  for (int kt = 0; kt < nk; kt += 2) {
    if (kt + 2 < nk) GLOAD(ra0, rb0, (kt + 2) * 64);
    COMPUTE(0);
    SSTORE(ra1, rb1, 1);
    __syncthreads();
    if (kt + 3 < nk) GLOAD(ra1, rb1, (kt + 3) * 64);
    COMPUTE(1);
    if (kt + 2 < nk) SSTORE(ra0, rb0, 0);
    __syncthreads();
  }
#undef GLOAD
#undef SSTORE
#undef COMPUTE
}

template <int NI> DI void zero_acc(f32x4 (&a)[4][NI]) {
#pragma unroll
  for (int m = 0; m < 4; ++m)
#pragma unroll
    for (int n = 0; n < NI; ++n) a[m][n] = f32x4{0.f, 0.f, 0.f, 0.f};
}

DI void cvt_tile(const float* __restrict__ src0, const float* __restrict__ src1, int ld, u16* __restrict__ dst, int K, int n0, int k0, int mode, u16* lds) {
  const int tid = TID();
  constexpr int LC = 66;
  __syncthreads();
  if (mode == 3) {
    for (int idx = tid; idx < 4096; idx += 256) {
      int n = idx >> 6, kk = idx & 63;
      lds[kk * LC + n] = f2bf(src0[(size_t)(n0 + n) * ld + k0 + kk]);
    }
  } else {
    for (int idx = tid; idx < 4096; idx += 256) {
      int kk = idx >> 6, n = idx & 63;
      int nn = n0 + n;
      float v = 0.f;
      if (mode == 0) v = src0[(size_t)(k0 + kk) * ld + nn];
      else if (mode == 1) {
        int col = nn < 1792 ? nn : (nn < 4352 ? nn + 16 : (nn < 4368 ? nn - 4352 + 1792 : -1));
        if (col >= 0) v = src0[(size_t)(k0 + kk) * ld + col];
        if (nn >= 1792 && nn < 2304) v *= 0.125f;
      } else {
        int g = nn >> 5, r = nn & 31;
        v = (r < 16) ? src0[(size_t)(k0 + kk) * ld + g * 16 + r] : src1[(size_t)(k0 + kk) * ld + g * 16 + r - 16];
      }
      lds[kk * LC + n] = f2bf(v);
    }
  }
  __syncthreads();
  for (int c = tid; c < 512; c += 256) {
    int n = c & 63, kc = (c >> 6) * 8;
    bf16x8 o;
#pragma unroll
    for (int j = 0; j < 8; ++j) o[j] = (short)lds[(kc + j) * LC + n];
    *(bf16x8*)(dst + (size_t)(n0 + n) * K + k0 + kc) = o;
  }
}

DI void mod_item(const Params& P, int item, char* smem) {
  const int l = item / 96, n0 = (item % 96) * 64;
  float* sc = (float*)smem;
  const int tid = TID();
  __syncthreads();
  for (int i = tid; i < 17 * 1024; i += 256) {
    int s = i >> 10, kk = i & 1023;
    float v = s < 16 ? P.c[s * 1024 + kk] : P.c_ctx[kk];
    sc[i] = siluf_(v);
  }
  __syncthreads();
  const int col = tid & 63, kp = tid >> 6;
  float a[17];
#pragma unroll
  for (int s = 0; s < 17; ++s) a[s] = 0.f;
  const float* w = P.w_mod + (size_t)l * 1024 * 6144 + n0 + col;
  for (int kk = kp * 256; kk < kp * 256 + 256; ++kk) {
    float wv = w[(size_t)kk * 6144];
#pragma unroll
    for (int s = 0; s < 17; ++s) a[s] += sc[s * 1024 + kk] * wv;
  }
  __syncthreads();
  float* red = (float*)smem;
#pragma unroll
  for (int s = 0; s < 17; ++s) red[(kp * 17 + s) * 64 + col] = a[s];
  __syncthreads();
  for (int i = tid; i < 17 * 64; i += 256) {
    int s = i >> 6, cc = i & 63;
    float v = red[(0 * 17 + s) * 64 + cc] + red[(1 * 17 + s) * 64 + cc] + red[(2 * 17 + s) * 64 + cc] + red[(3 * 17 + s) * 64 + cc];
    ((float*)(P.ws + OFF_mod))[((size_t)l * 17 + s) * 6144 + n0 + cc] = v + P.b_mod[l * 6144 + n0 + cc];
  }
}

DI void misc_item(const Params& P) {
  const int tid = TID();
  for (int i = tid; i < 1024; i += 256) {
    int pos = i >> 4, f = i & 15;
    float inv = powf(10000.f, -(float)f / 16.f);
    float ang = (float)pos * inv;
    ((float*)(P.ws + OFF_rope))[i * 2] = cosf(ang);
    ((float*)(P.ws + OFF_rope))[i * 2 + 1] = sinf(ang);
  }
  if (tid < 2) {
    const float* dl = P.diff_lambda + tid * 256;
    float s1 = 0.f, s2 = 0.f;
    for (int i = 0; i < 64; ++i) { s1 += dl[i] * dl[64 + i]; s2 += dl[128 + i] * dl[192 + i]; }
    float lam_init = 0.8f - 0.6f * expf(-0.3f * (float)tid);
    ((float*)(P.ws + OFF_lamv))[tid * 2] = expf(s1) - expf(s2) + lam_init;
    ((float*)(P.ws + OFF_lamv))[tid * 2 + 1] = lam_init;
  }
}

DI void phase_prologue(const Params& P, char* smem) {
  const int per_layer = 1120 + 4 * 256 + 4 * 128 + 256 + 16 + 16;
  const int ncvt = 2 * per_layer;
  const int total = ncvt + 192 + 1;
  for (int it = blockIdx.x; it < total; it += gridDim.x) {
    if (it < ncvt) {
      const int l = it / per_layer;
      int t = it % per_layer;
      const float* s0; u16* dst; int ld, K, ntk, mode;
      if (t < 1120) { s0 = P.w_in + (size_t)l * 1024 * INC; ld = INC; dst = ((u16*)(P.ws + OFF_WinT)) + (size_t)l * INP * 1024; K = 1024; ntk = 16; mode = 1; }
      else if (t < 2144) { t -= 1120; int kq = t >> 8; t &= 255; s0 = P.w_gate + ((size_t)l * 4 + kq) * 1024 * 1024; ld = 1024; dst = ((u16*)(P.ws + OFF_WgT)) + ((size_t)l * 4 + kq) * 1024 * 1024; K = 1024; ntk = 16; mode = 0; }
      else if (t < 2656) { t -= 2144; int kq = t >> 7; t &= 127; s0 = P.w_branch + ((size_t)l * 4 + kq) * 512 * 1024; ld = 1024; dst = ((u16*)(P.ws + OFF_WbT)) + ((size_t)l * 4 + kq) * 1024 * 512; K = 512; ntk = 8; mode = 0; }
      else if (t < 2912) { t -= 2656; s0 = P.w_out + (size_t)l * 1024 * 1024; ld = 1024; dst = ((u16*)(P.ws + OFF_WoT)) + (size_t)l * 1024 * 1024; K = 1024; ntk = 16; mode = 0; }
      else if (t < 2928) { t -= 2912; int g = t >> 2; t &= 3; s0 = P.pool_w + ((size_t)l * 4 + g) * 128 * 128; ld = 128; dst = ((u16*)(P.ws + OFF_poolT)) + ((size_t)l * 4 + g) * 128 * 128; K = 128; ntk = 2; mode = 0; }
      else { t -= 2928; int g = t >> 2; t &= 3; s0 = P.sgu_w + ((size_t)l * 4 + g) * 128 * 128; ld = 128; dst = ((u16*)(P.ws + OFF_sguW)) + ((size_t)l * 4 + g) * 128 * 128; K = 128; ntk = 2; mode = 3; }
      const int tn = t / ntk, tk = t % ntk;
      cvt_tile(s0, s0, ld, dst, K, tn * 64, tk * 64, mode, (u16*)smem);
    } else if (it < ncvt + 192) {
      mod_item(P, it - ncvt, smem);
    } else {
      misc_item(P);
    }
  }
}

DI void ffn_cvt_item(const Params& P, int l, int it, char* smem) {
  const int e = it / 384;
  int t = it % 384;
  if (t < 256) {
    cvt_tile(P.w1 + ((size_t)l * 16 + e) * 1024 * 512, P.w3 + ((size_t)l * 16 + e) * 1024 * 512, 512, ((u16*)(P.ws + OFF_W13T)) + (size_t)e * 1024 * 1024, 1024, (t >> 4) * 64, (t & 15) * 64, 2, (u16*)smem);
  } else {
    t -= 256;
    const float* s = P.w2 + ((size_t)l * 16 + e) * 512 * 1024;
    cvt_tile(s, s, 1024, ((u16*)(P.ws + OFF_W2T)) + (size_t)e * 1024 * 512, 512, (t >> 3) * 64, (t & 7) * 64, 0, (u16*)smem);
  }
}

DI void load_row_f32(const float* p, int lane, float (&v)[16]) {
#pragma unroll
  for (int k = 0; k < 4; ++k) { float4 t = *(const float4*)(p + lane * 4 + 256 * k); v[4 * k] = t.x; v[4 * k + 1] = t.y; v[4 * k + 2] = t.z; v[4 * k + 3] = t.w; }
}
DI void load_row_bf16(const u16* p, int lane, float (&v)[16]) {
#pragma unroll
  for (int k = 0; k < 4; ++k) { bf16x4 t = *(const bf16x4*)(p + lane * 4 + 256 * k); for (int i = 0; i < 4; ++i) v[4 * k + i] = bf2f((u16)t[i]); }
}
DI void store_row_f32(float* p, int lane, const float (&v)[16]) {
#pragma unroll
  for (int k = 0; k < 4; ++k) *(float4*)(p + lane * 4 + 256 * k) = make_float4(v[4 * k], v[4 * k + 1], v[4 * k + 2], v[4 * k + 3]);
}
DI void store_row_bf16(u16* p, int lane, const float (&v)[16]) {
#pragma unroll
  for (int k = 0; k < 4; ++k) *(bf16x4*)(p + lane * 4 + 256 * k) = pack4(v[4 * k], v[4 * k + 1], v[4 * k + 2], v[4 * k + 3]);
}
DI void ln_row(float (&v)[16], const float* g, const float* b, int lane) {
  float s = 0.f;
#pragma unroll
  for (int i = 0; i < 16; ++i) s += v[i];
  float mu = wave_sum(s) * (1.f / 1024.f);
  float q = 0.f;
#pragma unroll
  for (int i = 0; i < 16; ++i) { float d = v[i] - mu; q += d * d; }
  float rstd = rsqrtf(wave_sum(q) * (1.f / 1024.f) + LN_EPS);
  float gg[16], bb[16];
  load_row_f32(g, lane, gg); load_row_f32(b, lane, bb);
#pragma unroll
  for (int i = 0; i < 16; ++i) v[i] = (v[i] - mu) * rstd * gg[i] + bb[i];
}

DI void phase_h0(const Params& P) {
  const int lane = TID() & 63;
  const int gw = blockIdx.x * 4 + (TID() >> 6), nw = gridDim.x * 4;
  for (int row = gw; row < NTOK; row += nw) {
    int s = row / SP, p = row % SP;
    bool lat = p < SEQ;
    const float* xs = lat ? P.x + ((size_t)s * SEQ + p) * DM : P.ctx + ((size_t)s * CTXL + (p - SEQ)) * DM;
    const float* md = ((float*)(P.ws + OFF_mod)) + (size_t)(lat ? s : 16) * 6144;
    float v[16], sh[16], scl[16];
    load_row_f32(xs, lane, v); load_row_f32(md, lane, sh); load_row_f32(md + 1024, lane, scl);
#pragma unroll
    for (int i = 0; i < 16; ++i) v[i] = v[i] * (1.f + scl[i]) + sh[i];
    store_row_bf16(((u16*)(P.ws + OFF_H)) + (size_t)row * DM, lane, v);
  }
}

DI void compute_x1(const Params& P, int l, int row, int lane, float (&v)[16]) {
  int s = row / SP, p = row % SP;
  bool lat = p < SEQ;
  const float* xs;
  if (l == 0) xs = lat ? P.x + ((size_t)s * SEQ + p) * DM : P.ctx + ((size_t)s * CTXL + (p - SEQ)) * DM;
  else xs = P.out + ((size_t)s * SEQ + p) * DM;
  const float* md = ((float*)(P.ws + OFF_mod)) + ((size_t)l * 17 + (lat ? s : 16)) * 6144;
  float y[16], m2[16];
  load_row_f32(xs, lane, v); load_row_bf16(((u16*)(P.ws + OFF_Y)) + (size_t)row * DM, lane, y); load_row_f32(md + 2 * 1024, lane, m2);
#pragma unroll
  for (int i = 0; i < 16; ++i) v[i] = ALPHA * v[i] + m2[i] * y[i];
  ln_row(v, P.ln1_g + l * 1024, P.ln1_b + l * 1024, lane);
}

DI void phase_ln1(const Params& P, int l, char* smem) {
  const bool last = (l == 1);
  const int tid = TID();
  const int lane = tid & 63;
  const int gw = blockIdx.x * 4 + (tid >> 6), nw = gridDim.x * 4;
  float* wT = (float*)smem;
  __syncthreads();
  {
    const float* wr = P.w_router + (size_t)l * 1024 * 16;
    for (int i = tid; i < 4096; i += 256) {
      int c = i >> 2, e4 = (i & 3) * 4;
      float4 w = *(const float4*)(wr + (size_t)c * 16 + e4);
      wT[(e4 + 0) * 1024 + c] = w.x; wT[(e4 + 1) * 1024 + c] = w.y; wT[(e4 + 2) * 1024 + c] = w.z; wT[(e4 + 3) * 1024 + c] = w.w;
    }
  }
  __syncthreads();
  for (int row = gw; row < NTOK; row += nw) {
    int s = row / SP, p = row % SP;
    bool lat = p < SEQ;
    if (last && !lat) continue;
    float v[16];
    compute_x1(P, l, row, lane, v);
    const float* md = ((float*)(P.ws + OFF_mod)) + ((size_t)l * 17 + (lat ? s : 16)) * 6144;
    float m3[16], m4[16];
    load_row_f32(md + 3 * 1024, lane, m3); load_row_f32(md + 4 * 1024, lane, m4);
#pragma unroll
    for (int i = 0; i < 16; ++i) v[i] = v[i] * (1.f + m4[i]) + m3[i];
    store_row_bf16(((u16*)(P.ws + OFF_H)) + (size_t)row * DM, lane, v);
    float lg[16];
#pragma unroll
    for (int e = 0; e < 16; ++e) {
      float a = 0.f;
#pragma unroll
      for (int k = 0; k < 4; ++k) {
        float4 w = *(const float4*)(wT + e * 1024 + lane * 4 + 256 * k);
        a += v[4 * k] * w.x + v[4 * k + 1] * w.y + v[4 * k + 2] * w.z + v[4 * k + 3] * w.w;
      }
      lg[e] = a;
    }
#pragma unroll
    for (int e = 0; e < 16; ++e) lg[e] = wave_sum(lg[e]);
    float mx = lg[0];
#pragma unroll
    for (int e = 1; e < 16; ++e) mx = fmaxf(mx, lg[e]);
    float sum = 0.f;
#pragma unroll
    for (int e = 0; e < 16; ++e) { lg[e] = expf(lg[e] - mx); sum += lg[e]; }
    float inv = 1.f / sum;
    if (lane < 16) {
      float mine = 0.f;
#pragma unroll
      for (int e = 0; e < 16; ++e) if (lane == e) mine = lg[e];
      ((float*)(P.ws + OFF_aff))[(size_t)row * 16 + lane] = mine * inv;
    }
  }
  for (int it = blockIdx.x; it < 16 * 384; it += gridDim.x) ffn_cvt_item(P, l, it, smem);
}

DI int block_excl_scan(int v, int* red, int tid, int& total) {
  const int lane = tid & 63, wave = tid >> 6;
  int inc = v;
#pragma unroll
  for (int o = 1; o < 64; o <<= 1) { int t = __shfl_up(inc, o); if (lane >= o) inc += t; }
  __syncthreads();
  if (lane == 63) red[wave] = inc;
  __syncthreads();
  int base = 0;
#pragma unroll
  for (int w = 0; w < 4; ++w) { int t = red[w]; if (w < wave) base += t; }
  total = red[0] + red[1] + red[2] + red[3];
  return base + inc - v;
}

DI void phase_topk(const Params& P, int l, char* smem) {
  const bool last = (l == 1);
  const int tid = TID();
  unsigned* keys = (unsigned*)smem;
  int* red = (int*)(smem + 8192);
  const int nitems = last ? 256 : 512;
  for (int it = blockIdx.x; it < nitems; it += gridDim.x) {
    const bool isctx = it >= 256;
    const int se = it & 255, s = se >> 4, e = se & 15;
    const int n = isctx ? CTXL : SEQ, cap = isctx ? 32 : 256;
    const int row0 = s * SP + (isctx ? SEQ : 0);
    const int per = n >> 8;
    __syncthreads();
    for (int i = tid; i < n; i += 256) keys[i] = __float_as_uint(((float*)(P.ws + OFF_aff))[(size_t)(row0 + i) * 16 + e]);
    __syncthreads();
    unsigned kv[8];
#pragma unroll
    for (int j = 0; j < 8; ++j) kv[j] = (j < per) ? keys[tid * per + j] : 0u;
    unsigned prefix = 0u;
    int krem = cap;
    for (int bit = 31; bit >= 0; --bit) {
      const unsigned himask = (bit == 31) ? 0u : (0xFFFFFFFFu << (bit + 1));
      const unsigned want = prefix | (1u << bit);
      int c = 0;
#pragma unroll
      for (int j = 0; j < 8; ++j) c += (j < per && ((kv[j] & (himask | (1u << bit))) == want)) ? 1 : 0;
      c = (int)wave_sum((float)c);
      __syncthreads();
      if ((tid & 63) == 0) red[tid >> 6] = c;
      __syncthreads();
      const int cnt = red[0] + red[1] + red[2] + red[3];
      if (cnt >= krem) prefix = want; else krem -= cnt;
    }
    const unsigned T = prefix;
    int cgt = 0, ceq = 0;
#pragma unroll
    for (int j = 0; j < 8; ++j) if (j < per) { cgt += kv[j] > T ? 1 : 0; ceq += kv[j] == T ? 1 : 0; }
    int tot_gt, tot_eq, tot_sel;
    (void)block_excl_scan(cgt, red, tid, tot_gt);
    const int eq_before = block_excl_scan(ceq, red, tid, tot_eq);
    const int need_eq = cap - tot_gt;
    int eqc = eq_before, csel = 0;
    bool sel[8];
#pragma unroll
    for (int j = 0; j < 8; ++j) {
      sel[j] = false;
      if (j < per) {
        if (kv[j] > T) sel[j] = true;
        else if (kv[j] == T) { sel[j] = eqc < need_eq; ++eqc; }
        csel += sel[j] ? 1 : 0;
      }
    }
    int slot = block_excl_scan(csel, red, tid, tot_sel);
#pragma unroll
    for (int j = 0; j < 8; ++j) if (j < per) {
      const int t = tid * per + j;
      int rk = cap;
      if (sel[j]) {
        rk = slot++;
        const int R = isctx ? NFFN_LAT + (e * 16 + s) * 32 + rk : (s * 16 + e) * 256 + rk;
        ((int*)(P.ws + OFF_tokidx))[R] = row0 + t;
        ((float*)(P.ws + OFF_gatev))[R] = __uint_as_float(kv[j]);
      }
      ((int*)(P.ws + OFF_rank))[(size_t)(row0 + t) * 16 + e] = rk;
    }
  }
}

DI void phase_ln2(const Params& P, int l) {
  const bool last = (l == 1);
  const int lane = TID() & 63;
  const int gw = blockIdx.x * 4 + (TID() >> 6), nw = gridDim.x * 4;
  for (int row = gw; row < NTOK; row += nw) {
    int s = row / SP, p = row % SP;
    bool lat = p < SEQ;
    if (last && !lat) continue;
    float v[16];
    compute_x1(P, l, row, lane, v);
    float yf[16];
#pragma unroll
    for (int i = 0; i < 16; ++i) yf[i] = 0.f;
    const int cap = lat ? 256 : 32;
    for (int e = 0; e < 16; ++e) {
      int rk = ((int*)(P.ws + OFF_rank))[(size_t)row * 16 + e];
      if (rk < cap) {
        int R = lat ? (s * 16 + e) * 256 + rk : NFFN_LAT + (e * 16 + s) * 32 + rk;
        float t[16];
        load_row_bf16(((u16*)(P.ws + OFF_ye)) + (size_t)R * DM, lane, t);
#pragma unroll
        for (int i = 0; i < 16; ++i) yf[i] += t[i];
      }
    }
    const float* md = ((float*)(P.ws + OFF_mod)) + ((size_t)l * 17 + (lat ? s : 16)) * 6144;
    float m5[16];
    load_row_f32(md + 5 * 1024, lane, m5);
#pragma unroll
    for (int i = 0; i < 16; ++i) v[i] = ALPHA * v[i] + m5[i] * yf[i];
    ln_row(v, P.ln2_g + l * 1024, P.ln2_b + l * 1024, lane);
    if (lat) store_row_f32(P.out + ((size_t)s * SEQ + p) * DM, lane, v);
    if (!last) {
      const float* md2 = ((float*)(P.ws + OFF_mod)) + ((size_t)(l + 1) * 17 + (lat ? s : 16)) * 6144;
      float sh[16], scl[16];
      load_row_f32(md2, lane, sh); load_row_f32(md2 + 1024, lane, scl);
#pragma unroll
      for (int i = 0; i < 16; ++i) v[i] = v[i] * (1.f + scl[i]) + sh[i];
      store_row_bf16(((u16*)(P.ws + OFF_H)) + (size_t)row * DM, lane, v);
    }
  }
}

template <bool SWAP>
DI void proj_tile(const Params& P, int l, int hb, int mt, int nt, char* smem) {
  const int tid = TID(), wave = tid >> 6, lane = tid & 63, fr = lane & 15, fq = lane >> 4;
  const int wr = wave >> 1, wc = wave & 1;
  const int hrow0 = mt * 128, grow0 = hb * HROWS + hrow0;
  f32x4 acc[4][4];
  zero_acc<4>(acc);
  gemm_main<4, SWAP, false>(((u16*)(P.ws + OFF_H)), DM, nullptr, grow0, ((u16*)(P.ws + OFF_WinT)) + (size_t)l * INP * 1024, 1024, nt * 128, 1024, acc, (u16*)smem);
  const int jp = mt % 18;
  const int bl = mt / 18;
  const bool lat = jp < 16;
  if (SWAP) {
    u16* dst; int ldd, c0;
    if (nt < 4) { dst = ((u16*)(P.ws + OFF_xp)); ldd = 512; c0 = nt * 128; }
    else if (nt < 8) { dst = ((u16*)(P.ws + OFF_z)); ldd = 512; c0 = (nt - 4) * 128; }
    else if (nt < 14) { dst = ((u16*)(P.ws + OFF_xbc)); ldd = 768; c0 = (nt - 8) * 128; }
    else if (nt < 18) { dst = ((u16*)(P.ws + OFF_q)); ldd = 512; c0 = (nt - 14) * 128; }
    else if (nt < 22) { dst = ((u16*)(P.ws + OFF_k)); ldd = 512; c0 = (nt - 18) * 128; }
    else { dst = ((u16*)(P.ws + OFF_br3)); ldd = 512; c0 = (nt - 26) * 128; }
    const bool isu = nt >= 26;
    const bool rope = (nt >= 14 && nt < 22) && lat;
#pragma unroll
    for (int m = 0; m < 4; ++m) {
      int r = wr * 64 + m * 16 + fr;
      size_t orow = isu ? (size_t)(grow0 + r) : (size_t)(hrow0 + r);
      if (rope) {
        int t = jp * 128 + r;
        int prow = t >> 6, pcol = t & 63;
#pragma unroll
        for (int j = 0; j < 4; ++j) {
          int f = fq * 4 + j;
          float c1 = ((float*)(P.ws + OFF_rope))[(prow * 16 + f) * 2], s1 = ((float*)(P.ws + OFF_rope))[(prow * 16 + f) * 2 + 1];
          float c2 = ((float*)(P.ws + OFF_rope))[(pcol * 16 + f) * 2], s2 = ((float*)(P.ws + OFF_rope))[(pcol * 16 + f) * 2 + 1];
          float a = acc[m][0][j], b = acc[m][1][j];
          acc[m][0][j] = a * c1 - b * s1; acc[m][1][j] = a * s1 + b * c1;
          a = acc[m][2][j]; b = acc[m][3][j];
          acc[m][2][j] = a * c2 - b * s2; acc[m][3][j] = a * s2 + b * c2;
        }
      }
#pragma unroll
      for (int n = 0; n < 4; ++n) {
        f32x4 v = acc[m][n];
        if (isu) { v[0] = geluf_(v[0]); v[1] = geluf_(v[1]); v[2] = geluf_(v[2]); v[3] = geluf_(v[3]); }
        int col = c0 + wc * 64 + n * 16 + fq * 4;
        *(bf16x4*)(dst + orow * ldd + col) = pack4v(v);
      }
    }
  } else {
    if (nt == 34) {
      if (wc == 0) {
#pragma unroll
        for (int m = 0; m < 4; ++m)
#pragma unroll
          for (int j = 0; j < 4; ++j) ((float*)(P.ws + OFF_dtbuf))[(size_t)(hrow0 + wr * 64 + m * 16 + fq * 4 + j) * 16 + fr] = acc[m][0][j];
      }
    } else if (nt < 26) {
      int cb = (nt - 22) * 128 + wc * 64;
#pragma unroll
      for (int m = 0; m < 4; ++m)
#pragma unroll
        for (int n = 0; n < 4; ++n) {
          int c = cb + n * 16 + fr;
          int pos = jp * 128 + wr * 64 + m * 16 + fq * 4;
          *(bf16x4*)(((u16*)(P.ws + OFF_vT)) + ((size_t)bl * 512 + c) * SP + pos) = pack4v(acc[m][n]);
        }
    } else {
      int cb = (nt - 30) * 128 + wc * 64;
#pragma unroll
      for (int m = 0; m < 4; ++m)
#pragma unroll
        for (int n = 0; n < 4; ++n) {
          int c = cb + n * 16 + fr;
          int i0 = wr * 64 + m * 16 + fq * 4;
          f32x4 v = acc[m][n];
          *(bf16x4*)(((u16*)(P.ws + OFF_gvT)) + ((size_t)mt * 512 + c) * 128 + i0) = pack4(geluf_(v[0]), geluf_(v[1]), geluf_(v[2]), geluf_(v[3]));
        }
    }
  }
}

DI void phase_proj(const Params& P, int l, int hb, char* smem) {
  const bool last = (l == 1);
  for (int it = blockIdx.x; it < 144 * 35; it += gridDim.x) {
    int mt = it / 35, nt = it % 35;
    bool isctx = (mt % 18) >= 16;
    if (last && isctx) {
      bool need = (nt >= 8 && nt < 14) || (nt >= 18 && nt < 26) || nt == 34;
      if (!need) continue;
    }
    bool transposed = (nt >= 22 && nt < 26) || nt >= 30;
    if (transposed) proj_tile<false>(P, l, hb, mt, nt, smem);
    else proj_tile<true>(P, l, hb, mt, nt, smem);
  }
}

constexpr int LDK = 136;
DI void pool_item(const Params& P, int l, int hb, int mt, int g, char* smem) {
  const int tid = TID(), wave = tid >> 6, lane = tid & 63, fr = lane & 15, fq = lane >> 4;
  const int wr = wave >> 1, wc = wave & 1;
  u16* As = (u16*)smem;
  u16* Bs = As + 128 * LDK;
  const int jp = mt % 18, bl = mt / 18;
  const bool lat = jp < 16;
  const int n = lat ? SEQ : CTXL;
  const int p0 = lat ? jp * 128 : (jp - 16) * 128;
  const int seqbase = bl * SP + (lat ? 0 : SEQ);
  const int half = 1 << g;
  __syncthreads();
  {
    const int cch = tid & 15;
    const u16* src = ((u16*)(P.ws + OFF_xp)) + (size_t)seqbase * 512 + g * 128 + cch * 8;
    for (int ii = 0; ii < 8; ++ii) {
      int i = (tid >> 4) + 16 * ii;
      int p = p0 + i;
      int lo = max(p - half, 0), hi = min(p + half, n);
      float s[8];
#pragma unroll
      for (int e = 0; e < 8; ++e) s[e] = 0.f;
      for (int r = lo; r < hi; ++r) {
        bf16x8 t = *(const bf16x8*)(src + (size_t)r * 512);
#pragma unroll
        for (int e = 0; e < 8; ++e) s[e] += bf2f((u16)t[e]);
      }
      bf16x8 self = *(const bf16x8*)(src + (size_t)p * 512);
      float inv = 1.f / (float)(hi - lo);
      bf16x8 o;
#pragma unroll
      for (int e = 0; e < 8; ++e) o[e] = (short)f2bf(s[e] * inv - bf2f((u16)self[e]));
      *(bf16x8*)(As + i * LDK + cch * 8) = o;
    }
    const u16* wsrc = ((u16*)(P.ws + OFF_poolT)) + ((size_t)l * 4 + g) * 128 * 128;
    for (int cid = tid; cid < 2048; cid += 256) {
      int r = cid >> 4, c8 = (cid & 15) * 8;
      *(u32x4*)(Bs + r * LDK + c8) = *(const u32x4*)(wsrc + r * 128 + c8);
    }
  }
  __syncthreads();
  f32x4 acc[4][4];
  zero_acc<4>(acc);
  mma_lds<4, 4, true>(As + wr * 64 * LDK, LDK, Bs + wc * 64 * LDK, LDK, 4, acc, fr, fq);
  const float* psc = P.pool_scale + l * 512 + g * 128;
#pragma unroll
  for (int m = 0; m < 4; ++m)
#pragma unroll
    for (int nn = 0; nn < 4; ++nn) {
      int r = wr * 64 + m * 16 + fr, c = wc * 64 + nn * 16 + fq * 4;
      float4 sc = *(const float4*)(psc + c);
      f32x4 v = acc[m][nn];
      *(bf16x4*)(((u16*)(P.ws + OFF_br0)) + (size_t)(hb * HROWS + mt * 128 + r) * 512 + g * 128 + c) = pack4(v[0] * sc.x, v[1] * sc.y, v[2] * sc.z, v[3] * sc.w);
    }
}

DI void sgu_item(const Params& P, int l, int hb, int mt, char* smem) {
  const int tid = TID(), wave = tid >> 6, lane = tid & 63, fr = lane & 15, fq = lane >> 4;
  const int wr = wave >> 1, wc = wave & 1;
  u16* As = (u16*)smem;
  u16* Bs = As + 128 * LDK;
  float* st = (float*)(Bs + 128 * LDK);
  const u16* gv = ((u16*)(P.ws + OFF_gvT)) + (size_t)mt * 512 * 128;
  __syncthreads();
  {
    int i = tid & 127, part = tid >> 7;
    float s = 0.f;
#pragma unroll 16
    for (int c = part * 256; c < part * 256 + 256; ++c) s += bf2f(gv[c * 128 + i]);
    st[part * 128 + i] = s;
    __syncthreads();
    float mu = (st[i] + st[128 + i]) * (1.f / 512.f);
    __syncthreads();
    float qv = 0.f;
#pragma unroll 16
    for (int c = part * 256; c < part * 256 + 256; ++c) { float d = bf2f(gv[c * 128 + i]) - mu; qv += d * d; }
    st[part * 128 + i] = qv;
    __syncthreads();
    float var = (st[i] + st[128 + i]) * (1.f / 512.f);
    __syncthreads();
    if (part == 0) { st[256 + i] = mu; st[384 + i] = rsqrtf(var + LN_EPS); }
  }
  const float* mu = st + 256;
  const float* rs = st + 384;
  for (int g = 0; g < 4; ++g) {
    __syncthreads();
    const u16* wsrc = ((u16*)(P.ws + OFF_sguW)) + ((size_t)l * 4 + g) * 128 * 128;
    for (int cid = tid; cid < 2048; cid += 256) {
      int r = cid >> 4, c8 = (cid & 15) * 8;
      *(u32x4*)(As + r * LDK + c8) = *(const u32x4*)(wsrc + r * 128 + c8);
      bf16x8 t = *(const bf16x8*)(gv + (size_t)(g * 128 + r) * 128 + c8);
      float lg = P.sgu_ln_g[l * 512 + g * 128 + r], lb = P.sgu_ln_b[l * 512 + g * 128 + r];
      bf16x8 o;
#pragma unroll
      for (int e = 0; e < 8; ++e) o[e] = (short)f2bf((bf2f((u16)t[e]) - mu[c8 + e]) * rs[c8 + e] * lg + lb);
      *(bf16x8*)(Bs + r * LDK + c8) = o;
    }
    __syncthreads();
    f32x4 acc[4][4];
    zero_acc<4>(acc);
    mma_lds<4, 4, true>(As + wr * 64 * LDK, LDK, Bs + wc * 64 * LDK, LDK, 4, acc, fr, fq);
    const float* bs = P.sgu_b + ((size_t)l * 4 + g) * 128;
#pragma unroll
    for (int m = 0; m < 4; ++m) {
      int pp = wr * 64 + m * 16 + fr;
      float bias = bs[pp];
#pragma unroll
      for (int nn = 0; nn < 4; ++nn) {
        int d = wc * 64 + nn * 16 + fq * 4;
        u16* up = ((u16*)(P.ws + OFF_br3)) + (size_t)(hb * HROWS + mt * 128 + pp) * 512 + g * 128 + d;
        bf16x4 uu = *(const bf16x4*)up;
        f32x4 v = acc[m][nn];
        *(bf16x4*)up = pack4((v[0] + bias) * bf2f((u16)uu[0]), (v[1] + bias) * bf2f((u16)uu[1]), (v[2] + bias) * bf2f((u16)uu[2]), (v[3] + bias) * bf2f((u16)uu[3]));
      }
    }
  }
}

DI void attn_item(const Params& P, int l, int hb, int item, char* smem) {
  const int tid = TID(), wave = tid >> 6, lane = tid & 63, fr = lane & 15, fq = lane >> 4;
  const int qt = item % 18, h = (item / 18) & 3, bl = item / 72;
  const bool ctxq = qt >= 16;
  const int key0 = ctxq ? SEQ : 0, nkt = ctxq ? 4 : 36;
  const int hrow_q0 = bl * SP + qt * 128 + wave * 32;
  constexpr int KT = 64 * LDT, VT = 128 * LDT;
  u16* Ks = (u16*)smem;
  u16* Vs = Ks + 2 * KT;
  constexpr float LOG2E = 1.4426950408889634f;
  for (int sub = 0; sub < 2; ++sub) {
    const int hs = 2 * h + sub;
    bf16x8 qf[2][2];
#pragma unroll
    for (int qb = 0; qb < 2; ++qb)
#pragma unroll
      for (int ks = 0; ks < 2; ++ks) qf[qb][ks] = *(const bf16x8*)(((u16*)(P.ws + OFF_q)) + (size_t)(hrow_q0 + qb * 16 + fr) * 512 + hs * 64 + ks * 32 + fq * 8);
    f32x4 ot[8][2];
#pragma unroll
    for (int d = 0; d < 8; ++d) { ot[d][0] = f32x4{0.f, 0.f, 0.f, 0.f}; ot[d][1] = f32x4{0.f, 0.f, 0.f, 0.f}; }
    float mrow[2] = {-INFINITY, -INFINITY}, lrow[2] = {0.f, 0.f};
    const u16* Kg = ((u16*)(P.ws + OFF_k)) + ((size_t)bl * SP + key0) * 512 + hs * 64;
    const u16* Vg = ((u16*)(P.ws + OFF_vT)) + ((size_t)bl * 512 + h * 128) * SP + key0;
    u32x4 rk[2], rv[4];
    const u16* kgp = Kg + (size_t)(tid >> 2) * 512 + (tid & 3) * 16;
    const u16* vgp = Vg + (size_t)(tid >> 1) * SP + (tid & 1) * 32;
    u16* ksp = Ks + (tid >> 2) * LDT + (tid & 3) * 16;
    u16* vsp = Vs + (tid >> 1) * LDT + (tid & 1) * 32;
    auto gloadK = [&](int t) {
      const u16* kp = kgp + (size_t)t * 64 * 512;
      rk[0] = *(const u32x4*)(kp); rk[1] = *(const u32x4*)(kp + 8);
    };
    auto gloadV = [&](int t) {
      const u16* vp = vgp + t * 64;
      rv[0] = *(const u32x4*)(vp); rv[1] = *(const u32x4*)(vp + 8); rv[2] = *(const u32x4*)(vp + 16); rv[3] = *(const u32x4*)(vp + 24);
    };
    auto sstore = [&](int buf) {
      u16* kp = ksp + buf * KT;
      *(u32x4*)(kp) = rk[0]; *(u32x4*)(kp + 8) = rk[1];
      u16* vp = vsp + buf * VT;
      *(u32x4*)(vp) = rv[0]; *(u32x4*)(vp + 8) = rv[1]; *(u32x4*)(vp + 16) = rv[2]; *(u32x4*)(vp + 24) = rv[3];
    };
    gloadK(0); gloadV(0);
    __syncthreads();
    sstore(0);
    __syncthreads();
    for (int t = 0; t < nkt; ++t) {
      const int cur = t & 1;
      if (t + 1 < nkt) gloadK(t + 1);
      const u16* Kc = Ks + cur * KT;
      const u16* Vc = Vs + cur * VT;
      f32x4 st[4][2];
#pragma unroll
      for (int k4 = 0; k4 < 4; ++k4) { st[k4][0] = f32x4{0.f, 0.f, 0.f, 0.f}; st[k4][1] = f32x4{0.f, 0.f, 0.f, 0.f}; }
#pragma unroll
      for (int k4 = 0; k4 < 4; ++k4)
#pragma unroll
        for (int ks = 0; ks < 2; ++ks) {
          bf16x8 a = *(const bf16x8*)(Kc + (k4 * 16 + fr) * LDT + ks * 32 + fq * 8);
          st[k4][0] = MFMA16(a, qf[0][ks], st[k4][0]);
          st[k4][1] = MFMA16(a, qf[1][ks], st[k4][1]);
          if (ks == 1 && (k4 & 1)) __builtin_amdgcn_sched_barrier(0);
        }
      __builtin_amdgcn_sched_barrier(0);
#pragma unroll
      for (int qb = 0; qb < 2; ++qb) {
        float mx = -INFINITY;
#pragma unroll
        for (int k4 = 0; k4 < 4; ++k4)
#pragma unroll
          for (int j = 0; j < 4; ++j) mx = fmaxf(mx, st[k4][qb][j]);
        mx = fmaxf(mx, __shfl_xor(mx, 16));
        mx = fmaxf(mx, __shfl_xor(mx, 32));
        float mnew = fmaxf(mrow[qb], mx);
        float alpha = __builtin_amdgcn_exp2f((mrow[qb] - mnew) * LOG2E);
        mrow[qb] = mnew;
        float moff = mnew * LOG2E;
        float ps = 0.f;
#pragma unroll
        for (int k4 = 0; k4 < 4; ++k4)
#pragma unroll
          for (int j = 0; j < 4; ++j) { float pv = __builtin_amdgcn_exp2f(st[k4][qb][j] * LOG2E - moff); st[k4][qb][j] = pv; ps += pv; }
        lrow[qb] = lrow[qb] * alpha + ps;
#pragma unroll
        for (int d = 0; d < 8; ++d) { ot[d][qb][0] *= alpha; ot[d][qb][1] *= alpha; ot[d][qb][2] *= alpha; ot[d][qb][3] *= alpha; }
      }
      __builtin_amdgcn_sched_barrier(0);
      if (t + 1 < nkt) gloadV(t + 1);
#pragma unroll
      for (int ks2 = 0; ks2 < 2; ++ks2) {
        bf16x8 pf[2];
#pragma unroll
        for (int qb = 0; qb < 2; ++qb) {
          bf16x4 lo = pack4v(st[2 * ks2][qb]), hi = pack4v(st[2 * ks2 + 1][qb]);
          pf[qb] = __builtin_shufflevector(lo, hi, 0, 1, 2, 3, 4, 5, 6, 7);
        }
#pragma unroll
        for (int d = 0; d < 8; ++d) {
          const u16* vp = Vc + (d * 16 + fr) * LDT + ks2 * 32 + fq * 4;
          bf16x4 lo = *(const bf16x4*)vp, hi = *(const bf16x4*)(vp + 16);
          bf16x8 a = __builtin_shufflevector(lo, hi, 0, 1, 2, 3, 4, 5, 6, 7);
          ot[d][0] = MFMA16(a, pf[0], ot[d][0]);
          ot[d][1] = MFMA16(a, pf[1], ot[d][1]);
          if ((d & 3) == 3) __builtin_amdgcn_sched_barrier(0);
        }
      }
      if (t + 1 < nkt) sstore(cur ^ 1);
      __syncthreads();
    }
#pragma unroll
    for (int qb = 0; qb < 2; ++qb) {
      float lt = lrow[qb];
      lt += __shfl_xor(lt, 16);
      lt += __shfl_xor(lt, 32);
      float inv = 1.f / lt;
      size_t hrow = (size_t)(hrow_q0 + qb * 16 + fr);
      if (sub == 0) {
#pragma unroll
        for (int d = 0; d < 8; ++d) {
          f32x4 v = ot[d][qb];
          *(bf16x4*)(((u16*)(P.ws + OFF_o1)) + hrow * 512 + h * 128 + d * 16 + fq * 4) = pack4(v[0] * inv, v[1] * inv, v[2] * inv, v[3] * inv);
        }
      } else {
        const float lam = ((float*)(P.ws + OFF_lamv))[l * 2], lam_init = ((float*)(P.ws + OFF_lamv))[l * 2 + 1];
        float ss = 0.f;
#pragma unroll
        for (int d = 0; d < 8; ++d) {
          bf16x4 o1v = *(const bf16x4*)(((u16*)(P.ws + OFF_o1)) + hrow * 512 + h * 128 + d * 16 + fq * 4);
#pragma unroll
          for (int j = 0; j < 4; ++j) { float dd = bf2f((u16)o1v[j]) - lam * ot[d][qb][j] * inv; ot[d][qb][j] = dd; ss += dd * dd; }
        }
        ss += __shfl_xor(ss, 16);
        ss += __shfl_xor(ss, 32);
        float rr = rsqrtf(ss * (1.f / 128.f) + LN_EPS) * (1.f - lam_init);
        const float* gn = P.diff_norm_g + l * 128;
#pragma unroll
        for (int d = 0; d < 8; ++d) {
          int dv = d * 16 + fq * 4;
          float4 g4 = *(const float4*)(gn + dv);
          f32x4 v = ot[d][qb];
          *(bf16x4*)(((u16*)(P.ws + OFF_br2)) + ((size_t)hb * HROWS + hrow) * 512 + h * 128 + dv) = pack4(v[0] * rr * g4.x, v[1] * rr * g4.y, v[2] * rr * g4.z, v[3] * rr * g4.w);
        }
      }
    }
  }
}

template <bool TRANS>
DI void conv_stage(const Params& P, int l, const u16* xbase  , int chan0, int n, int p0, u16* dst, int ld, const float* scale) {
  const int tid = TID(), cl = tid & 63, ig = tid >> 6;
  const int ch = chan0 + cl;
  const float* cw = P.conv_w + (size_t)l * 5 * 768 + ch;
  const float w0 = cw[0], w1 = cw[768], w2 = cw[2 * 768], w3 = cw[3 * 768], w4 = cw[4 * 768];
  const float cb = P.conv_b[l * 768 + ch];
  const u16* xc = xbase + ch;
  const int pos0 = p0 + ig * 32 - 2;
  float xv[36];
#pragma unroll
  for (int i = 0; i < 36; ++i) { int pos = pos0 + i; xv[i] = (pos >= 0 && pos < n) ? bf2f(xc[(size_t)pos * 768]) : 0.f; }
#pragma unroll
  for (int ii = 0; ii < 32; ++ii) {
    float v = w0 * xv[ii] + w1 * xv[ii + 1] + w2 * xv[ii + 2] + w3 * xv[ii + 3] + w4 * xv[ii + 4] + cb;
    v = siluf_(v);
    int tok = ig * 32 + ii;
    if (scale) v *= scale[tok];
    if (TRANS) dst[cl * ld + tok] = f2bf(v); else dst[tok * ld + cl] = f2bf(v);
  }
}

DI void ssd_scalars(const Params& P, int l, int hrow0, int h, int dir, float* dts, float* S, float* tmp) {
  const int tid = TID();
  const float aneg = -expf(P.a_log[l * 16 + dir * 8 + h]);
  if (tid < 128) {
    float raw = ((float*)(P.ws + OFF_dtbuf))[(size_t)(hrow0 + tid) * 16 + dir * 8 + h] + P.dt_bias[l * 16 + dir * 8 + h];
    float dt = softplusf_(raw);
    dts[tid] = dt;
    tmp[tid] = dt * aneg;
  }
  __syncthreads();
  if (tid < 128) {
    float s = 0.f;
    if (dir == 0) { for (int i = 0; i <= tid; ++i) s += tmp[i]; }
    else { for (int i = 127; i >= tid; --i) s += tmp[i]; }
    S[tid] = s;
  }
  __syncthreads();
}

constexpr int SSD_STATE_STRIDE = 18 * 4096;
DI void ssd_state_item(const Params& P, int l, int hb, int item, char* smem) {
  const int tid = TID(), wave = tid >> 6, lane = tid & 63, fr = lane & 15, fq = lane >> 4;
  const int dir = item & 1, h = (item >> 1) & 7, jp = (item >> 4) % 18, bl = (item >> 4) / 18;
  const bool lat = jp < 16;
  const int n = lat ? SEQ : CTXL;
  const int p0 = lat ? jp * 128 : (jp - 16) * 128;
  const int seqbase = bl * SP + (lat ? 0 : SEQ);
  const int hrow0 = bl * SP + jp * 128;
  u16* At = (u16*)smem;
  u16* Bt = At + 64 * LDK;
  float* dts = (float*)(Bt + 64 * LDK);
  float* S = dts + 128;
  float* wgt = S + 128;
  __syncthreads();
  ssd_scalars(P, l, hrow0, h, dir, dts, S, wgt);
  const float total = (dir == 0) ? S[127] : S[0];
  __syncthreads();
  if (tid < 128) wgt[tid] = dts[tid] * __expf(total - S[tid]);
  __syncthreads();
  const u16* xb = ((u16*)(P.ws + OFF_xbc)) + (size_t)seqbase * 768;
  conv_stage<true>(P, l, xb, h * 64, n, p0, At, LDK, wgt);
  conv_stage<true>(P, l, xb, 512 + (h >> 2) * 64, n, p0, Bt, LDK, nullptr);
  __syncthreads();
  const int wr = wave >> 1, wc = wave & 1;
  f32x4 acc[2][2];
#pragma unroll
  for (int m = 0; m < 2; ++m) { acc[m][0] = f32x4{0.f, 0.f, 0.f, 0.f}; acc[m][1] = f32x4{0.f, 0.f, 0.f, 0.f}; }
  mma_lds<2, 2, false>(At + wr * 32 * LDK, LDK, Bt + wc * 32 * LDK, LDK, 4, acc, fr, fq);
  float* cs = ((float*)(P.ws + OFF_cstate)) + (((size_t)(bl * 2 + dir) * 8 + h) * 18 + jp) * 4096;
#pragma unroll
  for (int m = 0; m < 2; ++m)
#pragma unroll
    for (int nn = 0; nn < 2; ++nn)
#pragma unroll
      for (int j = 0; j < 4; ++j) cs[(wr * 32 + m * 16 + fq * 4 + j) * 64 + wc * 32 + nn * 16 + fr] = acc[m][nn][j];
  if (tid == 0) ((float*)(P.ws + OFF_decay))[((bl * 2 + dir) * 8 + h) * 18 + jp] = __expf(total);
}

DI void phase_carry(const Params& P) {
  const int total = 8 * 2 * 8 * 4096;
  for (int idx = blockIdx.x * 256 + TID(); idx < total; idx += gridDim.x * 256) {
    int pn = idx & 4095, bdh = idx >> 12;
    int dir = (bdh >> 3) & 1;
    const float* __restrict__ cs = ((const float*)(P.ws + OFF_cstate)) + (size_t)bdh * SSD_STATE_STRIDE + pn;
    u16* __restrict__ en = ((u16*)(P.ws + OFF_enter)) + (size_t)bdh * SSD_STATE_STRIDE + pn;
    const float* __restrict__ dc = ((const float*)(P.ws + OFF_decay)) + bdh * 18;
    float cv[18], dv[18];
#pragma unroll
    for (int jp = 0; jp < 18; ++jp) { cv[jp] = cs[(size_t)jp * 4096]; dv[jp] = dc[jp]; }
    float state = 0.f;
    if (dir == 0) {
#pragma unroll
      for (int st = 0; st < 18; ++st) {
        const int jp = st < 2 ? 16 + st : st - 2;
        en[(size_t)jp * 4096] = f2bf(state);
        state = state * dv[jp] + cv[jp];
      }
    } else {
#pragma unroll
      for (int st = 0; st < 18; ++st) {
        const int jp = 17 - st;
        en[(size_t)jp * 4096] = f2bf(state);
        state = state * dv[jp] + cv[jp];
      }
    }
  }
}

DI void ssd_out_item(const Params& P, int l, int hb, int item, char* smem) {
  const int tid = TID(), wave = tid >> 6, lane = tid & 63, fr = lane & 15, fq = lane >> 4;
  const int h = item & 7, jp = (item >> 3) % 18, bl = (item >> 3) / 18;
  const bool lat = jp < 16;
  const int n = lat ? SEQ : CTXL;
  const int p0 = lat ? jp * 128 : (jp - 16) * 128;
  const int seqbase = bl * SP + (lat ? 0 : SEQ);
  const int hrow0 = bl * SP + jp * 128;
  u16* Cs = (u16*)smem;
  u16* xT = Cs + 128 * LDT;
  u16* Et = xT + 64 * LDK;
  u16* Un = Et + 64 * LDT;
  float* fs = (float*)(Un + 128 * LDK);
  float* dts = fs;
  float* S = fs + 128;
  float* tmp = fs + 256;
  const int grp = h >> 2;
  __syncthreads();
  const u16* xb = ((u16*)(P.ws + OFF_xbc)) + (size_t)seqbase * 768;
  conv_stage<false>(P, l, xb, 640 + grp * 64, n, p0, Cs, LDT, nullptr);
  conv_stage<false>(P, l, xb, 512 + grp * 64, n, p0, Un, LDT, nullptr);
  conv_stage<true>(P, l, xb, h * 64, n, p0, xT, LDK, nullptr);
  __syncthreads();
  f32x4 cb[2][8];
#pragma unroll
  for (int m = 0; m < 2; ++m)
#pragma unroll
    for (int nn = 0; nn < 8; ++nn) cb[m][nn] = f32x4{0.f, 0.f, 0.f, 0.f};
  mma_lds<2, 8, false>(Cs + wave * 32 * LDT, LDT, Un, LDT, 2, cb, fr, fq);
  f32x4 yacc[2][4];
#pragma unroll
  for (int m = 0; m < 2; ++m)
#pragma unroll
    for (int nn = 0; nn < 4; ++nn) yacc[m][nn] = f32x4{0.f, 0.f, 0.f, 0.f};
  for (int dir = 0; dir < 2; ++dir) {
    __syncthreads();
    ssd_scalars(P, l, hrow0, h, dir, dts, S, tmp);
#pragma unroll
    for (int m = 0; m < 2; ++m)
#pragma unroll
      for (int j = 0; j < 4; ++j) {
        int lrow = wave * 32 + m * 16 + fq * 4 + j;
        float Sl = S[lrow];
#pragma unroll
        for (int nn = 0; nn < 8; ++nn) {
          int s = nn * 16 + fr;
          bool ok = dir == 0 ? (s <= lrow) : (s >= lrow);
          float coef = ok ? __expf(Sl - S[s]) * dts[s] : 0.f;
          Un[lrow * LDK + s] = f2bf(cb[m][nn][j] * coef);
        }
      }
    {
      const u16* en = ((u16*)(P.ws + OFF_enter)) + (((size_t)(bl * 2 + dir) * 8 + h) * 18 + jp) * 4096;
      for (int cid = tid; cid < 512; cid += 256) {
        int pr = cid >> 3, c8 = (cid & 7) * 8;
        *(u32x4*)(Et + pr * LDT + c8) = *(const u32x4*)(en + pr * 64 + c8);
      }
    }
    __syncthreads();
    mma_lds<2, 4, true>(Un + wave * 32 * LDK, LDK, xT, LDK, 4, yacc, fr, fq);
    f32x4 yi[2][4];
#pragma unroll
    for (int m = 0; m < 2; ++m)
#pragma unroll
      for (int nn = 0; nn < 4; ++nn) yi[m][nn] = f32x4{0.f, 0.f, 0.f, 0.f};
    mma_lds<2, 4, true>(Cs + wave * 32 * LDT, LDT, Et, LDT, 2, yi, fr, fq);
#pragma unroll
    for (int m = 0; m < 2; ++m) {
      float e = __expf(S[wave * 32 + m * 16 + fr]);
#pragma unroll
      for (int nn = 0; nn < 4; ++nn)
#pragma unroll
        for (int j = 0; j < 4; ++j) yacc[m][nn][j] += e * yi[m][nn][j];
    }
  }
  const float dsk = P.ssd_d[l * 8 + h];
  const float* gn = P.ssd_norm_g + l * 512 + h * 64;
#pragma unroll
  for (int m = 0; m < 2; ++m) {
    int lrow = wave * 32 + m * 16 + fr;
    float ss = 0.f;
#pragma unroll
    for (int nn = 0; nn < 4; ++nn) {
      int pc = nn * 16 + fq * 4;
      bf16x4 zz = *(const bf16x4*)(((u16*)(P.ws + OFF_z)) + (size_t)(hrow0 + lrow) * 512 + h * 64 + pc);
      float4 g4 = *(const float4*)(gn + pc);
      float gg[4] = {g4.x, g4.y, g4.z, g4.w};
      float o[4];
#pragma unroll
      for (int j = 0; j < 4; ++j) {
        float y = yacc[m][nn][j] + dsk * bf2f(xT[(pc + j) * LDK + lrow]);
        y *= siluf_(bf2f((u16)zz[j]));
        ss += y * y;
        o[j] = y * gg[j];
      }
      *(bf16x4*)(((u16*)(P.ws + OFF_br1)) + ((size_t)hb * HROWS + hrow0 + lrow) * 512 + h * 64 + pc) = pack4(o[0], o[1], o[2], o[3]);
    }
    ss += __shfl_xor(ss, 16);
    ss += __shfl_xor(ss, 32);
    if (fq == 0) ((float*)(P.ws + OFF_ssq))[((size_t)hb * HROWS + hrow0 + lrow) * 8 + h] = ss;
  }
}

DI void merge_tile(const Params& P, int l, int mt, int nt, char* smem) {
  const int tid = TID(), wave = tid >> 6, lane = tid & 63, fr = lane & 15, fq = lane >> 4;
  const int wr = wave >> 1, wc = wave & 1;
  const int row0 = mt * 128;
  f32x4 accS[4][2];
  zero_acc<2>(accS);
  const u16* brs[4] = {((u16*)(P.ws + OFF_br0)), ((u16*)(P.ws + OFF_br1)), ((u16*)(P.ws + OFF_br2)), ((u16*)(P.ws + OFF_br3))};
#pragma unroll 1
  for (int kq = 0; kq < 4; ++kq) {
    f32x4 g[4][2];
    zero_acc<2>(g);
    gemm_main<2, true, false>(((u16*)(P.ws + OFF_H)), DM, nullptr, row0, ((u16*)(P.ws + OFF_WgT)) + ((size_t)l * 4 + kq) * 1024 * 1024, 1024, nt * 64, 1024, g, (u16*)smem);
#pragma unroll
    for (int m = 0; m < 4; ++m)
#pragma unroll
      for (int n = 0; n < 2; ++n)
#pragma unroll
        for (int j = 0; j < 4; ++j) g[m][n][j] = sigmoidf_(g[m][n][j]);
    f32x4 bb[4][2];
    zero_acc<2>(bb);
    const u16* br = kq == 0 ? ((u16*)(P.ws + OFF_br0)) : (kq == 1 ? ((u16*)(P.ws + OFF_br1)) : (kq == 2 ? ((u16*)(P.ws + OFF_br2)) : ((u16*)(P.ws + OFF_br3))));
    gemm_main<2, true, false>(br, 512, nullptr, row0, ((u16*)(P.ws + OFF_WbT)) + ((size_t)l * 4 + kq) * 1024 * 512, 512, nt * 64, 512, bb, (u16*)smem);
#pragma unroll
    for (int m = 0; m < 4; ++m) {
      float rs = 1.f;
      if (kq == 1) {
        const float* sq = ((float*)(P.ws + OFF_ssq)) + (size_t)(row0 + wr * 64 + m * 16 + fr) * 8;
        float4 a = *(const float4*)sq, b = *(const float4*)(sq + 4);
        rs = rsqrtf((a.x + a.y + a.z + a.w + b.x + b.y + b.z + b.w) * (1.f / 512.f) + LN_EPS);
      }
#pragma unroll
      for (int n = 0; n < 2; ++n)
#pragma unroll
        for (int j = 0; j < 4; ++j) accS[m][n][j] += g[m][n][j] * bb[m][n][j] * rs;
    }
  }
  (void)brs;
#pragma unroll
  for (int m = 0; m < 4; ++m)
#pragma unroll
    for (int n = 0; n < 2; ++n) {
      int r = row0 + wr * 64 + m * 16 + fr, c = nt * 64 + wc * 32 + n * 16 + fq * 4;
      *(bf16x4*)(((u16*)(P.ws + OFF_acc)) + (size_t)r * DM + c) = pack4v(accS[m][n]);
    }
}

DI void phase_merge(const Params& P, int l, char* smem) {
  const bool last = (l == 1);
  for (int it = blockIdx.x; it < 288 * 16; it += gridDim.x) {
    int mt = it / 16, nt = it % 16;
    if (last && (mt % 18) >= 16) continue;
    merge_tile(P, l, mt, nt, smem);
  }
}

DI void phase_outproj(const Params& P, int l, char* smem) {
  const bool last = (l == 1);
  const int tid = TID(), wave = tid >> 6, lane = tid & 63, fr = lane & 15, fq = lane >> 4;
  const int wr = wave >> 1, wc = wave & 1;
  for (int it = blockIdx.x; it < 288 * 8; it += gridDim.x) {
    int mt = it / 8, nt = it % 8;
    if (last && (mt % 18) >= 16) continue;
    f32x4 acc[4][4];
    zero_acc<4>(acc);
    gemm_main<4, true, false>(((u16*)(P.ws + OFF_acc)), DM, nullptr, mt * 128, ((u16*)(P.ws + OFF_WoT)) + (size_t)l * 1024 * 1024, 1024, nt * 128, 1024, acc, (u16*)smem);
#pragma unroll
    for (int m = 0; m < 4; ++m)
#pragma unroll
      for (int n = 0; n < 4; ++n) {
        int r = mt * 128 + wr * 64 + m * 16 + fr, c = nt * 128 + wc * 64 + n * 16 + fq * 4;
        *(bf16x4*)(((u16*)(P.ws + OFF_Y)) + (size_t)r * DM + c) = pack4v(acc[m][n]);
      }
  }
}

DI void phase_ffn1(const Params& P, int l, char* smem) {
  const bool last = (l == 1);
  const int tid = TID(), wave = tid >> 6, lane = tid & 63, fr = lane & 15, fq = lane >> 4;
  const int wr = wave >> 1, wc = wave & 1;
  const int nmt = last ? 512 : 576;
  for (int it = blockIdx.x; it < nmt * 8; it += gridDim.x) {
    int mt = it / 8, nt = it % 8;
    int R0 = mt * 128;
    int e = R0 < NFFN_LAT ? (R0 >> 8) & 15 : (R0 - NFFN_LAT) >> 9;
    f32x4 acc[4][4];
    zero_acc<4>(acc);
    gemm_main<4, true, true>(((u16*)(P.ws + OFF_H)), DM, ((int*)(P.ws + OFF_tokidx)), R0, ((u16*)(P.ws + OFF_W13T)) + (size_t)e * 1024 * 1024, 1024, nt * 128, 1024, acc, (u16*)smem);
#pragma unroll
    for (int m = 0; m < 4; ++m)
#pragma unroll
      for (int n2 = 0; n2 < 2; ++n2) {
        int r = R0 + wr * 64 + m * 16 + fr;
        int hc = (nt * 4 + wc * 2 + n2) * 16 + fq * 4;
        f32x4 a = acc[m][2 * n2], b = acc[m][2 * n2 + 1];
        *(bf16x4*)(((u16*)(P.ws + OFF_hid)) + (size_t)r * 512 + hc) = pack4(siluf_(a[0]) * b[0], siluf_(a[1]) * b[1], siluf_(a[2]) * b[2], siluf_(a[3]) * b[3]);
      }
  }
}

DI void phase_ffn2(const Params& P, int l, char* smem) {
  const bool last = (l == 1);
  const int tid = TID(), wave = tid >> 6, lane = tid & 63, fr = lane & 15, fq = lane >> 4;
  const int wr = wave >> 1, wc = wave & 1;
  const int nmt = last ? 512 : 576;
  for (int it = blockIdx.x; it < nmt * 8; it += gridDim.x) {
    int mt = it / 8, nt = it % 8;
    int R0 = mt * 128;
    int e = R0 < NFFN_LAT ? (R0 >> 8) & 15 : (R0 - NFFN_LAT) >> 9;
    f32x4 acc[4][4];
    zero_acc<4>(acc);
    gemm_main<4, true, false>(((u16*)(P.ws + OFF_hid)), 512, nullptr, R0, ((u16*)(P.ws + OFF_W2T)) + (size_t)e * 1024 * 512, 512, nt * 128, 512, acc, (u16*)smem);
#pragma unroll
    for (int m = 0; m < 4; ++m) {
      int r = R0 + wr * 64 + m * 16 + fr;
      float gt = ((float*)(P.ws + OFF_gatev))[r];
#pragma unroll
      for (int n = 0; n < 4; ++n) {
        int c = nt * 128 + wc * 64 + n * 16 + fq * 4;
        f32x4 v = acc[m][n];
        *(bf16x4*)(((u16*)(P.ws + OFF_ye)) + (size_t)r * DM + c) = pack4(v[0] * gt, v[1] * gt, v[2] * gt, v[3] * gt);
      }
    }
  }
}

DI int wq_next(unsigned* ctr, char* smem) {
  volatile int* slot = (volatile int*)(smem + SMEM_BYTES - 32);
  __syncthreads();
  if (TID() == 0) *slot = (int)__hip_atomic_fetch_add(ctr, 1u, __ATOMIC_RELAXED, __HIP_MEMORY_SCOPE_AGENT);
  __syncthreads();
  return *slot;
}

DI void phase_mix2(const Params& P, int l, int hb, char* smem) {
  const bool last = (l == 1);
  const int nA = 576, nG = 144, nS = 2304, nP = 576;
  for (;;) {
    const int it = wq_next((unsigned*)(P.ws + OFF_bar) + 3600 + 16 * (l * 2 + hb), smem);
    if (it >= nA + nG + nS + nP) break;
    if (it < nA) {
      if (last && (it % 18) >= 16) continue;
      attn_item(P, l, hb, it, smem);
    } else if (it < nA + nG) {
      const int mt = it - nA;
      if (last && (mt % 18) >= 16) continue;
      sgu_item(P, l, hb, mt, smem);
    } else if (it < nA + nG + nS) {
      ssd_state_item(P, l, hb, it - nA - nG, smem);
    } else {
      const int t = it - nA - nG - nS;
      const int mt = t >> 2, g = t & 3;
      if (last && (mt % 18) >= 16) continue;
      pool_item(P, l, hb, mt, g, smem);
    }
  }
}

DI void phase_ssd_out(const Params& P, int l, int hb, char* smem) {
  const bool last = (l == 1);
  for (int it = blockIdx.x; it < 8 * 18 * 8; it += gridDim.x) {
    int jp = (it >> 3) % 18;
    if (last && jp >= 16) continue;
    ssd_out_item(P, l, hb, it, smem);
  }
}

#define XB_TMO      128
#define XB_XCNT(j)  (256  + 64 * (j))
#define XB_XSUB(j)  (1280 + 64 * (j))
#define XB_XGEN(j)  (2304 + 64 * (j))
#define XB_TOP      3328
#define XB_TOPGEN   3392
#define XCD_BAR_WORDS 3456
#define XB_SPIN_CAP (1u << 18)
#define LAS __attribute__((address_space(3)))

__device__ __forceinline__ unsigned xb_ld(unsigned* p)              { return __hip_atomic_load(p, __ATOMIC_RELAXED, __HIP_MEMORY_SCOPE_AGENT); }
__device__ __forceinline__ unsigned xb_add(unsigned* p, unsigned v) { return __hip_atomic_fetch_add(p, v, __ATOMIC_RELAXED, __HIP_MEMORY_SCOPE_AGENT); }
__device__ __forceinline__ unsigned xb_xcc_id() { return (unsigned)__builtin_amdgcn_s_getreg((3 << 11) | 20) & 0xFu; }
#define XB_SPIN(cond, bar) do { unsigned _sp = 0; while (cond) { __builtin_amdgcn_s_sleep(1); \
    if ((++_sp & 255u) == 0u) { if (xb_ld(&(bar)[XB_TMO])) break; if (_sp > XB_SPIN_CAP) { atomicAdd(&(bar)[XB_TMO], 1u); break; } } } } while (0)

struct XcdBarrier {
    unsigned* bar; unsigned x;
    volatile LAS unsigned* st;
};

__device__ __forceinline__ XcdBarrier xcd_barrier_post(unsigned* bar, volatile LAS unsigned* st) {
    XcdBarrier b; b.bar = bar; b.x = xb_xcc_id(); b.st = st;
    if (threadIdx.x == 0) (void)xb_add(&bar[XB_XCNT(b.x)], 1u);
    return b;
}
__device__ __forceinline__ void xcd_barrier_complete(unsigned* bar, unsigned x, unsigned& nloc, unsigned& nx) {
    const unsigned G = gridDim.x * gridDim.y * gridDim.z;
    unsigned sum, cnt, mine, sp = 0u;
    for (;;) {
        sum = 0u; cnt = 0u; mine = 0u;
#pragma unroll
        for (unsigned j = 0; j < 16; ++j) { const unsigned c = xb_ld(&bar[XB_XCNT(j)]); sum += c; cnt += (c > 0u) ? 1u : 0u; mine = (j == x) ? c : mine; }
        if (sum == G) break;
        __builtin_amdgcn_s_sleep(1);
        if ((++sp & 255u) == 0u) { if (xb_ld(&bar[XB_TMO])) break; if (sp > XB_SPIN_CAP) { atomicAdd(&bar[XB_TMO], 1u); break; } }
    }
    nloc = mine > 0u ? mine : 1u; nx = cnt > 0u ? cnt : 1u;
}

__device__ __forceinline__ void xcd_barrier(const XcdBarrier& b) {
    asm volatile("s_waitcnt vmcnt(0)" ::: "memory");
    __syncthreads();
    if (threadIdx.x == 0) {
        unsigned* bar = b.bar;
        __builtin_amdgcn_s_waitcnt(0);
        unsigned nloc = b.st[0], nx = b.st[1];
        if (nloc == 0u) { xcd_barrier_complete(bar, b.x, nloc, nx); b.st[0] = nloc; b.st[1] = nx; }
        const unsigned old = xb_add(&bar[XB_XSUB(b.x)], 1u);
        const unsigned gen = old / nloc;
        if (old + 1u == (gen + 1u) * nloc) {
            __builtin_amdgcn_fence(__ATOMIC_RELEASE, "agent");
            asm volatile("s_waitcnt vmcnt(0)" ::: "memory");
            const unsigned og = xb_add(&bar[XB_TOP], 1u);
            const unsigned tg = og / nx;
            if (og + 1u == (tg + 1u) * nx) xb_add(&bar[XB_TOPGEN], 1u);
            else XB_SPIN(xb_ld(&bar[XB_TOPGEN]) == tg, bar);
            __builtin_amdgcn_fence(__ATOMIC_ACQUIRE, "agent");
            xb_add(&bar[XB_XGEN(b.x)], 1u);
            asm volatile("s_waitcnt vmcnt(0)" ::: "memory");
        } else {
            XB_SPIN(xb_ld(&bar[XB_XGEN(b.x)]) == gen, bar);
            __builtin_amdgcn_fence(__ATOMIC_ACQUIRE, "agent");
            asm volatile("s_waitcnt vmcnt(0)" ::: "memory");
        }
    }
    __syncthreads();
}


template <bool COOP>
__global__ void __launch_bounds__(256, 2) mk_forward(Params P, int ph_begin, int ph_end) {
  __shared__ __attribute__((aligned(16))) char smem[SMEM_BYTES];
  int ph = 0;
  volatile LAS unsigned* xbst = (volatile LAS unsigned*)(smem + SMEM_BYTES - 16);
  XcdBarrier xb;
  if (COOP) {
    if (__builtin_amdgcn_workitem_id_x() == 0) { xbst[0] = 0u; xbst[1] = 0u; xbst[2] = 0u; xbst[3] = 0u; }
    __syncthreads();
    xb = xcd_barrier_post((unsigned*)(P.ws + OFF_bar), xbst);
  }
#define PHASE(code)                                         \
  {                                                         \
    if (ph >= ph_begin && ph < ph_end) { code; }            \
    ++ph;                                                   \
    if (COOP && ph > ph_begin && ph < ph_end) {             \
      if (ph == 1) cg::this_grid().sync();                  \
      else xcd_barrier(xb);                                 \
    }                                                       \
  }
  PHASE(phase_prologue(P, smem));
  PHASE(phase_h0(P));
  for (int l = 0; l < 2; ++l) {
    for (int hb = 0; hb < 2; ++hb) {
      PHASE(phase_proj(P, l, hb, smem));
      PHASE(phase_mix2(P, l, hb, smem));
      PHASE(phase_carry(P));
      PHASE(phase_ssd_out(P, l, hb, smem));
    }
    PHASE(phase_merge(P, l, smem));
    PHASE(phase_outproj(P, l, smem));
    PHASE(phase_ln1(P, l, smem));
    PHASE(phase_topk(P, l, smem));
    PHASE(phase_ffn1(P, l, smem));
    PHASE(phase_ffn2(P, l, smem));
    PHASE(phase_ln2(P, l));
  }
#undef PHASE
}

#ifndef MK_COOP
#define MK_COOP 1
#endif

extern "C" void kernel_launch(void* const* d_in, const int* in_sizes, int n_in, void* d_out, int out_size, void* d_ws, size_t ws_size,
                              hipStream_t stream) {
  Params p{};
  const float* const* in = (const float* const*)d_in;
  p.x = in[0]; p.c = in[1]; p.ctx = in[2]; p.c_ctx = in[3]; p.w_mod = in[4]; p.b_mod = in[5]; p.w_in = in[6]; p.conv_w = in[7];
  p.conv_b = in[8]; p.a_log = in[9]; p.dt_bias = in[10]; p.ssd_d = in[11]; p.ssd_norm_g = in[12]; p.diff_lambda = in[13];
  p.diff_norm_g = in[14]; p.pool_w = in[15]; p.pool_scale = in[16]; p.sgu_ln_g = in[17]; p.sgu_ln_b = in[18]; p.sgu_w = in[19];
  p.sgu_b = in[20]; p.w_gate = in[21]; p.w_branch = in[22]; p.w_out = in[23]; p.ln1_g = in[24]; p.ln1_b = in[25]; p.w_router = in[26];
  p.w1 = in[27]; p.w3 = in[28]; p.w2 = in[29]; p.ln2_g = in[30]; p.ln2_b = in[31];
  p.out = (float*)d_out;
  p.ws = (char*)d_ws;
  if (WS_NEED > ws_size) { fprintf(stderr, "workspace too small: need %zu have %zu\n", (size_t)WS_NEED, ws_size); return; }

  static int grid_blocks = 0;
  if (!grid_blocks) {
    int dev = 0, cus = 0, per_cu = 0;
    hipGetDevice(&dev);
    hipDeviceGetAttribute(&cus, hipDeviceAttributeMultiprocessorCount, dev);
    if (MK_COOP) hipOccupancyMaxActiveBlocksPerMultiprocessor(&per_cu, mk_forward<true>, 256, 0);
    else hipOccupancyMaxActiveBlocksPerMultiprocessor(&per_cu, mk_forward<false>, 256, 0);
    if (per_cu < 1) per_cu = 1;
    if (per_cu > 2) per_cu = 2;
    grid_blocks = cus * per_cu;
  }
#if MK_COOP
  hipMemsetAsync((char*)d_ws + OFF_bar, 0, 16384, stream);
  int b = 0, e = NPHASE;
  void* args[] = {&p, &b, &e};
  hipError_t err = hipLaunchCooperativeKernel((void*)mk_forward<true>, dim3(grid_blocks), dim3(256), args, 0, stream);
  if (err != hipSuccess) fprintf(stderr, "cooperative launch failed: %s (grid %d)\n", hipGetErrorString(err), grid_blocks);
#else
  for (int ph = 0; ph < NPHASE; ++ph) hipLaunchKernelGGL(mk_forward<false>, dim3(grid_blocks), dim3(256), 0, stream, p, ph, ph + 1);
#endif
}
```

```cpp
#include <hip/hip_runtime.h>
#include <hip/hip_cooperative_groups.h>
#include <cstdio>
#include <cstdint>
namespace cg = cooperative_groups;

typedef unsigned short u16;
using bf16x8 = __attribute__((ext_vector_type(8))) short;
using bf16x4 = __attribute__((ext_vector_type(4))) short;
using f32x4 = __attribute__((ext_vector_type(4))) float;
using u32x4 = __attribute__((ext_vector_type(4))) unsigned;

#define DI __device__ __forceinline__
#define MFMA16(a, b, c) __builtin_amdgcn_mfma_f32_16x16x32_bf16((a), (b), (c), 0, 0, 0)

constexpr int NB = 16, SEQ = 2048, CTXL = 256, SP = 2304, NTOK = NB * SP, DM = 1024;
constexpr int HROWS = 8 * SP;
constexpr int INC = 4368, INP = 4480;
constexpr int NFFN_LAT = 65536, NFFN_ALL = 73728;
constexpr float LN_EPS = 1e-5f;
constexpr float ALPHA = 1.41421356237309515f;
constexpr int SMEM_BYTES = 81920;
constexpr int NPHASE = 2 + 2 * (2 * 4 + 7);


constexpr size_t al256(size_t x) { return (x + 255) & ~(size_t)255; }
constexpr size_t U_ = (size_t)NTOK * 512 * 2;
constexpr size_t OFF_WinT = 0;
constexpr size_t OFF_WgT = OFF_WinT + al256((size_t)2 * INP * 1024 * 2);
constexpr size_t OFF_WbT = OFF_WgT + al256((size_t)2 * 4 * 1024 * 1024 * 2);
constexpr size_t OFF_WoT = OFF_WbT + al256((size_t)2 * 4 * 1024 * 512 * 2);
constexpr size_t OFF_poolT = OFF_WoT + al256((size_t)2 * 1024 * 1024 * 2);
constexpr size_t OFF_sguW = OFF_poolT + al256((size_t)2 * 4 * 128 * 128 * 2);
constexpr size_t OFF_mod = OFF_sguW + al256((size_t)2 * 4 * 128 * 128 * 2);
constexpr size_t OFF_rope = OFF_mod + al256((size_t)2 * 17 * 6144 * 4);
constexpr size_t OFF_lamv = OFF_rope + al256(64 * 16 * 2 * 4);
constexpr size_t OFF_bar = OFF_lamv + 256;
constexpr size_t OFF_aff = OFF_bar + 32768;
constexpr size_t OFF_rank = OFF_aff + al256((size_t)NTOK * 16 * 4);
constexpr size_t OFF_ssq = OFF_rank + al256((size_t)NTOK * 16 * 4);
constexpr size_t OFF_tokidx = OFF_ssq + al256((size_t)NTOK * 8 * 4);
constexpr size_t OFF_gatev = OFF_tokidx + al256((size_t)NFFN_ALL * 4);
constexpr size_t OFF_dtbuf = OFF_gatev + al256((size_t)NFFN_ALL * 4);
constexpr size_t OFF_decay = OFF_dtbuf + al256((size_t)HROWS * 16 * 4);
constexpr size_t OFF_H = OFF_decay + al256((size_t)8 * 2 * 8 * 18 * 4);
constexpr size_t OFF_Y = OFF_H + 2 * U_;
constexpr size_t OFF_o1 = OFF_Y;
constexpr size_t OFF_cstate = OFF_Y + U_ / 2;
constexpr size_t OFF_enter = OFF_Y + U_ / 2 + U_;
constexpr size_t OFF_RM = OFF_Y + 2 * U_;
constexpr size_t OFF_xp = OFF_RM;
constexpr size_t OFF_z = OFF_xp + U_ / 2;
constexpr size_t OFF_xbc = OFF_z + U_ / 2;
constexpr size_t OFF_q = OFF_xbc + (U_ / 4) * 3;
constexpr size_t OFF_k = OFF_q + U_ / 2;
constexpr size_t OFF_vT = OFF_k + U_ / 2;
constexpr size_t OFF_gvT = OFF_vT + U_ / 2;
constexpr size_t OFF_br0 = OFF_gvT + U_ / 2;
constexpr size_t OFF_br1 = OFF_br0 + U_;
constexpr size_t OFF_br2 = OFF_br1 + U_;
constexpr size_t OFF_br3 = OFF_br2 + U_;
constexpr size_t OFF_acc = OFF_RM;
constexpr size_t OFF_W13T = OFF_RM;
constexpr size_t OFF_W2T = OFF_W13T + (size_t)16 * 1024 * 1024 * 2;
constexpr size_t OFF_hid = OFF_W2T + (size_t)16 * 1024 * 512 * 2;
constexpr size_t OFF_ye = OFF_hid + (size_t)NFFN_ALL * 512 * 2;
constexpr size_t WS_MIX_END = OFF_br3 + U_;
constexpr size_t WS_FFN_END = OFF_ye + (size_t)NFFN_ALL * 1024 * 2;
constexpr size_t WS_NEED = WS_MIX_END > WS_FFN_END ? WS_MIX_END : WS_FFN_END;

struct Params {
  const float *x, *c, *ctx, *c_ctx, *w_mod, *b_mod, *w_in, *conv_w, *conv_b, *a_log, *dt_bias, *ssd_d, *ssd_norm_g,
      *diff_lambda, *diff_norm_g, *pool_w, *pool_scale, *sgu_ln_g, *sgu_ln_b, *sgu_w, *sgu_b, *w_gate, *w_branch, *w_out,
      *ln1_g, *ln1_b, *w_router, *w1, *w3, *w2, *ln2_g, *ln2_b;
  float* out;
  char* ws;
};

DI int TID() { int t = (int)__builtin_amdgcn_workitem_id_x(); asm volatile("" : "+v"(t)); return t; }
typedef __bf16 bf2_t __attribute__((ext_vector_type(2)));
typedef float f2_t __attribute__((ext_vector_type(2)));
typedef unsigned u32x2 __attribute__((ext_vector_type(2)));
DI unsigned pack2(float a, float b) { f2_t v = {a, b}; return __builtin_bit_cast(unsigned, __builtin_convertvector(v, bf2_t)); }
DI u16 f2bf(float x) { return (u16)(pack2(x, 0.f) & 0xffffu); }
DI float bf2f(u16 v) { return __uint_as_float(((unsigned)v) << 16); }
DI float sigmoidf_(float x) { return __builtin_amdgcn_rcpf(1.f + __expf(-x)); }
DI float siluf_(float x) { return x * __builtin_amdgcn_rcpf(1.f + __expf(-x)); }
DI float geluf_(float x) { float y = 0.7978845608028654f * (x + 0.044715f * x * x * x); float t = 1.f - 2.f * __builtin_amdgcn_rcpf(__expf(2.f * y) + 1.f); return 0.5f * x * (1.f + t); }
DI float softplusf_(float x) { return x > 20.f ? x : log1pf(__expf(x)); }
DI bf16x4 pack4(float a, float b, float c, float d) { u32x2 r = {pack2(a, b), pack2(c, d)}; return __builtin_bit_cast(bf16x4, r); }
DI bf16x4 pack4v(f32x4 v) { return pack4(v[0], v[1], v[2], v[3]); }
DI float wave_sum(float v) { for (int o = 32; o > 0; o >>= 1) v += __shfl_xor(v, o); return v; }

template <int MI, int NI, bool SWAP, bool LOWREG = false>
DI void mma_lds(const u16* As, int lda, const u16* Bs, int ldb, int ksteps, f32x4 (&acc)[MI][NI], int fr, int fq) {
  for (int ks = 0; ks < ksteps; ++ks) {
    if (LOWREG) __builtin_amdgcn_sched_barrier(0);
    bf16x8 a[MI], b[NI];
#pragma unroll
    for (int m = 0; m < MI; ++m) a[m] = *(const bf16x8*)(As + (m * 16 + fr) * lda + ks * 32 + fq * 8);
#pragma unroll
    for (int n = 0; n < NI; ++n) b[n] = *(const bf16x8*)(Bs + (n * 16 + fr) * ldb + ks * 32 + fq * 8);
#pragma unroll
    for (int m = 0; m < MI; ++m)
#pragma unroll
      for (int n = 0; n < NI; ++n) acc[m][n] = SWAP ? MFMA16(b[n], a[m], acc[m][n]) : MFMA16(a[m], b[n], acc[m][n]);
  }
}

constexpr int LDT = 72;
template <int NI, bool SWAP, bool GATHER, bool PF2 = true>
DI void gemm_main(const u16* __restrict__ A, int lda, const int* __restrict__ aidx, int arow0, const u16* __restrict__ Bt, int ldb, int brow0,
                  int K, f32x4 (&acc)[4][NI], u16* smem) {
  constexpr int BN = NI * 32;
  constexpr int NBL = BN / 32;
  const int tid = TID(), wave = tid >> 6, lane = tid & 63, fr = lane & 15, fq = lane >> 4;
  const int wr = wave >> 1, wc = wave & 1;
  u16* As = smem;
  u16* Bs = smem + 2 * 128 * LDT;
  const int lr = tid >> 3, lc = (tid & 7) * 8;
  const u16* ap[4];
#pragma unroll
  for (int i = 0; i < 4; ++i) {
    int r = arow0 + lr + 32 * i;
    size_t rr = GATHER ? (size_t)aidx[r] : (size_t)r;
    ap[i] = A + rr * lda + lc;
  }
  const u16* bp = Bt + (size_t)(brow0 + lr) * ldb + lc;
  u32x4 ra0[4], rb0[NBL], ra1[4], rb1[NBL];
  const int nk = K / 64;
#define GLOAD(RA, RB, KO)                                                                   \
  {                                                                                         \
    _Pragma("unroll") for (int i = 0; i < 4; ++i) RA[i] = *(const u32x4*)(ap[i] + (KO));    \
    _Pragma("unroll") for (int i = 0; i < NBL; ++i) RB[i] = *(const u32x4*)(bp + (size_t)(32 * i) * ldb + (KO)); \
  }
#define SSTORE(RA, RB, BUF)                                                                 \
  {                                                                                         \
    _Pragma("unroll") for (int i = 0; i < 4; ++i) *(u32x4*)(As + (BUF) * 128 * LDT + (lr + 32 * i) * LDT + lc) = RA[i];  \
    _Pragma("unroll") for (int i = 0; i < NBL; ++i) *(u32x4*)(Bs + (BUF) * BN * LDT + (lr + 32 * i) * LDT + lc) = RB[i]; \
  }
#define COMPUTE(BUF) mma_lds<4, NI, SWAP, !PF2>(As + (BUF) * 128 * LDT + wr * 64 * LDT, LDT, Bs + (BUF) * BN * LDT + wc * (NI * 16) * LDT, LDT, 2, acc, fr, fq)
  if (PF2) {
    GLOAD(ra0, rb0, 0);
    GLOAD(ra1, rb1, 64);
    __syncthreads();
    SSTORE(ra0, rb0, 0);
    __syncthreads();
    for (int kt = 0; kt < nk; kt += 2) {
      if (kt + 2 < nk) GLOAD(ra0, rb0, (kt + 2) * 64);
      COMPUTE(0);
      SSTORE(ra1, rb1, 1);
      __syncthreads();
      if (kt + 3 < nk) GLOAD(ra1, rb1, (kt + 3) * 64);
      COMPUTE(1);
      if (kt + 2 < nk) SSTORE(ra0, rb0, 0);
      __syncthreads();
    }
  } else {
    GLOAD(ra0, rb0, 0);
    __syncthreads();
    SSTORE(ra0, rb0, 0);
    __syncthreads();
    for (int kt = 0; kt < nk; kt += 2) {
      GLOAD(ra0, rb0, (kt + 1) * 64);
      COMPUTE(0);
      SSTORE(ra0, rb0, 1);
      __syncthreads();
      if (kt + 2 < nk) GLOAD(ra0, rb0, (kt + 2) * 64);
      COMPUTE(1);
      if (kt + 2 < nk) SSTORE(ra0, rb0, 0);
      __syncthreads();
    }
  }
#undef GLOAD
#undef SSTORE
#undef COMPUTE
}

template <int NI> DI void zero_acc(f32x4 (&a)[4][NI]) {
#pragma unroll
  for (int m = 0; m < 4; ++m)
#pragma unroll
    for (int n = 0; n < NI; ++n) a[m][n] = f32x4{0.f, 0.f, 0.f, 0.f};
}

DI void cvt_tile(const float* __restrict__ src0, const float* __restrict__ src1, int ld, u16* __restrict__ dst, int K, int n0, int k0, int mode, u16* lds) {
  const int tid = TID();
  constexpr int LC = 66;
  __syncthreads();
  if (mode == 3) {
    for (int idx = tid; idx < 4096; idx += 256) {
      int n = idx >> 6, kk = idx & 63;
      lds[kk * LC + n] = f2bf(src0[(size_t)(n0 + n) * ld + k0 + kk]);
    }
  } else {
    for (int idx = tid; idx < 4096; idx += 256) {
      int kk = idx >> 6, n = idx & 63;
      int nn = n0 + n;
      float v = 0.f;
      if (mode == 0) v = src0[(size_t)(k0 + kk) * ld + nn];
      else if (mode == 1) {
        int col = nn < 1792 ? nn : (nn < 4352 ? nn + 16 : (nn < 4368 ? nn - 4352 + 1792 : -1));
        if (col >= 0) v = src0[(size_t)(k0 + kk) * ld + col];
        if (nn >= 1792 && nn < 2304) v *= 0.125f;
      } else {
        int g = nn >> 5, r = nn & 31;
        v = (r < 16) ? src0[(size_t)(k0 + kk) * ld + g * 16 + r] : src1[(size_t)(k0 + kk) * ld + g * 16 + r - 16];
      }
      lds[kk * LC + n] = f2bf(v);
    }
  }
  __syncthreads();
  for (int c = tid; c < 512; c += 256) {
    int n = c & 63, kc = (c >> 6) * 8;
    bf16x8 o;
#pragma unroll
    for (int j = 0; j < 8; ++j) o[j] = (short)lds[(kc + j) * LC + n];
    *(bf16x8*)(dst + (size_t)(n0 + n) * K + k0 + kc) = o;
  }
}

DI void mod_item(const Params& P, int item, char* smem) {
  const int l = item / 96, n0 = (item % 96) * 64;
  float* sc = (float*)smem;
  const int tid = TID();
  __syncthreads();
  for (int i = tid; i < 17 * 1024; i += 256) {
    int s = i >> 10, kk = i & 1023;
    float v = s < 16 ? P.c[s * 1024 + kk] : P.c_ctx[kk];
    sc[i] = siluf_(v);
  }
  __syncthreads();
  const int col = tid & 63, kp = tid >> 6;
  float a[17];
#pragma unroll
  for (int s = 0; s < 17; ++s) a[s] = 0.f;
  const float* w = P.w_mod + (size_t)l * 1024 * 6144 + n0 + col;
  for (int kk = kp * 256; kk < kp * 256 + 256; ++kk) {
    float wv = w[(size_t)kk * 6144];
#pragma unroll
    for (int s = 0; s < 17; ++s) a[s] += sc[s * 1024 + kk] * wv;
  }
  __syncthreads();
  float* red = (float*)smem;
#pragma unroll
  for (int s = 0; s < 17; ++s) red[(kp * 17 + s) * 64 + col] = a[s];
  __syncthreads();
  for (int i = tid; i < 17 * 64; i += 256) {
    int s = i >> 6, cc = i & 63;
    float v = red[(0 * 17 + s) * 64 + cc] + red[(1 * 17 + s) * 64 + cc] + red[(2 * 17 + s) * 64 + cc] + red[(3 * 17 + s) * 64 + cc];
    ((float*)(P.ws + OFF_mod))[((size_t)l * 17 + s) * 6144 + n0 + cc] = v + P.b_mod[l * 6144 + n0 + cc];
  }
}

DI void misc_item(const Params& P) {
  const int tid = TID();
  for (int i = tid; i < 1024; i += 256) {
    int pos = i >> 4, f = i & 15;
    float inv = powf(10000.f, -(float)f / 16.f);
    float ang = (float)pos * inv;
    ((float*)(P.ws + OFF_rope))[i * 2] = cosf(ang);
    ((float*)(P.ws + OFF_rope))[i * 2 + 1] = sinf(ang);
  }
  if (tid < 2) {
    const float* dl = P.diff_lambda + tid * 256;
    float s1 = 0.f, s2 = 0.f;
    for (int i = 0; i < 64; ++i) { s1 += dl[i] * dl[64 + i]; s2 += dl[128 + i] * dl[192 + i]; }
    float lam_init = 0.8f - 0.6f * expf(-0.3f * (float)tid);
    ((float*)(P.ws + OFF_lamv))[tid * 2] = expf(s1) - expf(s2) + lam_init;
    ((float*)(P.ws + OFF_lamv))[tid * 2 + 1] = lam_init;
  }
}

DI void phase_prologue(const Params& P, char* smem) {
  const int per_layer = 1120 + 4 * 256 + 4 * 128 + 256 + 16 + 16;
  const int ncvt = 2 * per_layer;
  const int total = ncvt + 192 + 1;
  for (int it = blockIdx.x; it < total; it += gridDim.x) {
    if (it < ncvt) {
      const int l = it / per_layer;
      int t = it % per_layer;
      const float* s0; u16* dst; int ld, K, ntk, mode;
      if (t < 1120) { s0 = P.w_in + (size_t)l * 1024 * INC; ld = INC; dst = ((u16*)(P.ws + OFF_WinT)) + (size_t)l * INP * 1024; K = 1024; ntk = 16; mode = 1; }
      else if (t < 2144) { t -= 1120; int kq = t >> 8; t &= 255; s0 = P.w_gate + ((size_t)l * 4 + kq) * 1024 * 1024; ld = 1024; dst = ((u16*)(P.ws + OFF_WgT)) + ((size_t)l * 4 + kq) * 1024 * 1024; K = 1024; ntk = 16; mode = 0; }
      else if (t < 2656) { t -= 2144; int kq = t >> 7; t &= 127; s0 = P.w_branch + ((size_t)l * 4 + kq) * 512 * 1024; ld = 1024; dst = ((u16*)(P.ws + OFF_WbT)) + ((size_t)l * 4 + kq) * 1024 * 512; K = 512; ntk = 8; mode = 0; }
      else if (t < 2912) { t -= 2656; s0 = P.w_out + (size_t)l * 1024 * 1024; ld = 1024; dst = ((u16*)(P.ws + OFF_WoT)) + (size_t)l * 1024 * 1024; K = 1024; ntk = 16; mode = 0; }
      else if (t < 2928) { t -= 2912; int g = t >> 2; t &= 3; s0 = P.pool_w + ((size_t)l * 4 + g) * 128 * 128; ld = 128; dst = ((u16*)(P.ws + OFF_poolT)) + ((size_t)l * 4 + g) * 128 * 128; K = 128; ntk = 2; mode = 0; }
      else { t -= 2928; int g = t >> 2; t &= 3; s0 = P.sgu_w + ((size_t)l * 4 + g) * 128 * 128; ld = 128; dst = ((u16*)(P.ws + OFF_sguW)) + ((size_t)l * 4 + g) * 128 * 128; K = 128; ntk = 2; mode = 3; }
      const int tn = t / ntk, tk = t % ntk;
      cvt_tile(s0, s0, ld, dst, K, tn * 64, tk * 64, mode, (u16*)smem);
    } else if (it < ncvt + 192) {
      mod_item(P, it - ncvt, smem);
    } else {
      misc_item(P);
    }
  }
}

DI void ffn_cvt_item(const Params& P, int l, int it, char* smem) {
  const int e = it / 384;
  int t = it % 384;
  if (t < 256) {
    cvt_tile(P.w1 + ((size_t)l * 16 + e) * 1024 * 512, P.w3 + ((size_t)l * 16 + e) * 1024 * 512, 512, ((u16*)(P.ws + OFF_W13T)) + (size_t)e * 1024 * 1024, 1024, (t >> 4) * 64, (t & 15) * 64, 2, (u16*)smem);
  } else {
    t -= 256;
    const float* s = P.w2 + ((size_t)l * 16 + e) * 512 * 1024;
    cvt_tile(s, s, 1024, ((u16*)(P.ws + OFF_W2T)) + (size_t)e * 1024 * 512, 512, (t >> 3) * 64, (t & 7) * 64, 0, (u16*)smem);
  }
}

DI void load_row_f32(const float* p, int lane, float (&v)[16]) {
#pragma unroll
  for (int k = 0; k < 4; ++k) { float4 t = *(const float4*)(p + lane * 4 + 256 * k); v[4 * k] = t.x; v[4 * k + 1] = t.y; v[4 * k + 2] = t.z; v[4 * k + 3] = t.w; }
}
DI void load_row_bf16(const u16* p, int lane, float (&v)[16]) {
#pragma unroll
  for (int k = 0; k < 4; ++k) { bf16x4 t = *(const bf16x4*)(p + lane * 4 + 256 * k); for (int i = 0; i < 4; ++i) v[4 * k + i] = bf2f((u16)t[i]); }
}
DI void store_row_f32(float* p, int lane, const float (&v)[16]) {
#pragma unroll
  for (int k = 0; k < 4; ++k) *(float4*)(p + lane * 4 + 256 * k) = make_float4(v[4 * k], v[4 * k + 1], v[4 * k + 2], v[4 * k + 3]);
}
DI void store_row_bf16(u16* p, int lane, const float (&v)[16]) {
#pragma unroll
  for (int k = 0; k < 4; ++k) *(bf16x4*)(p + lane * 4 + 256 * k) = pack4(v[4 * k], v[4 * k + 1], v[4 * k + 2], v[4 * k + 3]);
}
DI void ln_row(float (&v)[16], const float* g, const float* b, int lane) {
  float s = 0.f;
#pragma unroll
  for (int i = 0; i < 16; ++i) s += v[i];
  float mu = wave_sum(s) * (1.f / 1024.f);
  float q = 0.f;
#pragma unroll
  for (int i = 0; i < 16; ++i) { float d = v[i] - mu; q += d * d; }
  float rstd = rsqrtf(wave_sum(q) * (1.f / 1024.f) + LN_EPS);
  float gg[16], bb[16];
  load_row_f32(g, lane, gg); load_row_f32(b, lane, bb);
#pragma unroll
  for (int i = 0; i < 16; ++i) v[i] = (v[i] - mu) * rstd * gg[i] + bb[i];
}

DI void phase_h0(const Params& P) {
  const int lane = TID() & 63;
  const int gw = blockIdx.x * 4 + (TID() >> 6), nw = gridDim.x * 4;
  for (int row = gw; row < NTOK; row += nw) {
    int s = row / SP, p = row % SP;
    bool lat = p < SEQ;
    const float* xs = lat ? P.x + ((size_t)s * SEQ + p) * DM : P.ctx + ((size_t)s * CTXL + (p - SEQ)) * DM;
    const float* md = ((float*)(P.ws + OFF_mod)) + (size_t)(lat ? s : 16) * 6144;
    float v[16], sh[16], scl[16];
    load_row_f32(xs, lane, v); load_row_f32(md, lane, sh); load_row_f32(md + 1024, lane, scl);
#pragma unroll
    for (int i = 0; i < 16; ++i) v[i] = v[i] * (1.f + scl[i]) + sh[i];
    store_row_bf16(((u16*)(P.ws + OFF_H)) + (size_t)row * DM, lane, v);
  }
}

DI void compute_x1(const Params& P, int l, int row, int lane, float (&v)[16]) {
  int s = row / SP, p = row % SP;
  bool lat = p < SEQ;
  const float* xs;
  if (l == 0) xs = lat ? P.x + ((size_t)s * SEQ + p) * DM : P.ctx + ((size_t)s * CTXL + (p - SEQ)) * DM;
  else xs = P.out + ((size_t)s * SEQ + p) * DM;
  const float* md = ((float*)(P.ws + OFF_mod)) + ((size_t)l * 17 + (lat ? s : 16)) * 6144;
  float y[16], m2[16];
  load_row_f32(xs, lane, v); load_row_bf16(((u16*)(P.ws + OFF_Y)) + (size_t)row * DM, lane, y); load_row_f32(md + 2 * 1024, lane, m2);
#pragma unroll
  for (int i = 0; i < 16; ++i) v[i] = ALPHA * v[i] + m2[i] * y[i];
  ln_row(v, P.ln1_g + l * 1024, P.ln1_b + l * 1024, lane);
}

DI void phase_ln1(const Params& P, int l, char* smem) {
  const bool last = (l == 1);
  const int tid = TID();
  const int lane = tid & 63;
  const int gw = blockIdx.x * 4 + (tid >> 6), nw = gridDim.x * 4;
  float* wT = (float*)smem;
  __syncthreads();
  {
    const float* wr = P.w_router + (size_t)l * 1024 * 16;
    for (int i = tid; i < 4096; i += 256) {
      int c = i >> 2, e4 = (i & 3) * 4;
      float4 w = *(const float4*)(wr + (size_t)c * 16 + e4);
      wT[(e4 + 0) * 1024 + c] = w.x; wT[(e4 + 1) * 1024 + c] = w.y; wT[(e4 + 2) * 1024 + c] = w.z; wT[(e4 + 3) * 1024 + c] = w.w;
    }
  }
  __syncthreads();
  for (int row = gw; row < NTOK; row += nw) {
    int s = row / SP, p = row % SP;
    bool lat = p < SEQ;
    if (last && !lat) continue;
    float v[16];
    compute_x1(P, l, row, lane, v);
    const float* md = ((float*)(P.ws + OFF_mod)) + ((size_t)l * 17 + (lat ? s : 16)) * 6144;
    float m3[16], m4[16];
    load_row_f32(md + 3 * 1024, lane, m3); load_row_f32(md + 4 * 1024, lane, m4);
#pragma unroll
    for (int i = 0; i < 16; ++i) v[i] = v[i] * (1.f + m4[i]) + m3[i];
    store_row_bf16(((u16*)(P.ws + OFF_H)) + (size_t)row * DM, lane, v);
    float lg[16];
#pragma unroll
    for (int e = 0; e < 16; ++e) {
      float a = 0.f;
#pragma unroll
      for (int k = 0; k < 4; ++k) {
        float4 w = *(const float4*)(wT + e * 1024 + lane * 4 + 256 * k);
        a += v[4 * k] * w.x + v[4 * k + 1] * w.y + v[4 * k + 2] * w.z + v[4 * k + 3] * w.w;
      }
      lg[e] = a;
    }
#pragma unroll
    for (int e = 0; e < 16; ++e) lg[e] = wave_sum(lg[e]);
    float mx = lg[0];
#pragma unroll
    for (int e = 1; e < 16; ++e) mx = fmaxf(mx, lg[e]);
    float sum = 0.f;
#pragma unroll
    for (int e = 0; e < 16; ++e) { lg[e] = expf(lg[e] - mx); sum += lg[e]; }
    float inv = 1.f / sum;
    if (lane < 16) {
      float mine = 0.f;
#pragma unroll
      for (int e = 0; e < 16; ++e) if (lane == e) mine = lg[e];
      ((float*)(P.ws + OFF_aff))[(size_t)row * 16 + lane] = mine * inv;
    }
  }
  for (int it = blockIdx.x; it < 16 * 384; it += gridDim.x) ffn_cvt_item(P, l, it, smem);
}

DI int block_excl_scan(int v, int* red, int tid, int& total) {
  const int lane = tid & 63, wave = tid >> 6;
  int inc = v;
#pragma unroll
  for (int o = 1; o < 64; o <<= 1) { int t = __shfl_up(inc, o); if (lane >= o) inc += t; }
  __syncthreads();
  if (lane == 63) red[wave] = inc;
  __syncthreads();
  int base = 0;
#pragma unroll
  for (int w = 0; w < 4; ++w) { int t = red[w]; if (w < wave) base += t; }
  total = red[0] + red[1] + red[2] + red[3];
  return base + inc - v;
}

DI void phase_topk(const Params& P, int l, char* smem) {
  const bool last = (l == 1);
  const int tid = TID();
  unsigned* keys = (unsigned*)smem;
  int* red = (int*)(smem + 8192);
  const int nitems = last ? 256 : 512;
  for (int it = blockIdx.x; it < nitems; it += gridDim.x) {
    const bool isctx = it >= 256;
    const int se = it & 255, s = se >> 4, e = se & 15;
    const int n = isctx ? CTXL : SEQ, cap = isctx ? 32 : 256;
    const int row0 = s * SP + (isctx ? SEQ : 0);
    const int per = n >> 8;
    __syncthreads();
    for (int i = tid; i < n; i += 256) keys[i] = __float_as_uint(((float*)(P.ws + OFF_aff))[(size_t)(row0 + i) * 16 + e]);
    __syncthreads();
    unsigned kv[8];
#pragma unroll
    for (int j = 0; j < 8; ++j) kv[j] = (j < per) ? keys[tid * per + j] : 0u;
    unsigned prefix = 0u;
    int krem = cap;
    for (int bit = 31; bit >= 0; --bit) {
      const unsigned himask = (bit == 31) ? 0u : (0xFFFFFFFFu << (bit + 1));
      const unsigned want = prefix | (1u << bit);
      int c = 0;
#pragma unroll
      for (int j = 0; j < 8; ++j) c += (j < per && ((kv[j] & (himask | (1u << bit))) == want)) ? 1 : 0;
      c = (int)wave_sum((float)c);
      __syncthreads();
      if ((tid & 63) == 0) red[tid >> 6] = c;
      __syncthreads();
      const int cnt = red[0] + red[1] + red[2] + red[3];
      if (cnt >= krem) prefix = want; else krem -= cnt;
    }
    const unsigned T = prefix;
    int cgt = 0, ceq = 0;
#pragma unroll
    for (int j = 0; j < 8; ++j) if (j < per) { cgt += kv[j] > T ? 1 : 0; ceq += kv[j] == T ? 1 : 0; }
    int tot_gt, tot_eq, tot_sel;
    (void)block_excl_scan(cgt, red, tid, tot_gt);
    const int eq_before = block_excl_scan(ceq, red, tid, tot_eq);
    const int need_eq = cap - tot_gt;
    int eqc = eq_before, csel = 0;
    bool sel[8];
#pragma unroll
    for (int j = 0; j < 8; ++j) {
      sel[j] = false;
      if (j < per) {
        if (kv[j] > T) sel[j] = true;
        else if (kv[j] == T) { sel[j] = eqc < need_eq; ++eqc; }
        csel += sel[j] ? 1 : 0;
      }
    }
    int slot = block_excl_scan(csel, red, tid, tot_sel);
#pragma unroll
    for (int j = 0; j < 8; ++j) if (j < per) {
      const int t = tid * per + j;
      int rk = cap;
      if (sel[j]) {
        rk = slot++;
        const int R = isctx ? NFFN_LAT + (e * 16 + s) * 32 + rk : (s * 16 + e) * 256 + rk;
        ((int*)(P.ws + OFF_tokidx))[R] = row0 + t;
        ((float*)(P.ws + OFF_gatev))[R] = __uint_as_float(kv[j]);
      }
      ((int*)(P.ws + OFF_rank))[(size_t)(row0 + t) * 16 + e] = rk;
    }
  }
}

DI void phase_ln2(const Params& P, int l) {
  const bool last = (l == 1);
  const int lane = TID() & 63;
  const int gw = blockIdx.x * 4 + (TID() >> 6), nw = gridDim.x * 4;
  for (int row = gw; row < NTOK; row += nw) {
    int s = row / SP, p = row % SP;
    bool lat = p < SEQ;
    if (last && !lat) continue;
    float v[16];
    compute_x1(P, l, row, lane, v);
    float yf[16];
#pragma unroll
    for (int i = 0; i < 16; ++i) yf[i] = 0.f;
    const int cap = lat ? 256 : 32;
    for (int e = 0; e < 16; ++e) {
      int rk = ((int*)(P.ws + OFF_rank))[(size_t)row * 16 + e];
      if (rk < cap) {
        int R = lat ? (s * 16 + e) * 256 + rk : NFFN_LAT + (e * 16 + s) * 32 + rk;
        float t[16];
        load_row_bf16(((u16*)(P.ws + OFF_ye)) + (size_t)R * DM, lane, t);
#pragma unroll
        for (int i = 0; i < 16; ++i) yf[i] += t[i];
      }
    }
    const float* md = ((float*)(P.ws + OFF_mod)) + ((size_t)l * 17 + (lat ? s : 16)) * 6144;
    float m5[16];
    load_row_f32(md + 5 * 1024, lane, m5);
#pragma unroll
    for (int i = 0; i < 16; ++i) v[i] = ALPHA * v[i] + m5[i] * yf[i];
    ln_row(v, P.ln2_g + l * 1024, P.ln2_b + l * 1024, lane);
    if (lat) store_row_f32(P.out + ((size_t)s * SEQ + p) * DM, lane, v);
    if (!last) {
      const float* md2 = ((float*)(P.ws + OFF_mod)) + ((size_t)(l + 1) * 17 + (lat ? s : 16)) * 6144;
      float sh[16], scl[16];
      load_row_f32(md2, lane, sh); load_row_f32(md2 + 1024, lane, scl);
#pragma unroll
      for (int i = 0; i < 16; ++i) v[i] = v[i] * (1.f + scl[i]) + sh[i];
      store_row_bf16(((u16*)(P.ws + OFF_H)) + (size_t)row * DM, lane, v);
    }
  }
}

DI int wq_next(unsigned* ctr, char* smem) {
  volatile int* slot = (volatile int*)(smem + SMEM_BYTES - 32);
  __syncthreads();
  if (TID() == 0) *slot = (int)__hip_atomic_fetch_add(ctr, 1u, __ATOMIC_RELAXED, __HIP_MEMORY_SCOPE_AGENT);
  __syncthreads();
  return *slot;
}

DI unsigned* wq_ctr(const Params& P, int ph) { return (unsigned*)(P.ws + OFF_bar) + 3600 + 16 * ph; }

template <bool SWAP>
DI void proj_tile(const Params& P, int l, int hb, int mt, int nt, char* smem) {
  const int tid = TID(), wave = tid >> 6, lane = tid & 63, fr = lane & 15, fq = lane >> 4;
  const int wr = wave >> 1, wc = wave & 1;
  const int hrow0 = mt * 128, grow0 = hb * HROWS + hrow0;
  f32x4 acc[4][4];
  zero_acc<4>(acc);
  gemm_main<4, SWAP, false>(((u16*)(P.ws + OFF_H)), DM, nullptr, grow0, ((u16*)(P.ws + OFF_WinT)) + (size_t)l * INP * 1024, 1024, nt * 128, 1024, acc, (u16*)smem);
  const int jp = mt % 18;
  const int bl = mt / 18;
  const bool lat = jp < 16;
  if (SWAP) {
    u16* dst; int ldd, c0;
    if (nt < 4) { dst = ((u16*)(P.ws + OFF_xp)); ldd = 512; c0 = nt * 128; }
    else if (nt < 8) { dst = ((u16*)(P.ws + OFF_z)); ldd = 512; c0 = (nt - 4) * 128; }
    else if (nt < 14) { dst = ((u16*)(P.ws + OFF_xbc)); ldd = 768; c0 = (nt - 8) * 128; }
    else if (nt < 18) { dst = ((u16*)(P.ws + OFF_q)); ldd = 512; c0 = (nt - 14) * 128; }
    else if (nt < 22) { dst = ((u16*)(P.ws + OFF_k)); ldd = 512; c0 = (nt - 18) * 128; }
    else { dst = ((u16*)(P.ws + OFF_br3)); ldd = 512; c0 = (nt - 26) * 128; }
    const bool isu = nt >= 26;
    const bool rope = (nt >= 14 && nt < 22) && lat;
#pragma unroll
    for (int m = 0; m < 4; ++m) {
      int r = wr * 64 + m * 16 + fr;
      size_t orow = isu ? (size_t)(grow0 + r) : (size_t)(hrow0 + r);
      if (rope) {
        int t = jp * 128 + r;
        int prow = t >> 6, pcol = t & 63;
#pragma unroll
        for (int j = 0; j < 4; ++j) {
          int f = fq * 4 + j;
          float c1 = ((float*)(P.ws + OFF_rope))[(prow * 16 + f) * 2], s1 = ((float*)(P.ws + OFF_rope))[(prow * 16 + f) * 2 + 1];
          float c2 = ((float*)(P.ws + OFF_rope))[(pcol * 16 + f) * 2], s2 = ((float*)(P.ws + OFF_rope))[(pcol * 16 + f) * 2 + 1];
          float a = acc[m][0][j], b = acc[m][1][j];
          acc[m][0][j] = a * c1 - b * s1; acc[m][1][j] = a * s1 + b * c1;
          a = acc[m][2][j]; b = acc[m][3][j];
          acc[m][2][j] = a * c2 - b * s2; acc[m][3][j] = a * s2 + b * c2;
        }
      }
#pragma unroll
      for (int n = 0; n < 4; ++n) {
        f32x4 v = acc[m][n];
        if (isu) { v[0] = geluf_(v[0]); v[1] = geluf_(v[1]); v[2] = geluf_(v[2]); v[3] = geluf_(v[3]); }
        int col = c0 + wc * 64 + n * 16 + fq * 4;
        *(bf16x4*)(dst + orow * ldd + col) = pack4v(v);
      }
    }
  } else {
    if (nt == 34) {
      if (wc == 0) {
#pragma unroll
        for (int m = 0; m < 4; ++m)
#pragma unroll
          for (int j = 0; j < 4; ++j) ((float*)(P.ws + OFF_dtbuf))[(size_t)(hrow0 + wr * 64 + m * 16 + fq * 4 + j) * 16 + fr] = acc[m][0][j];
      }
    } else if (nt < 26) {
      int cb = (nt - 22) * 128 + wc * 64;
#pragma unroll
      for (int m = 0; m < 4; ++m)
#pragma unroll
        for (int n = 0; n < 4; ++n) {
          int c = cb + n * 16 + fr;
          int pos = jp * 128 + wr * 64 + m * 16 + fq * 4;
          *(bf16x4*)(((u16*)(P.ws + OFF_vT)) + ((size_t)bl * 512 + c) * SP + pos) = pack4v(acc[m][n]);
        }
    } else {
      int cb = (nt - 30) * 128 + wc * 64;
#pragma unroll
      for (int m = 0; m < 4; ++m)
#pragma unroll
        for (int n = 0; n < 4; ++n) {
          int c = cb + n * 16 + fr;
          int i0 = wr * 64 + m * 16 + fq * 4;
          f32x4 v = acc[m][n];
          *(bf16x4*)(((u16*)(P.ws + OFF_gvT)) + ((size_t)mt * 512 + c) * 128 + i0) = pack4(geluf_(v[0]), geluf_(v[1]), geluf_(v[2]), geluf_(v[3]));
        }
    }
  }
}

DI void phase_proj(const Params& P, int l, int hb, char* smem, int ph) {
  const bool last = (l == 1);
  for (;;) {
    const int it = wq_next(wq_ctr(P, ph), smem);
    if (it >= 144 * 35) break;
    int mt = it / 35, nt = it % 35;
    bool isctx = (mt % 18) >= 16;
    if (last && isctx) {
      bool need = (nt >= 8 && nt < 14) || (nt >= 18 && nt < 26) || nt == 34;
      if (!need) continue;
    }
    bool transposed = (nt >= 22 && nt < 26) || nt >= 30;
    if (transposed) proj_tile<false>(P, l, hb, mt, nt, smem);
    else proj_tile<true>(P, l, hb, mt, nt, smem);
  }
}

constexpr int LDK = 136;
DI void pool_item(const Params& P, int l, int hb, int mt, int g, char* smem) {
  const int tid = TID(), wave = tid >> 6, lane = tid & 63, fr = lane & 15, fq = lane >> 4;
  const int wr = wave >> 1, wc = wave & 1;
  u16* As = (u16*)smem;
  u16* Bs = As + 128 * LDK;
  const int jp = mt % 18, bl = mt / 18;
  const bool lat = jp < 16;
  const int n = lat ? SEQ : CTXL;
  const int p0 = lat ? jp * 128 : (jp - 16) * 128;
  const int seqbase = bl * SP + (lat ? 0 : SEQ);
  const int half = 1 << g;
  __syncthreads();
  {
    const int cch = tid & 15;
    const u16* src = ((u16*)(P.ws + OFF_xp)) + (size_t)seqbase * 512 + g * 128 + cch * 8;
    for (int ii = 0; ii < 8; ++ii) {
      int i = (tid >> 4) + 16 * ii;
      int p = p0 + i;
      int lo = max(p - half, 0), hi = min(p + half, n);
      float s[8];
#pragma unroll
      for (int e = 0; e < 8; ++e) s[e] = 0.f;
      for (int r = lo; r < hi; ++r) {
        bf16x8 t = *(const bf16x8*)(src + (size_t)r * 512);
#pragma unroll
        for (int e = 0; e < 8; ++e) s[e] += bf2f((u16)t[e]);
      }
      bf16x8 self = *(const bf16x8*)(src + (size_t)p * 512);
      float inv = 1.f / (float)(hi - lo);
      bf16x8 o;
#pragma unroll
      for (int e = 0; e < 8; ++e) o[e] = (short)f2bf(s[e] * inv - bf2f((u16)self[e]));
      *(bf16x8*)(As + i * LDK + cch * 8) = o;
    }
    const u16* wsrc = ((u16*)(P.ws + OFF_poolT)) + ((size_t)l * 4 + g) * 128 * 128;
    for (int cid = tid; cid < 2048; cid += 256) {
      int r = cid >> 4, c8 = (cid & 15) * 8;
      *(u32x4*)(Bs + r * LDK + c8) = *(const u32x4*)(wsrc + r * 128 + c8);
    }
  }
  __syncthreads();
  f32x4 acc[4][4];
  zero_acc<4>(acc);
  mma_lds<4, 4, true>(As + wr * 64 * LDK, LDK, Bs + wc * 64 * LDK, LDK, 4, acc, fr, fq);
  const float* psc = P.pool_scale + l * 512 + g * 128;
#pragma unroll
  for (int m = 0; m < 4; ++m)
#pragma unroll
    for (int nn = 0; nn < 4; ++nn) {
      int r = wr * 64 + m * 16 + fr, c = wc * 64 + nn * 16 + fq * 4;
      float4 sc = *(const float4*)(psc + c);
      f32x4 v = acc[m][nn];
      *(bf16x4*)(((u16*)(P.ws + OFF_br0)) + (size_t)(hb * HROWS + mt * 128 + r) * 512 + g * 128 + c) = pack4(v[0] * sc.x, v[1] * sc.y, v[2] * sc.z, v[3] * sc.w);
    }
}

DI void sgu_item(const Params& P, int l, int hb, int mt, char* smem) {
  const int tid = TID(), wave = tid >> 6, lane = tid & 63, fr = lane & 15, fq = lane >> 4;
  const int wr = wave >> 1, wc = wave & 1;
  u16* As = (u16*)smem;
  u16* Bs = As + 128 * LDK;
  float* st = (float*)(Bs + 128 * LDK);
  const u16* gv = ((u16*)(P.ws + OFF_gvT)) + (size_t)mt * 512 * 128;
  __syncthreads();
  {
    int i = tid & 127, part = tid >> 7;
    float s = 0.f;
#pragma unroll 16
    for (int c = part * 256; c < part * 256 + 256; ++c) s += bf2f(gv[c * 128 + i]);
    st[part * 128 + i] = s;
    __syncthreads();
    float mu = (st[i] + st[128 + i]) * (1.f / 512.f);
    __syncthreads();
    float qv = 0.f;
#pragma unroll 16
    for (int c = part * 256; c < part * 256 + 256; ++c) { float d = bf2f(gv[c * 128 + i]) - mu; qv += d * d; }
    st[part * 128 + i] = qv;
    __syncthreads();
    float var = (st[i] + st[128 + i]) * (1.f / 512.f);
    __syncthreads();
    if (part == 0) { st[256 + i] = mu; st[384 + i] = rsqrtf(var + LN_EPS); }
  }
  const float* mu = st + 256;
  const float* rs = st + 384;
  for (int g = 0; g < 4; ++g) {
    __syncthreads();
    const u16* wsrc = ((u16*)(P.ws + OFF_sguW)) + ((size_t)l * 4 + g) * 128 * 128;
    for (int cid = tid; cid < 2048; cid += 256) {
      int r = cid >> 4, c8 = (cid & 15) * 8;
      *(u32x4*)(As + r * LDK + c8) = *(const u32x4*)(wsrc + r * 128 + c8);
      bf16x8 t = *(const bf16x8*)(gv + (size_t)(g * 128 + r) * 128 + c8);
      float lg = P.sgu_ln_g[l * 512 + g * 128 + r], lb = P.sgu_ln_b[l * 512 + g * 128 + r];
      bf16x8 o;
#pragma unroll
      for (int e = 0; e < 8; ++e) o[e] = (short)f2bf((bf2f((u16)t[e]) - mu[c8 + e]) * rs[c8 + e] * lg + lb);
      *(bf16x8*)(Bs + r * LDK + c8) = o;
    }
    __syncthreads();
    f32x4 acc[4][4];
    zero_acc<4>(acc);
    mma_lds<4, 4, true>(As + wr * 64 * LDK, LDK, Bs + wc * 64 * LDK, LDK, 4, acc, fr, fq);
    const float* bs = P.sgu_b + ((size_t)l * 4 + g) * 128;
#pragma unroll
    for (int m = 0; m < 4; ++m) {
      int pp = wr * 64 + m * 16 + fr;
      float bias = bs[pp];
#pragma unroll
      for (int nn = 0; nn < 4; ++nn) {
        int d = wc * 64 + nn * 16 + fq * 4;
        u16* up = ((u16*)(P.ws + OFF_br3)) + (size_t)(hb * HROWS + mt * 128 + pp) * 512 + g * 128 + d;
        bf16x4 uu = *(const bf16x4*)up;
        f32x4 v = acc[m][nn];
        *(bf16x4*)up = pack4((v[0] + bias) * bf2f((u16)uu[0]), (v[1] + bias) * bf2f((u16)uu[1]), (v[2] + bias) * bf2f((u16)uu[2]), (v[3] + bias) * bf2f((u16)uu[3]));
      }
    }
  }
}

DI void attn_item(const Params& P, int l, int hb, int item, char* smem) {
  const int tid = TID(), wave = tid >> 6, lane = tid & 63, fr = lane & 15, fq = lane >> 4;
  const int qt = item % 18, h = (item / 18) & 3, bl = item / 72;
  const bool ctxq = qt >= 16;
  const int key0 = ctxq ? SEQ : 0, nkt = ctxq ? 4 : 36;
  const int hrow_q0 = bl * SP + qt * 128 + wave * 32;
  constexpr int KT = 64 * LDT, VT = 128 * LDT;
  u16* Ks = (u16*)smem;
  u16* Vs = Ks + 2 * KT;
  constexpr float LOG2E = 1.4426950408889634f;
  for (int sub = 0; sub < 2; ++sub) {
    const int hs = 2 * h + sub;
    bf16x8 qf[2][2];
#pragma unroll
    for (int qb = 0; qb < 2; ++qb)
#pragma unroll
      for (int ks = 0; ks < 2; ++ks) qf[qb][ks] = *(const bf16x8*)(((u16*)(P.ws + OFF_q)) + (size_t)(hrow_q0 + qb * 16 + fr) * 512 + hs * 64 + ks * 32 + fq * 8);
    f32x4 ot[8][2];
#pragma unroll
    for (int d = 0; d < 8; ++d) { ot[d][0] = f32x4{0.f, 0.f, 0.f, 0.f}; ot[d][1] = f32x4{0.f, 0.f, 0.f, 0.f}; }
    float mrow[2] = {-INFINITY, -INFINITY}, lrow[2] = {0.f, 0.f};
    const u16* Kg = ((u16*)(P.ws + OFF_k)) + ((size_t)bl * SP + key0) * 512 + hs * 64;
    const u16* Vg = ((u16*)(P.ws + OFF_vT)) + ((size_t)bl * 512 + h * 128) * SP + key0;
    u32x4 rk[2], rv[4];
    const u16* kgp = Kg + (size_t)(tid >> 2) * 512 + (tid & 3) * 16;
    const u16* vgp = Vg + (size_t)(tid >> 1) * SP + (tid & 1) * 32;
    u16* ksp = Ks + (tid >> 2) * LDT + (tid & 3) * 16;
    u16* vsp = Vs + (tid >> 1) * LDT + (tid & 1) * 32;
    auto gloadK = [&](int t) {
      const u16* kp = kgp + (size_t)t * 64 * 512;
      rk[0] = *(const u32x4*)(kp); rk[1] = *(const u32x4*)(kp + 8);
    };
    auto gloadV = [&](int t) {
      const u16* vp = vgp + t * 64;
      rv[0] = *(const u32x4*)(vp); rv[1] = *(const u32x4*)(vp + 8); rv[2] = *(const u32x4*)(vp + 16); rv[3] = *(const u32x4*)(vp + 24);
    };
    auto sstore = [&](int buf) {
      u16* kp = ksp + buf * KT;
      *(u32x4*)(kp) = rk[0]; *(u32x4*)(kp + 8) = rk[1];
      u16* vp = vsp + buf * VT;
      *(u32x4*)(vp) = rv[0]; *(u32x4*)(vp + 8) = rv[1]; *(u32x4*)(vp + 16) = rv[2]; *(u32x4*)(vp + 24) = rv[3];
    };
    gloadK(0); gloadV(0);
    __syncthreads();
    sstore(0);
    __syncthreads();
    for (int t = 0; t < nkt; ++t) {
      const int cur = t & 1;
      if (t + 1 < nkt) gloadK(t + 1);
      const u16* Kc = Ks + cur * KT;
      const u16* Vc = Vs + cur * VT;
      f32x4 st[4][2];
#pragma unroll
      for (int k4 = 0; k4 < 4; ++k4) { st[k4][0] = f32x4{0.f, 0.f, 0.f, 0.f}; st[k4][1] = f32x4{0.f, 0.f, 0.f, 0.f}; }
#pragma unroll
      for (int k4 = 0; k4 < 4; ++k4)
#pragma unroll
        for (int ks = 0; ks < 2; ++ks) {
          bf16x8 a = *(const bf16x8*)(Kc + (k4 * 16 + fr) * LDT + ks * 32 + fq * 8);
          st[k4][0] = MFMA16(a, qf[0][ks], st[k4][0]);
          st[k4][1] = MFMA16(a, qf[1][ks], st[k4][1]);
          if (ks == 1 && (k4 & 1)) __builtin_amdgcn_sched_barrier(0);
        }
      __builtin_amdgcn_sched_barrier(0);
#pragma unroll
      for (int qb = 0; qb < 2; ++qb) {
        float mx = -INFINITY;
#pragma unroll
        for (int k4 = 0; k4 < 4; ++k4)
#pragma unroll
          for (int j = 0; j < 4; ++j) mx = fmaxf(mx, st[k4][qb][j]);
        mx = fmaxf(mx, __shfl_xor(mx, 16));
        mx = fmaxf(mx, __shfl_xor(mx, 32));
        float mnew = fmaxf(mrow[qb], mx);
        float alpha = __builtin_amdgcn_exp2f((mrow[qb] - mnew) * LOG2E);
        mrow[qb] = mnew;
        float moff = mnew * LOG2E;
        float ps = 0.f;
#pragma unroll
        for (int k4 = 0; k4 < 4; ++k4)
#pragma unroll
          for (int j = 0; j < 4; ++j) { float pv = __builtin_amdgcn_exp2f(st[k4][qb][j] * LOG2E - moff); st[k4][qb][j] = pv; ps += pv; }
        lrow[qb] = lrow[qb] * alpha + ps;
#pragma unroll
        for (int d = 0; d < 8; ++d) { ot[d][qb][0] *= alpha; ot[d][qb][1] *= alpha; ot[d][qb][2] *= alpha; ot[d][qb][3] *= alpha; }
      }
      __builtin_amdgcn_sched_barrier(0);
      if (t + 1 < nkt) gloadV(t + 1);
#pragma unroll
      for (int ks2 = 0; ks2 < 2; ++ks2) {
        bf16x8 pf[2];
#pragma unroll
        for (int qb = 0; qb < 2; ++qb) {
          bf16x4 lo = pack4v(st[2 * ks2][qb]), hi = pack4v(st[2 * ks2 + 1][qb]);
          pf[qb] = __builtin_shufflevector(lo, hi, 0, 1, 2, 3, 4, 5, 6, 7);
        }
#pragma unroll
        for (int d = 0; d < 8; ++d) {
          const u16* vp = Vc + (d * 16 + fr) * LDT + ks2 * 32 + fq * 4;
          bf16x4 lo = *(const bf16x4*)vp, hi = *(const bf16x4*)(vp + 16);
          bf16x8 a = __builtin_shufflevector(lo, hi, 0, 1, 2, 3, 4, 5, 6, 7);
          ot[d][0] = MFMA16(a, pf[0], ot[d][0]);
          ot[d][1] = MFMA16(a, pf[1], ot[d][1]);
          if ((d & 3) == 3) __builtin_amdgcn_sched_barrier(0);
        }
      }
      if (t + 1 < nkt) sstore(cur ^ 1);
      __syncthreads();
    }
#pragma unroll
    for (int qb = 0; qb < 2; ++qb) {
      float lt = lrow[qb];
      lt += __shfl_xor(lt, 16);
      lt += __shfl_xor(lt, 32);
      float inv = 1.f / lt;
      size_t hrow = (size_t)(hrow_q0 + qb * 16 + fr);
      if (sub == 0) {
#pragma unroll
        for (int d = 0; d < 8; ++d) {
          f32x4 v = ot[d][qb];
          *(bf16x4*)(((u16*)(P.ws + OFF_o1)) + hrow * 512 + h * 128 + d * 16 + fq * 4) = pack4(v[0] * inv, v[1] * inv, v[2] * inv, v[3] * inv);
        }
      } else {
        const float lam = ((float*)(P.ws + OFF_lamv))[l * 2], lam_init = ((float*)(P.ws + OFF_lamv))[l * 2 + 1];
        float ss = 0.f;
#pragma unroll
        for (int d = 0; d < 8; ++d) {
          bf16x4 o1v = *(const bf16x4*)(((u16*)(P.ws + OFF_o1)) + hrow * 512 + h * 128 + d * 16 + fq * 4);
#pragma unroll
          for (int j = 0; j < 4; ++j) { float dd = bf2f((u16)o1v[j]) - lam * ot[d][qb][j] * inv; ot[d][qb][j] = dd; ss += dd * dd; }
        }
        ss += __shfl_xor(ss, 16);
        ss += __shfl_xor(ss, 32);
        float rr = rsqrtf(ss * (1.f / 128.f) + LN_EPS) * (1.f - lam_init);
        const float* gn = P.diff_norm_g + l * 128;
#pragma unroll
        for (int d = 0; d < 8; ++d) {
          int dv = d * 16 + fq * 4;
          float4 g4 = *(const float4*)(gn + dv);
          f32x4 v = ot[d][qb];
          *(bf16x4*)(((u16*)(P.ws + OFF_br2)) + ((size_t)hb * HROWS + hrow) * 512 + h * 128 + dv) = pack4(v[0] * rr * g4.x, v[1] * rr * g4.y, v[2] * rr * g4.z, v[3] * rr * g4.w);
        }
      }
    }
  }
}

template <bool TRANS>
DI void conv_stage(const Params& P, int l, const u16* xbase  , int chan0, int n, int p0, u16* dst, int ld, const float* scale) {
  const int tid = TID(), cl = tid & 63, ig = tid >> 6;
  const int ch = chan0 + cl;
  const float* cw = P.conv_w + (size_t)l * 5 * 768 + ch;
  const float w0 = cw[0], w1 = cw[768], w2 = cw[2 * 768], w3 = cw[3 * 768], w4 = cw[4 * 768];
  const float cb = P.conv_b[l * 768 + ch];
  const u16* xc = xbase + ch;
#pragma unroll 1
  for (int g8 = 0; g8 < 4; ++g8) {
    const int tok0 = ig * 32 + g8 * 8;
    const int pos0 = p0 + tok0 - 2;
    float xv[12];
#pragma unroll
    for (int i = 0; i < 12; ++i) { int pos = pos0 + i; xv[i] = (pos >= 0 && pos < n) ? bf2f(xc[(size_t)pos * 768]) : 0.f; }
#pragma unroll
    for (int ii = 0; ii < 8; ++ii) {
      float v = w0 * xv[ii] + w1 * xv[ii + 1] + w2 * xv[ii + 2] + w3 * xv[ii + 3] + w4 * xv[ii + 4] + cb;
      v = v * __builtin_amdgcn_rcpf(1.f + __expf(-v));
      const int tok = tok0 + ii;
      if (scale) v *= scale[tok];
      if (TRANS) dst[cl * ld + tok] = f2bf(v); else dst[tok * ld + cl] = f2bf(v);
    }
  }
}

DI void ssd_scalars(const Params& P, int l, int hrow0, int h, int dir, float* dts, float* S, float* tmp) {
  const int tid = TID();
  const float aneg = -expf(P.a_log[l * 16 + dir * 8 + h]);
  float a = 0.f, inc = 0.f;
  if (tid < 128) {
    float raw = ((float*)(P.ws + OFF_dtbuf))[(size_t)(hrow0 + tid) * 16 + dir * 8 + h] + P.dt_bias[l * 16 + dir * 8 + h];
    float dt = softplusf_(raw);
    dts[tid] = dt;
    a = dt * aneg;
    inc = a;
    const int lane = tid & 63;
#pragma unroll
    for (int o = 1; o < 64; o <<= 1) { float t = __shfl_up(inc, o); if (lane >= o) inc += t; }
    if (lane == 63) tmp[tid >> 6] = inc;
  }
  __syncthreads();
  if (tid < 128) {
    const float t0 = tmp[0], t1 = tmp[1];
    const float pre = inc + (tid >= 64 ? t0 : 0.f);
    S[tid] = (dir == 0) ? pre : (t0 + t1) - pre + a;
  }
  __syncthreads();
}

constexpr int SSD_STATE_STRIDE = 18 * 4096;
DI void ssd_state_item(const Params& P, int l, int hb, int item, char* smem) {
  const int tid = TID(), wave = tid >> 6, lane = tid & 63, fr = lane & 15, fq = lane >> 4;
  const int dir = item & 1, h = (item >> 1) & 7, jp = (item >> 4) % 18, bl = (item >> 4) / 18;
  const bool lat = jp < 16;
  const int n = lat ? SEQ : CTXL;
  const int p0 = lat ? jp * 128 : (jp - 16) * 128;
  const int seqbase = bl * SP + (lat ? 0 : SEQ);
  const int hrow0 = bl * SP + jp * 128;
  u16* At = (u16*)smem;
  u16* Bt = At + 64 * LDK;
  float* dts = (float*)(Bt + 64 * LDK);
  float* S = dts + 128;
  float* wgt = S + 128;
  __syncthreads();
  ssd_scalars(P, l, hrow0, h, dir, dts, S, wgt);
  const float total = (dir == 0) ? S[127] : S[0];
  __syncthreads();
  if (tid < 128) wgt[tid] = dts[tid] * __expf(total - S[tid]);
  __syncthreads();
  const u16* xb = ((u16*)(P.ws + OFF_xbc)) + (size_t)seqbase * 768;
  conv_stage<true>(P, l, xb, h * 64, n, p0, At, LDK, wgt);
  conv_stage<true>(P, l, xb, 512 + (h >> 2) * 64, n, p0, Bt, LDK, nullptr);
  __syncthreads();
  const int wr = wave >> 1, wc = wave & 1;
  f32x4 acc[2][2];
#pragma unroll
  for (int m = 0; m < 2; ++m) { acc[m][0] = f32x4{0.f, 0.f, 0.f, 0.f}; acc[m][1] = f32x4{0.f, 0.f, 0.f, 0.f}; }
  mma_lds<2, 2, false>(At + wr * 32 * LDK, LDK, Bt + wc * 32 * LDK, LDK, 4, acc, fr, fq);
  float* cs = ((float*)(P.ws + OFF_cstate)) + (((size_t)(bl * 2 + dir) * 8 + h) * 18 + jp) * 4096;
#pragma unroll
  for (int m = 0; m < 2; ++m)
#pragma unroll
    for (int nn = 0; nn < 2; ++nn)
#pragma unroll
      for (int j = 0; j < 4; ++j) cs[(wr * 32 + m * 16 + fq * 4 + j) * 64 + wc * 32 + nn * 16 + fr] = acc[m][nn][j];
  if (tid == 0) ((float*)(P.ws + OFF_decay))[((bl * 2 + dir) * 8 + h) * 18 + jp] = __expf(total);
}

DI void phase_carry(const Params& P) {
  const int total = 8 * 2 * 8 * 4096;
  for (int idx = blockIdx.x * 256 + TID(); idx < total; idx += gridDim.x * 256) {
    int pn = idx & 4095, bdh = idx >> 12;
    int dir = (bdh >> 3) & 1;
    const float* __restrict__ cs = ((const float*)(P.ws + OFF_cstate)) + (size_t)bdh * SSD_STATE_STRIDE + pn;
    u16* __restrict__ en = ((u16*)(P.ws + OFF_enter)) + (size_t)bdh * SSD_STATE_STRIDE + pn;
    const float* __restrict__ dc = ((const float*)(P.ws + OFF_decay)) + bdh * 18;
    float cv[18], dv[18];
#pragma unroll
    for (int jp = 0; jp < 18; ++jp) { cv[jp] = cs[(size_t)jp * 4096]; dv[jp] = dc[jp]; }
    float state = 0.f;
    if (dir == 0) {
#pragma unroll
      for (int st = 0; st < 18; ++st) {
        const int jp = st < 2 ? 16 + st : st - 2;
        en[(size_t)jp * 4096] = f2bf(state);
        state = state * dv[jp] + cv[jp];
      }
    } else {
#pragma unroll
      for (int st = 0; st < 18; ++st) {
        const int jp = 17 - st;
        en[(size_t)jp * 4096] = f2bf(state);
        state = state * dv[jp] + cv[jp];
      }
    }
  }
}

DI void ssd_out_item(const Params& P, int l, int hb, int item, char* smem) {
  const int tid = TID(), wave = tid >> 6, lane = tid & 63, fr = lane & 15, fq = lane >> 4;
  const int h = item & 7, jp = (item >> 3) % 18, bl = (item >> 3) / 18;
  const bool lat = jp < 16;
  const int n = lat ? SEQ : CTXL;
  const int p0 = lat ? jp * 128 : (jp - 16) * 128;
  const int seqbase = bl * SP + (lat ? 0 : SEQ);
  const int hrow0 = bl * SP + jp * 128;
  u16* Cs = (u16*)smem;
  u16* xT = Cs + 128 * LDT;
  u16* Et = xT + 64 * LDK;
  u16* Un = Et + 64 * LDT;
  float* fs = (float*)(Un + 128 * LDK);
  float* dts = fs;
  float* S = fs + 128;
  float* tmp = fs + 256;
  const int grp = h >> 2;
  __syncthreads();
  const u16* xb = ((u16*)(P.ws + OFF_xbc)) + (size_t)seqbase * 768;
  conv_stage<false>(P, l, xb, 640 + grp * 64, n, p0, Cs, LDT, nullptr);
  conv_stage<false>(P, l, xb, 512 + grp * 64, n, p0, Un, LDT, nullptr);
  conv_stage<true>(P, l, xb, h * 64, n, p0, xT, LDK, nullptr);
  __syncthreads();
  f32x4 cb[2][8];
#pragma unroll
  for (int m = 0; m < 2; ++m)
#pragma unroll
    for (int nn = 0; nn < 8; ++nn) cb[m][nn] = f32x4{0.f, 0.f, 0.f, 0.f};
  mma_lds<2, 8, false>(Cs + wave * 32 * LDT, LDT, Un, LDT, 2, cb, fr, fq);
  f32x4 yacc[2][4];
#pragma unroll
  for (int m = 0; m < 2; ++m)
#pragma unroll
    for (int nn = 0; nn < 4; ++nn) yacc[m][nn] = f32x4{0.f, 0.f, 0.f, 0.f};
#pragma unroll 1
  for (int dir = 0; dir < 2; ++dir) {
    __syncthreads();
    ssd_scalars(P, l, hrow0, h, dir, dts, S, tmp);
#pragma unroll
    for (int m = 0; m < 2; ++m)
#pragma unroll
      for (int j = 0; j < 4; ++j) {
        int lrow = wave * 32 + m * 16 + fq * 4 + j;
        float Sl = S[lrow];
#pragma unroll
        for (int nn = 0; nn < 8; ++nn) {
          int s = nn * 16 + fr;
          bool ok = dir == 0 ? (s <= lrow) : (s >= lrow);
          float coef = ok ? __expf(Sl - S[s]) * dts[s] : 0.f;
          Un[lrow * LDK + s] = f2bf(cb[m][nn][j] * coef);
        }
      }
    {
      const u16* en = ((u16*)(P.ws + OFF_enter)) + (((size_t)(bl * 2 + dir) * 8 + h) * 18 + jp) * 4096;
      for (int cid = tid; cid < 512; cid += 256) {
        int pr = cid >> 3, c8 = (cid & 7) * 8;
        *(u32x4*)(Et + pr * LDT + c8) = *(const u32x4*)(en + pr * 64 + c8);
      }
    }
    __syncthreads();
    mma_lds<2, 4, true>(Un + wave * 32 * LDK, LDK, xT, LDK, 4, yacc, fr, fq);
    f32x4 yi[2][4];
#pragma unroll
    for (int m = 0; m < 2; ++m)
#pragma unroll
      for (int nn = 0; nn < 4; ++nn) yi[m][nn] = f32x4{0.f, 0.f, 0.f, 0.f};
    mma_lds<2, 4, true>(Cs + wave * 32 * LDT, LDT, Et, LDT, 2, yi, fr, fq);
#pragma unroll
    for (int m = 0; m < 2; ++m) {
      float e = __expf(S[wave * 32 + m * 16 + fr]);
#pragma unroll
      for (int nn = 0; nn < 4; ++nn)
#pragma unroll
        for (int j = 0; j < 4; ++j) yacc[m][nn][j] += e * yi[m][nn][j];
    }
  }
  const float dsk = P.ssd_d[l * 8 + h];
  const float* gn = P.ssd_norm_g + l * 512 + h * 64;
#pragma unroll
  for (int m = 0; m < 2; ++m) {
    int lrow = wave * 32 + m * 16 + fr;
    float ss = 0.f;
#pragma unroll
    for (int nn = 0; nn < 4; ++nn) {
      int pc = nn * 16 + fq * 4;
      bf16x4 zz = *(const bf16x4*)(((u16*)(P.ws + OFF_z)) + (size_t)(hrow0 + lrow) * 512 + h * 64 + pc);
      float4 g4 = *(const float4*)(gn + pc);
      float gg[4] = {g4.x, g4.y, g4.z, g4.w};
      float o[4];
#pragma unroll
      for (int j = 0; j < 4; ++j) {
        float y = yacc[m][nn][j] + dsk * bf2f(xT[(pc + j) * LDK + lrow]);
        y *= siluf_(bf2f((u16)zz[j]));
        ss += y * y;
        o[j] = y * gg[j];
      }
      *(bf16x4*)(((u16*)(P.ws + OFF_br1)) + ((size_t)hb * HROWS + hrow0 + lrow) * 512 + h * 64 + pc) = pack4(o[0], o[1], o[2], o[3]);
    }
    ss += __shfl_xor(ss, 16);
    ss += __shfl_xor(ss, 32);
    if (fq == 0) ((float*)(P.ws + OFF_ssq))[((size_t)hb * HROWS + hrow0 + lrow) * 8 + h] = ss;
  }
}

DI float bflo(unsigned p) { return __uint_as_float(p << 16); }
DI float bfhi(unsigned p) { return __uint_as_float(p & 0xffff0000u); }

DI void merge_tile(const Params& P, int l, int mt, int nt, char* smem) {
  const int row0 = mt * 128;
#pragma unroll 1
  for (int kq = 0; kq < 4; ++kq) {
    unsigned gp[4][4][2];
    {
      f32x4 g[4][4];
      zero_acc<4>(g);
      gemm_main<4, true, false, true>(((u16*)(P.ws + OFF_H)), DM, nullptr, row0, ((u16*)(P.ws + OFF_WgT)) + ((size_t)l * 4 + kq) * 1024 * 1024, 1024, nt * 128, 1024, g, (u16*)smem);
#pragma unroll
      for (int m = 0; m < 4; ++m)
#pragma unroll
        for (int n = 0; n < 4; ++n) {
          gp[m][n][0] = pack2(sigmoidf_(g[m][n][0]), sigmoidf_(g[m][n][1]));
          gp[m][n][1] = pack2(sigmoidf_(g[m][n][2]), sigmoidf_(g[m][n][3]));
        }
    }
    f32x4 bb[4][4];
    zero_acc<4>(bb);
    const u16* br = ((u16*)(P.ws + OFF_br0)) + (size_t)kq * (U_ / 2);
    gemm_main<4, true, false, false>(br, 512, nullptr, row0, ((u16*)(P.ws + OFF_WbT)) + ((size_t)l * 4 + kq) * 1024 * 512, 512, nt * 128, 512, bb, (u16*)smem);
    const int tid = TID(), wave = tid >> 6, lane = tid & 63, fr = lane & 15, fq = lane >> 4;
    const int wr = wave >> 1, wc = wave & 1;
#pragma unroll
    for (int m = 0; m < 4; ++m) {
      const int r = row0 + wr * 64 + m * 16 + fr;
      float rs = 1.f;
      if (kq == 1) {
        const float* sq = ((float*)(P.ws + OFF_ssq)) + (size_t)r * 8;
        float4 a = *(const float4*)sq, b = *(const float4*)(sq + 4);
        rs = rsqrtf((a.x + a.y + a.z + a.w + b.x + b.y + b.z + b.w) * (1.f / 512.f) + LN_EPS);
      }
#pragma unroll
      for (int n = 0; n < 4; ++n) {
        u32x2* dst = (u32x2*)(((u16*)(P.ws + OFF_acc)) + (size_t)r * DM + nt * 128 + wc * 64 + n * 16 + fq * 4);
        u32x2 prev = {0u, 0u};
        if (kq > 0) prev = *dst;
        const unsigned g0 = gp[m][n][0], g1 = gp[m][n][1];
        u32x2 o;
        o[0] = pack2(bflo(prev[0]) + bflo(g0) * bb[m][n][0] * rs, bfhi(prev[0]) + bfhi(g0) * bb[m][n][1] * rs);
        o[1] = pack2(bflo(prev[1]) + bflo(g1) * bb[m][n][2] * rs, bfhi(prev[1]) + bfhi(g1) * bb[m][n][3] * rs);
        *dst = o;
      }
    }
  }
}

DI void phase_merge(const Params& P, int l, char* smem, int ph) {
  const bool last = (l == 1);
  for (;;) {
    const int it = wq_next(wq_ctr(P, ph), smem);
    if (it >= 288 * 8) break;
    int mt = it / 8, nt = it % 8;
    if (last && (mt % 18) >= 16) continue;
    merge_tile(P, l, mt, nt, smem);
  }
}

DI void phase_outproj(const Params& P, int l, char* smem, int ph) {
  const bool last = (l == 1);
  const int tid = TID(), wave = tid >> 6, lane = tid & 63, fr = lane & 15, fq = lane >> 4;
  const int wr = wave >> 1, wc = wave & 1;
  for (;;) {
    const int it = wq_next(wq_ctr(P, ph), smem);
    if (it >= 288 * 8) break;
    int mt = it / 8, nt = it % 8;
    if (last && (mt % 18) >= 16) continue;
    f32x4 acc[4][4];
    zero_acc<4>(acc);
    gemm_main<4, true, false>(((u16*)(P.ws + OFF_acc)), DM, nullptr, mt * 128, ((u16*)(P.ws + OFF_WoT)) + (size_t)l * 1024 * 1024, 1024, nt * 128, 1024, acc, (u16*)smem);
#pragma unroll
    for (int m = 0; m < 4; ++m)
#pragma unroll
      for (int n = 0; n < 4; ++n) {
        int r = mt * 128 + wr * 64 + m * 16 + fr, c = nt * 128 + wc * 64 + n * 16 + fq * 4;
        *(bf16x4*)(((u16*)(P.ws + OFF_Y)) + (size_t)r * DM + c) = pack4v(acc[m][n]);
      }
  }
}

DI void phase_ffn1(const Params& P, int l, char* smem, int ph) {
  const bool last = (l == 1);
  const int tid = TID(), wave = tid >> 6, lane = tid & 63, fr = lane & 15, fq = lane >> 4;
  const int wr = wave >> 1, wc = wave & 1;
  const int nmt = last ? 512 : 576;
  for (;;) {
    const int it = wq_next(wq_ctr(P, ph), smem);
    if (it >= nmt * 8) break;
    int mt = it / 8, nt = it % 8;
    int R0 = mt * 128;
    int e = R0 < NFFN_LAT ? (R0 >> 8) & 15 : (R0 - NFFN_LAT) >> 9;
    f32x4 acc[4][4];
    zero_acc<4>(acc);
    gemm_main<4, true, true>(((u16*)(P.ws + OFF_H)), DM, ((int*)(P.ws + OFF_tokidx)), R0, ((u16*)(P.ws + OFF_W13T)) + (size_t)e * 1024 * 1024, 1024, nt * 128, 1024, acc, (u16*)smem);
#pragma unroll
    for (int m = 0; m < 4; ++m)
#pragma unroll
      for (int n2 = 0; n2 < 2; ++n2) {
        int r = R0 + wr * 64 + m * 16 + fr;
        int hc = (nt * 4 + wc * 2 + n2) * 16 + fq * 4;
        f32x4 a = acc[m][2 * n2], b = acc[m][2 * n2 + 1];
        *(bf16x4*)(((u16*)(P.ws + OFF_hid)) + (size_t)r * 512 + hc) = pack4(siluf_(a[0]) * b[0], siluf_(a[1]) * b[1], siluf_(a[2]) * b[2], siluf_(a[3]) * b[3]);
      }
  }
}

DI void phase_ffn2(const Params& P, int l, char* smem, int ph) {
  const bool last = (l == 1);
  const int tid = TID(), wave = tid >> 6, lane = tid & 63, fr = lane & 15, fq = lane >> 4;
  const int wr = wave >> 1, wc = wave & 1;
  const int nmt = last ? 512 : 576;
  for (;;) {
    const int it = wq_next(wq_ctr(P, ph), smem);
    if (it >= nmt * 8) break;
    int mt = it / 8, nt = it % 8;
    int R0 = mt * 128;
    int e = R0 < NFFN_LAT ? (R0 >> 8) & 15 : (R0 - NFFN_LAT) >> 9;
    f32x4 acc[4][4];
    zero_acc<4>(acc);
    gemm_main<4, true, false>(((u16*)(P.ws + OFF_hid)), 512, nullptr, R0, ((u16*)(P.ws + OFF_W2T)) + (size_t)e * 1024 * 512, 512, nt * 128, 512, acc, (u16*)smem);
#pragma unroll
    for (int m = 0; m < 4; ++m) {
      int r = R0 + wr * 64 + m * 16 + fr;
      float gt = ((float*)(P.ws + OFF_gatev))[r];
#pragma unroll
      for (int n = 0; n < 4; ++n) {
        int c = nt * 128 + wc * 64 + n * 16 + fq * 4;
        f32x4 v = acc[m][n];
        *(bf16x4*)(((u16*)(P.ws + OFF_ye)) + (size_t)r * DM + c) = pack4(v[0] * gt, v[1] * gt, v[2] * gt, v[3] * gt);
      }
    }
  }
}

DI void phase_mix2(const Params& P, int l, int hb, char* smem, int ph) {
  const bool last = (l == 1);
  const int nA = 576, nG = 144, nS = 2304, nP = 576;
  for (;;) {
    const int it = wq_next(wq_ctr(P, ph), smem);
    if (it >= nA + nG + nS + nP) break;
    if (it < nA) {
      if (last && (it % 18) >= 16) continue;
      attn_item(P, l, hb, it, smem);
    } else if (it < nA + nG) {
      const int mt = it - nA;
      if (last && (mt % 18) >= 16) continue;
      sgu_item(P, l, hb, mt, smem);
    } else if (it < nA + nG + nS) {
      ssd_state_item(P, l, hb, it - nA - nG, smem);
    } else {
      const int t = it - nA - nG - nS;
      const int mt = t >> 2, g = t & 3;
      if (last && (mt % 18) >= 16) continue;
      pool_item(P, l, hb, mt, g, smem);
    }
  }
}

DI void phase_ssd_out(const Params& P, int l, int hb, char* smem, int ph) {
  const bool last = (l == 1);
  for (;;) {
    const int it = wq_next(wq_ctr(P, ph), smem);
    if (it >= 8 * 18 * 8) break;
    int jp = (it >> 3) % 18;
    if (last && jp >= 16) continue;
    ssd_out_item(P, l, hb, it, smem);
  }
}

#define XB_TMO      128
#define XB_XCNT(j)  (256  + 64 * (j))
#define XB_XSUB(j)  (1280 + 64 * (j))
#define XB_XGEN(j)  (2304 + 64 * (j))
#define XB_TOP      3328
#define XB_TOPGEN   3392
#define XCD_BAR_WORDS 3456
#define XB_SPIN_CAP (1u << 18)
#define LAS __attribute__((address_space(3)))

__device__ __forceinline__ unsigned xb_ld(unsigned* p)              { return __hip_atomic_load(p, __ATOMIC_RELAXED, __HIP_MEMORY_SCOPE_AGENT); }
__device__ __forceinline__ unsigned xb_add(unsigned* p, unsigned v) { return __hip_atomic_fetch_add(p, v, __ATOMIC_RELAXED, __HIP_MEMORY_SCOPE_AGENT); }
__device__ __forceinline__ unsigned xb_xcc_id() { return (unsigned)__builtin_amdgcn_s_getreg((3 << 11) | 20) & 0xFu; }
#define XB_SPIN(cond, bar) do { unsigned _sp = 0; while (cond) { __builtin_amdgcn_s_sleep(1); \
    if ((++_sp & 255u) == 0u) { if (xb_ld(&(bar)[XB_TMO])) break; if (_sp > XB_SPIN_CAP) { atomicAdd(&(bar)[XB_TMO], 1u); break; } } } } while (0)

struct XcdBarrier {
    unsigned* bar; unsigned x;
    volatile LAS unsigned* st;
};

__device__ __forceinline__ XcdBarrier xcd_barrier_post(unsigned* bar, volatile LAS unsigned* st) {
    XcdBarrier b; b.bar = bar; b.x = xb_xcc_id(); b.st = st;
    if (threadIdx.x == 0) (void)xb_add(&bar[XB_XCNT(b.x)], 1u);
    return b;
}
__device__ __forceinline__ void xcd_barrier_complete(unsigned* bar, unsigned x, unsigned& nloc, unsigned& nx) {
    const unsigned G = gridDim.x * gridDim.y * gridDim.z;
    unsigned sum, cnt, mine, sp = 0u;
    for (;;) {
        sum = 0u; cnt = 0u; mine = 0u;
#pragma unroll
        for (unsigned j = 0; j < 16; ++j) { const unsigned c = xb_ld(&bar[XB_XCNT(j)]); sum += c; cnt += (c > 0u) ? 1u : 0u; mine = (j == x) ? c : mine; }
        if (sum == G) break;
        __builtin_amdgcn_s_sleep(1);
        if ((++sp & 255u) == 0u) { if (xb_ld(&bar[XB_TMO])) break; if (sp > XB_SPIN_CAP) { atomicAdd(&bar[XB_TMO], 1u); break; } }
    }
    nloc = mine > 0u ? mine : 1u; nx = cnt > 0u ? cnt : 1u;
}

__device__ __forceinline__ void xcd_barrier(const XcdBarrier& b) {
    asm volatile("s_waitcnt vmcnt(0)" ::: "memory");
    __syncthreads();
    if (threadIdx.x == 0) {
        unsigned* bar = b.bar;
        __builtin_amdgcn_s_waitcnt(0);
        unsigned nloc = b.st[0], nx = b.st[1];
        if (nloc == 0u) { xcd_barrier_complete(bar, b.x, nloc, nx); b.st[0] = nloc; b.st[1] = nx; }
        const unsigned old = xb_add(&bar[XB_XSUB(b.x)], 1u);
        const unsigned gen = old / nloc;
        if (old + 1u == (gen + 1u) * nloc) {
            __builtin_amdgcn_fence(__ATOMIC_RELEASE, "agent");
            asm volatile("s_waitcnt vmcnt(0)" ::: "memory");
            const unsigned og = xb_add(&bar[XB_TOP], 1u);
            const unsigned tg = og / nx;
            if (og + 1u == (tg + 1u) * nx) xb_add(&bar[XB_TOPGEN], 1u);
            else XB_SPIN(xb_ld(&bar[XB_TOPGEN]) == tg, bar);
            __builtin_amdgcn_fence(__ATOMIC_ACQUIRE, "agent");
            xb_add(&bar[XB_XGEN(b.x)], 1u);
            asm volatile("s_waitcnt vmcnt(0)" ::: "memory");
        } else {
            XB_SPIN(xb_ld(&bar[XB_XGEN(b.x)]) == gen, bar);
            __builtin_amdgcn_fence(__ATOMIC_ACQUIRE, "agent");
            asm volatile("s_waitcnt vmcnt(0)" ::: "memory");
        }
    }
    __syncthreads();
}


template <bool COOP>
__global__ void __launch_bounds__(256, 2) mk_forward(Params P, int ph_begin, int ph_end) {
  __shared__ __attribute__((aligned(16))) char smem[SMEM_BYTES];
  int ph = 0;
  volatile LAS unsigned* xbst = (volatile LAS unsigned*)(smem + SMEM_BYTES - 16);
  XcdBarrier xb;
  if (COOP) {
    if (__builtin_amdgcn_workitem_id_x() == 0) { xbst[0] = 0u; xbst[1] = 0u; xbst[2] = 0u; xbst[3] = 0u; }
    __syncthreads();
    xb = xcd_barrier_post((unsigned*)(P.ws + OFF_bar), xbst);
  }
#define PHASE(code)                                         \
  {                                                         \
    if (ph >= ph_begin && ph < ph_end) { code; }            \
    ++ph;                                                   \
    if (COOP && ph > ph_begin && ph < ph_end) {             \
      if (ph == 1) cg::this_grid().sync();                  \
      else xcd_barrier(xb);                                 \
    }                                                       \
  }
  PHASE(phase_prologue(P, smem));
  PHASE(phase_h0(P));
#pragma unroll 1
  for (int l = 0; l < 2; ++l) {
#pragma unroll 1
    for (int hb = 0; hb < 2; ++hb) {
      PHASE(phase_proj(P, l, hb, smem, ph));
      PHASE(phase_mix2(P, l, hb, smem, ph));
      PHASE(phase_carry(P));
      PHASE(phase_ssd_out(P, l, hb, smem, ph));
    }
    PHASE(phase_merge(P, l, smem, ph));
    PHASE(phase_outproj(P, l, smem, ph));
    PHASE(phase_ln1(P, l, smem));
    PHASE(phase_topk(P, l, smem));
    PHASE(phase_ffn1(P, l, smem, ph));
    PHASE(phase_ffn2(P, l, smem, ph));
    PHASE(phase_ln2(P, l));
  }
#undef PHASE
}

#ifndef MK_COOP
#define MK_COOP 1
#endif

extern "C" void kernel_launch(void* const* d_in, const int* in_sizes, int n_in, void* d_out, int out_size, void* d_ws, size_t ws_size,
                              hipStream_t stream) {
  Params p{};
  const float* const* in = (const float* const*)d_in;
  p.x = in[0]; p.c = in[1]; p.ctx = in[2]; p.c_ctx = in[3]; p.w_mod = in[4]; p.b_mod = in[5]; p.w_in = in[6]; p.conv_w = in[7];
  p.conv_b = in[8]; p.a_log = in[9]; p.dt_bias = in[10]; p.ssd_d = in[11]; p.ssd_norm_g = in[12]; p.diff_lambda = in[13];
  p.diff_norm_g = in[14]; p.pool_w = in[15]; p.pool_scale = in[16]; p.sgu_ln_g = in[17]; p.sgu_ln_b = in[18]; p.sgu_w = in[19];
  p.sgu_b = in[20]; p.w_gate = in[21]; p.w_branch = in[22]; p.w_out = in[23]; p.ln1_g = in[24]; p.ln1_b = in[25]; p.w_router = in[26];
  p.w1 = in[27]; p.w3 = in[28]; p.w2 = in[29]; p.ln2_g = in[30]; p.ln2_b = in[31];
  p.out = (float*)d_out;
  p.ws = (char*)d_ws;
  if (WS_NEED > ws_size) { fprintf(stderr, "workspace too small: need %zu have %zu\n", (size_t)WS_NEED, ws_size); return; }

  static int grid_blocks = 0;
  if (!grid_blocks) {
    int dev = 0, cus = 0, per_cu = 0;
    hipGetDevice(&dev);
    hipDeviceGetAttribute(&cus, hipDeviceAttributeMultiprocessorCount, dev);
    if (MK_COOP) hipOccupancyMaxActiveBlocksPerMultiprocessor(&per_cu, mk_forward<true>, 256, 0);
    else hipOccupancyMaxActiveBlocksPerMultiprocessor(&per_cu, mk_forward<false>, 256, 0);
    if (per_cu < 1) per_cu = 1;
    if (per_cu > 2) per_cu = 2;
    grid_blocks = cus * per_cu;
  }
#if MK_COOP
  hipMemsetAsync((char*)d_ws + OFF_bar, 0, 32768, stream);
  int b = 0, e = NPHASE;
  void* args[] = {&p, &b, &e};
  hipError_t err = hipLaunchCooperativeKernel((void*)mk_forward<true>, dim3(grid_blocks), dim3(256), args, 0, stream);
  if (err != hipSuccess) fprintf(stderr, "cooperative launch failed: %s (grid %d)\n", hipGetErrorString(err), grid_blocks);
#else
  for (int ph = 0; ph < NPHASE; ++ph) hipLaunchKernelGGL(mk_forward<false>, dim3(grid_blocks), dim3(256), 0, stream, p, ph, ph + 1);
#endif
}
```

```cpp
#include <hip/hip_runtime.h>
#include <hip/hip_cooperative_groups.h>
#include <cstdio>
#include <cstdint>
namespace cg = cooperative_groups;

typedef unsigned short u16;
using bf16x8 = __attribute__((ext_vector_type(8))) short;
using bf16x4 = __attribute__((ext_vector_type(4))) short;
using f32x4 = __attribute__((ext_vector_type(4))) float;
using u32x4 = __attribute__((ext_vector_type(4))) unsigned;

#define DI __device__ __forceinline__
#define MFMA16(a, b, c) __builtin_amdgcn_mfma_f32_16x16x32_bf16((a), (b), (c), 0, 0, 0)

constexpr int NB = 16, SEQ = 2048, CTXL = 256, SP = 2304, NTOK = NB * SP, DM = 1024;
constexpr int HROWS = 8 * SP;
constexpr int INC = 4368, INP = 4480;
constexpr int NFFN_LAT = 65536, NFFN_ALL = 73728;
constexpr float LN_EPS = 1e-5f;
constexpr float ALPHA = 1.41421356237309515f;
constexpr int SMEM_BYTES = 81920;
constexpr int NPHASE = 2 + 2 * (2 * 5 + 7);


constexpr size_t al256(size_t x) { return (x + 255) & ~(size_t)255; }
constexpr size_t U_ = (size_t)NTOK * 512 * 2;
constexpr size_t OFF_WinT = 0;
constexpr size_t OFF_WgT = OFF_WinT + al256((size_t)2 * INP * 1024 * 2);
constexpr size_t OFF_WbT = OFF_WgT + al256((size_t)2 * 4 * 1024 * 1024 * 2);
constexpr size_t OFF_WoT = OFF_WbT + al256((size_t)2 * 4 * 1024 * 512 * 2);
constexpr size_t OFF_poolT = OFF_WoT + al256((size_t)2 * 1024 * 1024 * 2);
constexpr size_t OFF_sguW = OFF_poolT + al256((size_t)2 * 4 * 128 * 128 * 2);
constexpr size_t OFF_mod = OFF_sguW + al256((size_t)2 * 4 * 128 * 128 * 2);
constexpr size_t OFF_rope = OFF_mod + al256((size_t)2 * 17 * 6144 * 4);
constexpr size_t OFF_lamv = OFF_rope + al256(64 * 16 * 2 * 4);
constexpr size_t OFF_bar = OFF_lamv + 256;
constexpr size_t OFF_aff = OFF_bar + 32768;
constexpr size_t OFF_rank = OFF_aff + al256((size_t)NTOK * 16 * 4);
constexpr size_t OFF_ssq = OFF_rank + al256((size_t)NTOK * 16 * 4);
constexpr size_t OFF_tokidx = OFF_ssq + al256((size_t)NTOK * 8 * 4);
constexpr size_t OFF_gatev = OFF_tokidx + al256((size_t)NFFN_ALL * 4);
constexpr size_t OFF_dtbuf = OFF_gatev + al256((size_t)NFFN_ALL * 4);
constexpr size_t OFF_decay = OFF_dtbuf + al256((size_t)HROWS * 16 * 4);
constexpr size_t OFF_H = OFF_decay + al256((size_t)8 * 2 * 8 * 18 * 4);
constexpr size_t OFF_Y = OFF_H + 2 * U_;
constexpr size_t OFF_xsT = OFF_Y;
constexpr size_t OFF_cstate = OFF_Y + U_ / 2;
constexpr size_t OFF_enter = OFF_Y + U_;
constexpr size_t OFF_bm = OFF_Y + U_ + U_ / 2;
constexpr size_t OFF_cm = OFF_bm + U_ / 8;
constexpr size_t OFF_bmT = OFF_cm + U_ / 8;
constexpr size_t OFF_RM = OFF_Y + 2 * U_;
constexpr size_t OFF_xp = OFF_RM;
constexpr size_t OFF_z = OFF_xp + U_ / 2;
constexpr size_t OFF_xbc = OFF_z + U_ / 2;
constexpr size_t OFF_o1 = OFF_xbc;
constexpr size_t OFF_q = OFF_xbc + (U_ / 4) * 3;
constexpr size_t OFF_k = OFF_q + U_ / 2;
constexpr size_t OFF_vT = OFF_k + U_ / 2;
constexpr size_t OFF_gvT = OFF_vT + U_ / 2;
constexpr size_t OFF_br0 = OFF_gvT + U_ / 2;
constexpr size_t OFF_br1 = OFF_br0 + U_;
constexpr size_t OFF_br2 = OFF_br1 + U_;
constexpr size_t OFF_br3 = OFF_br2 + U_;
constexpr size_t OFF_acc = OFF_RM;
constexpr size_t OFF_W13T = OFF_RM;
constexpr size_t OFF_W2T = OFF_W13T + (size_t)16 * 1024 * 1024 * 2;
constexpr size_t OFF_hid = OFF_W2T + (size_t)16 * 1024 * 512 * 2;
constexpr size_t OFF_ye = OFF_hid + (size_t)NFFN_ALL * 512 * 2;
constexpr size_t WS_MIX_END = OFF_br3 + U_;
constexpr size_t WS_FFN_END = OFF_ye + (size_t)NFFN_ALL * 1024 * 2;
constexpr size_t WS_NEED = WS_MIX_END > WS_FFN_END ? WS_MIX_END : WS_FFN_END;

struct Params {
  const float *x, *c, *ctx, *c_ctx, *w_mod, *b_mod, *w_in, *conv_w, *conv_b, *a_log, *dt_bias, *ssd_d, *ssd_norm_g,
      *diff_lambda, *diff_norm_g, *pool_w, *pool_scale, *sgu_ln_g, *sgu_ln_b, *sgu_w, *sgu_b, *w_gate, *w_branch, *w_out,
      *ln1_g, *ln1_b, *w_router, *w1, *w3, *w2, *ln2_g, *ln2_b;
  float* out;
  char* ws;
};

DI int TID() { int t = (int)__builtin_amdgcn_workitem_id_x(); asm volatile("" : "+v"(t)); return t; }
typedef __bf16 bf2_t __attribute__((ext_vector_type(2)));
typedef float f2_t __attribute__((ext_vector_type(2)));
typedef unsigned u32x2 __attribute__((ext_vector_type(2)));
DI unsigned pack2(float a, float b) { f2_t v = {a, b}; return __builtin_bit_cast(unsigned, __builtin_convertvector(v, bf2_t)); }
DI u16 f2bf(float x) { return (u16)(pack2(x, 0.f) & 0xffffu); }
DI float bf2f(u16 v) { return __uint_as_float(((unsigned)v) << 16); }
DI float bflo(unsigned p) { return __uint_as_float(p << 16); }
DI float bfhi(unsigned p) { return __uint_as_float(p & 0xffff0000u); }
DI float sigmoidf_(float x) { return __builtin_amdgcn_rcpf(1.f + __expf(-x)); }
DI float siluf_(float x) { return x * __builtin_amdgcn_rcpf(1.f + __expf(-x)); }
DI float geluf_(float x) { float y = 0.7978845608028654f * (x + 0.044715f * x * x * x); float t = 1.f - 2.f * __builtin_amdgcn_rcpf(__expf(2.f * y) + 1.f); return 0.5f * x * (1.f + t); }
DI float softplusf_(float x) { return x > 20.f ? x : log1pf(__expf(x)); }
DI bf16x4 pack4(float a, float b, float c, float d) { u32x2 r = {pack2(a, b), pack2(c, d)}; return __builtin_bit_cast(bf16x4, r); }
DI bf16x4 pack4v(f32x4 v) { return pack4(v[0], v[1], v[2], v[3]); }
DI float wave_sum(float v) { for (int o = 32; o > 0; o >>= 1) v += __shfl_xor(v, o); return v; }

template <int MI, int NI, bool SWAP, bool LOWREG = false>
DI void mma_lds(const u16* As, int lda, const u16* Bs, int ldb, int ksteps, f32x4 (&acc)[MI][NI], int fr, int fq) {
  for (int ks = 0; ks < ksteps; ++ks) {
    if (LOWREG) __builtin_amdgcn_sched_barrier(0);
    bf16x8 a[MI], b[NI];
#pragma unroll
    for (int m = 0; m < MI; ++m) a[m] = *(const bf16x8*)(As + (m * 16 + fr) * lda + ks * 32 + fq * 8);
#pragma unroll
    for (int n = 0; n < NI; ++n) b[n] = *(const bf16x8*)(Bs + (n * 16 + fr) * ldb + ks * 32 + fq * 8);
#pragma unroll
    for (int m = 0; m < MI; ++m)
#pragma unroll
      for (int n = 0; n < NI; ++n) acc[m][n] = SWAP ? MFMA16(b[n], a[m], acc[m][n]) : MFMA16(a[m], b[n], acc[m][n]);
  }
}

constexpr int LDT = 72;
template <int NI, bool SWAP, bool GATHER, bool PF2 = true>
DI void gemm_main(const u16* __restrict__ A, int lda, const int* __restrict__ aidx, int arow0, const u16* __restrict__ Bt, int ldb, int brow0,
                  int K, f32x4 (&acc)[4][NI], u16* smem) {
  constexpr int BN = NI * 32;
  constexpr int NBL = BN / 32;
  const int tid = TID(), wave = tid >> 6, lane = tid & 63, fr = lane & 15, fq = lane >> 4;
  const int wr = wave >> 1, wc = wave & 1;
  u16* As = smem;
  u16* Bs = smem + 2 * 128 * LDT;
  const int lr = tid >> 3, lc = (tid & 7) * 8;
  const u16* ap[4];
#pragma unroll
  for (int i = 0; i < 4; ++i) {
    int r = arow0 + lr + 32 * i;
    size_t rr = GATHER ? (size_t)aidx[r] : (size_t)r;
    ap[i] = A + rr * lda + lc;
  }
  const u16* bp = Bt + (size_t)(brow0 + lr) * ldb + lc;
  u32x4 ra0[4], rb0[NBL], ra1[4], rb1[NBL];
  const int nk = K / 64;
#define GLOAD(RA, RB, KO)                                                                   \
  {                                                                                         \
    _Pragma("unroll") for (int i = 0; i < 4; ++i) RA[i] = *(const u32x4*)(ap[i] + (KO));    \
    _Pragma("unroll") for (int i = 0; i < NBL; ++i) RB[i] = *(const u32x4*)(bp + (size_t)(32 * i) * ldb + (KO)); \
  }
#define SSTORE(RA, RB, BUF)                                                                 \
  {                                                                                         \
    _Pragma("unroll") for (int i = 0; i < 4; ++i) *(u32x4*)(As + (BUF) * 128 * LDT + (lr + 32 * i) * LDT + lc) = RA[i];  \
    _Pragma("unroll") for (int i = 0; i < NBL; ++i) *(u32x4*)(Bs + (BUF) * BN * LDT + (lr + 32 * i) * LDT + lc) = RB[i]; \
  }
#define COMPUTE(BUF) mma_lds<4, NI, SWAP, !PF2>(As + (BUF) * 128 * LDT + wr * 64 * LDT, LDT, Bs + (BUF) * BN * LDT + wc * (NI * 16) * LDT, LDT, 2, acc, fr, fq)
  if (PF2) {
    GLOAD(ra0, rb0, 0);
    GLOAD(ra1, rb1, 64);
    __syncthreads();
    SSTORE(ra0, rb0, 0);
    __syncthreads();
    for (int kt = 0; kt < nk; kt += 2) {
      if (kt + 2 < nk) GLOAD(ra0, rb0, (kt + 2) * 64);
      COMPUTE(0);
      SSTORE(ra1, rb1, 1);
      __syncthreads();
      if (kt + 3 < nk) GLOAD(ra1, rb1, (kt + 3) * 64);
      COMPUTE(1);
      if (kt + 2 < nk) SSTORE(ra0, rb0, 0);
      __syncthreads();
    }
  } else {
    GLOAD(ra0, rb0, 0);
    __syncthreads();
    SSTORE(ra0, rb0, 0);
    __syncthreads();
    for (int kt = 0; kt < nk; kt += 2) {
      GLOAD(ra0, rb0, (kt + 1) * 64);
      COMPUTE(0);
      SSTORE(ra0, rb0, 1);
      __syncthreads();
      if (kt + 2 < nk) GLOAD(ra0, rb0, (kt + 2) * 64);
      COMPUTE(1);
      if (kt + 2 < nk) SSTORE(ra0, rb0, 0);
      __syncthreads();
    }
  }
#undef GLOAD
#undef SSTORE
#undef COMPUTE
}

template <int NI> DI void zero_acc(f32x4 (&a)[4][NI]) {
#pragma unroll
  for (int m = 0; m < 4; ++m)
#pragma unroll
    for (int n = 0; n < NI; ++n) a[m][n] = f32x4{0.f, 0.f, 0.f, 0.f};
}

DI void cvt_tile(const float* __restrict__ src0, const float* __restrict__ src1, int ld, u16* __restrict__ dst, int K, int n0, int k0, int mode, u16* lds) {
  const int tid = TID();
  constexpr int LC = 66;
  __syncthreads();
  if (mode == 3) {
    for (int idx = tid; idx < 4096; idx += 256) {
      int n = idx >> 6, kk = idx & 63;
      lds[kk * LC + n] = f2bf(src0[(size_t)(n0 + n) * ld + k0 + kk]);
    }
  } else {
    for (int idx = tid; idx < 4096; idx += 256) {
      int kk = idx >> 6, n = idx & 63;
      int nn = n0 + n;
      float v = 0.f;
      if (mode == 0) v = src0[(size_t)(k0 + kk) * ld + nn];
      else if (mode == 1) {
        int col = nn < 1792 ? nn : (nn < 4352 ? nn + 16 : (nn < 4368 ? nn - 4352 + 1792 : -1));
        if (col >= 0) v = src0[(size_t)(k0 + kk) * ld + col];
        if (nn >= 1792 && nn < 2304) v *= 0.125f;
      } else {
        int g = nn >> 5, r = nn & 31;
        v = (r < 16) ? src0[(size_t)(k0 + kk) * ld + g * 16 + r] : src1[(size_t)(k0 + kk) * ld + g * 16 + r - 16];
      }
      lds[kk * LC + n] = f2bf(v);
    }
  }
  __syncthreads();
  for (int c = tid; c < 512; c += 256) {
    int n = c & 63, kc = (c >> 6) * 8;
    bf16x8 o;
#pragma unroll
    for (int j = 0; j < 8; ++j) o[j] = (short)lds[(kc + j) * LC + n];
    *(bf16x8*)(dst + (size_t)(n0 + n) * K + k0 + kc) = o;
  }
}

DI void mod_item(const Params& P, int item, char* smem) {
  const int l = item / 96, n0 = (item % 96) * 64;
  float* sc = (float*)smem;
  const int tid = TID();
  __syncthreads();
  for (int i = tid; i < 17 * 1024; i += 256) {
    int s = i >> 10, kk = i & 1023;
    float v = s < 16 ? P.c[s * 1024 + kk] : P.c_ctx[kk];
    sc[i] = siluf_(v);
  }
  __syncthreads();
  const int col = tid & 63, kp = tid >> 6;
  float a[17];
#pragma unroll
  for (int s = 0; s < 17; ++s) a[s] = 0.f;
  const float* w = P.w_mod + (size_t)l * 1024 * 6144 + n0 + col;
  for (int kk = kp * 256; kk < kp * 256 + 256; ++kk) {
    float wv = w[(size_t)kk * 6144];
#pragma unroll
    for (int s = 0; s < 17; ++s) a[s] += sc[s * 1024 + kk] * wv;
  }
  __syncthreads();
  float* red = (float*)smem;
#pragma unroll
  for (int s = 0; s < 17; ++s) red[(kp * 17 + s) * 64 + col] = a[s];
  __syncthreads();
  for (int i = tid; i < 17 * 64; i += 256) {
    int s = i >> 6, cc = i & 63;
    float v = red[(0 * 17 + s) * 64 + cc] + red[(1 * 17 + s) * 64 + cc] + red[(2 * 17 + s) * 64 + cc] + red[(3 * 17 + s) * 64 + cc];
    ((float*)(P.ws + OFF_mod))[((size_t)l * 17 + s) * 6144 + n0 + cc] = v + P.b_mod[l * 6144 + n0 + cc];
  }
}

DI void misc_item(const Params& P) {
  const int tid = TID();
  for (int i = tid; i < 1024; i += 256) {
    int pos = i >> 4, f = i & 15;
    float inv = powf(10000.f, -(float)f / 16.f);
    float ang = (float)pos * inv;
    ((float*)(P.ws + OFF_rope))[i * 2] = cosf(ang);
    ((float*)(P.ws + OFF_rope))[i * 2 + 1] = sinf(ang);
  }
  if (tid < 2) {
    const float* dl = P.diff_lambda + tid * 256;
    float s1 = 0.f, s2 = 0.f;
    for (int i = 0; i < 64; ++i) { s1 += dl[i] * dl[64 + i]; s2 += dl[128 + i] * dl[192 + i]; }
    float lam_init = 0.8f - 0.6f * expf(-0.3f * (float)tid);
    ((float*)(P.ws + OFF_lamv))[tid * 2] = expf(s1) - expf(s2) + lam_init;
    ((float*)(P.ws + OFF_lamv))[tid * 2 + 1] = lam_init;
  }
}

DI void phase_prologue(const Params& P, char* smem) {
  const int per_layer = 1120 + 4 * 256 + 4 * 128 + 256 + 16 + 16;
  const int ncvt = 2 * per_layer;
  const int total = ncvt + 192 + 1;
  for (int it = blockIdx.x; it < total; it += gridDim.x) {
    if (it < ncvt) {
      const int l = it / per_layer;
      int t = it % per_layer;
      const float* s0; u16* dst; int ld, K, ntk, mode;
      if (t < 1120) { s0 = P.w_in + (size_t)l * 1024 * INC; ld = INC; dst = ((u16*)(P.ws + OFF_WinT)) + (size_t)l * INP * 1024; K = 1024; ntk = 16; mode = 1; }
      else if (t < 2144) { t -= 1120; int kq = t >> 8; t &= 255; s0 = P.w_gate + ((size_t)l * 4 + kq) * 1024 * 1024; ld = 1024; dst = ((u16*)(P.ws + OFF_WgT)) + ((size_t)l * 4 + kq) * 1024 * 1024; K = 1024; ntk = 16; mode = 0; }
      else if (t < 2656) { t -= 2144; int kq = t >> 7; t &= 127; s0 = P.w_branch + ((size_t)l * 4 + kq) * 512 * 1024; ld = 1024; dst = ((u16*)(P.ws + OFF_WbT)) + ((size_t)l * 4 + kq) * 1024 * 512; K = 512; ntk = 8; mode = 0; }
      else if (t < 2912) { t -= 2656; s0 = P.w_out + (size_t)l * 1024 * 1024; ld = 1024; dst = ((u16*)(P.ws + OFF_WoT)) + (size_t)l * 1024 * 1024; K = 1024; ntk = 16; mode = 0; }
      else if (t < 2928) { t -= 2912; int g = t >> 2; t &= 3; s0 = P.pool_w + ((size_t)l * 4 + g) * 128 * 128; ld = 128; dst = ((u16*)(P.ws + OFF_poolT)) + ((size_t)l * 4 + g) * 128 * 128; K = 128; ntk = 2; mode = 0; }
      else { t -= 2928; int g = t >> 2; t &= 3; s0 = P.sgu_w + ((size_t)l * 4 + g) * 128 * 128; ld = 128; dst = ((u16*)(P.ws + OFF_sguW)) + ((size_t)l * 4 + g) * 128 * 128; K = 128; ntk = 2; mode = 3; }
      const int tn = t / ntk, tk = t % ntk;
      cvt_tile(s0, s0, ld, dst, K, tn * 64, tk * 64, mode, (u16*)smem);
    } else if (it < ncvt + 192) {
      mod_item(P, it - ncvt, smem);
    } else {
      misc_item(P);
    }
  }
}

DI void ffn_cvt_item(const Params& P, int l, int it, char* smem) {
  const int e = it / 384;
  int t = it % 384;
  if (t < 256) {
    cvt_tile(P.w1 + ((size_t)l * 16 + e) * 1024 * 512, P.w3 + ((size_t)l * 16 + e) * 1024 * 512, 512, ((u16*)(P.ws + OFF_W13T)) + (size_t)e * 1024 * 1024, 1024, (t >> 4) * 64, (t & 15) * 64, 2, (u16*)smem);
  } else {
    t -= 256;
    const float* s = P.w2 + ((size_t)l * 16 + e) * 512 * 1024;
    cvt_tile(s, s, 1024, ((u16*)(P.ws + OFF_W2T)) + (size_t)e * 1024 * 512, 512, (t >> 3) * 64, (t & 7) * 64, 0, (u16*)smem);
  }
}

DI void load_row_f32(const float* p, int lane, float (&v)[16]) {
#pragma unroll
  for (int k = 0; k < 4; ++k) { float4 t = *(const float4*)(p + lane * 4 + 256 * k); v[4 * k] = t.x; v[4 * k + 1] = t.y; v[4 * k + 2] = t.z; v[4 * k + 3] = t.w; }
}
DI void load_row_bf16(const u16* p, int lane, float (&v)[16]) {
#pragma unroll
  for (int k = 0; k < 4; ++k) { bf16x4 t = *(const bf16x4*)(p + lane * 4 + 256 * k); for (int i = 0; i < 4; ++i) v[4 * k + i] = bf2f((u16)t[i]); }
}
DI void store_row_f32(float* p, int lane, const float (&v)[16]) {
#pragma unroll
  for (int k = 0; k < 4; ++k) *(float4*)(p + lane * 4 + 256 * k) = make_float4(v[4 * k], v[4 * k + 1], v[4 * k + 2], v[4 * k + 3]);
}
DI void store_row_bf16(u16* p, int lane, const float (&v)[16]) {
#pragma unroll
  for (int k = 0; k < 4; ++k) *(bf16x4*)(p + lane * 4 + 256 * k) = pack4(v[4 * k], v[4 * k + 1], v[4 * k + 2], v[4 * k + 3]);
}
DI void ln_row(float (&v)[16], const float* g, const float* b, int lane) {
  float s = 0.f;
#pragma unroll
  for (int i = 0; i < 16; ++i) s += v[i];
  float mu = wave_sum(s) * (1.f / 1024.f);
  float q = 0.f;
#pragma unroll
  for (int i = 0; i < 16; ++i) { float d = v[i] - mu; q += d * d; }
  float rstd = rsqrtf(wave_sum(q) * (1.f / 1024.f) + LN_EPS);
  float gg[16], bb[16];
  load_row_f32(g, lane, gg); load_row_f32(b, lane, bb);
#pragma unroll
  for (int i = 0; i < 16; ++i) v[i] = (v[i] - mu) * rstd * gg[i] + bb[i];
}

DI void phase_h0(const Params& P) {
  const int lane = TID() & 63;
  const int gw = blockIdx.x * 4 + (TID() >> 6), nw = gridDim.x * 4;
  for (int row = gw; row < NTOK; row += nw) {
    int s = row / SP, p = row % SP;
    bool lat = p < SEQ;
    const float* xs = lat ? P.x + ((size_t)s * SEQ + p) * DM : P.ctx + ((size_t)s * CTXL + (p - SEQ)) * DM;
    const float* md = ((float*)(P.ws + OFF_mod)) + (size_t)(lat ? s : 16) * 6144;
    float v[16], sh[16], scl[16];
    load_row_f32(xs, lane, v); load_row_f32(md, lane, sh); load_row_f32(md + 1024, lane, scl);
#pragma unroll
    for (int i = 0; i < 16; ++i) v[i] = v[i] * (1.f + scl[i]) + sh[i];
    store_row_bf16(((u16*)(P.ws + OFF_H)) + (size_t)row * DM, lane, v);
  }
}

DI void compute_x1(const Params& P, int l, int row, int lane, float (&v)[16]) {
  int s = row / SP, p = row % SP;
  bool lat = p < SEQ;
  const float* xs;
  if (l == 0) xs = lat ? P.x + ((size_t)s * SEQ + p) * DM : P.ctx + ((size_t)s * CTXL + (p - SEQ)) * DM;
  else xs = P.out + ((size_t)s * SEQ + p) * DM;
  const float* md = ((float*)(P.ws + OFF_mod)) + ((size_t)l * 17 + (lat ? s : 16)) * 6144;
  float y[16], m2[16];
  load_row_f32(xs, lane, v); load_row_bf16(((u16*)(P.ws + OFF_Y)) + (size_t)row * DM, lane, y); load_row_f32(md + 2 * 1024, lane, m2);
#pragma unroll
  for (int i = 0; i < 16; ++i) v[i] = ALPHA * v[i] + m2[i] * y[i];
  ln_row(v, P.ln1_g + l * 1024, P.ln1_b + l * 1024, lane);
}

DI void phase_ln1(const Params& P, int l, char* smem) {
  const bool last = (l == 1);
  const int tid = TID();
  const int lane = tid & 63;
  const int gw = blockIdx.x * 4 + (tid >> 6), nw = gridDim.x * 4;
  float* wT = (float*)smem;
  __syncthreads();
  {
    const float* wr = P.w_router + (size_t)l * 1024 * 16;
    for (int i = tid; i < 4096; i += 256) {
      int c = i >> 2, e4 = (i & 3) * 4;
      float4 w = *(const float4*)(wr + (size_t)c * 16 + e4);
      wT[(e4 + 0) * 1024 + c] = w.x; wT[(e4 + 1) * 1024 + c] = w.y; wT[(e4 + 2) * 1024 + c] = w.z; wT[(e4 + 3) * 1024 + c] = w.w;
    }
  }
  __syncthreads();
  for (int row = gw; row < NTOK; row += nw) {
    int s = row / SP, p = row % SP;
    bool lat = p < SEQ;
    if (last && !lat) continue;
    float v[16];
    compute_x1(P, l, row, lane, v);
    const float* md = ((float*)(P.ws + OFF_mod)) + ((size_t)l * 17 + (lat ? s : 16)) * 6144;
    float m3[16], m4[16];
    load_row_f32(md + 3 * 1024, lane, m3); load_row_f32(md + 4 * 1024, lane, m4);
#pragma unroll
    for (int i = 0; i < 16; ++i) v[i] = v[i] * (1.f + m4[i]) + m3[i];
    store_row_bf16(((u16*)(P.ws + OFF_H)) + (size_t)row * DM, lane, v);
    float lg[16];
#pragma unroll
    for (int e = 0; e < 16; ++e) {
      float a = 0.f;
#pragma unroll
      for (int k = 0; k < 4; ++k) {
        float4 w = *(const float4*)(wT + e * 1024 + lane * 4 + 256 * k);
        a += v[4 * k] * w.x + v[4 * k + 1] * w.y + v[4 * k + 2] * w.z + v[4 * k + 3] * w.w;
      }
      lg[e] = a;
    }
#pragma unroll
    for (int e = 0; e < 16; ++e) lg[e] = wave_sum(lg[e]);
    float mx = lg[0];
#pragma unroll
    for (int e = 1; e < 16; ++e) mx = fmaxf(mx, lg[e]);
    float sum = 0.f;
#pragma unroll
    for (int e = 0; e < 16; ++e) { lg[e] = expf(lg[e] - mx); sum += lg[e]; }
    float inv = 1.f / sum;
    if (lane < 16) {
      float mine = 0.f;
#pragma unroll
      for (int e = 0; e < 16; ++e) if (lane == e) mine = lg[e];
      ((float*)(P.ws + OFF_aff))[(size_t)row * 16 + lane] = mine * inv;
    }
  }
}

DI int block_excl_scan(int v, int* red, int tid, int& total) {
  const int lane = tid & 63, wave = tid >> 6;
  int inc = v;
#pragma unroll
  for (int o = 1; o < 64; o <<= 1) { int t = __shfl_up(inc, o); if (lane >= o) inc += t; }
  __syncthreads();
  if (lane == 63) red[wave] = inc;
  __syncthreads();
  int base = 0;
#pragma unroll
  for (int w = 0; w < 4; ++w) { int t = red[w]; if (w < wave) base += t; }
  total = red[0] + red[1] + red[2] + red[3];
  return base + inc - v;
}

DI void phase_topk(const Params& P, int l, char* smem) {
  const bool last = (l == 1);
  const int tid = TID();
  unsigned* keys = (unsigned*)smem;
  int* red = (int*)(smem + 8192);
  const int nitems = last ? 256 : 512;
  for (int it = gridDim.x - 1 - blockIdx.x; it < 16 * 384; it += gridDim.x) ffn_cvt_item(P, l, it, smem);
  for (int it = blockIdx.x; it < nitems; it += gridDim.x) {
    const bool isctx = it >= 256;
    const int se = it & 255, s = se >> 4, e = se & 15;
    const int n = isctx ? CTXL : SEQ, cap = isctx ? 32 : 256;
    const int row0 = s * SP + (isctx ? SEQ : 0);
    const int per = n >> 8;
    __syncthreads();
    for (int i = tid; i < n; i += 256) keys[i] = __float_as_uint(((float*)(P.ws + OFF_aff))[(size_t)(row0 + i) * 16 + e]);
    __syncthreads();
    unsigned kv[8];
#pragma unroll
    for (int j = 0; j < 8; ++j) kv[j] = (j < per) ? keys[tid * per + j] : 0u;
    unsigned prefix = 0u;
    int krem = cap;
    for (int bit = 31; bit >= 0; --bit) {
      const unsigned himask = (bit == 31) ? 0u : (0xFFFFFFFFu << (bit + 1));
      const unsigned want = prefix | (1u << bit);
      int c = 0;
#pragma unroll
      for (int j = 0; j < 8; ++j) c += (j < per && ((kv[j] & (himask | (1u << bit))) == want)) ? 1 : 0;
      c = (int)wave_sum((float)c);
      __syncthreads();
      if ((tid & 63) == 0) red[tid >> 6] = c;
      __syncthreads();
      const int cnt = red[0] + red[1] + red[2] + red[3];
      if (cnt >= krem) prefix = want; else krem -= cnt;
    }
    const unsigned T = prefix;
    int cgt = 0, ceq = 0;
#pragma unroll
    for (int j = 0; j < 8; ++j) if (j < per) { cgt += kv[j] > T ? 1 : 0; ceq += kv[j] == T ? 1 : 0; }
    int tot_gt, tot_eq, tot_sel;
    (void)block_excl_scan(cgt, red, tid, tot_gt);
    const int eq_before = block_excl_scan(ceq, red, tid, tot_eq);
    const int need_eq = cap - tot_gt;
    int eqc = eq_before, csel = 0;
    bool sel[8];
#pragma unroll
    for (int j = 0; j < 8; ++j) {
      sel[j] = false;
      if (j < per) {
        if (kv[j] > T) sel[j] = true;
        else if (kv[j] == T) { sel[j] = eqc < need_eq; ++eqc; }
        csel += sel[j] ? 1 : 0;
      }
    }
    int slot = block_excl_scan(csel, red, tid, tot_sel);
#pragma unroll
    for (int j = 0; j < 8; ++j) if (j < per) {
      const int t = tid * per + j;
      int rk = cap;
      if (sel[j]) {
        rk = slot++;
        const int R = isctx ? NFFN_LAT + (e * 16 + s) * 32 + rk : (s * 16 + e) * 256 + rk;
        ((int*)(P.ws + OFF_tokidx))[R] = row0 + t;
        ((float*)(P.ws + OFF_gatev))[R] = __uint_as_float(kv[j]);
      }
      ((int*)(P.ws + OFF_rank))[(size_t)(row0 + t) * 16 + e] = rk;
    }
  }
}

DI void phase_ln2(const Params& P, int l) {
  const bool last = (l == 1);
  const int lane = TID() & 63;
  const int gw = blockIdx.x * 4 + (TID() >> 6), nw = gridDim.x * 4;
  for (int row = gw; row < NTOK; row += nw) {
    int s = row / SP, p = row % SP;
    bool lat = p < SEQ;
    if (last && !lat) continue;
    float v[16];
    compute_x1(P, l, row, lane, v);
    float yf[16];
#pragma unroll
    for (int i = 0; i < 16; ++i) yf[i] = 0.f;
    const int cap = lat ? 256 : 32;
    for (int e = 0; e < 16; ++e) {
      int rk = ((int*)(P.ws + OFF_rank))[(size_t)row * 16 + e];
      if (rk < cap) {
        int R = lat ? (s * 16 + e) * 256 + rk : NFFN_LAT + (e * 16 + s) * 32 + rk;
        float t[16];
        load_row_bf16(((u16*)(P.ws + OFF_ye)) + (size_t)R * DM, lane, t);
#pragma unroll
        for (int i = 0; i < 16; ++i) yf[i] += t[i];
      }
    }
    const float* md = ((float*)(P.ws + OFF_mod)) + ((size_t)l * 17 + (lat ? s : 16)) * 6144;
    float m5[16];
    load_row_f32(md + 5 * 1024, lane, m5);
#pragma unroll
    for (int i = 0; i < 16; ++i) v[i] = ALPHA * v[i] + m5[i] * yf[i];
    ln_row(v, P.ln2_g + l * 1024, P.ln2_b + l * 1024, lane);
    if (lat) store_row_f32(P.out + ((size_t)s * SEQ + p) * DM, lane, v);
    if (!last) {
      const float* md2 = ((float*)(P.ws + OFF_mod)) + ((size_t)(l + 1) * 17 + (lat ? s : 16)) * 6144;
      float sh[16], scl[16];
      load_row_f32(md2, lane, sh); load_row_f32(md2 + 1024, lane, scl);
#pragma unroll
      for (int i = 0; i < 16; ++i) v[i] = v[i] * (1.f + scl[i]) + sh[i];
      store_row_bf16(((u16*)(P.ws + OFF_H)) + (size_t)row * DM, lane, v);
    }
  }
}

DI int wq_next(unsigned* ctr, char* smem) {
  volatile int* slot = (volatile int*)(smem + SMEM_BYTES - 32);
  __syncthreads();
  if (TID() == 0) *slot = (int)__hip_atomic_fetch_add(ctr, 1u, __ATOMIC_RELAXED, __HIP_MEMORY_SCOPE_AGENT);
  __syncthreads();
  return *slot;
}

DI unsigned* wq_ctr(const Params& P, int ph) { return (unsigned*)(P.ws + OFF_bar) + 3600 + 16 * ph; }

template <bool SWAP>
DI void proj_tile(const Params& P, int l, int hb, int mt, int nt, char* smem) {
  const int tid = TID(), wave = tid >> 6, lane = tid & 63, fr = lane & 15, fq = lane >> 4;
  const int wr = wave >> 1, wc = wave & 1;
  const int hrow0 = mt * 128, grow0 = hb * HROWS + hrow0;
  f32x4 acc[4][4];
  zero_acc<4>(acc);
  gemm_main<4, SWAP, false>(((u16*)(P.ws + OFF_H)), DM, nullptr, grow0, ((u16*)(P.ws + OFF_WinT)) + (size_t)l * INP * 1024, 1024, nt * 128, 1024, acc, (u16*)smem);
  const int jp = mt % 18;
  const int bl = mt / 18;
  const bool lat = jp < 16;
  if (SWAP) {
    u16* dst; int ldd, c0;
    if (nt < 4) { dst = ((u16*)(P.ws + OFF_xp)); ldd = 512; c0 = nt * 128; }
    else if (nt < 8) { dst = ((u16*)(P.ws + OFF_z)); ldd = 512; c0 = (nt - 4) * 128; }
    else if (nt < 14) { dst = ((u16*)(P.ws + OFF_xbc)); ldd = 768; c0 = (nt - 8) * 128; }
    else if (nt < 18) { dst = ((u16*)(P.ws + OFF_q)); ldd = 512; c0 = (nt - 14) * 128; }
    else if (nt < 22) { dst = ((u16*)(P.ws + OFF_k)); ldd = 512; c0 = (nt - 18) * 128; }
    else { dst = ((u16*)(P.ws + OFF_br3)); ldd = 512; c0 = (nt - 26) * 128; }
    const bool isu = nt >= 26;
    const bool rope = (nt >= 14 && nt < 22) && lat;
#pragma unroll
    for (int m = 0; m < 4; ++m) {
      int r = wr * 64 + m * 16 + fr;
      size_t orow = isu ? (size_t)(grow0 + r) : (size_t)(hrow0 + r);
      if (rope) {
        int t = jp * 128 + r;
        int prow = t >> 6, pcol = t & 63;
#pragma unroll
        for (int j = 0; j < 4; ++j) {
          int f = fq * 4 + j;
          float c1 = ((float*)(P.ws + OFF_rope))[(prow * 16 + f) * 2], s1 = ((float*)(P.ws + OFF_rope))[(prow * 16 + f) * 2 + 1];
          float c2 = ((float*)(P.ws + OFF_rope))[(pcol * 16 + f) * 2], s2 = ((float*)(P.ws + OFF_rope))[(pcol * 16 + f) * 2 + 1];
          float a = acc[m][0][j], b = acc[m][1][j];
          acc[m][0][j] = a * c1 - b * s1; acc[m][1][j] = a * s1 + b * c1;
          a = acc[m][2][j]; b = acc[m][3][j];
          acc[m][2][j] = a * c2 - b * s2; acc[m][3][j] = a * s2 + b * c2;
        }
      }
#pragma unroll
      for (int n = 0; n < 4; ++n) {
        f32x4 v = acc[m][n];
        if (isu) { v[0] = geluf_(v[0]); v[1] = geluf_(v[1]); v[2] = geluf_(v[2]); v[3] = geluf_(v[3]); }
        int col = c0 + wc * 64 + n * 16 + fq * 4;
        *(bf16x4*)(dst + orow * ldd + col) = pack4v(v);
      }
    }
  } else {
    if (nt == 34) {
      if (wc == 0) {
#pragma unroll
        for (int m = 0; m < 4; ++m)
#pragma unroll
          for (int j = 0; j < 4; ++j) ((float*)(P.ws + OFF_dtbuf))[(size_t)(hrow0 + wr * 64 + m * 16 + fq * 4 + j) * 16 + fr] = acc[m][0][j];
      }
    } else if (nt < 26) {
      int cb = (nt - 22) * 128 + wc * 64;
#pragma unroll
      for (int m = 0; m < 4; ++m)
#pragma unroll
        for (int n = 0; n < 4; ++n) {
          int c = cb + n * 16 + fr;
          int pos = jp * 128 + wr * 64 + m * 16 + fq * 4;
          *(bf16x4*)(((u16*)(P.ws + OFF_vT)) + ((size_t)bl * 512 + c) * SP + pos) = pack4v(acc[m][n]);
        }
    } else {
      int cb = (nt - 30) * 128 + wc * 64;
#pragma unroll
      for (int m = 0; m < 4; ++m)
#pragma unroll
        for (int n = 0; n < 4; ++n) {
          int c = cb + n * 16 + fr;
          int i0 = wr * 64 + m * 16 + fq * 4;
          f32x4 v = acc[m][n];
          *(bf16x4*)(((u16*)(P.ws + OFF_gvT)) + ((size_t)mt * 512 + c) * 128 + i0) = pack4(geluf_(v[0]), geluf_(v[1]), geluf_(v[2]), geluf_(v[3]));
        }
    }
  }
}

DI void phase_proj(const Params& P, int l, int hb, char* smem, int ph) {
  const bool last = (l == 1);
  for (;;) {
    const int it = wq_next(wq_ctr(P, ph), smem);
    if (it >= 144 * 35) break;
    int mt = it / 35, nt = it % 35;
    bool isctx = (mt % 18) >= 16;
    if (last && isctx) {
      bool need = (nt >= 8 && nt < 14) || (nt >= 18 && nt < 26) || nt == 34;
      if (!need) continue;
    }
    bool transposed = (nt >= 22 && nt < 26) || nt >= 30;
    if (transposed) proj_tile<false>(P, l, hb, mt, nt, smem);
    else proj_tile<true>(P, l, hb, mt, nt, smem);
  }
}

constexpr int LDK = 136;
DI void pool_item(const Params& P, int l, int hb, int mt, int g, char* smem) {
  const int tid = TID(), wave = tid >> 6, lane = tid & 63, fr = lane & 15, fq = lane >> 4;
  const int wr = wave >> 1, wc = wave & 1;
  u16* As = (u16*)smem;
  u16* Bs = As + 128 * LDK;
  const int jp = mt % 18, bl = mt / 18;
  const bool lat = jp < 16;
  const int n = lat ? SEQ : CTXL;
  const int p0 = lat ? jp * 128 : (jp - 16) * 128;
  const int seqbase = bl * SP + (lat ? 0 : SEQ);
  const int half = 1 << g;
  __syncthreads();
  {
    const int cch = tid & 15;
    const u16* src = ((u16*)(P.ws + OFF_xp)) + (size_t)seqbase * 512 + g * 128 + cch * 8;
    for (int ii = 0; ii < 8; ++ii) {
      int i = (tid >> 4) + 16 * ii;
      int p = p0 + i;
      int lo = max(p - half, 0), hi = min(p + half, n);
      float s[8];
#pragma unroll
      for (int e = 0; e < 8; ++e) s[e] = 0.f;
      for (int r = lo; r < hi; ++r) {
        bf16x8 t = *(const bf16x8*)(src + (size_t)r * 512);
#pragma unroll
        for (int e = 0; e < 8; ++e) s[e] += bf2f((u16)t[e]);
      }
      bf16x8 self = *(const bf16x8*)(src + (size_t)p * 512);
      float inv = 1.f / (float)(hi - lo);
      bf16x8 o;
#pragma unroll
      for (int e = 0; e < 8; ++e) o[e] = (short)f2bf(s[e] * inv - bf2f((u16)self[e]));
      *(bf16x8*)(As + i * LDK + cch * 8) = o;
    }
    const u16* wsrc = ((u16*)(P.ws + OFF_poolT)) + ((size_t)l * 4 + g) * 128 * 128;
    for (int cid = tid; cid < 2048; cid += 256) {
      int r = cid >> 4, c8 = (cid & 15) * 8;
      *(u32x4*)(Bs + r * LDK + c8) = *(const u32x4*)(wsrc + r * 128 + c8);
    }
  }
  __syncthreads();
  f32x4 acc[4][4];
  zero_acc<4>(acc);
  mma_lds<4, 4, true>(As + wr * 64 * LDK, LDK, Bs + wc * 64 * LDK, LDK, 4, acc, fr, fq);
  const float* psc = P.pool_scale + l * 512 + g * 128;
#pragma unroll
  for (int m = 0; m < 4; ++m)
#pragma unroll
    for (int nn = 0; nn < 4; ++nn) {
      int r = wr * 64 + m * 16 + fr, c = wc * 64 + nn * 16 + fq * 4;
      float4 sc = *(const float4*)(psc + c);
      f32x4 v = acc[m][nn];
      *(bf16x4*)(((u16*)(P.ws + OFF_br0)) + (size_t)(hb * HROWS + mt * 128 + r) * 512 + g * 128 + c) = pack4(v[0] * sc.x, v[1] * sc.y, v[2] * sc.z, v[3] * sc.w);
    }
}

DI void sgu_item(const Params& P, int l, int hb, int mt, char* smem) {
  const int tid = TID(), wave = tid >> 6, lane = tid & 63, fr = lane & 15, fq = lane >> 4;
  const int wr = wave >> 1, wc = wave & 1;
  u16* As = (u16*)smem;
  u16* Bs = As + 128 * LDK;
  float* st = (float*)(Bs + 128 * LDK);
  const u16* gv = ((u16*)(P.ws + OFF_gvT)) + (size_t)mt * 512 * 128;
  __syncthreads();
  {
    int i = tid & 127, part = tid >> 7;
    float s = 0.f;
#pragma unroll 16
    for (int c = part * 256; c < part * 256 + 256; ++c) s += bf2f(gv[c * 128 + i]);
    st[part * 128 + i] = s;
    __syncthreads();
    float mu = (st[i] + st[128 + i]) * (1.f / 512.f);
    __syncthreads();
    float qv = 0.f;
#pragma unroll 16
    for (int c = part * 256; c < part * 256 + 256; ++c) { float d = bf2f(gv[c * 128 + i]) - mu; qv += d * d; }
    st[part * 128 + i] = qv;
    __syncthreads();
    float var = (st[i] + st[128 + i]) * (1.f / 512.f);
    __syncthreads();
    if (part == 0) { st[256 + i] = mu; st[384 + i] = rsqrtf(var + LN_EPS); }
  }
  const float* mu = st + 256;
  const float* rs = st + 384;
  for (int g = 0; g < 4; ++g) {
    __syncthreads();
    const u16* wsrc = ((u16*)(P.ws + OFF_sguW)) + ((size_t)l * 4 + g) * 128 * 128;
    for (int cid = tid; cid < 2048; cid += 256) {
      int r = cid >> 4, c8 = (cid & 15) * 8;
      *(u32x4*)(As + r * LDK + c8) = *(const u32x4*)(wsrc + r * 128 + c8);
      bf16x8 t = *(const bf16x8*)(gv + (size_t)(g * 128 + r) * 128 + c8);
      float lg = P.sgu_ln_g[l * 512 + g * 128 + r], lb = P.sgu_ln_b[l * 512 + g * 128 + r];
      bf16x8 o;
#pragma unroll
      for (int e = 0; e < 8; ++e) o[e] = (short)f2bf((bf2f((u16)t[e]) - mu[c8 + e]) * rs[c8 + e] * lg + lb);
      *(bf16x8*)(Bs + r * LDK + c8) = o;
    }
    __syncthreads();
    f32x4 acc[4][4];
    zero_acc<4>(acc);
    mma_lds<4, 4, true>(As + wr * 64 * LDK, LDK, Bs + wc * 64 * LDK, LDK, 4, acc, fr, fq);
    const float* bs = P.sgu_b + ((size_t)l * 4 + g) * 128;
#pragma unroll
    for (int m = 0; m < 4; ++m) {
      int pp = wr * 64 + m * 16 + fr;
      float bias = bs[pp];
#pragma unroll
      for (int nn = 0; nn < 4; ++nn) {
        int d = wc * 64 + nn * 16 + fq * 4;
        u16* up = ((u16*)(P.ws + OFF_br3)) + (size_t)(hb * HROWS + mt * 128 + pp) * 512 + g * 128 + d;
        bf16x4 uu = *(const bf16x4*)up;
        f32x4 v = acc[m][nn];
        *(bf16x4*)up = pack4((v[0] + bias) * bf2f((u16)uu[0]), (v[1] + bias) * bf2f((u16)uu[1]), (v[2] + bias) * bf2f((u16)uu[2]), (v[3] + bias) * bf2f((u16)uu[3]));
      }
    }
  }
}

DI void attn_item(const Params& P, int l, int hb, int item, char* smem) {
  const int tid = TID(), wave = tid >> 6, lane = tid & 63, fr = lane & 15, fq = lane >> 4;
  const int qt = item % 18, h = (item / 18) & 3, bl = item / 72;
  const bool ctxq = qt >= 16;
  const int key0 = ctxq ? SEQ : 0, nkt = ctxq ? 4 : 36;
  const int hrow_q0 = bl * SP + qt * 128 + wave * 32;
  constexpr int KT = 64 * LDT, VT = 128 * LDT;
  u16* Ks = (u16*)smem;
  u16* Vs = Ks + 2 * KT;
  constexpr float LOG2E = 1.4426950408889634f;
  for (int sub = 0; sub < 2; ++sub) {
    const int hs = 2 * h + sub;
    bf16x8 qf[2][2];
#pragma unroll
    for (int qb = 0; qb < 2; ++qb)
#pragma unroll
      for (int ks = 0; ks < 2; ++ks) qf[qb][ks] = *(const bf16x8*)(((u16*)(P.ws + OFF_q)) + (size_t)(hrow_q0 + qb * 16 + fr) * 512 + hs * 64 + ks * 32 + fq * 8);
    f32x4 ot[8][2];
#pragma unroll
    for (int d = 0; d < 8; ++d) { ot[d][0] = f32x4{0.f, 0.f, 0.f, 0.f}; ot[d][1] = f32x4{0.f, 0.f, 0.f, 0.f}; }
    float mrow[2] = {-INFINITY, -INFINITY}, lrow[2] = {0.f, 0.f};
    const u16* Kg = ((u16*)(P.ws + OFF_k)) + ((size_t)bl * SP + key0) * 512 + hs * 64;
    const u16* Vg = ((u16*)(P.ws + OFF_vT)) + ((size_t)bl * 512 + h * 128) * SP + key0;
    u32x4 rk[2], rv[4];
    const u16* kgp = Kg + (size_t)(tid >> 2) * 512 + (tid & 3) * 16;
    const u16* vgp = Vg + (size_t)(tid >> 1) * SP + (tid & 1) * 32;
    u16* ksp = Ks + (tid >> 2) * LDT + (tid & 3) * 16;
    u16* vsp = Vs + (tid >> 1) * LDT + (tid & 1) * 32;
    auto gloadK = [&](int t) {
      const u16* kp = kgp + (size_t)t * 64 * 512;
      rk[0] = *(const u32x4*)(kp); rk[1] = *(const u32x4*)(kp + 8);
    };
    auto gloadV = [&](int t) {
      const u16* vp = vgp + t * 64;
      rv[0] = *(const u32x4*)(vp); rv[1] = *(const u32x4*)(vp + 8); rv[2] = *(const u32x4*)(vp + 16); rv[3] = *(const u32x4*)(vp + 24);
    };
    auto sstore = [&](int buf) {
      u16* kp = ksp + buf * KT;
      *(u32x4*)(kp) = rk[0]; *(u32x4*)(kp + 8) = rk[1];
      u16* vp = vsp + buf * VT;
      *(u32x4*)(vp) = rv[0]; *(u32x4*)(vp + 8) = rv[1]; *(u32x4*)(vp + 16) = rv[2]; *(u32x4*)(vp + 24) = rv[3];
    };
    gloadK(0); gloadV(0);
    __syncthreads();
    sstore(0);
    __syncthreads();
    for (int t = 0; t < nkt; ++t) {
      const int cur = t & 1;
      if (t + 1 < nkt) gloadK(t + 1);
      const u16* Kc = Ks + cur * KT;
      const u16* Vc = Vs + cur * VT;
      f32x4 st[4][2];
#pragma unroll
      for (int k4 = 0; k4 < 4; ++k4) { st[k4][0] = f32x4{0.f, 0.f, 0.f, 0.f}; st[k4][1] = f32x4{0.f, 0.f, 0.f, 0.f}; }
#pragma unroll
      for (int k4 = 0; k4 < 4; ++k4)
#pragma unroll
        for (int ks = 0; ks < 2; ++ks) {
          bf16x8 a = *(const bf16x8*)(Kc + (k4 * 16 + fr) * LDT + ks * 32 + fq * 8);
          st[k4][0] = MFMA16(a, qf[0][ks], st[k4][0]);
          st[k4][1] = MFMA16(a, qf[1][ks], st[k4][1]);
          if (ks == 1 && (k4 & 1)) __builtin_amdgcn_sched_barrier(0);
        }
      __builtin_amdgcn_sched_barrier(0);
#pragma unroll
      for (int qb = 0; qb < 2; ++qb) {
        float mx = -INFINITY;
#pragma unroll
        for (int k4 = 0; k4 < 4; ++k4)
#pragma unroll
          for (int j = 0; j < 4; ++j) mx = fmaxf(mx, st[k4][qb][j]);
        mx = fmaxf(mx, __shfl_xor(mx, 16));
        mx = fmaxf(mx, __shfl_xor(mx, 32));
        const bool upd = mx > mrow[qb] + 5.5f;
        const float mnew = upd ? mx : mrow[qb];
        const float moff = mnew * LOG2E;
        float ps = 0.f;
#pragma unroll
        for (int k4 = 0; k4 < 4; ++k4)
#pragma unroll
          for (int j = 0; j < 4; ++j) { float pv = __builtin_amdgcn_exp2f(st[k4][qb][j] * LOG2E - moff); st[k4][qb][j] = pv; ps += pv; }
        if (__builtin_amdgcn_ballot_w64(upd) != 0ull) {
          const float alpha = __builtin_amdgcn_exp2f((mrow[qb] - mnew) * LOG2E);
          lrow[qb] *= alpha;
#pragma unroll
          for (int d = 0; d < 8; ++d) { ot[d][qb][0] *= alpha; ot[d][qb][1] *= alpha; ot[d][qb][2] *= alpha; ot[d][qb][3] *= alpha; }
        }
        mrow[qb] = mnew;
        lrow[qb] += ps;
      }
      __builtin_amdgcn_sched_barrier(0);
      if (t + 1 < nkt) gloadV(t + 1);
#pragma unroll
      for (int ks2 = 0; ks2 < 2; ++ks2) {
        bf16x8 pf[2];
#pragma unroll
        for (int qb = 0; qb < 2; ++qb) {
          bf16x4 lo = pack4v(st[2 * ks2][qb]), hi = pack4v(st[2 * ks2 + 1][qb]);
          pf[qb] = __builtin_shufflevector(lo, hi, 0, 1, 2, 3, 4, 5, 6, 7);
        }
#pragma unroll
        for (int d = 0; d < 8; ++d) {
          const u16* vp = Vc + (d * 16 + fr) * LDT + ks2 * 32 + fq * 4;
          bf16x4 lo = *(const bf16x4*)vp, hi = *(const bf16x4*)(vp + 16);
          bf16x8 a = __builtin_shufflevector(lo, hi, 0, 1, 2, 3, 4, 5, 6, 7);
          ot[d][0] = MFMA16(a, pf[0], ot[d][0]);
          ot[d][1] = MFMA16(a, pf[1], ot[d][1]);
          if ((d & 3) == 3) __builtin_amdgcn_sched_barrier(0);
        }
      }
      if (t + 1 < nkt) sstore(cur ^ 1);
      __syncthreads();
    }
#pragma unroll
    for (int qb = 0; qb < 2; ++qb) {
      float lt = lrow[qb];
      lt += __shfl_xor(lt, 16);
      lt += __shfl_xor(lt, 32);
      float inv = 1.f / lt;
      size_t hrow = (size_t)(hrow_q0 + qb * 16 + fr);
      if (sub == 0) {
#pragma unroll
        for (int d = 0; d < 8; ++d) {
          f32x4 v = ot[d][qb];
          *(bf16x4*)(((u16*)(P.ws + OFF_o1)) + hrow * 512 + h * 128 + d * 16 + fq * 4) = pack4(v[0] * inv, v[1] * inv, v[2] * inv, v[3] * inv);
        }
      } else {
        const float lam = ((float*)(P.ws + OFF_lamv))[l * 2], lam_init = ((float*)(P.ws + OFF_lamv))[l * 2 + 1];
        float ss = 0.f;
#pragma unroll
        for (int d = 0; d < 8; ++d) {
          bf16x4 o1v = *(const bf16x4*)(((u16*)(P.ws + OFF_o1)) + hrow * 512 + h * 128 + d * 16 + fq * 4);
#pragma unroll
          for (int j = 0; j < 4; ++j) { float dd = bf2f((u16)o1v[j]) - lam * ot[d][qb][j] * inv; ot[d][qb][j] = dd; ss += dd * dd; }
        }
        ss += __shfl_xor(ss, 16);
        ss += __shfl_xor(ss, 32);
        float rr = rsqrtf(ss * (1.f / 128.f) + LN_EPS) * (1.f - lam_init);
        const float* gn = P.diff_norm_g + l * 128;
#pragma unroll
        for (int d = 0; d < 8; ++d) {
          int dv = d * 16 + fq * 4;
          float4 g4 = *(const float4*)(gn + dv);
          f32x4 v = ot[d][qb];
          *(bf16x4*)(((u16*)(P.ws + OFF_br2)) + ((size_t)hb * HROWS + hrow) * 512 + h * 128 + dv) = pack4(v[0] * rr * g4.x, v[1] * rr * g4.y, v[2] * rr * g4.z, v[3] * rr * g4.w);
        }
      }
    }
  }
}

template <bool TRANS>
DI void conv_stage(const Params& P, int l, const u16* xbase  , int chan0, int n, int p0, u16* dst, int ld, const float* scale) {
  const int tid = TID(), cl = tid & 63, ig = tid >> 6;
  const int ch = chan0 + cl;
  const float* cw = P.conv_w + (size_t)l * 5 * 768 + ch;
  const float w0 = cw[0], w1 = cw[768], w2 = cw[2 * 768], w3 = cw[3 * 768], w4 = cw[4 * 768];
  const float cb = P.conv_b[l * 768 + ch];
  const u16* xc = xbase + ch;
#pragma unroll 1
  for (int g8 = 0; g8 < 4; ++g8) {
    const int tok0 = ig * 32 + g8 * 8;
    const int pos0 = p0 + tok0 - 2;
    float xv[12];
#pragma unroll
    for (int i = 0; i < 12; ++i) { int pos = pos0 + i; xv[i] = (pos >= 0 && pos < n) ? bf2f(xc[(size_t)pos * 768]) : 0.f; }
#pragma unroll
    for (int ii = 0; ii < 8; ++ii) {
      float v = w0 * xv[ii] + w1 * xv[ii + 1] + w2 * xv[ii + 2] + w3 * xv[ii + 3] + w4 * xv[ii + 4] + cb;
      v = v * __builtin_amdgcn_rcpf(1.f + __expf(-v));
      const int tok = tok0 + ii;
      if (scale) v *= scale[tok];
      if (TRANS) dst[cl * ld + tok] = f2bf(v); else dst[tok * ld + cl] = f2bf(v);
    }
  }
}

DI void ssd_scalars(const Params& P, int l, int hrow0, int h, int dir, float* dts, float* S, float* tmp) {
  const int tid = TID();
  const float aneg = -expf(P.a_log[l * 16 + dir * 8 + h]);
  float a = 0.f, inc = 0.f;
  if (tid < 128) {
    float raw = ((float*)(P.ws + OFF_dtbuf))[(size_t)(hrow0 + tid) * 16 + dir * 8 + h] + P.dt_bias[l * 16 + dir * 8 + h];
    float dt = softplusf_(raw);
    dts[tid] = dt;
    a = dt * aneg;
    inc = a;
    const int lane = tid & 63;
#pragma unroll
    for (int o = 1; o < 64; o <<= 1) { float t = __shfl_up(inc, o); if (lane >= o) inc += t; }
    if (lane == 63) tmp[tid >> 6] = inc;
  }
  __syncthreads();
  if (tid < 128) {
    const float t0 = tmp[0], t1 = tmp[1];
    const float pre = inc + (tid >= 64 ? t0 : 0.f);
    S[tid] = (dir == 0) ? pre : (t0 + t1) - pre + a;
  }
  __syncthreads();
}

constexpr int SSD_STATE_STRIDE = 18 * 4096;

DI void ssd_prep_item(const Params& P, int l, int hb, int mt, int slab, char* smem) {
  const int tid = TID();
  const int jp = mt % 18, bl = mt / 18;
  const bool lat = jp < 16;
  const int n = lat ? SEQ : CTXL;
  const int p0 = lat ? jp * 128 : (jp - 16) * 128;
  const int seqbase = bl * SP + (lat ? 0 : SEQ);
  const int hrow0 = bl * SP + jp * 128;
  u16* T = (u16*)smem;
  u16* Rm = T + 64 * LDK;
  __syncthreads();
  const u16* xb = ((u16*)(P.ws + OFF_xbc)) + (size_t)seqbase * 768;
  if (slab < 10) conv_stage<true>(P, l, xb, slab * 64, n, p0, T, LDK, nullptr);
  if (slab >= 8) conv_stage<false>(P, l, xb, slab * 64, n, p0, Rm, LDT, nullptr);
  __syncthreads();
  if (slab < 10) {
    u16* dst = slab < 8 ? ((u16*)(P.ws + OFF_xsT)) + ((size_t)mt * 512 + slab * 64) * 128 : ((u16*)(P.ws + OFF_bmT)) + ((size_t)mt * 128 + (slab - 8) * 64) * 128;
#pragma unroll
    for (int i = 0; i < 4; ++i) { int cid = tid + 256 * i; int r = cid >> 4, c8 = (cid & 15) * 8; *(u32x4*)(dst + (size_t)r * 128 + c8) = *(const u32x4*)(T + r * LDK + c8); }
  }
  if (slab >= 8) {
    u16* dst = (slab < 10 ? ((u16*)(P.ws + OFF_bm)) + (slab - 8) * 64 : ((u16*)(P.ws + OFF_cm)) + (slab - 10) * 64) + (size_t)hrow0 * 128;
#pragma unroll
    for (int i = 0; i < 4; ++i) { int cid = tid + 256 * i; int r = cid >> 3, c8 = (cid & 7) * 8; *(u32x4*)(dst + (size_t)r * 128 + c8) = *(const u32x4*)(Rm + r * LDT + c8); }
  }
}

DI void phase_ssd_prep(const Params& P, int l, int hb, char* smem, int ph) {
  for (;;) {
    const int it = wq_next(wq_ctr(P, ph), smem);
    if (it >= 144 * 12) break;
    ssd_prep_item(P, l, hb, it / 12, it % 12, smem);
  }
}

DI void ssd_state_item(const Params& P, int l, int hb, int item, char* smem) {
  const int tid = TID(), wave = tid >> 6, lane = tid & 63, fr = lane & 15, fq = lane >> 4;
  const int h = item & 7, jp = (item >> 3) % 18, bl = (item >> 3) / 18;
  const int mt = bl * 18 + jp;
  const int hrow0 = bl * SP + jp * 128;
  u16* At = (u16*)smem;
  u16* Bt = At + 64 * LDK;
  float* dts = (float*)(Bt + 64 * LDK);
  float* S = dts + 128;
  float* wgt = S + 128;
  __syncthreads();
  u32x4 xr[4];
  {
    const u16* bsrc = ((u16*)(P.ws + OFF_bmT)) + ((size_t)mt * 128 + (h >> 2) * 64) * 128;
    const u16* xsrc = ((u16*)(P.ws + OFF_xsT)) + ((size_t)mt * 512 + h * 64) * 128;
#pragma unroll
    for (int i = 0; i < 4; ++i) {
      int cid = tid + 256 * i; int r = cid >> 4, c8 = (cid & 15) * 8;
      *(u32x4*)(Bt + r * LDK + c8) = *(const u32x4*)(bsrc + (size_t)r * 128 + c8);
      xr[i] = *(const u32x4*)(xsrc + (size_t)r * 128 + c8);
    }
  }
  const int wr = wave >> 1, wc = wave & 1;
#pragma unroll 1
  for (int dir = 0; dir < 2; ++dir) {
    ssd_scalars(P, l, hrow0, h, dir, dts, S, wgt);
    const float total = (dir == 0) ? S[127] : S[0];
    __syncthreads();
    if (tid < 128) wgt[tid] = dts[tid] * __expf(total - S[tid]);
    __syncthreads();
#pragma unroll
    for (int i = 0; i < 4; ++i) {
      int cid = tid + 256 * i; int r = cid >> 4, c8 = (cid & 15) * 8;
      u32x4 o;
#pragma unroll
      for (int e2 = 0; e2 < 4; ++e2) o[e2] = pack2(bflo(xr[i][e2]) * wgt[c8 + 2 * e2], bfhi(xr[i][e2]) * wgt[c8 + 2 * e2 + 1]);
      *(u32x4*)(At + r * LDK + c8) = o;
    }
    __syncthreads();
    f32x4 acc[2][2];
#pragma unroll
    for (int m = 0; m < 2; ++m) { acc[m][0] = f32x4{0.f, 0.f, 0.f, 0.f}; acc[m][1] = f32x4{0.f, 0.f, 0.f, 0.f}; }
    mma_lds<2, 2, true>(At + wr * 32 * LDK, LDK, Bt + wc * 32 * LDK, LDK, 4, acc, fr, fq);
    u16* cs = ((u16*)(P.ws + OFF_cstate)) + (((size_t)(bl * 2 + dir) * 8 + h) * 18 + jp) * 4096;
#pragma unroll
    for (int m = 0; m < 2; ++m)
#pragma unroll
      for (int nn = 0; nn < 2; ++nn) *(bf16x4*)(cs + (wr * 32 + m * 16 + fr) * 64 + wc * 32 + nn * 16 + fq * 4) = pack4v(acc[m][nn]);
    if (tid == 0) ((float*)(P.ws + OFF_decay))[((bl * 2 + dir) * 8 + h) * 18 + jp] = __expf(total);
  }
}

DI void phase_carry(const Params& P) {
  const int total = 8 * 2 * 8 * 4096;
  for (int idx = blockIdx.x * 256 + TID(); idx < total; idx += gridDim.x * 256) {
    int pn = idx & 4095, bdh = idx >> 12;
    int dir = (bdh >> 3) & 1;
    const u16* __restrict__ cs = ((const u16*)(P.ws + OFF_cstate)) + (size_t)bdh * SSD_STATE_STRIDE + pn;
    u16* __restrict__ en = ((u16*)(P.ws + OFF_enter)) + (size_t)bdh * SSD_STATE_STRIDE + pn;
    const float* __restrict__ dc = ((const float*)(P.ws + OFF_decay)) + bdh * 18;
    float cv[18], dv[18];
#pragma unroll
    for (int jp = 0; jp < 18; ++jp) { cv[jp] = bf2f(cs[(size_t)jp * 4096]); dv[jp] = dc[jp]; }
    float state = 0.f;
    if (dir == 0) {
#pragma unroll
      for (int st = 0; st < 18; ++st) {
        const int jp = st < 2 ? 16 + st : st - 2;
        en[(size_t)jp * 4096] = f2bf(state);
        state = state * dv[jp] + cv[jp];
      }
    } else {
#pragma unroll
      for (int st = 0; st < 18; ++st) {
        const int jp = 17 - st;
        en[(size_t)jp * 4096] = f2bf(state);
        state = state * dv[jp] + cv[jp];
      }
    }
  }
}

DI void ssd_out_item(const Params& P, int l, int hb, int item, char* smem) {
  const int tid = TID(), wave = tid >> 6, lane = tid & 63, fr = lane & 15, fq = lane >> 4;
  const int h = item & 7, jp = (item >> 3) % 18, bl = (item >> 3) / 18;
  const bool lat = jp < 16;
  const int n = lat ? SEQ : CTXL;
  const int p0 = lat ? jp * 128 : (jp - 16) * 128;
  const int seqbase = bl * SP + (lat ? 0 : SEQ);
  const int hrow0 = bl * SP + jp * 128;
  u16* Cs = (u16*)smem;
  u16* xT = Cs + 128 * LDT;
  u16* Et = xT + 64 * LDK;
  u16* Un = Et + 64 * LDT;
  float* fs = (float*)(Un + 128 * LDK);
  float* dts = fs;
  float* S = fs + 128;
  float* tmp = fs + 256;
  const int grp = h >> 2;
  __syncthreads();
  {
    const int mt = bl * 18 + jp;
    const u16* csrc = ((u16*)(P.ws + OFF_cm)) + (size_t)hrow0 * 128 + grp * 64;
    const u16* bsrc = ((u16*)(P.ws + OFF_bm)) + (size_t)hrow0 * 128 + grp * 64;
    const u16* xsrc = ((u16*)(P.ws + OFF_xsT)) + ((size_t)mt * 512 + h * 64) * 128;
#pragma unroll
    for (int i = 0; i < 4; ++i) {
      int cid = tid + 256 * i;
      int r = cid >> 3, c8 = (cid & 7) * 8;
      *(u32x4*)(Cs + r * LDT + c8) = *(const u32x4*)(csrc + (size_t)r * 128 + c8);
      *(u32x4*)(Un + r * LDT + c8) = *(const u32x4*)(bsrc + (size_t)r * 128 + c8);
      int r2 = cid >> 4, c82 = (cid & 15) * 8;
      *(u32x4*)(xT + r2 * LDK + c82) = *(const u32x4*)(xsrc + (size_t)r2 * 128 + c82);
    }
  }
  __syncthreads();
  f32x4 cb[2][8];
#pragma unroll
  for (int m = 0; m < 2; ++m)
#pragma unroll
    for (int nn = 0; nn < 8; ++nn) cb[m][nn] = f32x4{0.f, 0.f, 0.f, 0.f};
  mma_lds<2, 8, false>(Cs + wave * 32 * LDT, LDT, Un, LDT, 2, cb, fr, fq);
  f32x4 yacc[2][4];
#pragma unroll
  for (int m = 0; m < 2; ++m)
#pragma unroll
    for (int nn = 0; nn < 4; ++nn) yacc[m][nn] = f32x4{0.f, 0.f, 0.f, 0.f};
#pragma unroll 1
  for (int dir = 0; dir < 2; ++dir) {
    __syncthreads();
    ssd_scalars(P, l, hrow0, h, dir, dts, S, tmp);
#pragma unroll
    for (int m = 0; m < 2; ++m)
#pragma unroll
      for (int j = 0; j < 4; ++j) {
        int lrow = wave * 32 + m * 16 + fq * 4 + j;
        float Sl = S[lrow];
#pragma unroll
        for (int nn = 0; nn < 8; ++nn) {
          int s = nn * 16 + fr;
          bool ok = dir == 0 ? (s <= lrow) : (s >= lrow);
          float coef = ok ? __expf(Sl - S[s]) * dts[s] : 0.f;
          Un[lrow * LDK + s] = f2bf(cb[m][nn][j] * coef);
        }
      }
    {
      const u16* en = ((u16*)(P.ws + OFF_enter)) + (((size_t)(bl * 2 + dir) * 8 + h) * 18 + jp) * 4096;
      for (int cid = tid; cid < 512; cid += 256) {
        int pr = cid >> 3, c8 = (cid & 7) * 8;
        *(u32x4*)(Et + pr * LDT + c8) = *(const u32x4*)(en + pr * 64 + c8);
      }
    }
    __syncthreads();
    mma_lds<2, 4, true>(Un + wave * 32 * LDK, LDK, xT, LDK, 4, yacc, fr, fq);
    f32x4 yi[2][4];
#pragma unroll
    for (int m = 0; m < 2; ++m)
#pragma unroll
      for (int nn = 0; nn < 4; ++nn) yi[m][nn] = f32x4{0.f, 0.f, 0.f, 0.f};
    mma_lds<2, 4, true>(Cs + wave * 32 * LDT, LDT, Et, LDT, 2, yi, fr, fq);
#pragma unroll
    for (int m = 0; m < 2; ++m) {
      float e = __expf(S[wave * 32 + m * 16 + fr]);
#pragma unroll
      for (int nn = 0; nn < 4; ++nn)
#pragma unroll
        for (int j = 0; j < 4; ++j) yacc[m][nn][j] += e * yi[m][nn][j];
    }
  }
  const float dsk = P.ssd_d[l * 8 + h];
  const float* gn = P.ssd_norm_g + l * 512 + h * 64;
#pragma unroll
  for (int m = 0; m < 2; ++m) {
    int lrow = wave * 32 + m * 16 + fr;
    float ss = 0.f;
#pragma unroll
    for (int nn = 0; nn < 4; ++nn) {
      int pc = nn * 16 + fq * 4;
      bf16x4 zz = *(const bf16x4*)(((u16*)(P.ws + OFF_z)) + (size_t)(hrow0 + lrow) * 512 + h * 64 + pc);
      float4 g4 = *(const float4*)(gn + pc);
      float gg[4] = {g4.x, g4.y, g4.z, g4.w};
      float o[4];
#pragma unroll
      for (int j = 0; j < 4; ++j) {
        float y = yacc[m][nn][j] + dsk * bf2f(xT[(pc + j) * LDK + lrow]);
        y *= siluf_(bf2f((u16)zz[j]));
        ss += y * y;
        o[j] = y * gg[j];
      }
      *(bf16x4*)(((u16*)(P.ws + OFF_br1)) + ((size_t)hb * HROWS + hrow0 + lrow) * 512 + h * 64 + pc) = pack4(o[0], o[1], o[2], o[3]);
    }
    ss += __shfl_xor(ss, 16);
    ss += __shfl_xor(ss, 32);
    if (fq == 0) ((float*)(P.ws + OFF_ssq))[((size_t)hb * HROWS + hrow0 + lrow) * 8 + h] = ss;
  }
}


DI void merge_tile(const Params& P, int l, int mt, int nt, char* smem) {
  const int row0 = mt * 128;
#pragma unroll 1
  for (int kq = 0; kq < 4; ++kq) {
    unsigned gp[4][4][2];
    {
      f32x4 g[4][4];
      zero_acc<4>(g);
      gemm_main<4, true, false, true>(((u16*)(P.ws + OFF_H)), DM, nullptr, row0, ((u16*)(P.ws + OFF_WgT)) + ((size_t)l * 4 + kq) * 1024 * 1024, 1024, nt * 128, 1024, g, (u16*)smem);
#pragma unroll
      for (int m = 0; m < 4; ++m)
#pragma unroll
        for (int n = 0; n < 4; ++n) {
          gp[m][n][0] = pack2(sigmoidf_(g[m][n][0]), sigmoidf_(g[m][n][1]));
          gp[m][n][1] = pack2(sigmoidf_(g[m][n][2]), sigmoidf_(g[m][n][3]));
        }
    }
    f32x4 bb[4][4];
    zero_acc<4>(bb);
    const u16* br = ((u16*)(P.ws + OFF_br0)) + (size_t)kq * (U_ / 2);
    gemm_main<4, true, false, false>(br, 512, nullptr, row0, ((u16*)(P.ws + OFF_WbT)) + ((size_t)l * 4 + kq) * 1024 * 512, 512, nt * 128, 512, bb, (u16*)smem);
    const int tid = TID(), wave = tid >> 6, lane = tid & 63, fr = lane & 15, fq = lane >> 4;
    const int wr = wave >> 1, wc = wave & 1;
#pragma unroll
    for (int m = 0; m < 4; ++m) {
      const int r = row0 + wr * 64 + m * 16 + fr;
      float rs = 1.f;
      if (kq == 1) {
        const float* sq = ((float*)(P.ws + OFF_ssq)) + (size_t)r * 8;
        float4 a = *(const float4*)sq, b = *(const float4*)(sq + 4);
        rs = rsqrtf((a.x + a.y + a.z + a.w + b.x + b.y + b.z + b.w) * (1.f / 512.f) + LN_EPS);
      }
#pragma unroll
      for (int n = 0; n < 4; ++n) {
        u32x2* dst = (u32x2*)(((u16*)(P.ws + OFF_acc)) + (size_t)r * DM + nt * 128 + wc * 64 + n * 16 + fq * 4);
        u32x2 prev = {0u, 0u};
        if (kq > 0) prev = *dst;
        const unsigned g0 = gp[m][n][0], g1 = gp[m][n][1];
        u32x2 o;
        o[0] = pack2(bflo(prev[0]) + bflo(g0) * bb[m][n][0] * rs, bfhi(prev[0]) + bfhi(g0) * bb[m][n][1] * rs);
        o[1] = pack2(bflo(prev[1]) + bflo(g1) * bb[m][n][2] * rs, bfhi(prev[1]) + bfhi(g1) * bb[m][n][3] * rs);
        *dst = o;
      }
    }
  }
}

DI void phase_merge(const Params& P, int l, char* smem, int ph) {
  const bool last = (l == 1);
  for (;;) {
    const int it = wq_next(wq_ctr(P, ph), smem);
    if (it >= 288 * 8) break;
    int mt = it / 8, nt = it % 8;
    if (last && (mt % 18) >= 16) continue;
    merge_tile(P, l, mt, nt, smem);
  }
}

DI void phase_outproj(const Params& P, int l, char* smem, int ph) {
  const bool last = (l == 1);
  const int tid = TID(), wave = tid >> 6, lane = tid & 63, fr = lane & 15, fq = lane >> 4;
  const int wr = wave >> 1, wc = wave & 1;
  for (;;) {
    const int it = wq_next(wq_ctr(P, ph), smem);
    if (it >= 288 * 8) break;
    int mt = it / 8, nt = it % 8;
    if (last && (mt % 18) >= 16) continue;
    f32x4 acc[4][4];
    zero_acc<4>(acc);
    gemm_main<4, true, false>(((u16*)(P.ws + OFF_acc)), DM, nullptr, mt * 128, ((u16*)(P.ws + OFF_WoT)) + (size_t)l * 1024 * 1024, 1024, nt * 128, 1024, acc, (u16*)smem);
#pragma unroll
    for (int m = 0; m < 4; ++m)
#pragma unroll
      for (int n = 0; n < 4; ++n) {
        int r = mt * 128 + wr * 64 + m * 16 + fr, c = nt * 128 + wc * 64 + n * 16 + fq * 4;
        *(bf16x4*)(((u16*)(P.ws + OFF_Y)) + (size_t)r * DM + c) = pack4v(acc[m][n]);
      }
  }
}

DI void phase_ffn1(const Params& P, int l, char* smem, int ph) {
  const bool last = (l == 1);
  const int tid = TID(), wave = tid >> 6, lane = tid & 63, fr = lane & 15, fq = lane >> 4;
  const int wr = wave >> 1, wc = wave & 1;
  const int nmt = last ? 512 : 576;
  for (;;) {
    const int it = wq_next(wq_ctr(P, ph), smem);
    if (it >= nmt * 8) break;
    int mt = it / 8, nt = it % 8;
    int R0 = mt * 128;
    int e = R0 < NFFN_LAT ? (R0 >> 8) & 15 : (R0 - NFFN_LAT) >> 9;
    f32x4 acc[4][4];
    zero_acc<4>(acc);
    gemm_main<4, true, true>(((u16*)(P.ws + OFF_H)), DM, ((int*)(P.ws + OFF_tokidx)), R0, ((u16*)(P.ws + OFF_W13T)) + (size_t)e * 1024 * 1024, 1024, nt * 128, 1024, acc, (u16*)smem);
#pragma unroll
    for (int m = 0; m < 4; ++m)
#pragma unroll
      for (int n2 = 0; n2 < 2; ++n2) {
        int r = R0 + wr * 64 + m * 16 + fr;
        int hc = (nt * 4 + wc * 2 + n2) * 16 + fq * 4;
        f32x4 a = acc[m][2 * n2], b = acc[m][2 * n2 + 1];
        *(bf16x4*)(((u16*)(P.ws + OFF_hid)) + (size_t)r * 512 + hc) = pack4(siluf_(a[0]) * b[0], siluf_(a[1]) * b[1], siluf_(a[2]) * b[2], siluf_(a[3]) * b[3]);
      }
  }
}

DI void phase_ffn2(const Params& P, int l, char* smem, int ph) {
  const bool last = (l == 1);
  const int tid = TID(), wave = tid >> 6, lane = tid & 63, fr = lane & 15, fq = lane >> 4;
  const int wr = wave >> 1, wc = wave & 1;
  const int nmt = last ? 512 : 576;
  for (;;) {
    const int it = wq_next(wq_ctr(P, ph), smem);
    if (it >= nmt * 8) break;
    int mt = it / 8, nt = it % 8;
    int R0 = mt * 128;
    int e = R0 < NFFN_LAT ? (R0 >> 8) & 15 : (R0 - NFFN_LAT) >> 9;
    f32x4 acc[4][4];
    zero_acc<4>(acc);
    gemm_main<4, true, false>(((u16*)(P.ws + OFF_hid)), 512, nullptr, R0, ((u16*)(P.ws + OFF_W2T)) + (size_t)e * 1024 * 512, 512, nt * 128, 512, acc, (u16*)smem);
#pragma unroll
    for (int m = 0; m < 4; ++m) {
      int r = R0 + wr * 64 + m * 16 + fr;
      float gt = ((float*)(P.ws + OFF_gatev))[r];
#pragma unroll
      for (int n = 0; n < 4; ++n) {
        int c = nt * 128 + wc * 64 + n * 16 + fq * 4;
        f32x4 v = acc[m][n];
        *(bf16x4*)(((u16*)(P.ws + OFF_ye)) + (size_t)r * DM + c) = pack4(v[0] * gt, v[1] * gt, v[2] * gt, v[3] * gt);
      }
    }
  }
}

DI void phase_mix2(const Params& P, int l, int hb, char* smem, int ph) {
  const bool last = (l == 1);
  const int nA = 576, nG = 144, nS = 1152, nP = 576;
  for (;;) {
    const int it = wq_next(wq_ctr(P, ph), smem);
    if (it >= nA + nG + nS + nP) break;
    if (it < nA) {
      if (last && (it % 18) >= 16) continue;
      attn_item(P, l, hb, it, smem);
    } else if (it < nA + nG) {
      const int mt = it - nA;
      if (last && (mt % 18) >= 16) continue;
      sgu_item(P, l, hb, mt, smem);
    } else if (it < nA + nG + nS) {
      ssd_state_item(P, l, hb, it - nA - nG, smem);
    } else {
      const int t = it - nA - nG - nS;
      const int mt = t >> 2, g = t & 3;
      if (last && (mt % 18) >= 16) continue;
      pool_item(P, l, hb, mt, g, smem);
    }
  }
}

DI void phase_ssd_out(const Params& P, int l, int hb, char* smem, int ph) {
  const bool last = (l == 1);
  for (;;) {
    const int it = wq_next(wq_ctr(P, ph), smem);
    if (it >= 8 * 18 * 8) break;
    int jp = (it >> 3) % 18;
    if (last && jp >= 16) continue;
    ssd_out_item(P, l, hb, it, smem);
  }
}

#define XB_TMO      128
#define XB_XCNT(j)  (256  + 64 * (j))
#define XB_XSUB(j)  (1280 + 64 * (j))
#define XB_XGEN(j)  (2304 + 64 * (j))
#define XB_TOP      3328
#define XB_TOPGEN   3392
#define XCD_BAR_WORDS 3456
#define XB_SPIN_CAP (1u << 18)
#define LAS __attribute__((address_space(3)))

__device__ __forceinline__ unsigned xb_ld(unsigned* p)              { return __hip_atomic_load(p, __ATOMIC_RELAXED, __HIP_MEMORY_SCOPE_AGENT); }
__device__ __forceinline__ unsigned xb_add(unsigned* p, unsigned v) { return __hip_atomic_fetch_add(p, v, __ATOMIC_RELAXED, __HIP_MEMORY_SCOPE_AGENT); }
__device__ __forceinline__ unsigned xb_xcc_id() { return (unsigned)__builtin_amdgcn_s_getreg((3 << 11) | 20) & 0xFu; }
#define XB_SPIN(cond, bar) do { unsigned _sp = 0; while (cond) { __builtin_amdgcn_s_sleep(1); \
    if ((++_sp & 255u) == 0u) { if (xb_ld(&(bar)[XB_TMO])) break; if (_sp > XB_SPIN_CAP) { atomicAdd(&(bar)[XB_TMO], 1u); break; } } } } while (0)

struct XcdBarrier {
    unsigned* bar; unsigned x;
    volatile LAS unsigned* st;
};

__device__ __forceinline__ XcdBarrier xcd_barrier_post(unsigned* bar, volatile LAS unsigned* st) {
    XcdBarrier b; b.bar = bar; b.x = xb_xcc_id(); b.st = st;
    if (threadIdx.x == 0) (void)xb_add(&bar[XB_XCNT(b.x)], 1u);
    return b;
}
__device__ __forceinline__ void xcd_barrier_complete(unsigned* bar, unsigned x, unsigned& nloc, unsigned& nx) {
    const unsigned G = gridDim.x * gridDim.y * gridDim.z;
    unsigned sum, cnt, mine, sp = 0u;
    for (;;) {
        sum = 0u; cnt = 0u; mine = 0u;
#pragma unroll
        for (unsigned j = 0; j < 16; ++j) { const unsigned c = xb_ld(&bar[XB_XCNT(j)]); sum += c; cnt += (c > 0u) ? 1u : 0u; mine = (j == x) ? c : mine; }
        if (sum == G) break;
        __builtin_amdgcn_s_sleep(1);
        if ((++sp & 255u) == 0u) { if (xb_ld(&bar[XB_TMO])) break; if (sp > XB_SPIN_CAP) { atomicAdd(&bar[XB_TMO], 1u); break; } }
    }
    nloc = mine > 0u ? mine : 1u; nx = cnt > 0u ? cnt : 1u;
}

__device__ __forceinline__ void xcd_barrier(const XcdBarrier& b) {
    asm volatile("s_waitcnt vmcnt(0)" ::: "memory");
    __syncthreads();
    if (threadIdx.x == 0) {
        unsigned* bar = b.bar;
        __builtin_amdgcn_s_waitcnt(0);
        unsigned nloc = b.st[0], nx = b.st[1];
        if (nloc == 0u) { xcd_barrier_complete(bar, b.x, nloc, nx); b.st[0] = nloc; b.st[1] = nx; }
        const unsigned old = xb_add(&bar[XB_XSUB(b.x)], 1u);
        const unsigned gen = old / nloc;
        if (old + 1u == (gen + 1u) * nloc) {
            __builtin_amdgcn_fence(__ATOMIC_RELEASE, "agent");
            asm volatile("s_waitcnt vmcnt(0)" ::: "memory");
            const unsigned og = xb_add(&bar[XB_TOP], 1u);
            const unsigned tg = og / nx;
            if (og + 1u == (tg + 1u) * nx) xb_add(&bar[XB_TOPGEN], 1u);
            else XB_SPIN(xb_ld(&bar[XB_TOPGEN]) == tg, bar);
            __builtin_amdgcn_fence(__ATOMIC_ACQUIRE, "agent");
            xb_add(&bar[XB_XGEN(b.x)], 1u);
            asm volatile("s_waitcnt vmcnt(0)" ::: "memory");
        } else {
            XB_SPIN(xb_ld(&bar[XB_XGEN(b.x)]) == gen, bar);
            __builtin_amdgcn_fence(__ATOMIC_ACQUIRE, "agent");
            asm volatile("s_waitcnt vmcnt(0)" ::: "memory");
        }
    }
    __syncthreads();
}


template <bool COOP>
__global__ void __launch_bounds__(256, 2) mk_forward(Params P, int ph_begin, int ph_end) {
  __shared__ __attribute__((aligned(16))) char smem[SMEM_BYTES];
  int ph = 0;
  volatile LAS unsigned* xbst = (volatile LAS unsigned*)(smem + SMEM_BYTES - 16);
  XcdBarrier xb;
  if (COOP) {
    if (__builtin_amdgcn_workitem_id_x() == 0) { xbst[0] = 0u; xbst[1] = 0u; xbst[2] = 0u; xbst[3] = 0u; }
    __syncthreads();
    xb = xcd_barrier_post((unsigned*)(P.ws + OFF_bar), xbst);
  }
#define PHASE(code)                                         \
  {                                                         \
    if (ph >= ph_begin && ph < ph_end) { code; }            \
    ++ph;                                                   \
    if (COOP && ph > ph_begin && ph < ph_end) {             \
      if (ph == 1) cg::this_grid().sync();                  \
      else xcd_barrier(xb);                                 \
    }                                                       \
  }
  PHASE(phase_prologue(P, smem));
  PHASE(phase_h0(P));
#pragma unroll 1
  for (int l = 0; l < 2; ++l) {
#pragma unroll 1
    for (int hb = 0; hb < 2; ++hb) {
      PHASE(phase_proj(P, l, hb, smem, ph));
      PHASE(phase_ssd_prep(P, l, hb, smem, ph));
      PHASE(phase_mix2(P, l, hb, smem, ph));
      PHASE(phase_carry(P));
      PHASE(phase_ssd_out(P, l, hb, smem, ph));
    }
    PHASE(phase_merge(P, l, smem, ph));
    PHASE(phase_outproj(P, l, smem, ph));
    PHASE(phase_ln1(P, l, smem));
    PHASE(phase_topk(P, l, smem));
    PHASE(phase_ffn1(P, l, smem, ph));
    PHASE(phase_ffn2(P, l, smem, ph));
    PHASE(phase_ln2(P, l));
  }
#undef PHASE
}

#ifndef MK_COOP
#define MK_COOP 1
#endif

extern "C" void kernel_launch(void* const* d_in, const int* in_sizes, int n_in, void* d_out, int out_size, void* d_ws, size_t ws_size,
                              hipStream_t stream) {
  Params p{};
  const float* const* in = (const float* const*)d_in;
  p.x = in[0]; p.c = in[1]; p.ctx = in[2]; p.c_ctx = in[3]; p.w_mod = in[4]; p.b_mod = in[5]; p.w_in = in[6]; p.conv_w = in[7];
  p.conv_b = in[8]; p.a_log = in[9]; p.dt_bias = in[10]; p.ssd_d = in[11]; p.ssd_norm_g = in[12]; p.diff_lambda = in[13];
  p.diff_norm_g = in[14]; p.pool_w = in[15]; p.pool_scale = in[16]; p.sgu_ln_g = in[17]; p.sgu_ln_b = in[18]; p.sgu_w = in[19];
  p.sgu_b = in[20]; p.w_gate = in[21]; p.w_branch = in[22]; p.w_out = in[23]; p.ln1_g = in[24]; p.ln1_b = in[25]; p.w_router = in[26];
  p.w1 = in[27]; p.w3 = in[28]; p.w2 = in[29]; p.ln2_g = in[30]; p.ln2_b = in[31];
  p.out = (float*)d_out;
  p.ws = (char*)d_ws;
  if (WS_NEED > ws_size) { fprintf(stderr, "workspace too small: need %zu have %zu\n", (size_t)WS_NEED, ws_size); return; }

  static int grid_blocks = 0;
  if (!grid_blocks) {
    int dev = 0, cus = 0, per_cu = 0;
    hipGetDevice(&dev);
    hipDeviceGetAttribute(&cus, hipDeviceAttributeMultiprocessorCount, dev);
    if (MK_COOP) hipOccupancyMaxActiveBlocksPerMultiprocessor(&per_cu, mk_forward<true>, 256, 0);
    else hipOccupancyMaxActiveBlocksPerMultiprocessor(&per_cu, mk_forward<false>, 256, 0);
    if (per_cu < 1) per_cu = 1;
    if (per_cu > 2) per_cu = 2;
    grid_blocks = cus * per_cu;
  }
#if MK_COOP
  hipMemsetAsync((char*)d_ws + OFF_bar, 0, 32768, stream);
  int b = 0, e = NPHASE;
  void* args[] = {&p, &b, &e};
  hipError_t err = hipLaunchCooperativeKernel((void*)mk_forward<true>, dim3(grid_blocks), dim3(256), args, 0, stream);
  if (err != hipSuccess) fprintf(stderr, "cooperative launch failed: %s (grid %d)\n", hipGetErrorString(err), grid_blocks);
#else
  for (int ph = 0; ph < NPHASE; ++ph) hipLaunchKernelGGL(mk_forward<false>, dim3(grid_blocks), dim3(256), 0, stream, p, ph, ph + 1);
#endif
}
```

```cpp
#include <hip/hip_runtime.h>
#include <hip/hip_cooperative_groups.h>
#include <cstdio>
#include <cstdint>
namespace cg = cooperative_groups;

typedef unsigned short u16;
using bf16x8 = __attribute__((ext_vector_type(8))) short;
using bf16x4 = __attribute__((ext_vector_type(4))) short;
using f32x4 = __attribute__((ext_vector_type(4))) float;
using u32x4 = __attribute__((ext_vector_type(4))) unsigned;

#define DI __device__ __forceinline__
#define MFMA16(a, b, c) __builtin_amdgcn_mfma_f32_16x16x32_bf16((a), (b), (c), 0, 0, 0)

constexpr int NB = 16, SEQ = 2048, CTXL = 256, SP = 2304, NTOK = NB * SP, DM = 1024;
constexpr int HROWS = 8 * SP;
constexpr int INC = 4368, INP = 4480;
constexpr int NFFN_LAT = 65536, NFFN_ALL = 73728;
constexpr float LN_EPS = 1e-5f;
constexpr float ALPHA = 1.41421356237309515f;
constexpr int SMEM_BYTES = 81920;
constexpr int NPHASE = 2 + 2 * (2 * 5 + 7);


constexpr size_t al256(size_t x) { return (x + 255) & ~(size_t)255; }
constexpr size_t U_ = (size_t)NTOK * 512 * 2;
constexpr size_t OFF_WinT = 0;
constexpr size_t OFF_WgT = OFF_WinT + al256((size_t)2 * INP * 1024 * 2);
constexpr size_t OFF_WbT = OFF_WgT + al256((size_t)2 * 4 * 1024 * 1024 * 2);
constexpr size_t OFF_WoT = OFF_WbT + al256((size_t)2 * 4 * 1024 * 512 * 2);
constexpr size_t OFF_poolT = OFF_WoT + al256((size_t)2 * 1024 * 1024 * 2);
constexpr size_t OFF_sguW = OFF_poolT + al256((size_t)2 * 4 * 128 * 128 * 2);
constexpr size_t OFF_mod = OFF_sguW + al256((size_t)2 * 4 * 128 * 128 * 2);
constexpr size_t OFF_rope = OFF_mod + al256((size_t)2 * 17 * 6144 * 4);
constexpr size_t OFF_lamv = OFF_rope + al256(64 * 16 * 2 * 4);
constexpr size_t OFF_bar = OFF_lamv + 256;
constexpr size_t OFF_aff = OFF_bar + 32768;
constexpr size_t OFF_rank = OFF_aff + al256((size_t)NTOK * 16 * 4);
constexpr size_t OFF_ssq = OFF_rank + al256((size_t)NTOK * 16 * 4);
constexpr size_t OFF_tokidx = OFF_ssq + al256((size_t)NTOK * 8 * 4);
constexpr size_t OFF_gatev = OFF_tokidx + al256((size_t)NFFN_ALL * 4);
constexpr size_t OFF_dtbuf = OFF_gatev + al256((size_t)NFFN_ALL * 4);
constexpr size_t OFF_decay = OFF_dtbuf + al256((size_t)HROWS * 16 * 4);
constexpr size_t OFF_H = OFF_decay + al256((size_t)8 * 2 * 8 * 18 * 4);
constexpr size_t OFF_Y = OFF_H + 2 * U_;
constexpr size_t OFF_xsT = OFF_Y;
constexpr size_t OFF_cstate = OFF_Y + U_ / 2;
constexpr size_t OFF_enter = OFF_Y + U_;
constexpr size_t OFF_bm = OFF_Y + U_ + U_ / 2;
constexpr size_t OFF_cm = OFF_bm + U_ / 8;
constexpr size_t OFF_bmT = OFF_cm + U_ / 8;
constexpr size_t OFF_RM = OFF_Y + 2 * U_;
constexpr size_t OFF_xp = OFF_RM;
constexpr size_t OFF_z = OFF_xp + U_ / 2;
constexpr size_t OFF_xbc = OFF_z + U_ / 2;
constexpr size_t OFF_o1 = OFF_xbc;
constexpr size_t OFF_q = OFF_xbc + (U_ / 4) * 3;
constexpr size_t OFF_k = OFF_q + U_ / 2;
constexpr size_t OFF_vT = OFF_k + U_ / 2;
constexpr size_t OFF_gvT = OFF_vT + U_ / 2;
constexpr size_t OFF_br0 = OFF_gvT + U_ / 2;
constexpr size_t OFF_br1 = OFF_br0 + U_;
constexpr size_t OFF_br2 = OFF_br1 + U_;
constexpr size_t OFF_br3 = OFF_br2 + U_;
constexpr size_t OFF_acc = OFF_RM;
constexpr size_t OFF_W13T = OFF_RM;
constexpr size_t OFF_W2T = OFF_W13T + (size_t)16 * 1024 * 1024 * 2;
constexpr size_t OFF_hid = OFF_W2T + (size_t)16 * 1024 * 512 * 2;
constexpr size_t OFF_ye = OFF_hid + (size_t)NFFN_ALL * 512 * 2;
constexpr size_t WS_MIX_END = OFF_br3 + U_;
constexpr size_t WS_FFN_END = OFF_ye + (size_t)NFFN_ALL * 1024 * 2;
constexpr size_t WS_NEED = WS_MIX_END > WS_FFN_END ? WS_MIX_END : WS_FFN_END;

struct Params {
  const float *x, *c, *ctx, *c_ctx, *w_mod, *b_mod, *w_in, *conv_w, *conv_b, *a_log, *dt_bias, *ssd_d, *ssd_norm_g,
      *diff_lambda, *diff_norm_g, *pool_w, *pool_scale, *sgu_ln_g, *sgu_ln_b, *sgu_w, *sgu_b, *w_gate, *w_branch, *w_out,
      *ln1_g, *ln1_b, *w_router, *w1, *w3, *w2, *ln2_g, *ln2_b;
  float* out;
  char* ws;
};

DI int TID() { int t = (int)__builtin_amdgcn_workitem_id_x(); asm volatile("" : "+v"(t)); return t; }
typedef __bf16 bf2_t __attribute__((ext_vector_type(2)));
typedef float f2_t __attribute__((ext_vector_type(2)));
typedef unsigned u32x2 __attribute__((ext_vector_type(2)));
DI unsigned pack2(float a, float b) { f2_t v = {a, b}; return __builtin_bit_cast(unsigned, __builtin_convertvector(v, bf2_t)); }
DI u16 f2bf(float x) { return (u16)(pack2(x, 0.f) & 0xffffu); }
DI float bf2f(u16 v) { return __uint_as_float(((unsigned)v) << 16); }
DI float bflo(unsigned p) { return __uint_as_float(p << 16); }
DI float bfhi(unsigned p) { return __uint_as_float(p & 0xffff0000u); }
DI float sigmoidf_(float x) { return __builtin_amdgcn_rcpf(1.f + __expf(-x)); }
DI float siluf_(float x) { return x * __builtin_amdgcn_rcpf(1.f + __expf(-x)); }
DI float geluf_(float x) { float y = 0.7978845608028654f * (x + 0.044715f * x * x * x); float t = 1.f - 2.f * __builtin_amdgcn_rcpf(__expf(2.f * y) + 1.f); return 0.5f * x * (1.f + t); }
DI float softplusf_(float x) { return x > 20.f ? x : log1pf(__expf(x)); }
DI bf16x4 pack4(float a, float b, float c, float d) { u32x2 r = {pack2(a, b), pack2(c, d)}; return __builtin_bit_cast(bf16x4, r); }
DI bf16x4 pack4v(f32x4 v) { return pack4(v[0], v[1], v[2], v[3]); }
DI float wave_sum(float v) { for (int o = 32; o > 0; o >>= 1) v += __shfl_xor(v, o); return v; }

template <int MI, int NI, bool SWAP, bool LOWREG = false>
DI void mma_lds(const u16* As, int lda, const u16* Bs, int ldb, int ksteps, f32x4 (&acc)[MI][NI], int fr, int fq) {
  for (int ks = 0; ks < ksteps; ++ks) {
    if (LOWREG) __builtin_amdgcn_sched_barrier(0);
    bf16x8 a[MI], b[NI];
#pragma unroll
    for (int m = 0; m < MI; ++m) a[m] = *(const bf16x8*)(As + (m * 16 + fr) * lda + ks * 32 + fq * 8);
#pragma unroll
    for (int n = 0; n < NI; ++n) b[n] = *(const bf16x8*)(Bs + (n * 16 + fr) * ldb + ks * 32 + fq * 8);
#pragma unroll
    for (int m = 0; m < MI; ++m)
#pragma unroll
      for (int n = 0; n < NI; ++n) acc[m][n] = SWAP ? MFMA16(b[n], a[m], acc[m][n]) : MFMA16(a[m], b[n], acc[m][n]);
  }
}

constexpr int LDT = 72;
template <int NI, bool SWAP, bool GATHER, bool PF2 = true>
DI void gemm_main(const u16* __restrict__ A, int lda, const int* __restrict__ aidx, int arow0, const u16* __restrict__ Bt, int ldb, int brow0,
                  int K, f32x4 (&acc)[4][NI], u16* smem) {
  constexpr int BN = NI * 32;
  constexpr int NBL = BN / 32;
  const int tid = TID(), wave = tid >> 6, lane = tid & 63, fr = lane & 15, fq = lane >> 4;
  const int wr = wave >> 1, wc = wave & 1;
  u16* As = smem;
  u16* Bs = smem + 2 * 128 * LDT;
  const int lr = tid >> 3, lc = (tid & 7) * 8;
  const u16* ap[4];
#pragma unroll
  for (int i = 0; i < 4; ++i) {
    int r = arow0 + lr + 32 * i;
    size_t rr = GATHER ? (size_t)aidx[r] : (size_t)r;
    ap[i] = A + rr * lda + lc;
  }
  const u16* bp = Bt + (size_t)(brow0 + lr) * ldb + lc;
  u32x4 ra0[4], rb0[NBL], ra1[4], rb1[NBL];
  const int nk = K / 64;
#define GLOAD(RA, RB, KO)                                                                   \
  {                                                                                         \
    _Pragma("unroll") for (int i = 0; i < 4; ++i) RA[i] = *(const u32x4*)(ap[i] + (KO));    \
    _Pragma("unroll") for (int i = 0; i < NBL; ++i) RB[i] = *(const u32x4*)(bp + (size_t)(32 * i) * ldb + (KO)); \
  }
#define SSTORE_A(RA, BUF) { _Pragma("unroll") for (int i = 0; i < 4; ++i) *(u32x4*)(As + (BUF) * 128 * LDT + (lr + 32 * i) * LDT + lc) = RA[i]; }
#define SSTORE_B(RB, BUF) { _Pragma("unroll") for (int i = 0; i < NBL; ++i) *(u32x4*)(Bs + (BUF) * BN * LDT + (lr + 32 * i) * LDT + lc) = RB[i]; }
#define SSTORE(RA, RB, BUF) { SSTORE_A(RA, BUF) SSTORE_B(RB, BUF) }
#define COMPUTE(BUF) mma_lds<4, NI, SWAP, !PF2>(As + (BUF) * 128 * LDT + wr * 64 * LDT, LDT, Bs + (BUF) * BN * LDT + wc * (NI * 16) * LDT, LDT, 2, acc, fr, fq)
#define COMPUTE_KS(BUF, KS) mma_lds<4, NI, SWAP, false>(As + (BUF) * 128 * LDT + wr * 64 * LDT + (KS) * 32, LDT, Bs + (BUF) * BN * LDT + wc * (NI * 16) * LDT + (KS) * 32, LDT, 1, acc, fr, fq)
  if (PF2) {
    GLOAD(ra0, rb0, 0);
    GLOAD(ra1, rb1, 64);
    __syncthreads();
    SSTORE(ra0, rb0, 0);
    __syncthreads();
    for (int kt = 0; kt < nk; kt += 2) {
      if (kt + 2 < nk) GLOAD(ra0, rb0, (kt + 2) * 64);
      COMPUTE_KS(0, 0);
      SSTORE_A(ra1, 1);
      COMPUTE_KS(0, 1);
      SSTORE_B(rb1, 1);
      __syncthreads();
      if (kt + 3 < nk) GLOAD(ra1, rb1, (kt + 3) * 64);
      COMPUTE_KS(1, 0);
      if (kt + 2 < nk) SSTORE_A(ra0, 0);
      COMPUTE_KS(1, 1);
      if (kt + 2 < nk) SSTORE_B(rb0, 0);
      __syncthreads();
    }
  } else {
    GLOAD(ra0, rb0, 0);
    __syncthreads();
    SSTORE(ra0, rb0, 0);
    __syncthreads();
    for (int kt = 0; kt < nk; kt += 2) {
      GLOAD(ra0, rb0, (kt + 1) * 64);
      COMPUTE(0);
      SSTORE(ra0, rb0, 1);
      __syncthreads();
      if (kt + 2 < nk) GLOAD(ra0, rb0, (kt + 2) * 64);
      COMPUTE(1);
      if (kt + 2 < nk) SSTORE(ra0, rb0, 0);
      __syncthreads();
    }
  }
#undef GLOAD
#undef SSTORE
#undef COMPUTE
#undef COMPUTE_KS
#undef SSTORE_A
#undef SSTORE_B
}

template <int NI> DI void zero_acc(f32x4 (&a)[4][NI]) {
#pragma unroll
  for (int m = 0; m < 4; ++m)
#pragma unroll
    for (int n = 0; n < NI; ++n) a[m][n] = f32x4{0.f, 0.f, 0.f, 0.f};
}

DI void cvt_tile(const float* __restrict__ src0, const float* __restrict__ src1, int ld, u16* __restrict__ dst, int K, int n0, int k0, int mode, u16* lds) {
  const int tid = TID();
  constexpr int LC = 66;
  __syncthreads();
  float v[16];
  if (mode == 3) {
#pragma unroll
    for (int i = 0; i < 16; ++i) { int idx = tid + 256 * i; int n = idx >> 6, kk = idx & 63; v[i] = src0[(size_t)(n0 + n) * ld + k0 + kk]; }
#pragma unroll
    for (int i = 0; i < 16; ++i) { int idx = tid + 256 * i; int n = idx >> 6, kk = idx & 63; lds[kk * LC + n] = f2bf(v[i]); }
  } else {
#pragma unroll
    for (int i = 0; i < 16; ++i) {
      int idx = tid + 256 * i;
      int kk = idx >> 6, n = idx & 63;
      int nn = n0 + n;
      float t = 0.f;
      if (mode == 0) t = src0[(size_t)(k0 + kk) * ld + nn];
      else if (mode == 1) {
        int col = nn < 1792 ? nn : (nn < 4352 ? nn + 16 : (nn < 4368 ? nn - 4352 + 1792 : -1));
        if (col >= 0) t = src0[(size_t)(k0 + kk) * ld + col];
        if (nn >= 1792 && nn < 2304) t *= 0.125f;
      } else {
        int g = nn >> 5, r = nn & 31;
        t = (r < 16) ? src0[(size_t)(k0 + kk) * ld + g * 16 + r] : src1[(size_t)(k0 + kk) * ld + g * 16 + r - 16];
      }
      v[i] = t;
    }
#pragma unroll
    for (int i = 0; i < 16; ++i) { int idx = tid + 256 * i; int kk = idx >> 6, n = idx & 63; lds[kk * LC + n] = f2bf(v[i]); }
  }
  __syncthreads();
  for (int c = tid; c < 512; c += 256) {
    int n = c & 63, kc = (c >> 6) * 8;
    bf16x8 o;
#pragma unroll
    for (int j = 0; j < 8; ++j) o[j] = (short)lds[(kc + j) * LC + n];
    *(bf16x8*)(dst + (size_t)(n0 + n) * K + k0 + kc) = o;
  }
}

DI void mod_item(const Params& P, int item, char* smem) {
  const int l = item / 96, n0 = (item % 96) * 64;
  float* sc = (float*)smem;
  const int tid = TID();
  __syncthreads();
  for (int i = tid; i < 17 * 1024; i += 256) {
    int s = i >> 10, kk = i & 1023;
    float v = s < 16 ? P.c[s * 1024 + kk] : P.c_ctx[kk];
    sc[i] = siluf_(v);
  }
  __syncthreads();
  const int col = tid & 63, kp = tid >> 6;
  float a[17];
#pragma unroll
  for (int s = 0; s < 17; ++s) a[s] = 0.f;
  const float* w = P.w_mod + (size_t)l * 1024 * 6144 + n0 + col;
  for (int k0 = kp * 256; k0 < kp * 256 + 256; k0 += 16) {
    float wv[16];
#pragma unroll
    for (int u = 0; u < 16; ++u) wv[u] = w[(size_t)(k0 + u) * 6144];
#pragma unroll
    for (int u = 0; u < 16; ++u)
#pragma unroll
      for (int s = 0; s < 17; ++s) a[s] += sc[s * 1024 + k0 + u] * wv[u];
  }
  __syncthreads();
  float* red = (float*)smem;
#pragma unroll
  for (int s = 0; s < 17; ++s) red[(kp * 17 + s) * 64 + col] = a[s];
  __syncthreads();
  for (int i = tid; i < 17 * 64; i += 256) {
    int s = i >> 6, cc = i & 63;
    float v = red[(0 * 17 + s) * 64 + cc] + red[(1 * 17 + s) * 64 + cc] + red[(2 * 17 + s) * 64 + cc] + red[(3 * 17 + s) * 64 + cc];
    ((float*)(P.ws + OFF_mod))[((size_t)l * 17 + s) * 6144 + n0 + cc] = v + P.b_mod[l * 6144 + n0 + cc];
  }
}

DI void misc_item(const Params& P) {
  const int tid = TID();
  for (int i = tid; i < 1024; i += 256) {
    int pos = i >> 4, f = i & 15;
    float inv = powf(10000.f, -(float)f / 16.f);
    float ang = (float)pos * inv;
    ((float*)(P.ws + OFF_rope))[i * 2] = cosf(ang);
    ((float*)(P.ws + OFF_rope))[i * 2 + 1] = sinf(ang);
  }
  if (tid < 2) {
    const float* dl = P.diff_lambda + tid * 256;
    float s1 = 0.f, s2 = 0.f;
    for (int i = 0; i < 64; ++i) { s1 += dl[i] * dl[64 + i]; s2 += dl[128 + i] * dl[192 + i]; }
    float lam_init = 0.8f - 0.6f * expf(-0.3f * (float)tid);
    ((float*)(P.ws + OFF_lamv))[tid * 2] = expf(s1) - expf(s2) + lam_init;
    ((float*)(P.ws + OFF_lamv))[tid * 2 + 1] = lam_init;
  }
}

DI void phase_prologue(const Params& P, char* smem) {
  const int per_layer = 1120 + 4 * 256 + 4 * 128 + 256 + 16 + 16;
  const int ncvt = 2 * per_layer;
  const int total = ncvt + 192 + 1;
  for (int it0 = blockIdx.x; it0 < total; it0 += gridDim.x) {
    const int it = it0 < 193 ? ncvt + it0 : it0 - 193;
    if (it < ncvt) {
      const int l = it / per_layer;
      int t = it % per_layer;
      const float* s0; u16* dst; int ld, K, ntk, mode;
      if (t < 1120) { s0 = P.w_in + (size_t)l * 1024 * INC; ld = INC; dst = ((u16*)(P.ws + OFF_WinT)) + (size_t)l * INP * 1024; K = 1024; ntk = 16; mode = 1; }
      else if (t < 2144) { t -= 1120; int kq = t >> 8; t &= 255; s0 = P.w_gate + ((size_t)l * 4 + kq) * 1024 * 1024; ld = 1024; dst = ((u16*)(P.ws + OFF_WgT)) + ((size_t)l * 4 + kq) * 1024 * 1024; K = 1024; ntk = 16; mode = 0; }
      else if (t < 2656) { t -= 2144; int kq = t >> 7; t &= 127; s0 = P.w_branch + ((size_t)l * 4 + kq) * 512 * 1024; ld = 1024; dst = ((u16*)(P.ws + OFF_WbT)) + ((size_t)l * 4 + kq) * 1024 * 512; K = 512; ntk = 8; mode = 0; }
      else if (t < 2912) { t -= 2656; s0 = P.w_out + (size_t)l * 1024 * 1024; ld = 1024; dst = ((u16*)(P.ws + OFF_WoT)) + (size_t)l * 1024 * 1024; K = 1024; ntk = 16; mode = 0; }
      else if (t < 2928) { t -= 2912; int g = t >> 2; t &= 3; s0 = P.pool_w + ((size_t)l * 4 + g) * 128 * 128; ld = 128; dst = ((u16*)(P.ws + OFF_poolT)) + ((size_t)l * 4 + g) * 128 * 128; K = 128; ntk = 2; mode = 0; }
      else { t -= 2928; int g = t >> 2; t &= 3; s0 = P.sgu_w + ((size_t)l * 4 + g) * 128 * 128; ld = 128; dst = ((u16*)(P.ws + OFF_sguW)) + ((size_t)l * 4 + g) * 128 * 128; K = 128; ntk = 2; mode = 3; }
      const int tn = t / ntk, tk = t % ntk;
      cvt_tile(s0, s0, ld, dst, K, tn * 64, tk * 64, mode, (u16*)smem);
    } else if (it < ncvt + 192) {
      mod_item(P, it - ncvt, smem);
    } else {
      misc_item(P);
    }
  }
}

DI void ffn_cvt_item(const Params& P, int l, int it, char* smem) {
  const int e = it / 384;
  int t = it % 384;
  if (t < 256) {
    cvt_tile(P.w1 + ((size_t)l * 16 + e) * 1024 * 512, P.w3 + ((size_t)l * 16 + e) * 1024 * 512, 512, ((u16*)(P.ws + OFF_W13T)) + (size_t)e * 1024 * 1024, 1024, (t >> 4) * 64, (t & 15) * 64, 2, (u16*)smem);
  } else {
    t -= 256;
    const float* s = P.w2 + ((size_t)l * 16 + e) * 512 * 1024;
    cvt_tile(s, s, 1024, ((u16*)(P.ws + OFF_W2T)) + (size_t)e * 1024 * 512, 512, (t >> 3) * 64, (t & 7) * 64, 0, (u16*)smem);
  }
}

DI void load_row_f32(const float* p, int lane, float (&v)[16]) {
#pragma unroll
  for (int k = 0; k < 4; ++k) { float4 t = *(const float4*)(p + lane * 4 + 256 * k); v[4 * k] = t.x; v[4 * k + 1] = t.y; v[4 * k + 2] = t.z; v[4 * k + 3] = t.w; }
}
DI void load_row_bf16(const u16* p, int lane, float (&v)[16]) {
#pragma unroll
  for (int k = 0; k < 4; ++k) { bf16x4 t = *(const bf16x4*)(p + lane * 4 + 256 * k); for (int i = 0; i < 4; ++i) v[4 * k + i] = bf2f((u16)t[i]); }
}
DI void store_row_f32(float* p, int lane, const float (&v)[16]) {
#pragma unroll
  for (int k = 0; k < 4; ++k) *(float4*)(p + lane * 4 + 256 * k) = make_float4(v[4 * k], v[4 * k + 1], v[4 * k + 2], v[4 * k + 3]);
}
DI void store_row_bf16(u16* p, int lane, const float (&v)[16]) {
#pragma unroll
  for (int k = 0; k < 4; ++k) *(bf16x4*)(p + lane * 4 + 256 * k) = pack4(v[4 * k], v[4 * k + 1], v[4 * k + 2], v[4 * k + 3]);
}
DI void ln_row(float (&v)[16], const float* g, const float* b, int lane) {
  float s = 0.f;
#pragma unroll
  for (int i = 0; i < 16; ++i) s += v[i];
  float mu = wave_sum(s) * (1.f / 1024.f);
  float q = 0.f;
#pragma unroll
  for (int i = 0; i < 16; ++i) { float d = v[i] - mu; q += d * d; }
  float rstd = rsqrtf(wave_sum(q) * (1.f / 1024.f) + LN_EPS);
  float gg[16], bb[16];
  load_row_f32(g, lane, gg); load_row_f32(b, lane, bb);
#pragma unroll
  for (int i = 0; i < 16; ++i) v[i] = (v[i] - mu) * rstd * gg[i] + bb[i];
}

DI void phase_h0(const Params& P) {
  const int lane = TID() & 63;
  const int gw = blockIdx.x * 4 + (TID() >> 6), nw = gridDim.x * 4;
  for (int row = gw; row < NTOK; row += nw) {
    int s = row / SP, p = row % SP;
    bool lat = p < SEQ;
    const float* xs = lat ? P.x + ((size_t)s * SEQ + p) * DM : P.ctx + ((size_t)s * CTXL + (p - SEQ)) * DM;
    const float* md = ((float*)(P.ws + OFF_mod)) + (size_t)(lat ? s : 16) * 6144;
    float v[16], sh[16], scl[16];
    load_row_f32(xs, lane, v); load_row_f32(md, lane, sh); load_row_f32(md + 1024, lane, scl);
#pragma unroll
    for (int i = 0; i < 16; ++i) v[i] = v[i] * (1.f + scl[i]) + sh[i];
    store_row_bf16(((u16*)(P.ws + OFF_H)) + (size_t)row * DM, lane, v);
  }
}

DI void compute_x1(const Params& P, int l, int row, int lane, float (&v)[16]) {
  int s = row / SP, p = row % SP;
  bool lat = p < SEQ;
  const float* xs;
  if (l == 0) xs = lat ? P.x + ((size_t)s * SEQ + p) * DM : P.ctx + ((size_t)s * CTXL + (p - SEQ)) * DM;
  else xs = P.out + ((size_t)s * SEQ + p) * DM;
  const float* md = ((float*)(P.ws + OFF_mod)) + ((size_t)l * 17 + (lat ? s : 16)) * 6144;
  float y[16], m2[16];
  load_row_f32(xs, lane, v); load_row_bf16(((u16*)(P.ws + OFF_Y)) + (size_t)row * DM, lane, y); load_row_f32(md + 2 * 1024, lane, m2);
#pragma unroll
  for (int i = 0; i < 16; ++i) v[i] = ALPHA * v[i] + m2[i] * y[i];
  ln_row(v, P.ln1_g + l * 1024, P.ln1_b + l * 1024, lane);
}

DI void phase_ln1(const Params& P, int l, char* smem) {
  const bool last = (l == 1);
  const int tid = TID();
  const int lane = tid & 63;
  const int gw = blockIdx.x * 4 + (tid >> 6), nw = gridDim.x * 4;
  float* wT = (float*)smem;
  __syncthreads();
  {
    const float* wr = P.w_router + (size_t)l * 1024 * 16;
    for (int i = tid; i < 4096; i += 256) {
      int c = i >> 2, e4 = (i & 3) * 4;
      float4 w = *(const float4*)(wr + (size_t)c * 16 + e4);
      wT[(e4 + 0) * 1024 + c] = w.x; wT[(e4 + 1) * 1024 + c] = w.y; wT[(e4 + 2) * 1024 + c] = w.z; wT[(e4 + 3) * 1024 + c] = w.w;
    }
  }
  __syncthreads();
  for (int row = gw; row < NTOK; row += nw) {
    int s = row / SP, p = row % SP;
    bool lat = p < SEQ;
    if (last && !lat) continue;
    float v[16];
    compute_x1(P, l, row, lane, v);
    const float* md = ((float*)(P.ws + OFF_mod)) + ((size_t)l * 17 + (lat ? s : 16)) * 6144;
    float m3[16], m4[16];
    load_row_f32(md + 3 * 1024, lane, m3); load_row_f32(md + 4 * 1024, lane, m4);
#pragma unroll
    for (int i = 0; i < 16; ++i) v[i] = v[i] * (1.f + m4[i]) + m3[i];
    store_row_bf16(((u16*)(P.ws + OFF_H)) + (size_t)row * DM, lane, v);
    float lg[16];
#pragma unroll
    for (int e = 0; e < 16; ++e) {
      float a = 0.f;
#pragma unroll
      for (int k = 0; k < 4; ++k) {
        float4 w = *(const float4*)(wT + e * 1024 + lane * 4 + 256 * k);
        a += v[4 * k] * w.x + v[4 * k + 1] * w.y + v[4 * k + 2] * w.z + v[4 * k + 3] * w.w;
      }
      lg[e] = a;
    }
#pragma unroll
    for (int e = 0; e < 16; ++e) lg[e] = wave_sum(lg[e]);
    float mx = lg[0];
#pragma unroll
    for (int e = 1; e < 16; ++e) mx = fmaxf(mx, lg[e]);
    float sum = 0.f;
#pragma unroll
    for (int e = 0; e < 16; ++e) { lg[e] = expf(lg[e] - mx); sum += lg[e]; }
    float inv = 1.f / sum;
    if (lane < 16) {
      float mine = 0.f;
#pragma unroll
      for (int e = 0; e < 16; ++e) if (lane == e) mine = lg[e];
      ((float*)(P.ws + OFF_aff))[(size_t)row * 16 + lane] = mine * inv;
    }
  }
}

DI int block_excl_scan(int v, int* red, int tid, int& total) {
  const int lane = tid & 63, wave = tid >> 6;
  int inc = v;
#pragma unroll
  for (int o = 1; o < 64; o <<= 1) { int t = __shfl_up(inc, o); if (lane >= o) inc += t; }
  __syncthreads();
  if (lane == 63) red[wave] = inc;
  __syncthreads();
  int base = 0;
#pragma unroll
  for (int w = 0; w < 4; ++w) { int t = red[w]; if (w < wave) base += t; }
  total = red[0] + red[1] + red[2] + red[3];
  return base + inc - v;
}

DI void phase_topk(const Params& P, int l, char* smem) {
  const bool last = (l == 1);
  const int tid = TID();
  unsigned* keys = (unsigned*)smem;
  int* red = (int*)(smem + 8192);
  const int nitems = last ? 256 : 512;
  for (int it = gridDim.x - 1 - blockIdx.x; it < 16 * 384; it += gridDim.x) ffn_cvt_item(P, l, it, smem);
  for (int it = blockIdx.x; it < nitems; it += gridDim.x) {
    const bool isctx = it >= 256;
    const int se = it & 255, s = se >> 4, e = se & 15;
    const int n = isctx ? CTXL : SEQ, cap = isctx ? 32 : 256;
    const int row0 = s * SP + (isctx ? SEQ : 0);
    const int per = n >> 8;
    __syncthreads();
    for (int i = tid; i < n; i += 256) keys[i] = __float_as_uint(((float*)(P.ws + OFF_aff))[(size_t)(row0 + i) * 16 + e]);
    __syncthreads();
    unsigned kv[8];
#pragma unroll
    for (int j = 0; j < 8; ++j) kv[j] = (j < per) ? keys[tid * per + j] : 0u;
    unsigned prefix = 0u;
    int krem = cap;
    for (int bit = 31; bit >= 0; --bit) {
      const unsigned himask = (bit == 31) ? 0u : (0xFFFFFFFFu << (bit + 1));
      const unsigned want = prefix | (1u << bit);
      int c = 0;
#pragma unroll
      for (int j = 0; j < 8; ++j) c += (j < per && ((kv[j] & (himask | (1u << bit))) == want)) ? 1 : 0;
      c = (int)wave_sum((float)c);
      __syncthreads();
      if ((tid & 63) == 0) red[tid >> 6] = c;
      __syncthreads();
      const int cnt = red[0] + red[1] + red[2] + red[3];
      if (cnt >= krem) prefix = want; else krem -= cnt;
    }
    const unsigned T = prefix;
    int cgt = 0, ceq = 0;
#pragma unroll
    for (int j = 0; j < 8; ++j) if (j < per) { cgt += kv[j] > T ? 1 : 0; ceq += kv[j] == T ? 1 : 0; }
    int tot_gt, tot_eq, tot_sel;
    (void)block_excl_scan(cgt, red, tid, tot_gt);
    const int eq_before = block_excl_scan(ceq, red, tid, tot_eq);
    const int need_eq = cap - tot_gt;
    int eqc = eq_before, csel = 0;
    bool sel[8];
#pragma unroll
    for (int j = 0; j < 8; ++j) {
      sel[j] = false;
      if (j < per) {
        if (kv[j] > T) sel[j] = true;
        else if (kv[j] == T) { sel[j] = eqc < need_eq; ++eqc; }
        csel += sel[j] ? 1 : 0;
      }
    }
    int slot = block_excl_scan(csel, red, tid, tot_sel);
#pragma unroll
    for (int j = 0; j < 8; ++j) if (j < per) {
      const int t = tid * per + j;
      int rk = cap;
      if (sel[j]) {
        rk = slot++;
        const int R = isctx ? NFFN_LAT + (e * 16 + s) * 32 + rk : (s * 16 + e) * 256 + rk;
        ((int*)(P.ws + OFF_tokidx))[R] = row0 + t;
        ((float*)(P.ws + OFF_gatev))[R] = __uint_as_float(kv[j]);
      }
      ((int*)(P.ws + OFF_rank))[(size_t)(row0 + t) * 16 + e] = rk;
    }
  }
}

DI void phase_ln2(const Params& P, int l) {
  const bool last = (l == 1);
  const int lane = TID() & 63;
  const int gw = blockIdx.x * 4 + (TID() >> 6), nw = gridDim.x * 4;
  for (int row = gw; row < NTOK; row += nw) {
    int s = row / SP, p = row % SP;
    bool lat = p < SEQ;
    if (last && !lat) continue;
    float v[16];
    compute_x1(P, l, row, lane, v);
    float yf[16];
#pragma unroll
    for (int i = 0; i < 16; ++i) yf[i] = 0.f;
    const int cap = lat ? 256 : 32;
    for (int e = 0; e < 16; ++e) {
      int rk = ((int*)(P.ws + OFF_rank))[(size_t)row * 16 + e];
      if (rk < cap) {
        int R = lat ? (s * 16 + e) * 256 + rk : NFFN_LAT + (e * 16 + s) * 32 + rk;
        float t[16];
        load_row_bf16(((u16*)(P.ws + OFF_ye)) + (size_t)R * DM, lane, t);
#pragma unroll
        for (int i = 0; i < 16; ++i) yf[i] += t[i];
      }
    }
    const float* md = ((float*)(P.ws + OFF_mod)) + ((size_t)l * 17 + (lat ? s : 16)) * 6144;
    float m5[16];
    load_row_f32(md + 5 * 1024, lane, m5);
#pragma unroll
    for (int i = 0; i < 16; ++i) v[i] = ALPHA * v[i] + m5[i] * yf[i];
    ln_row(v, P.ln2_g + l * 1024, P.ln2_b + l * 1024, lane);
    if (lat) store_row_f32(P.out + ((size_t)s * SEQ + p) * DM, lane, v);
    if (!last) {
      const float* md2 = ((float*)(P.ws + OFF_mod)) + ((size_t)(l + 1) * 17 + (lat ? s : 16)) * 6144;
      float sh[16], scl[16];
      load_row_f32(md2, lane, sh); load_row_f32(md2 + 1024, lane, scl);
#pragma unroll
      for (int i = 0; i < 16; ++i) v[i] = v[i] * (1.f + scl[i]) + sh[i];
      store_row_bf16(((u16*)(P.ws + OFF_H)) + (size_t)row * DM, lane, v);
    }
  }
}

DI int wq_next(unsigned* ctr, char* smem) {
  volatile int* slot = (volatile int*)(smem + SMEM_BYTES - 32);
  __syncthreads();
  if (TID() == 0) *slot = (int)__hip_atomic_fetch_add(ctr, 1u, __ATOMIC_RELAXED, __HIP_MEMORY_SCOPE_AGENT);
  __syncthreads();
  return *slot;
}

DI unsigned* wq_ctr(const Params& P, int ph) { return (unsigned*)(P.ws + OFF_bar) + 3600 + 16 * ph; }

template <bool SWAP>
DI void proj_tile(const Params& P, int l, int hb, int mt, int nt, char* smem) {
  const int tid = TID(), wave = tid >> 6, lane = tid & 63, fr = lane & 15, fq = lane >> 4;
  const int wr = wave >> 1, wc = wave & 1;
  const int hrow0 = mt * 128, grow0 = hb * HROWS + hrow0;
  f32x4 acc[4][4];
  zero_acc<4>(acc);
  gemm_main<4, SWAP, false>(((u16*)(P.ws + OFF_H)), DM, nullptr, grow0, ((u16*)(P.ws + OFF_WinT)) + (size_t)l * INP * 1024, 1024, nt * 128, 1024, acc, (u16*)smem);
  const int jp = mt % 18;
  const int bl = mt / 18;
  const bool lat = jp < 16;
  if (SWAP) {
    u16* dst; int ldd, c0;
    if (nt < 4) { dst = ((u16*)(P.ws + OFF_xp)); ldd = 512; c0 = nt * 128; }
    else if (nt < 8) { dst = ((u16*)(P.ws + OFF_z)); ldd = 512; c0 = (nt - 4) * 128; }
    else if (nt < 14) { dst = ((u16*)(P.ws + OFF_xbc)); ldd = 768; c0 = (nt - 8) * 128; }
    else if (nt < 18) { dst = ((u16*)(P.ws + OFF_q)); ldd = 512; c0 = (nt - 14) * 128; }
    else if (nt < 22) { dst = ((u16*)(P.ws + OFF_k)); ldd = 512; c0 = (nt - 18) * 128; }
    else { dst = ((u16*)(P.ws + OFF_br3)); ldd = 512; c0 = (nt - 26) * 128; }
    const bool isu = nt >= 26;
    const bool rope = (nt >= 14 && nt < 22) && lat;
#pragma unroll
    for (int m = 0; m < 4; ++m) {
      int r = wr * 64 + m * 16 + fr;
      size_t orow = isu ? (size_t)(grow0 + r) : (size_t)(hrow0 + r);
      if (rope) {
        int t = jp * 128 + r;
        int prow = t >> 6, pcol = t & 63;
#pragma unroll
        for (int j = 0; j < 4; ++j) {
          int f = fq * 4 + j;
          float c1 = ((float*)(P.ws + OFF_rope))[(prow * 16 + f) * 2], s1 = ((float*)(P.ws + OFF_rope))[(prow * 16 + f) * 2 + 1];
          float c2 = ((float*)(P.ws + OFF_rope))[(pcol * 16 + f) * 2], s2 = ((float*)(P.ws + OFF_rope))[(pcol * 16 + f) * 2 + 1];
          float a = acc[m][0][j], b = acc[m][1][j];
          acc[m][0][j] = a * c1 - b * s1; acc[m][1][j] = a * s1 + b * c1;
          a = acc[m][2][j]; b = acc[m][3][j];
          acc[m][2][j] = a * c2 - b * s2; acc[m][3][j] = a * s2 + b * c2;
        }
      }
#pragma unroll
      for (int n = 0; n < 4; ++n) {
        f32x4 v = acc[m][n];
        if (isu) { v[0] = geluf_(v[0]); v[1] = geluf_(v[1]); v[2] = geluf_(v[2]); v[3] = geluf_(v[3]); }
        int col = c0 + wc * 64 + n * 16 + fq * 4;
        *(bf16x4*)(dst + orow * ldd + col) = pack4v(v);
      }
    }
  } else {
    if (nt == 34) {
      if (wc == 0) {
#pragma unroll
        for (int m = 0; m < 4; ++m)
#pragma unroll
          for (int j = 0; j < 4; ++j) ((float*)(P.ws + OFF_dtbuf))[(size_t)(hrow0 + wr * 64 + m * 16 + fq * 4 + j) * 16 + fr] = acc[m][0][j];
      }
    } else if (nt < 26) {
      int cb = (nt - 22) * 128 + wc * 64;
#pragma unroll
      for (int m = 0; m < 4; ++m)
#pragma unroll
        for (int n = 0; n < 4; ++n) {
          int c = cb + n * 16 + fr;
          int pos = jp * 128 + wr * 64 + m * 16 + fq * 4;
          *(bf16x4*)(((u16*)(P.ws + OFF_vT)) + ((size_t)bl * 512 + c) * SP + pos) = pack4v(acc[m][n]);
        }
    } else {
      int cb = (nt - 30) * 128 + wc * 64;
#pragma unroll
      for (int m = 0; m < 4; ++m)
#pragma unroll
        for (int n = 0; n < 4; ++n) {
          int c = cb + n * 16 + fr;
          int i0 = wr * 64 + m * 16 + fq * 4;
          f32x4 v = acc[m][n];
          *(bf16x4*)(((u16*)(P.ws + OFF_gvT)) + ((size_t)mt * 512 + c) * 128 + i0) = pack4(geluf_(v[0]), geluf_(v[1]), geluf_(v[2]), geluf_(v[3]));
        }
    }
  }
}

DI void phase_proj(const Params& P, int l, int hb, char* smem, int ph) {
  const bool last = (l == 1);
  for (;;) {
    const int it = wq_next(wq_ctr(P, ph), smem);
    if (it >= 144 * 35) break;
    int mt = it / 35, nt = it % 35;
    bool isctx = (mt % 18) >= 16;
    if (last && isctx) {
      bool need = (nt >= 8 && nt < 14) || (nt >= 18 && nt < 26) || nt == 34;
      if (!need) continue;
    }
    bool transposed = (nt >= 22 && nt < 26) || nt >= 30;
    if (transposed) proj_tile<false>(P, l, hb, mt, nt, smem);
    else proj_tile<true>(P, l, hb, mt, nt, smem);
  }
}

constexpr int LDK = 136;
DI void pool_item(const Params& P, int l, int hb, int mt, int g, char* smem) {
  const int tid = TID(), wave = tid >> 6, lane = tid & 63, fr = lane & 15, fq = lane >> 4;
  const int wr = wave >> 1, wc = wave & 1;
  u16* As = (u16*)smem;
  u16* Bs = As + 128 * LDK;
  const int jp = mt % 18, bl = mt / 18;
  const bool lat = jp < 16;
  const int n = lat ? SEQ : CTXL;
  const int p0 = lat ? jp * 128 : (jp - 16) * 128;
  const int seqbase = bl * SP + (lat ? 0 : SEQ);
  const int half = 1 << g;
  __syncthreads();
  {
    const int cch = tid & 15;
    const u16* src = ((u16*)(P.ws + OFF_xp)) + (size_t)seqbase * 512 + g * 128 + cch * 8;
    for (int ii = 0; ii < 8; ++ii) {
      int i = (tid >> 4) + 16 * ii;
      int p = p0 + i;
      int lo = max(p - half, 0), hi = min(p + half, n);
      float s[8];
#pragma unroll
      for (int e = 0; e < 8; ++e) s[e] = 0.f;
      for (int r = lo; r < hi; ++r) {
        bf16x8 t = *(const bf16x8*)(src + (size_t)r * 512);
#pragma unroll
        for (int e = 0; e < 8; ++e) s[e] += bf2f((u16)t[e]);
      }
      bf16x8 self = *(const bf16x8*)(src + (size_t)p * 512);
      float inv = 1.f / (float)(hi - lo);
      bf16x8 o;
#pragma unroll
      for (int e = 0; e < 8; ++e) o[e] = (short)f2bf(s[e] * inv - bf2f((u16)self[e]));
      *(bf16x8*)(As + i * LDK + cch * 8) = o;
    }
    const u16* wsrc = ((u16*)(P.ws + OFF_poolT)) + ((size_t)l * 4 + g) * 128 * 128;
    for (int cid = tid; cid < 2048; cid += 256) {
      int r = cid >> 4, c8 = (cid & 15) * 8;
      *(u32x4*)(Bs + r * LDK + c8) = *(const u32x4*)(wsrc + r * 128 + c8);
    }
  }
  __syncthreads();
  f32x4 acc[4][4];
  zero_acc<4>(acc);
  mma_lds<4, 4, true>(As + wr * 64 * LDK, LDK, Bs + wc * 64 * LDK, LDK, 4, acc, fr, fq);
  const float* psc = P.pool_scale + l * 512 + g * 128;
#pragma unroll
  for (int m = 0; m < 4; ++m)
#pragma unroll
    for (int nn = 0; nn < 4; ++nn) {
      int r = wr * 64 + m * 16 + fr, c = wc * 64 + nn * 16 + fq * 4;
      float4 sc = *(const float4*)(psc + c);
      f32x4 v = acc[m][nn];
      *(bf16x4*)(((u16*)(P.ws + OFF_br0)) + (size_t)(hb * HROWS + mt * 128 + r) * 512 + g * 128 + c) = pack4(v[0] * sc.x, v[1] * sc.y, v[2] * sc.z, v[3] * sc.w);
    }
}

DI void sgu_item(const Params& P, int l, int hb, int mt, int g, char* smem) {
  const int tid = TID(), wave = tid >> 6, lane = tid & 63, fr = lane & 15, fq = lane >> 4;
  const int wr = wave >> 1, wc = wave & 1;
  u16* As = (u16*)smem;
  u16* Bs = As + 128 * LDK;
  float* st = (float*)(Bs + 128 * LDK);
  const u16* gv = ((u16*)(P.ws + OFF_gvT)) + (size_t)mt * 512 * 128;
  __syncthreads();
  {
    float* ps = (float*)smem;
    float* pq = ps + 16 * 128;
    const int cg = tid >> 4, tc = tid & 15;
    float s8[8], q8[8];
#pragma unroll
    for (int e2 = 0; e2 < 8; ++e2) { s8[e2] = 0.f; q8[e2] = 0.f; }
#pragma unroll 8
    for (int c = 0; c < 32; ++c) {
      u32x4 t = *(const u32x4*)(gv + (size_t)(cg * 32 + c) * 128 + tc * 8);
#pragma unroll
      for (int e2 = 0; e2 < 4; ++e2) {
        float a = bflo(t[e2]), b = bfhi(t[e2]);
        s8[2 * e2] += a; q8[2 * e2] += a * a; s8[2 * e2 + 1] += b; q8[2 * e2 + 1] += b * b;
      }
    }
#pragma unroll
    for (int e2 = 0; e2 < 8; ++e2) { ps[cg * 128 + tc * 8 + e2] = s8[e2]; pq[cg * 128 + tc * 8 + e2] = q8[e2]; }
    __syncthreads();
    if (tid < 128) {
      float s = 0.f, q = 0.f;
#pragma unroll
      for (int g2 = 0; g2 < 16; ++g2) { s += ps[g2 * 128 + tid]; q += pq[g2 * 128 + tid]; }
      const float mu_ = s * (1.f / 512.f);
      const float var = fmaxf(q * (1.f / 512.f) - mu_ * mu_, 0.f);
      st[256 + tid] = mu_; st[384 + tid] = rsqrtf(var + LN_EPS);
    }
  }
  const float* mu = st + 256;
  const float* rs = st + 384;
  {
    __syncthreads();
    const u16* wsrc = ((u16*)(P.ws + OFF_sguW)) + ((size_t)l * 4 + g) * 128 * 128;
    for (int cid = tid; cid < 2048; cid += 256) {
      int r = cid >> 4, c8 = (cid & 15) * 8;
      *(u32x4*)(As + r * LDK + c8) = *(const u32x4*)(wsrc + r * 128 + c8);
      bf16x8 t = *(const bf16x8*)(gv + (size_t)(g * 128 + r) * 128 + c8);
      float lg = P.sgu_ln_g[l * 512 + g * 128 + r], lb = P.sgu_ln_b[l * 512 + g * 128 + r];
      bf16x8 o;
#pragma unroll
      for (int e = 0; e < 8; ++e) o[e] = (short)f2bf((bf2f((u16)t[e]) - mu[c8 + e]) * rs[c8 + e] * lg + lb);
      *(bf16x8*)(Bs + r * LDK + c8) = o;
    }
    __syncthreads();
    f32x4 acc[4][4];
    zero_acc<4>(acc);
    mma_lds<4, 4, true>(As + wr * 64 * LDK, LDK, Bs + wc * 64 * LDK, LDK, 4, acc, fr, fq);
    const float* bs = P.sgu_b + ((size_t)l * 4 + g) * 128;
#pragma unroll
    for (int m = 0; m < 4; ++m) {
      int pp = wr * 64 + m * 16 + fr;
      float bias = bs[pp];
#pragma unroll
      for (int nn = 0; nn < 4; ++nn) {
        int d = wc * 64 + nn * 16 + fq * 4;
        u16* up = ((u16*)(P.ws + OFF_br3)) + (size_t)(hb * HROWS + mt * 128 + pp) * 512 + g * 128 + d;
        bf16x4 uu = *(const bf16x4*)up;
        f32x4 v = acc[m][nn];
        *(bf16x4*)up = pack4((v[0] + bias) * bf2f((u16)uu[0]), (v[1] + bias) * bf2f((u16)uu[1]), (v[2] + bias) * bf2f((u16)uu[2]), (v[3] + bias) * bf2f((u16)uu[3]));
      }
    }
  }
}

DI void attn_item(const Params& P, int l, int hb, int item, char* smem) {
  const int tid = TID(), wave = tid >> 6, lane = tid & 63, fr = lane & 15, fq = lane >> 4;
  int qt, h, bl;
  if (item < 512) { bl = item >> 6; h = (item >> 4) & 3; qt = item & 15; }
  else { const int j = item - 512; bl = j >> 3; h = (j >> 1) & 3; qt = 16 + (j & 1); }
  const bool ctxq = qt >= 16;
  const int key0 = ctxq ? SEQ : 0, nkt = ctxq ? 4 : 36;
  const int hrow_q0 = bl * SP + qt * 128 + wave * 32;
  constexpr int KT = 64 * LDT, VT = 128 * LDT;
  u16* Ks = (u16*)smem;
  u16* Vs = Ks + 2 * KT;
  constexpr float LOG2E = 1.4426950408889634f;
  for (int sub = 0; sub < 2; ++sub) {
    const int hs = 2 * h + sub;
    bf16x8 qf[2][2];
#pragma unroll
    for (int qb = 0; qb < 2; ++qb)
#pragma unroll
      for (int ks = 0; ks < 2; ++ks) qf[qb][ks] = *(const bf16x8*)(((u16*)(P.ws + OFF_q)) + (size_t)(hrow_q0 + qb * 16 + fr) * 512 + hs * 64 + ks * 32 + fq * 8);
    f32x4 ot[8][2];
#pragma unroll
    for (int d = 0; d < 8; ++d) { ot[d][0] = f32x4{0.f, 0.f, 0.f, 0.f}; ot[d][1] = f32x4{0.f, 0.f, 0.f, 0.f}; }
    float mrow[2] = {-INFINITY, -INFINITY}, lrow[2] = {0.f, 0.f};
    const u16* Kg = ((u16*)(P.ws + OFF_k)) + ((size_t)bl * SP + key0) * 512 + hs * 64;
    const u16* Vg = ((u16*)(P.ws + OFF_vT)) + ((size_t)bl * 512 + h * 128) * SP + key0;
    u32x4 rk[2], rv[4];
    const u16* kgp = Kg + (size_t)(tid >> 2) * 512 + (tid & 3) * 16;
    const u16* vgp = Vg + (size_t)(tid >> 1) * SP + (tid & 1) * 32;
    u16* ksp = Ks + (tid >> 2) * LDT + (tid & 3) * 16;
    u16* vsp = Vs + (tid >> 1) * LDT + (tid & 1) * 32;
    auto gloadK = [&](int t) {
      const u16* kp = kgp + (size_t)t * 64 * 512;
      rk[0] = *(const u32x4*)(kp); rk[1] = *(const u32x4*)(kp + 8);
    };
    auto gloadV = [&](int t) {
      const u16* vp = vgp + t * 64;
      rv[0] = *(const u32x4*)(vp); rv[1] = *(const u32x4*)(vp + 8); rv[2] = *(const u32x4*)(vp + 16); rv[3] = *(const u32x4*)(vp + 24);
    };
    auto sstore = [&](int buf) {
      u16* kp = ksp + buf * KT;
      *(u32x4*)(kp) = rk[0]; *(u32x4*)(kp + 8) = rk[1];
      u16* vp = vsp + buf * VT;
      *(u32x4*)(vp) = rv[0]; *(u32x4*)(vp + 8) = rv[1]; *(u32x4*)(vp + 16) = rv[2]; *(u32x4*)(vp + 24) = rv[3];
    };
    gloadK(0); gloadV(0);
    __syncthreads();
    sstore(0);
    __syncthreads();
    for (int t = 0; t < nkt; ++t) {
      const int cur = t & 1;
      if (t + 1 < nkt) gloadK(t + 1);
      const u16* Kc = Ks + cur * KT;
      const u16* Vc = Vs + cur * VT;
      f32x4 st[4][2];
#pragma unroll
      for (int k4 = 0; k4 < 4; ++k4) { st[k4][0] = f32x4{0.f, 0.f, 0.f, 0.f}; st[k4][1] = f32x4{0.f, 0.f, 0.f, 0.f}; }
#pragma unroll
      for (int k4 = 0; k4 < 4; ++k4)
#pragma unroll
        for (int ks = 0; ks < 2; ++ks) {
          bf16x8 a = *(const bf16x8*)(Kc + (k4 * 16 + fr) * LDT + ks * 32 + fq * 8);
          st[k4][0] = MFMA16(a, qf[0][ks], st[k4][0]);
          st[k4][1] = MFMA16(a, qf[1][ks], st[k4][1]);
          if (ks == 1 && (k4 & 1)) __builtin_amdgcn_sched_barrier(0);
        }
      __builtin_amdgcn_sched_barrier(0);
#pragma unroll
      for (int qb = 0; qb < 2; ++qb) {
        float mx = -INFINITY;
#pragma unroll
        for (int k4 = 0; k4 < 4; ++k4)
#pragma unroll
          for (int j = 0; j < 4; ++j) mx = fmaxf(mx, st[k4][qb][j]);
        mx = fmaxf(mx, __shfl_xor(mx, 16));
        mx = fmaxf(mx, __shfl_xor(mx, 32));
        const bool upd = mx > mrow[qb] + 5.5f;
        const float mnew = upd ? mx : mrow[qb];
        const float moff = mnew * LOG2E;
        float ps = 0.f;
#pragma unroll
        for (int k4 = 0; k4 < 4; ++k4)
#pragma unroll
          for (int j = 0; j < 4; ++j) { float pv = __builtin_amdgcn_exp2f(st[k4][qb][j] * LOG2E - moff); st[k4][qb][j] = pv; ps += pv; }
        if (__builtin_amdgcn_ballot_w64(upd) != 0ull) {
          const float alpha = __builtin_amdgcn_exp2f((mrow[qb] - mnew) * LOG2E);
          lrow[qb] *= alpha;
#pragma unroll
          for (int d = 0; d < 8; ++d) { ot[d][qb][0] *= alpha; ot[d][qb][1] *= alpha; ot[d][qb][2] *= alpha; ot[d][qb][3] *= alpha; }
        }
        mrow[qb] = mnew;
        lrow[qb] += ps;
      }
      __builtin_amdgcn_sched_barrier(0);
      if (t + 1 < nkt) gloadV(t + 1);
#pragma unroll
      for (int ks2 = 0; ks2 < 2; ++ks2) {
        bf16x8 pf[2];
#pragma unroll
        for (int qb = 0; qb < 2; ++qb) {
          bf16x4 lo = pack4v(st[2 * ks2][qb]), hi = pack4v(st[2 * ks2 + 1][qb]);
          pf[qb] = __builtin_shufflevector(lo, hi, 0, 1, 2, 3, 4, 5, 6, 7);
        }
#pragma unroll
        for (int d = 0; d < 8; ++d) {
          const u16* vp = Vc + (d * 16 + fr) * LDT + ks2 * 32 + fq * 4;
          bf16x4 lo = *(const bf16x4*)vp, hi = *(const bf16x4*)(vp + 16);
          bf16x8 a = __builtin_shufflevector(lo, hi, 0, 1, 2, 3, 4, 5, 6, 7);
          ot[d][0] = MFMA16(a, pf[0], ot[d][0]);
          ot[d][1] = MFMA16(a, pf[1], ot[d][1]);
          if ((d & 3) == 3) __builtin_amdgcn_sched_barrier(0);
        }
      }
      if (t + 1 < nkt) sstore(cur ^ 1);
      __syncthreads();
    }
#pragma unroll
    for (int qb = 0; qb < 2; ++qb) {
      float lt = lrow[qb];
      lt += __shfl_xor(lt, 16);
      lt += __shfl_xor(lt, 32);
      float inv = 1.f / lt;
      size_t hrow = (size_t)(hrow_q0 + qb * 16 + fr);
      if (sub == 0) {
#pragma unroll
        for (int d = 0; d < 8; ++d) {
          f32x4 v = ot[d][qb];
          *(bf16x4*)(((u16*)(P.ws + OFF_o1)) + hrow * 512 + h * 128 + d * 16 + fq * 4) = pack4(v[0] * inv, v[1] * inv, v[2] * inv, v[3] * inv);
        }
      } else {
        const float lam = ((float*)(P.ws + OFF_lamv))[l * 2], lam_init = ((float*)(P.ws + OFF_lamv))[l * 2 + 1];
        float ss = 0.f;
#pragma unroll
        for (int d = 0; d < 8; ++d) {
          bf16x4 o1v = *(const bf16x4*)(((u16*)(P.ws + OFF_o1)) + hrow * 512 + h * 128 + d * 16 + fq * 4);
#pragma unroll
          for (int j = 0; j < 4; ++j) { float dd = bf2f((u16)o1v[j]) - lam * ot[d][qb][j] * inv; ot[d][qb][j] = dd; ss += dd * dd; }
        }
        ss += __shfl_xor(ss, 16);
        ss += __shfl_xor(ss, 32);
        float rr = rsqrtf(ss * (1.f / 128.f) + LN_EPS) * (1.f - lam_init);
        const float* gn = P.diff_norm_g + l * 128;
#pragma unroll
        for (int d = 0; d < 8; ++d) {
          int dv = d * 16 + fq * 4;
          float4 g4 = *(const float4*)(gn + dv);
          f32x4 v = ot[d][qb];
          *(bf16x4*)(((u16*)(P.ws + OFF_br2)) + ((size_t)hb * HROWS + hrow) * 512 + h * 128 + dv) = pack4(v[0] * rr * g4.x, v[1] * rr * g4.y, v[2] * rr * g4.z, v[3] * rr * g4.w);
        }
      }
    }
  }
}

template <bool TRANS>
DI void conv_stage(const Params& P, int l, const u16* xbase  , int chan0, int n, int p0, u16* dst, int ld, const float* scale) {
  const int tid = TID(), cl = tid & 63, ig = tid >> 6;
  const int ch = chan0 + cl;
  const float* cw = P.conv_w + (size_t)l * 5 * 768 + ch;
  const float w0 = cw[0], w1 = cw[768], w2 = cw[2 * 768], w3 = cw[3 * 768], w4 = cw[4 * 768];
  const float cb = P.conv_b[l * 768 + ch];
  const u16* xc = xbase + ch;
#pragma unroll 1
  for (int g8 = 0; g8 < 4; ++g8) {
    const int tok0 = ig * 32 + g8 * 8;
    const int pos0 = p0 + tok0 - 2;
    float xv[12];
#pragma unroll
    for (int i = 0; i < 12; ++i) { int pos = pos0 + i; xv[i] = (pos >= 0 && pos < n) ? bf2f(xc[(size_t)pos * 768]) : 0.f; }
#pragma unroll
    for (int ii = 0; ii < 8; ++ii) {
      float v = w0 * xv[ii] + w1 * xv[ii + 1] + w2 * xv[ii + 2] + w3 * xv[ii + 3] + w4 * xv[ii + 4] + cb;
      v = v * __builtin_amdgcn_rcpf(1.f + __expf(-v));
      const int tok = tok0 + ii;
      if (scale) v *= scale[tok];
      if (TRANS) dst[cl * ld + tok] = f2bf(v); else dst[tok * ld + cl] = f2bf(v);
    }
  }
}

DI void ssd_scalars(const Params& P, int l, int hrow0, int h, int dir, float* dts, float* S, float* tmp) {
  const int tid = TID();
  const float aneg = -expf(P.a_log[l * 16 + dir * 8 + h]);
  float a = 0.f, inc = 0.f;
  if (tid < 128) {
    float raw = ((float*)(P.ws + OFF_dtbuf))[(size_t)(hrow0 + tid) * 16 + dir * 8 + h] + P.dt_bias[l * 16 + dir * 8 + h];
    float dt = softplusf_(raw);
    dts[tid] = dt;
    a = dt * aneg;
    inc = a;
    const int lane = tid & 63;
#pragma unroll
    for (int o = 1; o < 64; o <<= 1) { float t = __shfl_up(inc, o); if (lane >= o) inc += t; }
    if (lane == 63) tmp[tid >> 6] = inc;
  }
  __syncthreads();
  if (tid < 128) {
    const float t0 = tmp[0], t1 = tmp[1];
    const float pre = inc + (tid >= 64 ? t0 : 0.f);
    S[tid] = (dir == 0) ? pre : (t0 + t1) - pre + a;
  }
  __syncthreads();
}

constexpr int SSD_STATE_STRIDE = 18 * 4096;

DI void ssd_prep_item(const Params& P, int l, int hb, int mt, int slab, char* smem) {
  const int tid = TID();
  const int jp = mt % 18, bl = mt / 18;
  const bool lat = jp < 16;
  const int n = lat ? SEQ : CTXL;
  const int p0 = lat ? jp * 128 : (jp - 16) * 128;
  const int seqbase = bl * SP + (lat ? 0 : SEQ);
  const int hrow0 = bl * SP + jp * 128;
  u16* T = (u16*)smem;
  u16* Rm = T + 64 * LDK;
  __syncthreads();
  const u16* xb = ((u16*)(P.ws + OFF_xbc)) + (size_t)seqbase * 768;
  if (slab < 10) conv_stage<true>(P, l, xb, slab * 64, n, p0, T, LDK, nullptr);
  if (slab >= 8) conv_stage<false>(P, l, xb, slab * 64, n, p0, Rm, LDT, nullptr);
  __syncthreads();
  if (slab < 10) {
    u16* dst = slab < 8 ? ((u16*)(P.ws + OFF_xsT)) + ((size_t)mt * 512 + slab * 64) * 128 : ((u16*)(P.ws + OFF_bmT)) + ((size_t)mt * 128 + (slab - 8) * 64) * 128;
#pragma unroll
    for (int i = 0; i < 4; ++i) { int cid = tid + 256 * i; int r = cid >> 4, c8 = (cid & 15) * 8; *(u32x4*)(dst + (size_t)r * 128 + c8) = *(const u32x4*)(T + r * LDK + c8); }
  }
  if (slab >= 8) {
    u16* dst = (slab < 10 ? ((u16*)(P.ws + OFF_bm)) + (slab - 8) * 64 : ((u16*)(P.ws + OFF_cm)) + (slab - 10) * 64) + (size_t)hrow0 * 128;
#pragma unroll
    for (int i = 0; i < 4; ++i) { int cid = tid + 256 * i; int r = cid >> 3, c8 = (cid & 7) * 8; *(u32x4*)(dst + (size_t)r * 128 + c8) = *(const u32x4*)(Rm + r * LDT + c8); }
  }
}

DI void phase_ssd_prep(const Params& P, int l, int hb, char* smem, int ph) {
  for (;;) {
    const int it = wq_next(wq_ctr(P, ph), smem);
    if (it >= 144 * 12) break;
    ssd_prep_item(P, l, hb, it / 12, it % 12, smem);
  }
}

DI void ssd_state_item(const Params& P, int l, int hb, int item, char* smem) {
  const int tid = TID(), wave = tid >> 6, lane = tid & 63, fr = lane & 15, fq = lane >> 4;
  const int h = item & 7, jp = (item >> 3) % 18, bl = (item >> 3) / 18;
  const int mt = bl * 18 + jp;
  const int hrow0 = bl * SP + jp * 128;
  u16* At = (u16*)smem;
  u16* Bt = At + 64 * LDK;
  float* dts = (float*)(Bt + 64 * LDK);
  float* S = dts + 128;
  float* wgt = S + 128;
  __syncthreads();
  u32x4 xr[4];
  {
    const u16* bsrc = ((u16*)(P.ws + OFF_bmT)) + ((size_t)mt * 128 + (h >> 2) * 64) * 128;
    const u16* xsrc = ((u16*)(P.ws + OFF_xsT)) + ((size_t)mt * 512 + h * 64) * 128;
#pragma unroll
    for (int i = 0; i < 4; ++i) {
      int cid = tid + 256 * i; int r = cid >> 4, c8 = (cid & 15) * 8;
      *(u32x4*)(Bt + r * LDK + c8) = *(const u32x4*)(bsrc + (size_t)r * 128 + c8);
      xr[i] = *(const u32x4*)(xsrc + (size_t)r * 128 + c8);
    }
  }
  const int wr = wave >> 1, wc = wave & 1;
#pragma unroll 1
  for (int dir = 0; dir < 2; ++dir) {
    ssd_scalars(P, l, hrow0, h, dir, dts, S, wgt);
    const float total = (dir == 0) ? S[127] : S[0];
    __syncthreads();
    if (tid < 128) wgt[tid] = dts[tid] * __expf(total - S[tid]);
    __syncthreads();
#pragma unroll
    for (int i = 0; i < 4; ++i) {
      int cid = tid + 256 * i; int r = cid >> 4, c8 = (cid & 15) * 8;
      u32x4 o;
#pragma unroll
      for (int e2 = 0; e2 < 4; ++e2) o[e2] = pack2(bflo(xr[i][e2]) * wgt[c8 + 2 * e2], bfhi(xr[i][e2]) * wgt[c8 + 2 * e2 + 1]);
      *(u32x4*)(At + r * LDK + c8) = o;
    }
    __syncthreads();
    f32x4 acc[2][2];
#pragma unroll
    for (int m = 0; m < 2; ++m) { acc[m][0] = f32x4{0.f, 0.f, 0.f, 0.f}; acc[m][1] = f32x4{0.f, 0.f, 0.f, 0.f}; }
    mma_lds<2, 2, true>(At + wr * 32 * LDK, LDK, Bt + wc * 32 * LDK, LDK, 4, acc, fr, fq);
    u16* cs = ((u16*)(P.ws + OFF_cstate)) + (((size_t)(bl * 2 + dir) * 8 + h) * 18 + jp) * 4096;
#pragma unroll
    for (int m = 0; m < 2; ++m)
#pragma unroll
      for (int nn = 0; nn < 2; ++nn) *(bf16x4*)(cs + (wr * 32 + m * 16 + fr) * 64 + wc * 32 + nn * 16 + fq * 4) = pack4v(acc[m][nn]);
    if (tid == 0) ((float*)(P.ws + OFF_decay))[((bl * 2 + dir) * 8 + h) * 18 + jp] = __expf(total);
  }
}

DI void phase_carry(const Params& P) {
  const int total = 8 * 2 * 8 * 4096;
  for (int idx = blockIdx.x * 256 + TID(); idx < total; idx += gridDim.x * 256) {
    int pn = idx & 4095, bdh = idx >> 12;
    int dir = (bdh >> 3) & 1;
    const u16* __restrict__ cs = ((const u16*)(P.ws + OFF_cstate)) + (size_t)bdh * SSD_STATE_STRIDE + pn;
    u16* __restrict__ en = ((u16*)(P.ws + OFF_enter)) + (size_t)bdh * SSD_STATE_STRIDE + pn;
    const float* __restrict__ dc = ((const float*)(P.ws + OFF_decay)) + bdh * 18;
    float cv[18], dv[18];
#pragma unroll
    for (int jp = 0; jp < 18; ++jp) { cv[jp] = bf2f(cs[(size_t)jp * 4096]); dv[jp] = dc[jp]; }
    float state = 0.f;
    if (dir == 0) {
#pragma unroll
      for (int st = 0; st < 18; ++st) {
        const int jp = st < 2 ? 16 + st : st - 2;
        en[(size_t)jp * 4096] = f2bf(state);
        state = state * dv[jp] + cv[jp];
      }
    } else {
#pragma unroll
      for (int st = 0; st < 18; ++st) {
        const int jp = 17 - st;
        en[(size_t)jp * 4096] = f2bf(state);
        state = state * dv[jp] + cv[jp];
      }
    }
  }
}

DI void ssd_out_item(const Params& P, int l, int hb, int item, char* smem) {
  const int tid = TID(), wave = tid >> 6, lane = tid & 63, fr = lane & 15, fq = lane >> 4;
  const int h = item & 7, jp = (item >> 3) % 18, bl = (item >> 3) / 18;
  const bool lat = jp < 16;
  const int n = lat ? SEQ : CTXL;
  const int p0 = lat ? jp * 128 : (jp - 16) * 128;
  const int seqbase = bl * SP + (lat ? 0 : SEQ);
  const int hrow0 = bl * SP + jp * 128;
  u16* Cs = (u16*)smem;
  u16* xT = Cs + 128 * LDT;
  u16* Et = xT + 64 * LDK;
  u16* Un = Et + 64 * LDT;
  float* fs = (float*)(Un + 128 * LDK);
  float* dts = fs;
  float* S = fs + 128;
  float* tmp = fs + 256;
  const int grp = h >> 2;
  __syncthreads();
  {
    const int mt = bl * 18 + jp;
    const u16* csrc = ((u16*)(P.ws + OFF_cm)) + (size_t)hrow0 * 128 + grp * 64;
    const u16* bsrc = ((u16*)(P.ws + OFF_bm)) + (size_t)hrow0 * 128 + grp * 64;
    const u16* xsrc = ((u16*)(P.ws + OFF_xsT)) + ((size_t)mt * 512 + h * 64) * 128;
#pragma unroll
    for (int i = 0; i < 4; ++i) {
      int cid = tid + 256 * i;
      int r = cid >> 3, c8 = (cid & 7) * 8;
      *(u32x4*)(Cs + r * LDT + c8) = *(const u32x4*)(csrc + (size_t)r * 128 + c8);
      *(u32x4*)(Un + r * LDT + c8) = *(const u32x4*)(bsrc + (size_t)r * 128 + c8);
      int r2 = cid >> 4, c82 = (cid & 15) * 8;
      *(u32x4*)(xT + r2 * LDK + c82) = *(const u32x4*)(xsrc + (size_t)r2 * 128 + c82);
    }
  }
  __syncthreads();
  f32x4 cb[2][8];
#pragma unroll
  for (int m = 0; m < 2; ++m)
#pragma unroll
    for (int nn = 0; nn < 8; ++nn) cb[m][nn] = f32x4{0.f, 0.f, 0.f, 0.f};
  mma_lds<2, 8, false>(Cs + wave * 32 * LDT, LDT, Un, LDT, 2, cb, fr, fq);
  f32x4 yacc[2][4];
#pragma unroll
  for (int m = 0; m < 2; ++m)
#pragma unroll
    for (int nn = 0; nn < 4; ++nn) yacc[m][nn] = f32x4{0.f, 0.f, 0.f, 0.f};
#pragma unroll 1
  for (int dir = 0; dir < 2; ++dir) {
    __syncthreads();
    ssd_scalars(P, l, hrow0, h, dir, dts, S, tmp);
#pragma unroll
    for (int m = 0; m < 2; ++m)
#pragma unroll
      for (int j = 0; j < 4; ++j) {
        int lrow = wave * 32 + m * 16 + fq * 4 + j;
        float Sl = S[lrow];
#pragma unroll
        for (int nn = 0; nn < 8; ++nn) {
          int s = nn * 16 + fr;
          bool ok = dir == 0 ? (s <= lrow) : (s >= lrow);
          float coef = ok ? __expf(Sl - S[s]) * dts[s] : 0.f;
          Un[lrow * LDK + s] = f2bf(cb[m][nn][j] * coef);
        }
      }
    {
      const u16* en = ((u16*)(P.ws + OFF_enter)) + (((size_t)(bl * 2 + dir) * 8 + h) * 18 + jp) * 4096;
      for (int cid = tid; cid < 512; cid += 256) {
        int pr = cid >> 3, c8 = (cid & 7) * 8;
        *(u32x4*)(Et + pr * LDT + c8) = *(const u32x4*)(en + pr * 64 + c8);
      }
    }
    __syncthreads();
    mma_lds<2, 4, true>(Un + wave * 32 * LDK, LDK, xT, LDK, 4, yacc, fr, fq);
    f32x4 yi[2][4];
#pragma unroll
    for (int m = 0; m < 2; ++m)
#pragma unroll
      for (int nn = 0; nn < 4; ++nn) yi[m][nn] = f32x4{0.f, 0.f, 0.f, 0.f};
    mma_lds<2, 4, true>(Cs + wave * 32 * LDT, LDT, Et, LDT, 2, yi, fr, fq);
#pragma unroll
    for (int m = 0; m < 2; ++m) {
      float e = __expf(S[wave * 32 + m * 16 + fr]);
#pragma unroll
      for (int nn = 0; nn < 4; ++nn)
#pragma unroll
        for (int j = 0; j < 4; ++j) yacc[m][nn][j] += e * yi[m][nn][j];
    }
  }
  const float dsk = P.ssd_d[l * 8 + h];
  const float* gn = P.ssd_norm_g + l * 512 + h * 64;
#pragma unroll
  for (int m = 0; m < 2; ++m) {
    int lrow = wave * 32 + m * 16 + fr;
    float ss = 0.f;
#pragma unroll
    for (int nn = 0; nn < 4; ++nn) {
      int pc = nn * 16 + fq * 4;
      bf16x4 zz = *(const bf16x4*)(((u16*)(P.ws + OFF_z)) + (size_t)(hrow0 + lrow) * 512 + h * 64 + pc);
      float4 g4 = *(const float4*)(gn + pc);
      float gg[4] = {g4.x, g4.y, g4.z, g4.w};
      float o[4];
#pragma unroll
      for (int j = 0; j < 4; ++j) {
        float y = yacc[m][nn][j] + dsk * bf2f(xT[(pc + j) * LDK + lrow]);
        y *= siluf_(bf2f((u16)zz[j]));
        ss += y * y;
        o[j] = y * gg[j];
      }
      *(bf16x4*)(((u16*)(P.ws + OFF_br1)) + ((size_t)hb * HROWS + hrow0 + lrow) * 512 + h * 64 + pc) = pack4(o[0], o[1], o[2], o[3]);
    }
    ss += __shfl_xor(ss, 16);
    ss += __shfl_xor(ss, 32);
    if (fq == 0) ((float*)(P.ws + OFF_ssq))[((size_t)hb * HROWS + hrow0 + lrow) * 8 + h] = ss;
  }
}


DI void merge_tile(const Params& P, int l, int mt, int nt, char* smem) {
  const int row0 = mt * 128;
#pragma unroll 1
  for (int kq = 0; kq < 4; ++kq) {
    unsigned gp[4][4][2];
    {
      f32x4 g[4][4];
      zero_acc<4>(g);
      gemm_main<4, true, false, true>(((u16*)(P.ws + OFF_H)), DM, nullptr, row0, ((u16*)(P.ws + OFF_WgT)) + ((size_t)l * 4 + kq) * 1024 * 1024, 1024, nt * 128, 1024, g, (u16*)smem);
#pragma unroll
      for (int m = 0; m < 4; ++m)
#pragma unroll
        for (int n = 0; n < 4; ++n) {
          gp[m][n][0] = pack2(sigmoidf_(g[m][n][0]), sigmoidf_(g[m][n][1]));
          gp[m][n][1] = pack2(sigmoidf_(g[m][n][2]), sigmoidf_(g[m][n][3]));
        }
    }
    f32x4 bb[4][4];
    zero_acc<4>(bb);
    const u16* br = ((u16*)(P.ws + OFF_br0)) + (size_t)kq * (U_ / 2);
    gemm_main<4, true, false, false>(br, 512, nullptr, row0, ((u16*)(P.ws + OFF_WbT)) + ((size_t)l * 4 + kq) * 1024 * 512, 512, nt * 128, 512, bb, (u16*)smem);
    const int tid = TID(), wave = tid >> 6, lane = tid & 63, fr = lane & 15, fq = lane >> 4;
    const int wr = wave >> 1, wc = wave & 1;
#pragma unroll
    for (int m = 0; m < 4; ++m) {
      const int r = row0 + wr * 64 + m * 16 + fr;
      float rs = 1.f;
      if (kq == 1) {
        const float* sq = ((float*)(P.ws + OFF_ssq)) + (size_t)r * 8;
        float4 a = *(const float4*)sq, b = *(const float4*)(sq + 4);
        rs = rsqrtf((a.x + a.y + a.z + a.w + b.x + b.y + b.z + b.w) * (1.f / 512.f) + LN_EPS);
      }
#pragma unroll
      for (int n = 0; n < 4; ++n) {
        u32x2* dst = (u32x2*)(((u16*)(P.ws + OFF_acc)) + (size_t)r * DM + nt * 128 + wc * 64 + n * 16 + fq * 4);
        u32x2 prev = {0u, 0u};
        if (kq > 0) prev = *dst;
        const unsigned g0 = gp[m][n][0], g1 = gp[m][n][1];
        u32x2 o;
        o[0] = pack2(bflo(prev[0]) + bflo(g0) * bb[m][n][0] * rs, bfhi(prev[0]) + bfhi(g0) * bb[m][n][1] * rs);
        o[1] = pack2(bflo(prev[1]) + bflo(g1) * bb[m][n][2] * rs, bfhi(prev[1]) + bfhi(g1) * bb[m][n][3] * rs);
        *dst = o;
      }
    }
  }
}

DI void phase_merge(const Params& P, int l, char* smem, int ph) {
  const bool last = (l == 1);
  for (;;) {
    const int it = wq_next(wq_ctr(P, ph), smem);
    if (it >= 288 * 8) break;
    int mt = it / 8, nt = it % 8;
    if (last && (mt % 18) >= 16) continue;
    merge_tile(P, l, mt, nt, smem);
  }
}

DI void phase_outproj(const Params& P, int l, char* smem, int ph) {
  const bool last = (l == 1);
  const int tid = TID(), wave = tid >> 6, lane = tid & 63, fr = lane & 15, fq = lane >> 4;
  const int wr = wave >> 1, wc = wave & 1;
  for (;;) {
    const int it = wq_next(wq_ctr(P, ph), smem);
    if (it >= 288 * 8) break;
    int mt = it / 8, nt = it % 8;
    if (last && (mt % 18) >= 16) continue;
    f32x4 acc[4][4];
    zero_acc<4>(acc);
    gemm_main<4, true, false>(((u16*)(P.ws + OFF_acc)), DM, nullptr, mt * 128, ((u16*)(P.ws + OFF_WoT)) + (size_t)l * 1024 * 1024, 1024, nt * 128, 1024, acc, (u16*)smem);
#pragma unroll
    for (int m = 0; m < 4; ++m)
#pragma unroll
      for (int n = 0; n < 4; ++n) {
        int r = mt * 128 + wr * 64 + m * 16 + fr, c = nt * 128 + wc * 64 + n * 16 + fq * 4;
        *(bf16x4*)(((u16*)(P.ws + OFF_Y)) + (size_t)r * DM + c) = pack4v(acc[m][n]);
      }
  }
}

DI void phase_ffn1(const Params& P, int l, char* smem, int ph) {
  const bool last = (l == 1);
  const int tid = TID(), wave = tid >> 6, lane = tid & 63, fr = lane & 15, fq = lane >> 4;
  const int wr = wave >> 1, wc = wave & 1;
  const int nmt = last ? 512 : 576;
  for (;;) {
    const int it = wq_next(wq_ctr(P, ph), smem);
    if (it >= nmt * 8) break;
    int mt = it / 8, nt = it % 8;
    int R0 = mt * 128;
    int e = R0 < NFFN_LAT ? (R0 >> 8) & 15 : (R0 - NFFN_LAT) >> 9;
    f32x4 acc[4][4];
    zero_acc<4>(acc);
    gemm_main<4, true, true>(((u16*)(P.ws + OFF_H)), DM, ((int*)(P.ws + OFF_tokidx)), R0, ((u16*)(P.ws + OFF_W13T)) + (size_t)e * 1024 * 1024, 1024, nt * 128, 1024, acc, (u16*)smem);
#pragma unroll
    for (int m = 0; m < 4; ++m)
#pragma unroll
      for (int n2 = 0; n2 < 2; ++n2) {
        int r = R0 + wr * 64 + m * 16 + fr;
        int hc = (nt * 4 + wc * 2 + n2) * 16 + fq * 4;
        f32x4 a = acc[m][2 * n2], b = acc[m][2 * n2 + 1];
        *(bf16x4*)(((u16*)(P.ws + OFF_hid)) + (size_t)r * 512 + hc) = pack4(siluf_(a[0]) * b[0], siluf_(a[1]) * b[1], siluf_(a[2]) * b[2], siluf_(a[3]) * b[3]);
      }
  }
}

DI void phase_ffn2(const Params& P, int l, char* smem, int ph) {
  const bool last = (l == 1);
  const int tid = TID(), wave = tid >> 6, lane = tid & 63, fr = lane & 15, fq = lane >> 4;
  const int wr = wave >> 1, wc = wave & 1;
  const int nmt = last ? 512 : 576;
  for (;;) {
    const int it = wq_next(wq_ctr(P, ph), smem);
    if (it >= nmt * 8) break;
    int mt = it / 8, nt = it % 8;
    int R0 = mt * 128;
    int e = R0 < NFFN_LAT ? (R0 >> 8) & 15 : (R0 - NFFN_LAT) >> 9;
    f32x4 acc[4][4];
    zero_acc<4>(acc);
    gemm_main<4, true, false>(((u16*)(P.ws + OFF_hid)), 512, nullptr, R0, ((u16*)(P.ws + OFF_W2T)) + (size_t)e * 1024 * 512, 512, nt * 128, 512, acc, (u16*)smem);
#pragma unroll
    for (int m = 0; m < 4; ++m) {
      int r = R0 + wr * 64 + m * 16 + fr;
      float gt = ((float*)(P.ws + OFF_gatev))[r];
#pragma unroll
      for (int n = 0; n < 4; ++n) {
        int c = nt * 128 + wc * 64 + n * 16 + fq * 4;
        f32x4 v = acc[m][n];
        *(bf16x4*)(((u16*)(P.ws + OFF_ye)) + (size_t)r * DM + c) = pack4(v[0] * gt, v[1] * gt, v[2] * gt, v[3] * gt);
      }
    }
  }
}

DI void phase_mix2(const Params& P, int l, int hb, char* smem, int ph) {
  const bool last = (l == 1);
  const int nG = 576, nA = 576, nS = 1152, nP = 576;
  for (;;) {
    const int it = wq_next(wq_ctr(P, ph), smem);
    if (it >= nA + nG + nS + nP) break;
    if (it < nG) {
      const int mt = it >> 2, g = it & 3;
      if (last && (mt % 18) >= 16) continue;
      sgu_item(P, l, hb, mt, g, smem);
    } else if (it < nG + nA) {
      const int ia = it - nG;
      if (last && ia >= 512) continue;
      attn_item(P, l, hb, ia, smem);
    } else if (it < nA + nG + nS) {
      ssd_state_item(P, l, hb, it - nA - nG, smem);
    } else {
      const int t = it - nA - nG - nS;
      const int mt = t >> 2, g = t & 3;
      if (last && (mt % 18) >= 16) continue;
      pool_item(P, l, hb, mt, g, smem);
    }
  }
}

DI void phase_ssd_out(const Params& P, int l, int hb, char* smem, int ph) {
  const bool last = (l == 1);
  for (;;) {
    const int it = wq_next(wq_ctr(P, ph), smem);
    if (it >= 8 * 18 * 8) break;
    int jp = (it >> 3) % 18;
    if (last && jp >= 16) continue;
    ssd_out_item(P, l, hb, it, smem);
  }
}

#define XB_TMO      128
#define XB_XCNT(j)  (256  + 64 * (j))
#define XB_XSUB(j)  (1280 + 64 * (j))
#define XB_XGEN(j)  (2304 + 64 * (j))
#define XB_TOP      3328
#define XB_TOPGEN   3392
#define XCD_BAR_WORDS 3456
#define XB_SPIN_CAP (1u << 18)
#define LAS __attribute__((address_space(3)))

__device__ __forceinline__ unsigned xb_ld(unsigned* p)              { return __hip_atomic_load(p, __ATOMIC_RELAXED, __HIP_MEMORY_SCOPE_AGENT); }
__device__ __forceinline__ unsigned xb_add(unsigned* p, unsigned v) { return __hip_atomic_fetch_add(p, v, __ATOMIC_RELAXED, __HIP_MEMORY_SCOPE_AGENT); }
__device__ __forceinline__ unsigned xb_xcc_id() { return (unsigned)__builtin_amdgcn_s_getreg((3 << 11) | 20) & 0xFu; }
#define XB_SPIN(cond, bar) do { unsigned _sp = 0; while (cond) { __builtin_amdgcn_s_sleep(1); \
    if ((++_sp & 255u) == 0u) { if (xb_ld(&(bar)[XB_TMO])) break; if (_sp > XB_SPIN_CAP) { atomicAdd(&(bar)[XB_TMO], 1u); break; } } } } while (0)

struct XcdBarrier {
    unsigned* bar; unsigned x;
    volatile LAS unsigned* st;
};

__device__ __forceinline__ XcdBarrier xcd_barrier_post(unsigned* bar, volatile LAS unsigned* st) {
    XcdBarrier b; b.bar = bar; b.x = xb_xcc_id(); b.st = st;
    if (threadIdx.x == 0) (void)xb_add(&bar[XB_XCNT(b.x)], 1u);
    return b;
}
__device__ __forceinline__ void xcd_barrier_complete(unsigned* bar, unsigned x, unsigned& nloc, unsigned& nx) {
    const unsigned G = gridDim.x * gridDim.y * gridDim.z;
    unsigned sum, cnt, mine, sp = 0u;
    for (;;) {
        sum = 0u; cnt = 0u; mine = 0u;
#pragma unroll
        for (unsigned j = 0; j < 16; ++j) { const unsigned c = xb_ld(&bar[XB_XCNT(j)]); sum += c; cnt += (c > 0u) ? 1u : 0u; mine = (j == x) ? c : mine; }
        if (sum == G) break;
        __builtin_amdgcn_s_sleep(1);
        if ((++sp & 255u) == 0u) { if (xb_ld(&bar[XB_TMO])) break; if (sp > XB_SPIN_CAP) { atomicAdd(&bar[XB_TMO], 1u); break; } }
    }
    nloc = mine > 0u ? mine : 1u; nx = cnt > 0u ? cnt : 1u;
}

__device__ __forceinline__ void xcd_barrier(const XcdBarrier& b) {
    asm volatile("s_waitcnt vmcnt(0)" ::: "memory");
    __syncthreads();
    if (threadIdx.x == 0) {
        unsigned* bar = b.bar;
        __builtin_amdgcn_s_waitcnt(0);
        unsigned nloc = b.st[0], nx = b.st[1];
        if (nloc == 0u) { xcd_barrier_complete(bar, b.x, nloc, nx); b.st[0] = nloc; b.st[1] = nx; }
        const unsigned old = xb_add(&bar[XB_XSUB(b.x)], 1u);
        const unsigned gen = old / nloc;
        if (old + 1u == (gen + 1u) * nloc) {
            __builtin_amdgcn_fence(__ATOMIC_RELEASE, "agent");
            asm volatile("s_waitcnt vmcnt(0)" ::: "memory");
            const unsigned og = xb_add(&bar[XB_TOP], 1u);
            const unsigned tg = og / nx;
            if (og + 1u == (tg + 1u) * nx) xb_add(&bar[XB_TOPGEN], 1u);
            else XB_SPIN(xb_ld(&bar[XB_TOPGEN]) == tg, bar);
            __builtin_amdgcn_fence(__ATOMIC_ACQUIRE, "agent");
            xb_add(&bar[XB_XGEN(b.x)], 1u);
            asm volatile("s_waitcnt vmcnt(0)" ::: "memory");
        } else {
            XB_SPIN(xb_ld(&bar[XB_XGEN(b.x)]) == gen, bar);
            __builtin_amdgcn_fence(__ATOMIC_ACQUIRE, "agent");
            asm volatile("s_waitcnt vmcnt(0)" ::: "memory");
        }
    }
    __syncthreads();
}


template <bool COOP>
__global__ void __launch_bounds__(256, 2) mk_forward(Params P, int ph_begin, int ph_end) {
  __shared__ __attribute__((aligned(16))) char smem[SMEM_BYTES];
  int ph = 0;
  volatile LAS unsigned* xbst = (volatile LAS unsigned*)(smem + SMEM_BYTES - 16);
  XcdBarrier xb;
  if (COOP) {
    if (__builtin_amdgcn_workitem_id_x() == 0) { xbst[0] = 0u; xbst[1] = 0u; xbst[2] = 0u; xbst[3] = 0u; }
    __syncthreads();
    xb = xcd_barrier_post((unsigned*)(P.ws + OFF_bar), xbst);
  }
#define PHASE(code)                                         \
  {                                                         \
    if (ph >= ph_begin && ph < ph_end) { code; }            \
    ++ph;                                                   \
    if (COOP && ph > ph_begin && ph < ph_end) {             \
      if (ph == 1) cg::this_grid().sync();                  \
      else xcd_barrier(xb);                                 \
    }                                                       \
  }
  PHASE(phase_prologue(P, smem));
  PHASE(phase_h0(P));
#pragma unroll 1
  for (int l = 0; l < 2; ++l) {
#pragma unroll 1
    for (int hb = 0; hb < 2; ++hb) {
      PHASE(phase_proj(P, l, hb, smem, ph));
      PHASE(phase_ssd_prep(P, l, hb, smem, ph));
      PHASE(phase_mix2(P, l, hb, smem, ph));
      PHASE(phase_carry(P));
      PHASE(phase_ssd_out(P, l, hb, smem, ph));
    }
    PHASE(phase_merge(P, l, smem, ph));
    PHASE(phase_outproj(P, l, smem, ph));
    PHASE(phase_ln1(P, l, smem));
    PHASE(phase_topk(P, l, smem));
    PHASE(phase_ffn1(P, l, smem, ph));
    PHASE(phase_ffn2(P, l, smem, ph));
    PHASE(phase_ln2(P, l));
  }
#undef PHASE
}

#ifndef MK_COOP
#define MK_COOP 1
#endif

extern "C" void kernel_launch(void* const* d_in, const int* in_sizes, int n_in, void* d_out, int out_size, void* d_ws, size_t ws_size,
                              hipStream_t stream) {
  Params p{};
  const float* const* in = (const float* const*)d_in;
  p.x = in[0]; p.c = in[1]; p.ctx = in[2]; p.c_ctx = in[3]; p.w_mod = in[4]; p.b_mod = in[5]; p.w_in = in[6]; p.conv_w = in[7];
  p.conv_b = in[8]; p.a_log = in[9]; p.dt_bias = in[10]; p.ssd_d = in[11]; p.ssd_norm_g = in[12]; p.diff_lambda = in[13];
  p.diff_norm_g = in[14]; p.pool_w = in[15]; p.pool_scale = in[16]; p.sgu_ln_g = in[17]; p.sgu_ln_b = in[18]; p.sgu_w = in[19];
  p.sgu_b = in[20]; p.w_gate = in[21]; p.w_branch = in[22]; p.w_out = in[23]; p.ln1_g = in[24]; p.ln1_b = in[25]; p.w_router = in[26];
  p.w1 = in[27]; p.w3 = in[28]; p.w2 = in[29]; p.ln2_g = in[30]; p.ln2_b = in[31];
  p.out = (float*)d_out;
  p.ws = (char*)d_ws;
  if (WS_NEED > ws_size) { fprintf(stderr, "workspace too small: need %zu have %zu\n", (size_t)WS_NEED, ws_size); return; }

  static int grid_blocks = 0;
  if (!grid_blocks) {
    int dev = 0, cus = 0, per_cu = 0;
    hipGetDevice(&dev);
    hipDeviceGetAttribute(&cus, hipDeviceAttributeMultiprocessorCount, dev);
    (void)hipOccupancyMaxActiveBlocksPerMultiprocessor(&per_cu, mk_forward<(MK_COOP != 0)>, 256, 0);
    if (per_cu < 1) per_cu = 1;
    if (per_cu > 2) per_cu = 2;
    grid_blocks = cus * per_cu;
  }
#if MK_COOP
  hipMemsetAsync((char*)d_ws + OFF_bar, 0, 32768, stream);
  int b = 0, e = NPHASE;
  void* args[] = {&p, &b, &e};
  hipError_t err = hipLaunchCooperativeKernel((void*)mk_forward<true>, dim3(grid_blocks), dim3(256), args, 0, stream);
  if (err != hipSuccess) fprintf(stderr, "cooperative launch failed: %s (grid %d)\n", hipGetErrorString(err), grid_blocks);
#else
  for (int ph = 0; ph < NPHASE; ++ph) hipLaunchKernelGGL(mk_forward<false>, dim3(grid_blocks), dim3(256), 0, stream, p, ph, ph + 1);
#endif
}
```

```cpp
#include <hip/hip_runtime.h>
#include <hip/hip_cooperative_groups.h>
#include <cstdio>
#include <cstdint>
namespace cg = cooperative_groups;

typedef unsigned short u16;
using bf16x8 = __attribute__((ext_vector_type(8))) short;
using bf16x4 = __attribute__((ext_vector_type(4))) short;
using f32x4 = __attribute__((ext_vector_type(4))) float;
using u32x4 = __attribute__((ext_vector_type(4))) unsigned;

#define DI __device__ __forceinline__
#define MFMA16(a, b, c) __builtin_amdgcn_mfma_f32_16x16x32_bf16((a), (b), (c), 0, 0, 0)

constexpr int NB = 16, SEQ = 2048, CTXL = 256, SP = 2304, NTOK = NB * SP, DM = 1024;
constexpr int HROWS = 8 * SP;
constexpr int INC = 4368, INP = 4480;
constexpr int NFFN_LAT = 65536, NFFN_ALL = 73728;
constexpr float LN_EPS = 1e-5f;
constexpr float ALPHA = 1.41421356237309515f;
constexpr int SMEM_BYTES = 81920;
constexpr int NPHASE = 2 + 2 * (2 * 5 + 7);


constexpr size_t al256(size_t x) { return (x + 255) & ~(size_t)255; }
constexpr size_t U_ = (size_t)NTOK * 512 * 2;
constexpr size_t OFF_WinT = 0;
constexpr size_t OFF_WgT = OFF_WinT + al256((size_t)2 * INP * 1024 * 2);
constexpr size_t OFF_WbT = OFF_WgT + al256((size_t)2 * 4 * 1024 * 1024 * 2);
constexpr size_t OFF_WoT = OFF_WbT + al256((size_t)2 * 4 * 1024 * 512 * 2);
constexpr size_t OFF_poolT = OFF_WoT + al256((size_t)2 * 1024 * 1024 * 2);
constexpr size_t OFF_sguW = OFF_poolT + al256((size_t)2 * 4 * 128 * 128 * 2);
constexpr size_t OFF_mod = OFF_sguW + al256((size_t)2 * 4 * 128 * 128 * 2);
constexpr size_t OFF_rope = OFF_mod + al256((size_t)2 * 17 * 6144 * 4);
constexpr size_t OFF_lamv = OFF_rope + al256(64 * 16 * 2 * 4);
constexpr size_t OFF_bar = OFF_lamv + 256;
constexpr size_t OFF_aff = OFF_bar + 32768;
constexpr size_t OFF_rank = OFF_aff + al256((size_t)NTOK * 16 * 4);
constexpr size_t OFF_ssq = OFF_rank + al256((size_t)NTOK * 16 * 4);
constexpr size_t OFF_tokidx = OFF_ssq + al256((size_t)NTOK * 8 * 4);
constexpr size_t OFF_gatev = OFF_tokidx + al256((size_t)NFFN_ALL * 4);
constexpr size_t OFF_dtbuf = OFF_gatev + al256((size_t)NFFN_ALL * 4);
constexpr size_t OFF_decay = OFF_dtbuf + al256((size_t)HROWS * 16 * 4);
constexpr size_t OFF_H = OFF_decay + al256((size_t)8 * 2 * 8 * 18 * 4);
constexpr size_t OFF_Y = OFF_H + 2 * U_;
constexpr size_t OFF_xsT = OFF_Y;
constexpr size_t OFF_cstate = OFF_Y + U_ / 2;
constexpr size_t OFF_enter = OFF_Y + U_;
constexpr size_t OFF_bm = OFF_Y + U_ + U_ / 2;
constexpr size_t OFF_cm = OFF_bm + U_ / 8;
constexpr size_t OFF_bmT = OFF_cm + U_ / 8;
constexpr size_t OFF_RM = OFF_Y + 2 * U_;
constexpr size_t OFF_xp = OFF_RM;
constexpr size_t OFF_z = OFF_xp + U_ / 2;
constexpr size_t OFF_xbc = OFF_z + U_ / 2;
constexpr size_t OFF_o1 = OFF_xbc;
constexpr size_t OFF_q = OFF_xbc + (U_ / 4) * 3;
constexpr size_t OFF_k = OFF_q + U_ / 2;
constexpr size_t OFF_vT = OFF_k + U_ / 2;
constexpr size_t OFF_gvT = OFF_vT + U_ / 2;
constexpr size_t OFF_br0 = OFF_gvT + U_ / 2;
constexpr size_t OFF_br1 = OFF_br0 + U_;
constexpr size_t OFF_br2 = OFF_br1 + U_;
constexpr size_t OFF_br3 = OFF_br2 + U_;
constexpr size_t OFF_acc = OFF_RM;
constexpr size_t OFF_W13T = OFF_RM;
constexpr size_t OFF_W2T = OFF_W13T + (size_t)16 * 1024 * 1024 * 2;
constexpr size_t OFF_hid = OFF_W2T + (size_t)16 * 1024 * 512 * 2;
constexpr size_t OFF_ye = OFF_hid + (size_t)NFFN_ALL * 512 * 2;
constexpr size_t WS_MIX_END = OFF_br3 + U_;
constexpr size_t WS_FFN_END = OFF_ye + (size_t)NFFN_ALL * 1024 * 2;
constexpr size_t WS_NEED = WS_MIX_END > WS_FFN_END ? WS_MIX_END : WS_FFN_END;

struct Params {
  const float *x, *c, *ctx, *c_ctx, *w_mod, *b_mod, *w_in, *conv_w, *conv_b, *a_log, *dt_bias, *ssd_d, *ssd_norm_g,
      *diff_lambda, *diff_norm_g, *pool_w, *pool_scale, *sgu_ln_g, *sgu_ln_b, *sgu_w, *sgu_b, *w_gate, *w_branch, *w_out,
      *ln1_g, *ln1_b, *w_router, *w1, *w3, *w2, *ln2_g, *ln2_b;
  float* out;
  char* ws;
};

DI int TID() { int t = (int)__builtin_amdgcn_workitem_id_x(); asm volatile("" : "+v"(t)); return t; }
typedef __bf16 bf2_t __attribute__((ext_vector_type(2)));
typedef float f2_t __attribute__((ext_vector_type(2)));
typedef unsigned u32x2 __attribute__((ext_vector_type(2)));
DI unsigned pack2(float a, float b) { f2_t v = {a, b}; return __builtin_bit_cast(unsigned, __builtin_convertvector(v, bf2_t)); }
DI u16 f2bf(float x) { return (u16)(pack2(x, 0.f) & 0xffffu); }
DI float bf2f(u16 v) { return __uint_as_float(((unsigned)v) << 16); }
DI float bflo(unsigned p) { return __uint_as_float(p << 16); }
DI float bfhi(unsigned p) { return __uint_as_float(p & 0xffff0000u); }
DI float sigmoidf_(float x) { return __builtin_amdgcn_rcpf(1.f + __expf(-x)); }
DI float siluf_(float x) { return x * __builtin_amdgcn_rcpf(1.f + __expf(-x)); }
DI float geluf_(float x) { float y = 0.7978845608028654f * (x + 0.044715f * x * x * x); float t = 1.f - 2.f * __builtin_amdgcn_rcpf(__expf(2.f * y) + 1.f); return 0.5f * x * (1.f + t); }
DI float softplusf_(float x) { return x > 20.f ? x : log1pf(__expf(x)); }
DI bf16x4 pack4(float a, float b, float c, float d) { u32x2 r = {pack2(a, b), pack2(c, d)}; return __builtin_bit_cast(bf16x4, r); }
DI bf16x4 pack4v(f32x4 v) { return pack4(v[0], v[1], v[2], v[3]); }
DI float wave_sum(float v) { for (int o = 32; o > 0; o >>= 1) v += __shfl_xor(v, o); return v; }

template <int MI, int NI, bool SWAP, bool LOWREG = false>
DI void mma_lds(const u16* As, int lda, const u16* Bs, int ldb, int ksteps, f32x4 (&acc)[MI][NI], int fr, int fq) {
  for (int ks = 0; ks < ksteps; ++ks) {
    if (LOWREG) __builtin_amdgcn_sched_barrier(0);
    bf16x8 a[MI], b[NI];
#pragma unroll
    for (int m = 0; m < MI; ++m) a[m] = *(const bf16x8*)(As + (m * 16 + fr) * lda + ks * 32 + fq * 8);
#pragma unroll
    for (int n = 0; n < NI; ++n) b[n] = *(const bf16x8*)(Bs + (n * 16 + fr) * ldb + ks * 32 + fq * 8);
#pragma unroll
    for (int m = 0; m < MI; ++m)
#pragma unroll
      for (int n = 0; n < NI; ++n) acc[m][n] = SWAP ? MFMA16(b[n], a[m], acc[m][n]) : MFMA16(a[m], b[n], acc[m][n]);
  }
}

constexpr int LDT = 72;
template <int NI, bool SWAP, bool GATHER, bool PF2 = true>
DI void gemm_main(const u16* __restrict__ A, int lda, const int* __restrict__ aidx, int arow0, const u16* __restrict__ Bt, int ldb, int brow0,
                  int K, f32x4 (&acc)[4][NI], u16* smem) {
  constexpr int BN = NI * 32;
  constexpr int NBL = BN / 32;
  const int tid = TID(), wave = tid >> 6, lane = tid & 63, fr = lane & 15, fq = lane >> 4;
  const int wr = wave >> 1, wc = wave & 1;
  u16* As = smem;
  u16* Bs = smem + 2 * 128 * LDT;
  const int lr = tid >> 3, lc = (tid & 7) * 8;
  const u16* ap[4];
#pragma unroll
  for (int i = 0; i < 4; ++i) {
    int r = arow0 + lr + 32 * i;
    size_t rr = GATHER ? (size_t)aidx[r] : (size_t)r;
    ap[i] = A + rr * lda + lc;
  }
  const u16* bp = Bt + (size_t)(brow0 + lr) * ldb + lc;
  u32x4 ra0[4], rb0[NBL], ra1[4], rb1[NBL];
  const int nk = K / 64;
#define GLOAD(RA, RB, KO)                                                                   \
  {                                                                                         \
    _Pragma("unroll") for (int i = 0; i < 4; ++i) RA[i] = *(const u32x4*)(ap[i] + (KO));    \
    _Pragma("unroll") for (int i = 0; i < NBL; ++i) RB[i] = *(const u32x4*)(bp + (size_t)(32 * i) * ldb + (KO)); \
  }
#define SSTORE_A(RA, BUF) { _Pragma("unroll") for (int i = 0; i < 4; ++i) *(u32x4*)(As + (BUF) * 128 * LDT + (lr + 32 * i) * LDT + lc) = RA[i]; }
#define SSTORE_B(RB, BUF) { _Pragma("unroll") for (int i = 0; i < NBL; ++i) *(u32x4*)(Bs + (BUF) * BN * LDT + (lr + 32 * i) * LDT + lc) = RB[i]; }
#define SSTORE(RA, RB, BUF) { SSTORE_A(RA, BUF) SSTORE_B(RB, BUF) }
#define COMPUTE(BUF) mma_lds<4, NI, SWAP, !PF2>(As + (BUF) * 128 * LDT + wr * 64 * LDT, LDT, Bs + (BUF) * BN * LDT + wc * (NI * 16) * LDT, LDT, 2, acc, fr, fq)
#define COMPUTE_KS(BUF, KS) mma_lds<4, NI, SWAP, false>(As + (BUF) * 128 * LDT + wr * 64 * LDT + (KS) * 32, LDT, Bs + (BUF) * BN * LDT + wc * (NI * 16) * LDT + (KS) * 32, LDT, 1, acc, fr, fq)
  if (PF2) {
    GLOAD(ra0, rb0, 0);
    GLOAD(ra1, rb1, 64);
    __syncthreads();
    SSTORE(ra0, rb0, 0);
    __syncthreads();
    for (int kt = 0; kt < nk; kt += 2) {
      if (kt + 2 < nk) GLOAD(ra0, rb0, (kt + 2) * 64);
      COMPUTE_KS(0, 0);
      SSTORE_A(ra1, 1);
      COMPUTE_KS(0, 1);
      SSTORE_B(rb1, 1);
      __syncthreads();
      if (kt + 3 < nk) GLOAD(ra1, rb1, (kt + 3) * 64);
      COMPUTE_KS(1, 0);
      if (kt + 2 < nk) SSTORE_A(ra0, 0);
      COMPUTE_KS(1, 1);
      if (kt + 2 < nk) SSTORE_B(rb0, 0);
      __syncthreads();
    }
  } else {
    GLOAD(ra0, rb0, 0);
    __syncthreads();
    SSTORE(ra0, rb0, 0);
    __syncthreads();
    for (int kt = 0; kt < nk; kt += 2) {
      GLOAD(ra0, rb0, (kt + 1) * 64);
      COMPUTE(0);
      SSTORE(ra0, rb0, 1);
      __syncthreads();
      if (kt + 2 < nk) GLOAD(ra0, rb0, (kt + 2) * 64);
      COMPUTE(1);
      if (kt + 2 < nk) SSTORE(ra0, rb0, 0);
      __syncthreads();
    }
  }
#undef GLOAD
#undef SSTORE
#undef COMPUTE
#undef COMPUTE_KS
#undef SSTORE_A
#undef SSTORE_B
}

template <int NI> DI void zero_acc(f32x4 (&a)[4][NI]) {
#pragma unroll
  for (int m = 0; m < 4; ++m)
#pragma unroll
    for (int n = 0; n < NI; ++n) a[m][n] = f32x4{0.f, 0.f, 0.f, 0.f};
}

DI void cvt_tile(const float* __restrict__ src0, const float* __restrict__ src1, int ld, u16* __restrict__ dst, int K, int n0, int k0, int mode, u16* lds) {
  const int tid = TID();
  constexpr int LC = 66;
  __syncthreads();
  float v[16];
  if (mode == 3) {
#pragma unroll
    for (int i = 0; i < 16; ++i) { int idx = tid + 256 * i; int n = idx >> 6, kk = idx & 63; v[i] = src0[(size_t)(n0 + n) * ld + k0 + kk]; }
#pragma unroll
    for (int i = 0; i < 16; ++i) { int idx = tid + 256 * i; int n = idx >> 6, kk = idx & 63; lds[kk * LC + n] = f2bf(v[i]); }
  } else {
#pragma unroll
    for (int i = 0; i < 16; ++i) {
      int idx = tid + 256 * i;
      int kk = idx >> 6, n = idx & 63;
      int nn = n0 + n;
      float t = 0.f;
      if (mode == 0) t = src0[(size_t)(k0 + kk) * ld + nn];
      else if (mode == 1) {
        int col = nn < 1792 ? nn : (nn < 4352 ? nn + 16 : (nn < 4368 ? nn - 4352 + 1792 : -1));
        if (col >= 0) t = src0[(size_t)(k0 + kk) * ld + col];
        if (nn >= 1792 && nn < 2304) t *= 0.125f;
      } else {
        int g = nn >> 5, r = nn & 31;
        t = (r < 16) ? src0[(size_t)(k0 + kk) * ld + g * 16 + r] : src1[(size_t)(k0 + kk) * ld + g * 16 + r - 16];
      }
      v[i] = t;
    }
#pragma unroll
    for (int i = 0; i < 16; ++i) { int idx = tid + 256 * i; int kk = idx >> 6, n = idx & 63; lds[kk * LC + n] = f2bf(v[i]); }
  }
  __syncthreads();
  for (int c = tid; c < 512; c += 256) {
    int n = c & 63, kc = (c >> 6) * 8;
    bf16x8 o;
#pragma unroll
    for (int j = 0; j < 8; ++j) o[j] = (short)lds[(kc + j) * LC + n];
    *(bf16x8*)(dst + (size_t)(n0 + n) * K + k0 + kc) = o;
  }
}

DI void mod_item(const Params& P, int item, char* smem) {
  const int l = item / 96, n0 = (item % 96) * 64;
  float* sc = (float*)smem;
  const int tid = TID();
  __syncthreads();
  for (int i = tid; i < 17 * 1024; i += 256) {
    int s = i >> 10, kk = i & 1023;
    float v = s < 16 ? P.c[s * 1024 + kk] : P.c_ctx[kk];
    sc[i] = siluf_(v);
  }
  __syncthreads();
  const int col = tid & 63, kp = tid >> 6;
  float a[17];
#pragma unroll
  for (int s = 0; s < 17; ++s) a[s] = 0.f;
  const float* w = P.w_mod + (size_t)l * 1024 * 6144 + n0 + col;
  for (int k0 = kp * 256; k0 < kp * 256 + 256; k0 += 16) {
    float wv[16];
#pragma unroll
    for (int u = 0; u < 16; ++u) wv[u] = w[(size_t)(k0 + u) * 6144];
#pragma unroll
    for (int u = 0; u < 16; ++u)
#pragma unroll
      for (int s = 0; s < 17; ++s) a[s] += sc[s * 1024 + k0 + u] * wv[u];
  }
  __syncthreads();
  float* red = (float*)smem;
#pragma unroll
  for (int s = 0; s < 17; ++s) red[(kp * 17 + s) * 64 + col] = a[s];
  __syncthreads();
  for (int i = tid; i < 17 * 64; i += 256) {
    int s = i >> 6, cc = i & 63;
    float v = red[(0 * 17 + s) * 64 + cc] + red[(1 * 17 + s) * 64 + cc] + red[(2 * 17 + s) * 64 + cc] + red[(3 * 17 + s) * 64 + cc];
    ((float*)(P.ws + OFF_mod))[((size_t)l * 17 + s) * 6144 + n0 + cc] = v + P.b_mod[l * 6144 + n0 + cc];
  }
}

DI void misc_item(const Params& P) {
  const int tid = TID();
  for (int i = tid; i < 1024; i += 256) {
    int pos = i >> 4, f = i & 15;
    float inv = powf(10000.f, -(float)f / 16.f);
    float ang = (float)pos * inv;
    ((float*)(P.ws + OFF_rope))[i * 2] = cosf(ang);
    ((float*)(P.ws + OFF_rope))[i * 2 + 1] = sinf(ang);
  }
  if (tid < 2) {
    const float* dl = P.diff_lambda + tid * 256;
    float s1 = 0.f, s2 = 0.f;
    for (int i = 0; i < 64; ++i) { s1 += dl[i] * dl[64 + i]; s2 += dl[128 + i] * dl[192 + i]; }
    float lam_init = 0.8f - 0.6f * expf(-0.3f * (float)tid);
    ((float*)(P.ws + OFF_lamv))[tid * 2] = expf(s1) - expf(s2) + lam_init;
    ((float*)(P.ws + OFF_lamv))[tid * 2 + 1] = lam_init;
  }
}

DI void phase_prologue(const Params& P, char* smem) {
  const int per_layer = 1120 + 4 * 256 + 4 * 128 + 256 + 16 + 16;
  const int ncvt = 2 * per_layer;
  const int total = ncvt + 192 + 1;
  for (int it0 = blockIdx.x; it0 < total; it0 += gridDim.x) {
    const int it = it0 < 193 ? ncvt + it0 : it0 - 193;
    if (it < ncvt) {
      const int l = it / per_layer;
      int t = it % per_layer;
      const float* s0; u16* dst; int ld, K, ntk, mode;
      if (t < 1120) { s0 = P.w_in + (size_t)l * 1024 * INC; ld = INC; dst = ((u16*)(P.ws + OFF_WinT)) + (size_t)l * INP * 1024; K = 1024; ntk = 16; mode = 1; }
      else if (t < 2144) { t -= 1120; int kq = t >> 8; t &= 255; s0 = P.w_gate + ((size_t)l * 4 + kq) * 1024 * 1024; ld = 1024; dst = ((u16*)(P.ws + OFF_WgT)) + ((size_t)l * 4 + kq) * 1024 * 1024; K = 1024; ntk = 16; mode = 0; }
      else if (t < 2656) { t -= 2144; int kq = t >> 7; t &= 127; s0 = P.w_branch + ((size_t)l * 4 + kq) * 512 * 1024; ld = 1024; dst = ((u16*)(P.ws + OFF_WbT)) + ((size_t)l * 4 + kq) * 1024 * 512; K = 512; ntk = 8; mode = 0; }
      else if (t < 2912) { t -= 2656; s0 = P.w_out + (size_t)l * 1024 * 1024; ld = 1024; dst = ((u16*)(P.ws + OFF_WoT)) + (size_t)l * 1024 * 1024; K = 1024; ntk = 16; mode = 0; }
      else if (t < 2928) { t -= 2912; int g = t >> 2; t &= 3; s0 = P.pool_w + ((size_t)l * 4 + g) * 128 * 128; ld = 128; dst = ((u16*)(P.ws + OFF_poolT)) + ((size_t)l * 4 + g) * 128 * 128; K = 128; ntk = 2; mode = 0; }
      else { t -= 2928; int g = t >> 2; t &= 3; s0 = P.sgu_w + ((size_t)l * 4 + g) * 128 * 128; ld = 128; dst = ((u16*)(P.ws + OFF_sguW)) + ((size_t)l * 4 + g) * 128 * 128; K = 128; ntk = 2; mode = 3; }
      const int tn = t / ntk, tk = t % ntk;
      cvt_tile(s0, s0, ld, dst, K, tn * 64, tk * 64, mode, (u16*)smem);
    } else if (it < ncvt + 192) {
      mod_item(P, it - ncvt, smem);
    } else {
      misc_item(P);
    }
  }
}

DI void ffn_cvt_item(const Params& P, int l, int it, char* smem) {
  const int e = it / 384;
  int t = it % 384;
  if (t < 256) {
    cvt_tile(P.w1 + ((size_t)l * 16 + e) * 1024 * 512, P.w3 + ((size_t)l * 16 + e) * 1024 * 512, 512, ((u16*)(P.ws + OFF_W13T)) + (size_t)e * 1024 * 1024, 1024, (t >> 4) * 64, (t & 15) * 64, 2, (u16*)smem);
  } else {
    t -= 256;
    const float* s = P.w2 + ((size_t)l * 16 + e) * 512 * 1024;
    cvt_tile(s, s, 1024, ((u16*)(P.ws + OFF_W2T)) + (size_t)e * 1024 * 512, 512, (t >> 3) * 64, (t & 7) * 64, 0, (u16*)smem);
  }
}

DI void load_row_f32(const float* p, int lane, float (&v)[16]) {
#pragma unroll
  for (int k = 0; k < 4; ++k) { float4 t = *(const float4*)(p + lane * 4 + 256 * k); v[4 * k] = t.x; v[4 * k + 1] = t.y; v[4 * k + 2] = t.z; v[4 * k + 3] = t.w; }
}
DI void load_row_bf16(const u16* p, int lane, float (&v)[16]) {
#pragma unroll
  for (int k = 0; k < 4; ++k) { bf16x4 t = *(const bf16x4*)(p + lane * 4 + 256 * k); for (int i = 0; i < 4; ++i) v[4 * k + i] = bf2f((u16)t[i]); }
}
DI void store_row_f32(float* p, int lane, const float (&v)[16]) {
#pragma unroll
  for (int k = 0; k < 4; ++k) *(float4*)(p + lane * 4 + 256 * k) = make_float4(v[4 * k], v[4 * k + 1], v[4 * k + 2], v[4 * k + 3]);
}
DI void store_row_bf16(u16* p, int lane, const float (&v)[16]) {
#pragma unroll
  for (int k = 0; k < 4; ++k) *(bf16x4*)(p + lane * 4 + 256 * k) = pack4(v[4 * k], v[4 * k + 1], v[4 * k + 2], v[4 * k + 3]);
}
DI void ln_row(float (&v)[16], const float* g, const float* b, int lane) {
  float s = 0.f;
#pragma unroll
  for (int i = 0; i < 16; ++i) s += v[i];
  float mu = wave_sum(s) * (1.f / 1024.f);
  float q = 0.f;
#pragma unroll
  for (int i = 0; i < 16; ++i) { float d = v[i] - mu; q += d * d; }
  float rstd = rsqrtf(wave_sum(q) * (1.f / 1024.f) + LN_EPS);
  float gg[16], bb[16];
  load_row_f32(g, lane, gg); load_row_f32(b, lane, bb);
#pragma unroll
  for (int i = 0; i < 16; ++i) v[i] = (v[i] - mu) * rstd * gg[i] + bb[i];
}

DI void phase_h0(const Params& P) {
  const int lane = TID() & 63;
  const int gw = blockIdx.x * 4 + (TID() >> 6), nw = gridDim.x * 4;
  for (int row = gw; row < NTOK; row += nw) {
    int s = row / SP, p = row % SP;
    bool lat = p < SEQ;
    const float* xs = lat ? P.x + ((size_t)s * SEQ + p) * DM : P.ctx + ((size_t)s * CTXL + (p - SEQ)) * DM;
    const float* md = ((float*)(P.ws + OFF_mod)) + (size_t)(lat ? s : 16) * 6144;
    float v[16], sh[16], scl[16];
    load_row_f32(xs, lane, v); load_row_f32(md, lane, sh); load_row_f32(md + 1024, lane, scl);
#pragma unroll
    for (int i = 0; i < 16; ++i) v[i] = v[i] * (1.f + scl[i]) + sh[i];
    store_row_bf16(((u16*)(P.ws + OFF_H)) + (size_t)row * DM, lane, v);
  }
}

DI void compute_x1(const Params& P, int l, int row, int lane, float (&v)[16]) {
  int s = row / SP, p = row % SP;
  bool lat = p < SEQ;
  const float* xs;
  if (l == 0) xs = lat ? P.x + ((size_t)s * SEQ + p) * DM : P.ctx + ((size_t)s * CTXL + (p - SEQ)) * DM;
  else xs = P.out + ((size_t)s * SEQ + p) * DM;
  const float* md = ((float*)(P.ws + OFF_mod)) + ((size_t)l * 17 + (lat ? s : 16)) * 6144;
  float y[16], m2[16];
  load_row_f32(xs, lane, v); load_row_bf16(((u16*)(P.ws + OFF_Y)) + (size_t)row * DM, lane, y); load_row_f32(md + 2 * 1024, lane, m2);
#pragma unroll
  for (int i = 0; i < 16; ++i) v[i] = ALPHA * v[i] + m2[i] * y[i];
  ln_row(v, P.ln1_g + l * 1024, P.ln1_b + l * 1024, lane);
}

DI void phase_ln1(const Params& P, int l, char* smem) {
  const bool last = (l == 1);
  const int tid = TID();
  const int lane = tid & 63;
  const int gw = blockIdx.x * 4 + (tid >> 6), nw = gridDim.x * 4;
  float* wT = (float*)smem;
  __syncthreads();
  {
    const float* wr = P.w_router + (size_t)l * 1024 * 16;
    for (int i = tid; i < 4096; i += 256) {
      int c = i >> 2, e4 = (i & 3) * 4;
      float4 w = *(const float4*)(wr + (size_t)c * 16 + e4);
      wT[(e4 + 0) * 1024 + c] = w.x; wT[(e4 + 1) * 1024 + c] = w.y; wT[(e4 + 2) * 1024 + c] = w.z; wT[(e4 + 3) * 1024 + c] = w.w;
    }
  }
  __syncthreads();
  for (int row = gw; row < NTOK; row += nw) {
    int s = row / SP, p = row % SP;
    bool lat = p < SEQ;
    if (last && !lat) continue;
    float v[16];
    compute_x1(P, l, row, lane, v);
    const float* md = ((float*)(P.ws + OFF_mod)) + ((size_t)l * 17 + (lat ? s : 16)) * 6144;
    float m3[16], m4[16];
    load_row_f32(md + 3 * 1024, lane, m3); load_row_f32(md + 4 * 1024, lane, m4);
#pragma unroll
    for (int i = 0; i < 16; ++i) v[i] = v[i] * (1.f + m4[i]) + m3[i];
    store_row_bf16(((u16*)(P.ws + OFF_H)) + (size_t)row * DM, lane, v);
    float lg[16];
#pragma unroll
    for (int e = 0; e < 16; ++e) {
      float a = 0.f;
#pragma unroll
      for (int k = 0; k < 4; ++k) {
        float4 w = *(const float4*)(wT + e * 1024 + lane * 4 + 256 * k);
        a += v[4 * k] * w.x + v[4 * k + 1] * w.y + v[4 * k + 2] * w.z + v[4 * k + 3] * w.w;
      }
      lg[e] = a;
    }
#pragma unroll
    for (int e = 0; e < 16; ++e) lg[e] = wave_sum(lg[e]);
    float mx = lg[0];
#pragma unroll
    for (int e = 1; e < 16; ++e) mx = fmaxf(mx, lg[e]);
    float sum = 0.f;
#pragma unroll
    for (int e = 0; e < 16; ++e) { lg[e] = expf(lg[e] - mx); sum += lg[e]; }
    float inv = 1.f / sum;
    if (lane < 16) {
      float mine = 0.f;
#pragma unroll
      for (int e = 0; e < 16; ++e) if (lane == e) mine = lg[e];
      ((float*)(P.ws + OFF_aff))[(size_t)row * 16 + lane] = mine * inv;
    }
  }
}

DI int block_excl_scan(int v, int* red, int tid, int& total) {
  const int lane = tid & 63, wave = tid >> 6;
  int inc = v;
#pragma unroll
  for (int o = 1; o < 64; o <<= 1) { int t = __shfl_up(inc, o); if (lane >= o) inc += t; }
  __syncthreads();
  if (lane == 63) red[wave] = inc;
  __syncthreads();
  int base = 0;
#pragma unroll
  for (int w = 0; w < 4; ++w) { int t = red[w]; if (w < wave) base += t; }
  total = red[0] + red[1] + red[2] + red[3];
  return base + inc - v;
}

DI void phase_topk(const Params& P, int l, char* smem) {
  const bool last = (l == 1);
  const int tid = TID();
  unsigned* keys = (unsigned*)smem;
  int* red = (int*)(smem + 8192);
  const int nitems = last ? 256 : 512;
  for (int it = gridDim.x - 1 - blockIdx.x; it < 16 * 384; it += gridDim.x) ffn_cvt_item(P, l, it, smem);
  for (int it = blockIdx.x; it < nitems; it += gridDim.x) {
    const bool isctx = it >= 256;
    const int se = it & 255, s = se >> 4, e = se & 15;
    const int n = isctx ? CTXL : SEQ, cap = isctx ? 32 : 256;
    const int row0 = s * SP + (isctx ? SEQ : 0);
    const int per = n >> 8;
    __syncthreads();
    for (int i = tid; i < n; i += 256) keys[i] = __float_as_uint(((float*)(P.ws + OFF_aff))[(size_t)(row0 + i) * 16 + e]);
    __syncthreads();
    unsigned kv[8];
#pragma unroll
    for (int j = 0; j < 8; ++j) kv[j] = (j < per) ? keys[tid * per + j] : 0u;
    unsigned prefix = 0u;
    int krem = cap;
    for (int bit = 31; bit >= 0; --bit) {
      const unsigned himask = (bit == 31) ? 0u : (0xFFFFFFFFu << (bit + 1));
      const unsigned want = prefix | (1u << bit);
      int c = 0;
#pragma unroll
      for (int j = 0; j < 8; ++j) c += (j < per && ((kv[j] & (himask | (1u << bit))) == want)) ? 1 : 0;
      c = (int)wave_sum((float)c);
      __syncthreads();
      if ((tid & 63) == 0) red[tid >> 6] = c;
      __syncthreads();
      const int cnt = red[0] + red[1] + red[2] + red[3];
      if (cnt >= krem) prefix = want; else krem -= cnt;
    }
    const unsigned T = prefix;
    int cgt = 0, ceq = 0;
#pragma unroll
    for (int j = 0; j < 8; ++j) if (j < per) { cgt += kv[j] > T ? 1 : 0; ceq += kv[j] == T ? 1 : 0; }
    int tot_gt, tot_eq, tot_sel;
    (void)block_excl_scan(cgt, red, tid, tot_gt);
    const int eq_before = block_excl_scan(ceq, red, tid, tot_eq);
    const int need_eq = cap - tot_gt;
    int eqc = eq_before, csel = 0;
    bool sel[8];
#pragma unroll
    for (int j = 0; j < 8; ++j) {
      sel[j] = false;
      if (j < per) {
        if (kv[j] > T) sel[j] = true;
        else if (kv[j] == T) { sel[j] = eqc < need_eq; ++eqc; }
        csel += sel[j] ? 1 : 0;
      }
    }
    int slot = block_excl_scan(csel, red, tid, tot_sel);
#pragma unroll
    for (int j = 0; j < 8; ++j) if (j < per) {
      const int t = tid * per + j;
      int rk = cap;
      if (sel[j]) {
        rk = slot++;
        const int R = isctx ? NFFN_LAT + (e * 16 + s) * 32 + rk : (s * 16 + e) * 256 + rk;
        ((int*)(P.ws + OFF_tokidx))[R] = row0 + t;
        ((float*)(P.ws + OFF_gatev))[R] = __uint_as_float(kv[j]);
      }
      ((int*)(P.ws + OFF_rank))[(size_t)(row0 + t) * 16 + e] = rk;
    }
  }
}

DI void phase_ln2(const Params& P, int l) {
  const bool last = (l == 1);
  const int lane = TID() & 63;
  const int gw = blockIdx.x * 4 + (TID() >> 6), nw = gridDim.x * 4;
  for (int row = gw; row < NTOK; row += nw) {
    int s = row / SP, p = row % SP;
    bool lat = p < SEQ;
    if (last && !lat) continue;
    float v[16];
    compute_x1(P, l, row, lane, v);
    float yf[16];
#pragma unroll
    for (int i = 0; i < 16; ++i) yf[i] = 0.f;
    const int cap = lat ? 256 : 32;
    int rks[16];
    {
      const int4* rp = (const int4*)(((int*)(P.ws + OFF_rank)) + (size_t)row * 16);
      int4 r0 = rp[0], r1 = rp[1], r2 = rp[2], r3 = rp[3];
      rks[0] = r0.x; rks[1] = r0.y; rks[2] = r0.z; rks[3] = r0.w; rks[4] = r1.x; rks[5] = r1.y; rks[6] = r1.z; rks[7] = r1.w;
      rks[8] = r2.x; rks[9] = r2.y; rks[10] = r2.z; rks[11] = r2.w; rks[12] = r3.x; rks[13] = r3.y; rks[14] = r3.z; rks[15] = r3.w;
    }
#pragma unroll
    for (int e = 0; e < 16; ++e) {
      const int rk = __builtin_amdgcn_readfirstlane(rks[e]);
      if (rk < cap) {
        int R = lat ? (s * 16 + e) * 256 + rk : NFFN_LAT + (e * 16 + s) * 32 + rk;
        float t[16];
        load_row_bf16(((u16*)(P.ws + OFF_ye)) + (size_t)R * DM, lane, t);
#pragma unroll
        for (int i = 0; i < 16; ++i) yf[i] += t[i];
      }
    }
    const float* md = ((float*)(P.ws + OFF_mod)) + ((size_t)l * 17 + (lat ? s : 16)) * 6144;
    float m5[16];
    load_row_f32(md + 5 * 1024, lane, m5);
#pragma unroll
    for (int i = 0; i < 16; ++i) v[i] = ALPHA * v[i] + m5[i] * yf[i];
    ln_row(v, P.ln2_g + l * 1024, P.ln2_b + l * 1024, lane);
    if (lat) store_row_f32(P.out + ((size_t)s * SEQ + p) * DM, lane, v);
    if (!last) {
      const float* md2 = ((float*)(P.ws + OFF_mod)) + ((size_t)(l + 1) * 17 + (lat ? s : 16)) * 6144;
      float sh[16], scl[16];
      load_row_f32(md2, lane, sh); load_row_f32(md2 + 1024, lane, scl);
#pragma unroll
      for (int i = 0; i < 16; ++i) v[i] = v[i] * (1.f + scl[i]) + sh[i];
      store_row_bf16(((u16*)(P.ws + OFF_H)) + (size_t)row * DM, lane, v);
    }
  }
}

DI int wq_next(unsigned* ctr, char* smem) {
  volatile int* slot = (volatile int*)(smem + SMEM_BYTES - 32);
  __syncthreads();
  if (TID() == 0) *slot = (int)__hip_atomic_fetch_add(ctr, 1u, __ATOMIC_RELAXED, __HIP_MEMORY_SCOPE_AGENT);
  __syncthreads();
  return *slot;
}

DI unsigned* wq_ctr(const Params& P, int ph) { return (unsigned*)(P.ws + OFF_bar) + 3600 + 16 * ph; }

template <bool SWAP>
DI void proj_tile(const Params& P, int l, int hb, int mt, int nt, char* smem) {
  const int tid = TID(), wave = tid >> 6, lane = tid & 63, fr = lane & 15, fq = lane >> 4;
  const int wr = wave >> 1, wc = wave & 1;
  const int hrow0 = mt * 128, grow0 = hb * HROWS + hrow0;
  f32x4 acc[4][4];
  zero_acc<4>(acc);
  gemm_main<4, SWAP, false>(((u16*)(P.ws + OFF_H)), DM, nullptr, grow0, ((u16*)(P.ws + OFF_WinT)) + (size_t)l * INP * 1024, 1024, nt * 128, 1024, acc, (u16*)smem);
  const int jp = mt % 18;
  const int bl = mt / 18;
  const bool lat = jp < 16;
  if (SWAP) {
    u16* dst; int ldd, c0;
    if (nt < 4) { dst = ((u16*)(P.ws + OFF_xp)); ldd = 512; c0 = nt * 128; }
    else if (nt < 8) { dst = ((u16*)(P.ws + OFF_z)); ldd = 512; c0 = (nt - 4) * 128; }
    else if (nt < 14) { dst = ((u16*)(P.ws + OFF_xbc)); ldd = 768; c0 = (nt - 8) * 128; }
    else if (nt < 18) { dst = ((u16*)(P.ws + OFF_q)); ldd = 512; c0 = (nt - 14) * 128; }
    else if (nt < 22) { dst = ((u16*)(P.ws + OFF_k)); ldd = 512; c0 = (nt - 18) * 128; }
    else { dst = ((u16*)(P.ws + OFF_br3)); ldd = 512; c0 = (nt - 26) * 128; }
    const bool isu = nt >= 26;
    const bool rope = (nt >= 14 && nt < 22) && lat;
#pragma unroll
    for (int m = 0; m < 4; ++m) {
      int r = wr * 64 + m * 16 + fr;
      size_t orow = isu ? (size_t)(grow0 + r) : (size_t)(hrow0 + r);
      if (rope) {
        int t = jp * 128 + r;
        int prow = t >> 6, pcol = t & 63;
#pragma unroll
        for (int j = 0; j < 4; ++j) {
          int f = fq * 4 + j;
          float c1 = ((float*)(P.ws + OFF_rope))[(prow * 16 + f) * 2], s1 = ((float*)(P.ws + OFF_rope))[(prow * 16 + f) * 2 + 1];
          float c2 = ((float*)(P.ws + OFF_rope))[(pcol * 16 + f) * 2], s2 = ((float*)(P.ws + OFF_rope))[(pcol * 16 + f) * 2 + 1];
          float a = acc[m][0][j], b = acc[m][1][j];
          acc[m][0][j] = a * c1 - b * s1; acc[m][1][j] = a * s1 + b * c1;
          a = acc[m][2][j]; b = acc[m][3][j];
          acc[m][2][j] = a * c2 - b * s2; acc[m][3][j] = a * s2 + b * c2;
        }
      }
#pragma unroll
      for (int n = 0; n < 4; ++n) {
        f32x4 v = acc[m][n];
        if (isu) { v[0] = geluf_(v[0]); v[1] = geluf_(v[1]); v[2] = geluf_(v[2]); v[3] = geluf_(v[3]); }
        int col = c0 + wc * 64 + n * 16 + fq * 4;
        *(bf16x4*)(dst + orow * ldd + col) = pack4v(v);
      }
    }
  } else {
    if (nt == 34) {
      if (wc == 0) {
#pragma unroll
        for (int m = 0; m < 4; ++m)
#pragma unroll
          for (int j = 0; j < 4; ++j) ((float*)(P.ws + OFF_dtbuf))[(size_t)(hrow0 + wr * 64 + m * 16 + fq * 4 + j) * 16 + fr] = acc[m][0][j];
      }
    } else if (nt < 26) {
      int cb = (nt - 22) * 128 + wc * 64;
#pragma unroll
      for (int m = 0; m < 4; ++m)
#pragma unroll
        for (int n = 0; n < 4; ++n) {
          int c = cb + n * 16 + fr;
          int pos = jp * 128 + wr * 64 + m * 16 + fq * 4;
          *(bf16x4*)(((u16*)(P.ws + OFF_vT)) + ((size_t)bl * 512 + c) * SP + pos) = pack4v(acc[m][n]);
        }
    } else {
      int cb = (nt - 30) * 128 + wc * 64;
#pragma unroll
      for (int m = 0; m < 4; ++m)
#pragma unroll
        for (int n = 0; n < 4; ++n) {
          int c = cb + n * 16 + fr;
          int i0 = wr * 64 + m * 16 + fq * 4;
          f32x4 v = acc[m][n];
          *(bf16x4*)(((u16*)(P.ws + OFF_gvT)) + ((size_t)mt * 512 + c) * 128 + i0) = pack4(geluf_(v[0]), geluf_(v[1]), geluf_(v[2]), geluf_(v[3]));
        }
    }
  }
}

DI void phase_proj(const Params& P, int l, int hb, char* smem, int ph) {
  const bool last = (l == 1);
  for (;;) {
    const int it = wq_next(wq_ctr(P, ph), smem);
    if (it >= 144 * 35) break;
    int mt = it / 35, nt = it % 35;
    bool isctx = (mt % 18) >= 16;
    if (last && isctx) {
      bool need = (nt >= 8 && nt < 14) || (nt >= 18 && nt < 26) || nt == 34;
      if (!need) continue;
    }
    bool transposed = (nt >= 22 && nt < 26) || nt >= 30;
    if (transposed) proj_tile<false>(P, l, hb, mt, nt, smem);
    else proj_tile<true>(P, l, hb, mt, nt, smem);
  }
}

constexpr int LDK = 136;
DI void pool_item(const Params& P, int l, int hb, int mt, int g, char* smem) {
  const int tid = TID(), wave = tid >> 6, lane = tid & 63, fr = lane & 15, fq = lane >> 4;
  const int wr = wave >> 1, wc = wave & 1;
  u16* As = (u16*)smem;
  u16* Bs = As + 128 * LDK;
  const int jp = mt % 18, bl = mt / 18;
  const bool lat = jp < 16;
  const int n = lat ? SEQ : CTXL;
  const int p0 = lat ? jp * 128 : (jp - 16) * 128;
  const int seqbase = bl * SP + (lat ? 0 : SEQ);
  const int half = 1 << g;
  __syncthreads();
  {
    const int cch = tid & 15;
    const u16* src = ((u16*)(P.ws + OFF_xp)) + (size_t)seqbase * 512 + g * 128 + cch * 8;
    for (int ii = 0; ii < 8; ++ii) {
      int i = (tid >> 4) + 16 * ii;
      int p = p0 + i;
      int lo = max(p - half, 0), hi = min(p + half, n);
      float s[8];
#pragma unroll
      for (int e = 0; e < 8; ++e) s[e] = 0.f;
      for (int r = lo; r < hi; ++r) {
        bf16x8 t = *(const bf16x8*)(src + (size_t)r * 512);
#pragma unroll
        for (int e = 0; e < 8; ++e) s[e] += bf2f((u16)t[e]);
      }
      bf16x8 self = *(const bf16x8*)(src + (size_t)p * 512);
      float inv = 1.f / (float)(hi - lo);
      bf16x8 o;
#pragma unroll
      for (int e = 0; e < 8; ++e) o[e] = (short)f2bf(s[e] * inv - bf2f((u16)self[e]));
      *(bf16x8*)(As + i * LDK + cch * 8) = o;
    }
    const u16* wsrc = ((u16*)(P.ws + OFF_poolT)) + ((size_t)l * 4 + g) * 128 * 128;
    for (int cid = tid; cid < 2048; cid += 256) {
      int r = cid >> 4, c8 = (cid & 15) * 8;
      *(u32x4*)(Bs + r * LDK + c8) = *(const u32x4*)(wsrc + r * 128 + c8);
    }
  }
  __syncthreads();
  f32x4 acc[4][4];
  zero_acc<4>(acc);
  mma_lds<4, 4, true>(As + wr * 64 * LDK, LDK, Bs + wc * 64 * LDK, LDK, 4, acc, fr, fq);
  const float* psc = P.pool_scale + l * 512 + g * 128;
#pragma unroll
  for (int m = 0; m < 4; ++m)
#pragma unroll
    for (int nn = 0; nn < 4; ++nn) {
      int r = wr * 64 + m * 16 + fr, c = wc * 64 + nn * 16 + fq * 4;
      float4 sc = *(const float4*)(psc + c);
      f32x4 v = acc[m][nn];
      *(bf16x4*)(((u16*)(P.ws + OFF_br0)) + (size_t)(hb * HROWS + mt * 128 + r) * 512 + g * 128 + c) = pack4(v[0] * sc.x, v[1] * sc.y, v[2] * sc.z, v[3] * sc.w);
    }
}

DI void sgu_item(const Params& P, int l, int hb, int mt, int g, char* smem) {
  const int tid = TID(), wave = tid >> 6, lane = tid & 63, fr = lane & 15, fq = lane >> 4;
  const int wr = wave >> 1, wc = wave & 1;
  u16* As = (u16*)smem;
  u16* Bs = As + 128 * LDK;
  float* st = (float*)(Bs + 128 * LDK);
  const u16* gv = ((u16*)(P.ws + OFF_gvT)) + (size_t)mt * 512 * 128;
  __syncthreads();
  {
    float* ps = (float*)smem;
    float* pq = ps + 16 * 128;
    const int cg = tid >> 4, tc = tid & 15;
    float s8[8], q8[8];
#pragma unroll
    for (int e2 = 0; e2 < 8; ++e2) { s8[e2] = 0.f; q8[e2] = 0.f; }
#pragma unroll 8
    for (int c = 0; c < 32; ++c) {
      u32x4 t = *(const u32x4*)(gv + (size_t)(cg * 32 + c) * 128 + tc * 8);
#pragma unroll
      for (int e2 = 0; e2 < 4; ++e2) {
        float a = bflo(t[e2]), b = bfhi(t[e2]);
        s8[2 * e2] += a; q8[2 * e2] += a * a; s8[2 * e2 + 1] += b; q8[2 * e2 + 1] += b * b;
      }
    }
#pragma unroll
    for (int e2 = 0; e2 < 8; ++e2) { ps[cg * 128 + tc * 8 + e2] = s8[e2]; pq[cg * 128 + tc * 8 + e2] = q8[e2]; }
    __syncthreads();
    if (tid < 128) {
      float s = 0.f, q = 0.f;
#pragma unroll
      for (int g2 = 0; g2 < 16; ++g2) { s += ps[g2 * 128 + tid]; q += pq[g2 * 128 + tid]; }
      const float mu_ = s * (1.f / 512.f);
      const float var = fmaxf(q * (1.f / 512.f) - mu_ * mu_, 0.f);
      st[256 + tid] = mu_; st[384 + tid] = rsqrtf(var + LN_EPS);
    }
  }
  const float* mu = st + 256;
  const float* rs = st + 384;
  {
    __syncthreads();
    const u16* wsrc = ((u16*)(P.ws + OFF_sguW)) + ((size_t)l * 4 + g) * 128 * 128;
    for (int cid = tid; cid < 2048; cid += 256) {
      int r = cid >> 4, c8 = (cid & 15) * 8;
      *(u32x4*)(As + r * LDK + c8) = *(const u32x4*)(wsrc + r * 128 + c8);
      bf16x8 t = *(const bf16x8*)(gv + (size_t)(g * 128 + r) * 128 + c8);
      float lg = P.sgu_ln_g[l * 512 + g * 128 + r], lb = P.sgu_ln_b[l * 512 + g * 128 + r];
      bf16x8 o;
#pragma unroll
      for (int e = 0; e < 8; ++e) o[e] = (short)f2bf((bf2f((u16)t[e]) - mu[c8 + e]) * rs[c8 + e] * lg + lb);
      *(bf16x8*)(Bs + r * LDK + c8) = o;
    }
    __syncthreads();
    f32x4 acc[4][4];
    zero_acc<4>(acc);
    mma_lds<4, 4, true>(As + wr * 64 * LDK, LDK, Bs + wc * 64 * LDK, LDK, 4, acc, fr, fq);
    const float* bs = P.sgu_b + ((size_t)l * 4 + g) * 128;
#pragma unroll
    for (int m = 0; m < 4; ++m) {
      int pp = wr * 64 + m * 16 + fr;
      float bias = bs[pp];
#pragma unroll
      for (int nn = 0; nn < 4; ++nn) {
        int d = wc * 64 + nn * 16 + fq * 4;
        u16* up = ((u16*)(P.ws + OFF_br3)) + (size_t)(hb * HROWS + mt * 128 + pp) * 512 + g * 128 + d;
        bf16x4 uu = *(const bf16x4*)up;
        f32x4 v = acc[m][nn];
        *(bf16x4*)up = pack4((v[0] + bias) * bf2f((u16)uu[0]), (v[1] + bias) * bf2f((u16)uu[1]), (v[2] + bias) * bf2f((u16)uu[2]), (v[3] + bias) * bf2f((u16)uu[3]));
      }
    }
  }
}

DI void attn_item(const Params& P, int l, int hb, int item, char* smem) {
  const int tid = TID(), wave = tid >> 6, lane = tid & 63, fr = lane & 15, fq = lane >> 4;
  int qt, h, bl;
  if (item < 512) { bl = item >> 6; h = (item >> 4) & 3; qt = item & 15; }
  else { const int j = item - 512; bl = j >> 3; h = (j >> 1) & 3; qt = 16 + (j & 1); }
  const bool ctxq = qt >= 16;
  const int key0 = ctxq ? SEQ : 0, nkt = ctxq ? 4 : 36;
  const int hrow_q0 = bl * SP + qt * 128 + wave * 32;
  constexpr int KT = 64 * LDT, VT = 128 * LDT;
  u16* Ks = (u16*)smem;
  u16* Vs = Ks + 2 * KT;
  constexpr float LOG2E = 1.4426950408889634f;
  for (int sub = 0; sub < 2; ++sub) {
    const int hs = 2 * h + sub;
    bf16x8 qf[2][2];
#pragma unroll
    for (int qb = 0; qb < 2; ++qb)
#pragma unroll
      for (int ks = 0; ks < 2; ++ks) qf[qb][ks] = *(const bf16x8*)(((u16*)(P.ws + OFF_q)) + (size_t)(hrow_q0 + qb * 16 + fr) * 512 + hs * 64 + ks * 32 + fq * 8);
    f32x4 ot[8][2];
#pragma unroll
    for (int d = 0; d < 8; ++d) { ot[d][0] = f32x4{0.f, 0.f, 0.f, 0.f}; ot[d][1] = f32x4{0.f, 0.f, 0.f, 0.f}; }
    float mrow[2] = {-INFINITY, -INFINITY}, lrow[2] = {0.f, 0.f};
    const u16* Kg = ((u16*)(P.ws + OFF_k)) + ((size_t)bl * SP + key0) * 512 + hs * 64;
    const u16* Vg = ((u16*)(P.ws + OFF_vT)) + ((size_t)bl * 512 + h * 128) * SP + key0;
    u32x4 rk[2], rv[4];
    const u16* kgp = Kg + (size_t)(tid >> 2) * 512 + (tid & 3) * 16;
    const u16* vgp = Vg + (size_t)(tid >> 1) * SP + (tid & 1) * 32;
    u16* ksp = Ks + (tid >> 2) * LDT + (tid & 3) * 16;
    u16* vsp = Vs + (tid >> 1) * LDT + (tid & 1) * 32;
    auto gloadK = [&](int t) {
      const u16* kp = kgp + (size_t)t * 64 * 512;
      rk[0] = *(const u32x4*)(kp); rk[1] = *(const u32x4*)(kp + 8);
    };
    auto gloadV = [&](int t) {
      const u16* vp = vgp + t * 64;
      rv[0] = *(const u32x4*)(vp); rv[1] = *(const u32x4*)(vp + 8); rv[2] = *(const u32x4*)(vp + 16); rv[3] = *(const u32x4*)(vp + 24);
    };
    auto sstore = [&](int buf) {
      u16* kp = ksp + buf * KT;
      *(u32x4*)(kp) = rk[0]; *(u32x4*)(kp + 8) = rk[1];
      u16* vp = vsp + buf * VT;
      *(u32x4*)(vp) = rv[0]; *(u32x4*)(vp + 8) = rv[1]; *(u32x4*)(vp + 16) = rv[2]; *(u32x4*)(vp + 24) = rv[3];
    };
    gloadK(0); gloadV(0);
    __syncthreads();
    sstore(0);
    __syncthreads();
    for (int t = 0; t < nkt; ++t) {
      const int cur = t & 1;
      if (t + 1 < nkt) gloadK(t + 1);
      const u16* Kc = Ks + cur * KT;
      const u16* Vc = Vs + cur * VT;
      f32x4 st[4][2];
#pragma unroll
      for (int k4 = 0; k4 < 4; ++k4) { st[k4][0] = f32x4{0.f, 0.f, 0.f, 0.f}; st[k4][1] = f32x4{0.f, 0.f, 0.f, 0.f}; }
#pragma unroll
      for (int k4 = 0; k4 < 4; ++k4)
#pragma unroll
        for (int ks = 0; ks < 2; ++ks) {
          bf16x8 a = *(const bf16x8*)(Kc + (k4 * 16 + fr) * LDT + ks * 32 + fq * 8);
          st[k4][0] = MFMA16(a, qf[0][ks], st[k4][0]);
          st[k4][1] = MFMA16(a, qf[1][ks], st[k4][1]);
          if (ks == 1 && (k4 & 1)) __builtin_amdgcn_sched_barrier(0);
        }
      __builtin_amdgcn_sched_barrier(0);
#pragma unroll
      for (int qb = 0; qb < 2; ++qb) {
        float mx = -INFINITY;
#pragma unroll
        for (int k4 = 0; k4 < 4; ++k4)
#pragma unroll
          for (int j = 0; j < 4; ++j) mx = fmaxf(mx, st[k4][qb][j]);
        mx = fmaxf(mx, __shfl_xor(mx, 16));
        mx = fmaxf(mx, __shfl_xor(mx, 32));
        const bool upd = mx > mrow[qb] + 5.5f;
        const float mnew = upd ? mx : mrow[qb];
        const float moff = mnew * LOG2E;
        float ps = 0.f;
#pragma unroll
        for (int k4 = 0; k4 < 4; ++k4)
#pragma unroll
          for (int j = 0; j < 4; ++j) { float pv = __builtin_amdgcn_exp2f(st[k4][qb][j] * LOG2E - moff); st[k4][qb][j] = pv; ps += pv; }
        if (__builtin_amdgcn_ballot_w64(upd) != 0ull) {
          const float alpha = __builtin_amdgcn_exp2f((mrow[qb] - mnew) * LOG2E);
          lrow[qb] *= alpha;
#pragma unroll
          for (int d = 0; d < 8; ++d) { ot[d][qb][0] *= alpha; ot[d][qb][1] *= alpha; ot[d][qb][2] *= alpha; ot[d][qb][3] *= alpha; }
        }
        mrow[qb] = mnew;
        lrow[qb] += ps;
      }
      __builtin_amdgcn_sched_barrier(0);
      if (t + 1 < nkt) gloadV(t + 1);
#pragma unroll
      for (int ks2 = 0; ks2 < 2; ++ks2) {
        bf16x8 pf[2];
#pragma unroll
        for (int qb = 0; qb < 2; ++qb) {
          bf16x4 lo = pack4v(st[2 * ks2][qb]), hi = pack4v(st[2 * ks2 + 1][qb]);
          pf[qb] = __builtin_shufflevector(lo, hi, 0, 1, 2, 3, 4, 5, 6, 7);
        }
#pragma unroll
        for (int d = 0; d < 8; ++d) {
          const u16* vp = Vc + (d * 16 + fr) * LDT + ks2 * 32 + fq * 4;
          bf16x4 lo = *(const bf16x4*)vp, hi = *(const bf16x4*)(vp + 16);
          bf16x8 a = __builtin_shufflevector(lo, hi, 0, 1, 2, 3, 4, 5, 6, 7);
          ot[d][0] = MFMA16(a, pf[0], ot[d][0]);
          ot[d][1] = MFMA16(a, pf[1], ot[d][1]);
          if ((d & 3) == 3) __builtin_amdgcn_sched_barrier(0);
        }
      }
      if (t + 1 < nkt) sstore(cur ^ 1);
      __syncthreads();
    }
#pragma unroll
    for (int qb = 0; qb < 2; ++qb) {
      float lt = lrow[qb];
      lt += __shfl_xor(lt, 16);
      lt += __shfl_xor(lt, 32);
      float inv = 1.f / lt;
      size_t hrow = (size_t)(hrow_q0 + qb * 16 + fr);
      if (sub == 0) {
#pragma unroll
        for (int d = 0; d < 8; ++d) {
          f32x4 v = ot[d][qb];
          *(bf16x4*)(((u16*)(P.ws + OFF_o1)) + hrow * 512 + h * 128 + d * 16 + fq * 4) = pack4(v[0] * inv, v[1] * inv, v[2] * inv, v[3] * inv);
        }
      } else {
        const float lam = ((float*)(P.ws + OFF_lamv))[l * 2], lam_init = ((float*)(P.ws + OFF_lamv))[l * 2 + 1];
        float ss = 0.f;
#pragma unroll
        for (int d = 0; d < 8; ++d) {
          bf16x4 o1v = *(const bf16x4*)(((u16*)(P.ws + OFF_o1)) + hrow * 512 + h * 128 + d * 16 + fq * 4);
#pragma unroll
          for (int j = 0; j < 4; ++j) { float dd = bf2f((u16)o1v[j]) - lam * ot[d][qb][j] * inv; ot[d][qb][j] = dd; ss += dd * dd; }
        }
        ss += __shfl_xor(ss, 16);
        ss += __shfl_xor(ss, 32);
        float rr = rsqrtf(ss * (1.f / 128.f) + LN_EPS) * (1.f - lam_init);
        const float* gn = P.diff_norm_g + l * 128;
#pragma unroll
        for (int d = 0; d < 8; ++d) {
          int dv = d * 16 + fq * 4;
          float4 g4 = *(const float4*)(gn + dv);
          f32x4 v = ot[d][qb];
          *(bf16x4*)(((u16*)(P.ws + OFF_br2)) + ((size_t)hb * HROWS + hrow) * 512 + h * 128 + dv) = pack4(v[0] * rr * g4.x, v[1] * rr * g4.y, v[2] * rr * g4.z, v[3] * rr * g4.w);
        }
      }
    }
  }
}

template <bool TRANS>
DI void conv_stage(const Params& P, int l, const u16* xbase  , int chan0, int n, int p0, u16* dst, int ld, const float* scale) {
  const int tid = TID(), cl = tid & 63, ig = tid >> 6;
  const int ch = chan0 + cl;
  const float* cw = P.conv_w + (size_t)l * 5 * 768 + ch;
  const float w0 = cw[0], w1 = cw[768], w2 = cw[2 * 768], w3 = cw[3 * 768], w4 = cw[4 * 768];
  const float cb = P.conv_b[l * 768 + ch];
  const u16* xc = xbase + ch;
#pragma unroll 1
  for (int g8 = 0; g8 < 4; ++g8) {
    const int tok0 = ig * 32 + g8 * 8;
    const int pos0 = p0 + tok0 - 2;
    float xv[12];
#pragma unroll
    for (int i = 0; i < 12; ++i) { int pos = pos0 + i; xv[i] = (pos >= 0 && pos < n) ? bf2f(xc[(size_t)pos * 768]) : 0.f; }
#pragma unroll
    for (int ii = 0; ii < 8; ++ii) {
      float v = w0 * xv[ii] + w1 * xv[ii + 1] + w2 * xv[ii + 2] + w3 * xv[ii + 3] + w4 * xv[ii + 4] + cb;
      v = v * __builtin_amdgcn_rcpf(1.f + __expf(-v));
      const int tok = tok0 + ii;
      if (scale) v *= scale[tok];
      if (TRANS) dst[cl * ld + tok] = f2bf(v); else dst[tok * ld + cl] = f2bf(v);
    }
  }
}

DI void ssd_scalars(const Params& P, int l, int hrow0, int h, int dir, float* dts, float* S, float* tmp) {
  const int tid = TID();
  const float aneg = -expf(P.a_log[l * 16 + dir * 8 + h]);
  float a = 0.f, inc = 0.f;
  if (tid < 128) {
    float raw = ((float*)(P.ws + OFF_dtbuf))[(size_t)(hrow0 + tid) * 16 + dir * 8 + h] + P.dt_bias[l * 16 + dir * 8 + h];
    float dt = softplusf_(raw);
    dts[tid] = dt;
    a = dt * aneg;
    inc = a;
    const int lane = tid & 63;
#pragma unroll
    for (int o = 1; o < 64; o <<= 1) { float t = __shfl_up(inc, o); if (lane >= o) inc += t; }
    if (lane == 63) tmp[tid >> 6] = inc;
  }
  __syncthreads();
  if (tid < 128) {
    const float t0 = tmp[0], t1 = tmp[1];
    const float pre = inc + (tid >= 64 ? t0 : 0.f);
    S[tid] = (dir == 0) ? pre : (t0 + t1) - pre + a;
  }
  __syncthreads();
}

constexpr int SSD_STATE_STRIDE = 18 * 4096;

DI void ssd_prep_item(const Params& P, int l, int hb, int mt, int slab, char* smem) {
  const int tid = TID();
  const int jp = mt % 18, bl = mt / 18;
  const bool lat = jp < 16;
  const int n = lat ? SEQ : CTXL;
  const int p0 = lat ? jp * 128 : (jp - 16) * 128;
  const int seqbase = bl * SP + (lat ? 0 : SEQ);
  const int hrow0 = bl * SP + jp * 128;
  u16* T = (u16*)smem;
  u16* Rm = T + 64 * LDK;
  __syncthreads();
  const u16* xb = ((u16*)(P.ws + OFF_xbc)) + (size_t)seqbase * 768;
  {
    const int cg = tid & 7, tg = tid >> 3;
    const int ch0 = slab * 64 + cg * 8;
    float w[5][8], cbv[8];
#pragma unroll
    for (int d = 0; d < 5; ++d) {
      const float4 a = *(const float4*)(P.conv_w + ((size_t)l * 5 + d) * 768 + ch0), b = *(const float4*)(P.conv_w + ((size_t)l * 5 + d) * 768 + ch0 + 4);
      w[d][0] = a.x; w[d][1] = a.y; w[d][2] = a.z; w[d][3] = a.w; w[d][4] = b.x; w[d][5] = b.y; w[d][6] = b.z; w[d][7] = b.w;
    }
    {
      const float4 a = *(const float4*)(P.conv_b + l * 768 + ch0), b = *(const float4*)(P.conv_b + l * 768 + ch0 + 4);
      cbv[0] = a.x; cbv[1] = a.y; cbv[2] = a.z; cbv[3] = a.w; cbv[4] = b.x; cbv[5] = b.y; cbv[6] = b.z; cbv[7] = b.w;
    }
    const int tok0 = tg * 4;
    u32x4 xr[8];
#pragma unroll
    for (int i = 0; i < 8; ++i) {
      const int pos = p0 + tok0 - 2 + i;
      xr[i] = u32x4{0u, 0u, 0u, 0u};
      if (pos >= 0 && pos < n) xr[i] = *(const u32x4*)(xb + (size_t)pos * 768 + ch0);
    }
    float o[4][8];
#pragma unroll
    for (int t = 0; t < 4; ++t)
#pragma unroll
      for (int e2 = 0; e2 < 4; ++e2) {
        float a0 = cbv[2 * e2], a1 = cbv[2 * e2 + 1];
#pragma unroll
        for (int d = 0; d < 5; ++d) { a0 += w[d][2 * e2] * bflo(xr[t + d][e2]); a1 += w[d][2 * e2 + 1] * bfhi(xr[t + d][e2]); }
        o[t][2 * e2] = siluf_(a0); o[t][2 * e2 + 1] = siluf_(a1);
      }
    if (slab < 10) {
#pragma unroll
      for (int e2 = 0; e2 < 8; ++e2) *(bf16x4*)(T + (cg * 8 + e2) * LDK + tok0) = pack4(o[0][e2], o[1][e2], o[2][e2], o[3][e2]);
    }
    if (slab >= 8) {
#pragma unroll
      for (int t = 0; t < 4; ++t) {
        u32x4 v = {pack2(o[t][0], o[t][1]), pack2(o[t][2], o[t][3]), pack2(o[t][4], o[t][5]), pack2(o[t][6], o[t][7])};
        *(u32x4*)(Rm + (tok0 + t) * LDT + cg * 8) = v;
      }
    }
  }
  __syncthreads();
  if (slab < 10) {
    u16* dst = slab < 8 ? ((u16*)(P.ws + OFF_xsT)) + ((size_t)mt * 512 + slab * 64) * 128 : ((u16*)(P.ws + OFF_bmT)) + ((size_t)mt * 128 + (slab - 8) * 64) * 128;
#pragma unroll
    for (int i = 0; i < 4; ++i) { int cid = tid + 256 * i; int r = cid >> 4, c8 = (cid & 15) * 8; *(u32x4*)(dst + (size_t)r * 128 + c8) = *(const u32x4*)(T + r * LDK + c8); }
  }
  if (slab >= 8) {
    u16* dst = (slab < 10 ? ((u16*)(P.ws + OFF_bm)) + (slab - 8) * 64 : ((u16*)(P.ws + OFF_cm)) + (slab - 10) * 64) + (size_t)hrow0 * 128;
#pragma unroll
    for (int i = 0; i < 4; ++i) { int cid = tid + 256 * i; int r = cid >> 3, c8 = (cid & 7) * 8; *(u32x4*)(dst + (size_t)r * 128 + c8) = *(const u32x4*)(Rm + r * LDT + c8); }
  }
}

DI void phase_ssd_prep(const Params& P, int l, int hb, char* smem, int ph) {
  for (;;) {
    const int it = wq_next(wq_ctr(P, ph), smem);
    if (it >= 144 * 12) break;
    ssd_prep_item(P, l, hb, it / 12, it % 12, smem);
  }
}

DI void ssd_state_item(const Params& P, int l, int hb, int item, char* smem) {
  const int tid = TID(), wave = tid >> 6, lane = tid & 63, fr = lane & 15, fq = lane >> 4;
  const int h = item & 7, jp = (item >> 3) % 18, bl = (item >> 3) / 18;
  const int mt = bl * 18 + jp;
  const int hrow0 = bl * SP + jp * 128;
  u16* At = (u16*)smem;
  u16* Bt = At + 64 * LDK;
  float* dts = (float*)(Bt + 64 * LDK);
  float* S = dts + 128;
  float* wgt = S + 128;
  __syncthreads();
  u32x4 xr[4];
  {
    const u16* bsrc = ((u16*)(P.ws + OFF_bmT)) + ((size_t)mt * 128 + (h >> 2) * 64) * 128;
    const u16* xsrc = ((u16*)(P.ws + OFF_xsT)) + ((size_t)mt * 512 + h * 64) * 128;
#pragma unroll
    for (int i = 0; i < 4; ++i) {
      int cid = tid + 256 * i; int r = cid >> 4, c8 = (cid & 15) * 8;
      *(u32x4*)(Bt + r * LDK + c8) = *(const u32x4*)(bsrc + (size_t)r * 128 + c8);
      xr[i] = *(const u32x4*)(xsrc + (size_t)r * 128 + c8);
    }
  }
  const int wr = wave >> 1, wc = wave & 1;
#pragma unroll 1
  for (int dir = 0; dir < 2; ++dir) {
    ssd_scalars(P, l, hrow0, h, dir, dts, S, wgt);
    const float total = (dir == 0) ? S[127] : S[0];
    __syncthreads();
    if (tid < 128) wgt[tid] = dts[tid] * __expf(total - S[tid]);
    __syncthreads();
#pragma unroll
    for (int i = 0; i < 4; ++i) {
      int cid = tid + 256 * i; int r = cid >> 4, c8 = (cid & 15) * 8;
      u32x4 o;
#pragma unroll
      for (int e2 = 0; e2 < 4; ++e2) o[e2] = pack2(bflo(xr[i][e2]) * wgt[c8 + 2 * e2], bfhi(xr[i][e2]) * wgt[c8 + 2 * e2 + 1]);
      *(u32x4*)(At + r * LDK + c8) = o;
    }
    __syncthreads();
    f32x4 acc[2][2];
#pragma unroll
    for (int m = 0; m < 2; ++m) { acc[m][0] = f32x4{0.f, 0.f, 0.f, 0.f}; acc[m][1] = f32x4{0.f, 0.f, 0.f, 0.f}; }
    mma_lds<2, 2, true>(At + wr * 32 * LDK, LDK, Bt + wc * 32 * LDK, LDK, 4, acc, fr, fq);
    u16* cs = ((u16*)(P.ws + OFF_cstate)) + (((size_t)(bl * 2 + dir) * 8 + h) * 18 + jp) * 4096;
#pragma unroll
    for (int m = 0; m < 2; ++m)
#pragma unroll
      for (int nn = 0; nn < 2; ++nn) *(bf16x4*)(cs + (wr * 32 + m * 16 + fr) * 64 + wc * 32 + nn * 16 + fq * 4) = pack4v(acc[m][nn]);
    if (tid == 0) ((float*)(P.ws + OFF_decay))[((bl * 2 + dir) * 8 + h) * 18 + jp] = __expf(total);
  }
}

DI void phase_carry(const Params& P) {
  const int total = 8 * 2 * 8 * 4096;
  for (int idx = blockIdx.x * 256 + TID(); idx < total; idx += gridDim.x * 256) {
    int pn = idx & 4095, bdh = idx >> 12;
    int dir = (bdh >> 3) & 1;
    const u16* __restrict__ cs = ((const u16*)(P.ws + OFF_cstate)) + (size_t)bdh * SSD_STATE_STRIDE + pn;
    u16* __restrict__ en = ((u16*)(P.ws + OFF_enter)) + (size_t)bdh * SSD_STATE_STRIDE + pn;
    const float* __restrict__ dc = ((const float*)(P.ws + OFF_decay)) + bdh * 18;
    float cv[18], dv[18];
#pragma unroll
    for (int jp = 0; jp < 18; ++jp) { cv[jp] = bf2f(cs[(size_t)jp * 4096]); dv[jp] = dc[jp]; }
    float state = 0.f;
    if (dir == 0) {
#pragma unroll
      for (int st = 0; st < 18; ++st) {
        const int jp = st < 2 ? 16 + st : st - 2;
        en[(size_t)jp * 4096] = f2bf(state);
        state = state * dv[jp] + cv[jp];
      }
    } else {
#pragma unroll
      for (int st = 0; st < 18; ++st) {
        const int jp = 17 - st;
        en[(size_t)jp * 4096] = f2bf(state);
        state = state * dv[jp] + cv[jp];
      }
    }
  }
}

DI void ssd_out_item(const Params& P, int l, int hb, int item, char* smem) {
  const int tid = TID(), wave = tid >> 6, lane = tid & 63, fr = lane & 15, fq = lane >> 4;
  const int h = item & 7, jp = (item >> 3) % 18, bl = (item >> 3) / 18;
  const bool lat = jp < 16;
  const int n = lat ? SEQ : CTXL;
  const int p0 = lat ? jp * 128 : (jp - 16) * 128;
  const int seqbase = bl * SP + (lat ? 0 : SEQ);
  const int hrow0 = bl * SP + jp * 128;
  u16* Cs = (u16*)smem;
  u16* xT = Cs + 128 * LDT;
  u16* Et = xT + 64 * LDK;
  u16* Un = Et + 64 * LDT;
  float* fs = (float*)(Un + 128 * LDK);
  float* dts = fs;
  float* S = fs + 128;
  float* tmp = fs + 256;
  const int grp = h >> 2;
  __syncthreads();
  {
    const int mt = bl * 18 + jp;
    const u16* csrc = ((u16*)(P.ws + OFF_cm)) + (size_t)hrow0 * 128 + grp * 64;
    const u16* bsrc = ((u16*)(P.ws + OFF_bm)) + (size_t)hrow0 * 128 + grp * 64;
    const u16* xsrc = ((u16*)(P.ws + OFF_xsT)) + ((size_t)mt * 512 + h * 64) * 128;
#pragma unroll
    for (int i = 0; i < 4; ++i) {
      int cid = tid + 256 * i;
      int r = cid >> 3, c8 = (cid & 7) * 8;
      *(u32x4*)(Cs + r * LDT + c8) = *(const u32x4*)(csrc + (size_t)r * 128 + c8);
      *(u32x4*)(Un + r * LDT + c8) = *(const u32x4*)(bsrc + (size_t)r * 128 + c8);
      int r2 = cid >> 4, c82 = (cid & 15) * 8;
      *(u32x4*)(xT + r2 * LDK + c82) = *(const u32x4*)(xsrc + (size_t)r2 * 128 + c82);
    }
  }
  __syncthreads();
  f32x4 cb[2][8];
#pragma unroll
  for (int m = 0; m < 2; ++m)
#pragma unroll
    for (int nn = 0; nn < 8; ++nn) cb[m][nn] = f32x4{0.f, 0.f, 0.f, 0.f};
  mma_lds<2, 8, false>(Cs + wave * 32 * LDT, LDT, Un, LDT, 2, cb, fr, fq);
  f32x4 yacc[2][4];
#pragma unroll
  for (int m = 0; m < 2; ++m)
#pragma unroll
    for (int nn = 0; nn < 4; ++nn) yacc[m][nn] = f32x4{0.f, 0.f, 0.f, 0.f};
#pragma unroll 1
  for (int dir = 0; dir < 2; ++dir) {
    __syncthreads();
    ssd_scalars(P, l, hrow0, h, dir, dts, S, tmp);
#pragma unroll
    for (int m = 0; m < 2; ++m)
#pragma unroll
      for (int j = 0; j < 4; ++j) {
        int lrow = wave * 32 + m * 16 + fq * 4 + j;
        float Sl = S[lrow];
#pragma unroll
        for (int nn = 0; nn < 8; ++nn) {
          int s = nn * 16 + fr;
          bool ok = dir == 0 ? (s <= lrow) : (s >= lrow);
          float coef = ok ? __expf(Sl - S[s]) * dts[s] : 0.f;
          Un[lrow * LDK + s] = f2bf(cb[m][nn][j] * coef);
        }
      }
    {
      const u16* en = ((u16*)(P.ws + OFF_enter)) + (((size_t)(bl * 2 + dir) * 8 + h) * 18 + jp) * 4096;
      for (int cid = tid; cid < 512; cid += 256) {
        int pr = cid >> 3, c8 = (cid & 7) * 8;
        *(u32x4*)(Et + pr * LDT + c8) = *(const u32x4*)(en + pr * 64 + c8);
      }
    }
    __syncthreads();
    mma_lds<2, 4, true>(Un + wave * 32 * LDK, LDK, xT, LDK, 4, yacc, fr, fq);
    f32x4 yi[2][4];
#pragma unroll
    for (int m = 0; m < 2; ++m)
#pragma unroll
      for (int nn = 0; nn < 4; ++nn) yi[m][nn] = f32x4{0.f, 0.f, 0.f, 0.f};
    mma_lds<2, 4, true>(Cs + wave * 32 * LDT, LDT, Et, LDT, 2, yi, fr, fq);
#pragma unroll
    for (int m = 0; m < 2; ++m) {
      float e = __expf(S[wave * 32 + m * 16 + fr]);
#pragma unroll
      for (int nn = 0; nn < 4; ++nn)
#pragma unroll
        for (int j = 0; j < 4; ++j) yacc[m][nn][j] += e * yi[m][nn][j];
    }
  }
  const float dsk = P.ssd_d[l * 8 + h];
  const float* gn = P.ssd_norm_g + l * 512 + h * 64;
#pragma unroll
  for (int m = 0; m < 2; ++m) {
    int lrow = wave * 32 + m * 16 + fr;
    float ss = 0.f;
#pragma unroll
    for (int nn = 0; nn < 4; ++nn) {
      int pc = nn * 16 + fq * 4;
      bf16x4 zz = *(const bf16x4*)(((u16*)(P.ws + OFF_z)) + (size_t)(hrow0 + lrow) * 512 + h * 64 + pc);
      float4 g4 = *(const float4*)(gn + pc);
      float gg[4] = {g4.x, g4.y, g4.z, g4.w};
      float o[4];
#pragma unroll
      for (int j = 0; j < 4; ++j) {
        float y = yacc[m][nn][j] + dsk * bf2f(xT[(pc + j) * LDK + lrow]);
        y *= siluf_(bf2f((u16)zz[j]));
        ss += y * y;
        o[j] = y * gg[j];
      }
      *(bf16x4*)(((u16*)(P.ws + OFF_br1)) + ((size_t)hb * HROWS + hrow0 + lrow) * 512 + h * 64 + pc) = pack4(o[0], o[1], o[2], o[3]);
    }
    ss += __shfl_xor(ss, 16);
    ss += __shfl_xor(ss, 32);
    if (fq == 0) ((float*)(P.ws + OFF_ssq))[((size_t)hb * HROWS + hrow0 + lrow) * 8 + h] = ss;
  }
}


DI void merge_tile(const Params& P, int l, int mt, int nt, char* smem) {
  const int row0 = mt * 128;
#pragma unroll 1
  for (int kq = 0; kq < 4; ++kq) {
    unsigned gp[4][4][2];
    {
      f32x4 g[4][4];
      zero_acc<4>(g);
      gemm_main<4, true, false, true>(((u16*)(P.ws + OFF_H)), DM, nullptr, row0, ((u16*)(P.ws + OFF_WgT)) + ((size_t)l * 4 + kq) * 1024 * 1024, 1024, nt * 128, 1024, g, (u16*)smem);
#pragma unroll
      for (int m = 0; m < 4; ++m)
#pragma unroll
        for (int n = 0; n < 4; ++n) {
          gp[m][n][0] = pack2(sigmoidf_(g[m][n][0]), sigmoidf_(g[m][n][1]));
          gp[m][n][1] = pack2(sigmoidf_(g[m][n][2]), sigmoidf_(g[m][n][3]));
        }
    }
    f32x4 bb[4][4];
    zero_acc<4>(bb);
    const u16* br = ((u16*)(P.ws + OFF_br0)) + (size_t)kq * (U_ / 2);
    gemm_main<4, true, false, false>(br, 512, nullptr, row0, ((u16*)(P.ws + OFF_WbT)) + ((size_t)l * 4 + kq) * 1024 * 512, 512, nt * 128, 512, bb, (u16*)smem);
    const int tid = TID(), wave = tid >> 6, lane = tid & 63, fr = lane & 15, fq = lane >> 4;
    const int wr = wave >> 1, wc = wave & 1;
#pragma unroll
    for (int m = 0; m < 4; ++m) {
      const int r = row0 + wr * 64 + m * 16 + fr;
      float rs = 1.f;
      if (kq == 1) {
        const float* sq = ((float*)(P.ws + OFF_ssq)) + (size_t)r * 8;
        float4 a = *(const float4*)sq, b = *(const float4*)(sq + 4);
        rs = rsqrtf((a.x + a.y + a.z + a.w + b.x + b.y + b.z + b.w) * (1.f / 512.f) + LN_EPS);
      }
#pragma unroll
      for (int n = 0; n < 4; ++n) {
        u32x2* dst = (u32x2*)(((u16*)(P.ws + OFF_acc)) + (size_t)r * DM + nt * 128 + wc * 64 + n * 16 + fq * 4);
        u32x2 prev = {0u, 0u};
        if (kq > 0) prev = *dst;
        const unsigned g0 = gp[m][n][0], g1 = gp[m][n][1];
        u32x2 o;
        o[0] = pack2(bflo(prev[0]) + bflo(g0) * bb[m][n][0] * rs, bfhi(prev[0]) + bfhi(g0) * bb[m][n][1] * rs);
        o[1] = pack2(bflo(prev[1]) + bflo(g1) * bb[m][n][2] * rs, bfhi(prev[1]) + bfhi(g1) * bb[m][n][3] * rs);
        *dst = o;
      }
    }
  }
}

DI void phase_merge(const Params& P, int l, char* smem, int ph) {
  const bool last = (l == 1);
  for (;;) {
    const int it = wq_next(wq_ctr(P, ph), smem);
    if (it >= 288 * 8) break;
    int mt = it / 8, nt = it % 8;
    if (last && (mt % 18) >= 16) continue;
    merge_tile(P, l, mt, nt, smem);
  }
}

DI void phase_outproj(const Params& P, int l, char* smem, int ph) {
  const bool last = (l == 1);
  const int tid = TID(), wave = tid >> 6, lane = tid & 63, fr = lane & 15, fq = lane >> 4;
  const int wr = wave >> 1, wc = wave & 1;
  for (;;) {
    const int it = wq_next(wq_ctr(P, ph), smem);
    if (it >= 288 * 8) break;
    int mt = it / 8, nt = it % 8;
    if (last && (mt % 18) >= 16) continue;
    f32x4 acc[4][4];
    zero_acc<4>(acc);
    gemm_main<4, true, false>(((u16*)(P.ws + OFF_acc)), DM, nullptr, mt * 128, ((u16*)(P.ws + OFF_WoT)) + (size_t)l * 1024 * 1024, 1024, nt * 128, 1024, acc, (u16*)smem);
#pragma unroll
    for (int m = 0; m < 4; ++m)
#pragma unroll
      for (int n = 0; n < 4; ++n) {
        int r = mt * 128 + wr * 64 + m * 16 + fr, c = nt * 128 + wc * 64 + n * 16 + fq * 4;
        *(bf16x4*)(((u16*)(P.ws + OFF_Y)) + (size_t)r * DM + c) = pack4v(acc[m][n]);
      }
  }
}

DI void phase_ffn1(const Params& P, int l, char* smem, int ph) {
  const bool last = (l == 1);
  const int tid = TID(), wave = tid >> 6, lane = tid & 63, fr = lane & 15, fq = lane >> 4;
  const int wr = wave >> 1, wc = wave & 1;
  const int nmt = last ? 512 : 576;
  for (;;) {
    const int it = wq_next(wq_ctr(P, ph), smem);
    if (it >= nmt * 8) break;
    int mt = it / 8, nt = it % 8;
    int R0 = mt * 128;
    int e = R0 < NFFN_LAT ? (R0 >> 8) & 15 : (R0 - NFFN_LAT) >> 9;
    f32x4 acc[4][4];
    zero_acc<4>(acc);
    gemm_main<4, true, true>(((u16*)(P.ws + OFF_H)), DM, ((int*)(P.ws + OFF_tokidx)), R0, ((u16*)(P.ws + OFF_W13T)) + (size_t)e * 1024 * 1024, 1024, nt * 128, 1024, acc, (u16*)smem);
#pragma unroll
    for (int m = 0; m < 4; ++m)
#pragma unroll
      for (int n2 = 0; n2 < 2; ++n2) {
        int r = R0 + wr * 64 + m * 16 + fr;
        int hc = (nt * 4 + wc * 2 + n2) * 16 + fq * 4;
        f32x4 a = acc[m][2 * n2], b = acc[m][2 * n2 + 1];
        *(bf16x4*)(((u16*)(P.ws + OFF_hid)) + (size_t)r * 512 + hc) = pack4(siluf_(a[0]) * b[0], siluf_(a[1]) * b[1], siluf_(a[2]) * b[2], siluf_(a[3]) * b[3]);
      }
  }
}

DI void phase_ffn2(const Params& P, int l, char* smem, int ph) {
  const bool last = (l == 1);
  const int tid = TID(), wave = tid >> 6, lane = tid & 63, fr = lane & 15, fq = lane >> 4;
  const int wr = wave >> 1, wc = wave & 1;
  const int nmt = last ? 512 : 576;
  for (;;) {
    const int it = wq_next(wq_ctr(P, ph), smem);
    if (it >= nmt * 8) break;
    int mt = it / 8, nt = it % 8;
    int R0 = mt * 128;
    int e = R0 < NFFN_LAT ? (R0 >> 8) & 15 : (R0 - NFFN_LAT) >> 9;
    f32x4 acc[4][4];
    zero_acc<4>(acc);
    gemm_main<4, true, false>(((u16*)(P.ws + OFF_hid)), 512, nullptr, R0, ((u16*)(P.ws + OFF_W2T)) + (size_t)e * 1024 * 512, 512, nt * 128, 512, acc, (u16*)smem);
#pragma unroll
    for (int m = 0; m < 4; ++m) {
      int r = R0 + wr * 64 + m * 16 + fr;
      float gt = ((float*)(P.ws + OFF_gatev))[r];
#pragma unroll
      for (int n = 0; n < 4; ++n) {
        int c = nt * 128 + wc * 64 + n * 16 + fq * 4;
        f32x4 v = acc[m][n];
        *(bf16x4*)(((u16*)(P.ws + OFF_ye)) + (size_t)r * DM + c) = pack4(v[0] * gt, v[1] * gt, v[2] * gt, v[3] * gt);
      }
    }
  }
}

DI void phase_mix2(const Params& P, int l, int hb, char* smem, int ph) {
  const bool last = (l == 1);
  const int nG = 576, nA = 576, nS = 1152, nP = 576;
  for (;;) {
    const int it = wq_next(wq_ctr(P, ph), smem);
    if (it >= nA + nG + nS + nP) break;
    if (it < nG) {
      const int mt = it >> 2, g = it & 3;
      if (last && (mt % 18) >= 16) continue;
      sgu_item(P, l, hb, mt, g, smem);
    } else if (it < nG + nA) {
      const int ia = it - nG;
      if (last && ia >= 512) continue;
      attn_item(P, l, hb, ia, smem);
    } else if (it < nA + nG + nS) {
      ssd_state_item(P, l, hb, it - nA - nG, smem);
    } else {
      const int t = it - nA - nG - nS;
      const int mt = t >> 2, g = t & 3;
      if (last && (mt % 18) >= 16) continue;
      pool_item(P, l, hb, mt, g, smem);
    }
  }
}

DI void phase_ssd_out(const Params& P, int l, int hb, char* smem, int ph) {
  const bool last = (l == 1);
  for (;;) {
    const int it = wq_next(wq_ctr(P, ph), smem);
    if (it >= 8 * 18 * 8) break;
    int jp = (it >> 3) % 18;
    if (last && jp >= 16) continue;
    ssd_out_item(P, l, hb, it, smem);
  }
}

#define XB_TMO      128
#define XB_XCNT(j)  (256  + 64 * (j))
#define XB_XSUB(j)  (1280 + 64 * (j))
#define XB_XGEN(j)  (2304 + 64 * (j))
#define XB_TOP      3328
#define XB_TOPGEN   3392
#define XCD_BAR_WORDS 3456
#define XB_SPIN_CAP (1u << 18)
#define LAS __attribute__((address_space(3)))

__device__ __forceinline__ unsigned xb_ld(unsigned* p)              { return __hip_atomic_load(p, __ATOMIC_RELAXED, __HIP_MEMORY_SCOPE_AGENT); }
__device__ __forceinline__ unsigned xb_add(unsigned* p, unsigned v) { return __hip_atomic_fetch_add(p, v, __ATOMIC_RELAXED, __HIP_MEMORY_SCOPE_AGENT); }
__device__ __forceinline__ unsigned xb_xcc_id() { return (unsigned)__builtin_amdgcn_s_getreg((3 << 11) | 20) & 0xFu; }
#define XB_SPIN(cond, bar) do { unsigned _sp = 0; while (cond) { __builtin_amdgcn_s_sleep(1); \
    if ((++_sp & 255u) == 0u) { if (xb_ld(&(bar)[XB_TMO])) break; if (_sp > XB_SPIN_CAP) { atomicAdd(&(bar)[XB_TMO], 1u); break; } } } } while (0)

struct XcdBarrier {
    unsigned* bar; unsigned x;
    volatile LAS unsigned* st;
};

__device__ __forceinline__ XcdBarrier xcd_barrier_post(unsigned* bar, volatile LAS unsigned* st) {
    XcdBarrier b; b.bar = bar; b.x = xb_xcc_id(); b.st = st;
    if (threadIdx.x == 0) (void)xb_add(&bar[XB_XCNT(b.x)], 1u);
    return b;
}
__device__ __forceinline__ void xcd_barrier_complete(unsigned* bar, unsigned x, unsigned& nloc, unsigned& nx) {
    const unsigned G = gridDim.x * gridDim.y * gridDim.z;
    unsigned sum, cnt, mine, sp = 0u;
    for (;;) {
        sum = 0u; cnt = 0u; mine = 0u;
#pragma unroll
        for (unsigned j = 0; j < 16; ++j) { const unsigned c = xb_ld(&bar[XB_XCNT(j)]); sum += c; cnt += (c > 0u) ? 1u : 0u; mine = (j == x) ? c : mine; }
        if (sum == G) break;
        __builtin_amdgcn_s_sleep(1);
        if ((++sp & 255u) == 0u) { if (xb_ld(&bar[XB_TMO])) break; if (sp > XB_SPIN_CAP) { atomicAdd(&bar[XB_TMO], 1u); break; } }
    }
    nloc = mine > 0u ? mine : 1u; nx = cnt > 0u ? cnt : 1u;
}

__device__ __forceinline__ void xcd_barrier(const XcdBarrier& b) {
    asm volatile("s_waitcnt vmcnt(0)" ::: "memory");
    __syncthreads();
    if (threadIdx.x == 0) {
        unsigned* bar = b.bar;
        __builtin_amdgcn_s_waitcnt(0);
        unsigned nloc = b.st[0], nx = b.st[1];
        if (nloc == 0u) { xcd_barrier_complete(bar, b.x, nloc, nx); b.st[0] = nloc; b.st[1] = nx; }
        const unsigned old = xb_add(&bar[XB_XSUB(b.x)], 1u);
        const unsigned gen = old / nloc;
        if (old + 1u == (gen + 1u) * nloc) {
            __builtin_amdgcn_fence(__ATOMIC_RELEASE, "agent");
            asm volatile("s_waitcnt vmcnt(0)" ::: "memory");
            const unsigned og = xb_add(&bar[XB_TOP], 1u);
            const unsigned tg = og / nx;
            if (og + 1u == (tg + 1u) * nx) xb_add(&bar[XB_TOPGEN], 1u);
            else XB_SPIN(xb_ld(&bar[XB_TOPGEN]) == tg, bar);
            __builtin_amdgcn_fence(__ATOMIC_ACQUIRE, "agent");
            xb_add(&bar[XB_XGEN(b.x)], 1u);
            asm volatile("s_waitcnt vmcnt(0)" ::: "memory");
        } else {
            XB_SPIN(xb_ld(&bar[XB_XGEN(b.x)]) == gen, bar);
            __builtin_amdgcn_fence(__ATOMIC_ACQUIRE, "agent");
            asm volatile("s_waitcnt vmcnt(0)" ::: "memory");
        }
    }
    __syncthreads();
}


template <bool COOP>
__global__ void __launch_bounds__(256, 2) mk_forward(Params P, int ph_begin, int ph_end) {
  __shared__ __attribute__((aligned(16))) char smem[SMEM_BYTES];
  int ph = 0;
  volatile LAS unsigned* xbst = (volatile LAS unsigned*)(smem + SMEM_BYTES - 16);
  XcdBarrier xb;
  if (COOP) {
    if (__builtin_amdgcn_workitem_id_x() == 0) { xbst[0] = 0u; xbst[1] = 0u; xbst[2] = 0u; xbst[3] = 0u; }
    __syncthreads();
    xb = xcd_barrier_post((unsigned*)(P.ws + OFF_bar), xbst);
  }
#define PHASE(code)                                         \
  {                                                         \
    if (ph >= ph_begin && ph < ph_end) { code; }            \
    ++ph;                                                   \
    if (COOP && ph > ph_begin && ph < ph_end) {             \
      if (ph == 1) cg::this_grid().sync();                  \
      else xcd_barrier(xb);                                 \
    }                                                       \
  }
  PHASE(phase_prologue(P, smem));
  PHASE(phase_h0(P));
#pragma unroll 1
  for (int l = 0; l < 2; ++l) {
#pragma unroll 1
    for (int hb = 0; hb < 2; ++hb) {
      PHASE(phase_proj(P, l, hb, smem, ph));
      PHASE(phase_ssd_prep(P, l, hb, smem, ph));
      PHASE(phase_mix2(P, l, hb, smem, ph));
      PHASE(phase_carry(P));
      PHASE(phase_ssd_out(P, l, hb, smem, ph));
    }
    PHASE(phase_merge(P, l, smem, ph));
    PHASE(phase_outproj(P, l, smem, ph));
    PHASE(phase_ln1(P, l, smem));
    PHASE(phase_topk(P, l, smem));
    PHASE(phase_ffn1(P, l, smem, ph));
    PHASE(phase_ffn2(P, l, smem, ph));
    PHASE(phase_ln2(P, l));
  }
#undef PHASE
}

#ifndef MK_COOP
#define MK_COOP 1
#endif

extern "C" void kernel_launch(void* const* d_in, const int* in_sizes, int n_in, void* d_out, int out_size, void* d_ws, size_t ws_size,
                              hipStream_t stream) {
  Params p{};
  const float* const* in = (const float* const*)d_in;
  p.x = in[0]; p.c = in[1]; p.ctx = in[2]; p.c_ctx = in[3]; p.w_mod = in[4]; p.b_mod = in[5]; p.w_in = in[6]; p.conv_w = in[7];
  p.conv_b = in[8]; p.a_log = in[9]; p.dt_bias = in[10]; p.ssd_d = in[11]; p.ssd_norm_g = in[12]; p.diff_lambda = in[13];
  p.diff_norm_g = in[14]; p.pool_w = in[15]; p.pool_scale = in[16]; p.sgu_ln_g = in[17]; p.sgu_ln_b = in[18]; p.sgu_w = in[19];
  p.sgu_b = in[20]; p.w_gate = in[21]; p.w_branch = in[22]; p.w_out = in[23]; p.ln1_g = in[24]; p.ln1_b = in[25]; p.w_router = in[26];
  p.w1 = in[27]; p.w3 = in[28]; p.w2 = in[29]; p.ln2_g = in[30]; p.ln2_b = in[31];
  p.out = (float*)d_out;
  p.ws = (char*)d_ws;
  if (WS_NEED > ws_size) { fprintf(stderr, "workspace too small: need %zu have %zu\n", (size_t)WS_NEED, ws_size); return; }

  static int grid_blocks = 0;
  if (!grid_blocks) {
    int dev = 0, cus = 0, per_cu = 0;
    hipGetDevice(&dev);
    hipDeviceGetAttribute(&cus, hipDeviceAttributeMultiprocessorCount, dev);
    (void)hipOccupancyMaxActiveBlocksPerMultiprocessor(&per_cu, mk_forward<(MK_COOP != 0)>, 256, 0);
    if (per_cu < 1) per_cu = 1;
    if (per_cu > 2) per_cu = 2;
    grid_blocks = cus * per_cu;
  }
#if MK_COOP
  hipMemsetAsync((char*)d_ws + OFF_bar, 0, 32768, stream);
  int b = 0, e = NPHASE;
  void* args[] = {&p, &b, &e};
  hipError_t err = hipLaunchCooperativeKernel((void*)mk_forward<true>, dim3(grid_blocks), dim3(256), args, 0, stream);
  if (err != hipSuccess) fprintf(stderr, "cooperative launch failed: %s (grid %d)\n", hipGetErrorString(err), grid_blocks);
#else
  for (int ph = 0; ph < NPHASE; ++ph) hipLaunchKernelGGL(mk_forward<false>, dim3(grid_blocks), dim3(256), 0, stream, p, ph, ph + 1);
#endif
}
```

```cpp
#include <hip/hip_runtime.h>
#include <hip/hip_cooperative_groups.h>
#include <cstdio>
#include <cstdint>
namespace cg = cooperative_groups;

typedef unsigned short u16;
using bf16x8 = __attribute__((ext_vector_type(8))) short;
using bf16x4 = __attribute__((ext_vector_type(4))) short;
using f32x4 = __attribute__((ext_vector_type(4))) float;
using u32x4 = __attribute__((ext_vector_type(4))) unsigned;

#define DI __device__ __forceinline__
#define MFMA16(a, b, c) __builtin_amdgcn_mfma_f32_16x16x32_bf16((a), (b), (c), 0, 0, 0)

constexpr int NB = 16, SEQ = 2048, CTXL = 256, SP = 2304, NTOK = NB * SP, DM = 1024;
constexpr int HROWS = 8 * SP;
constexpr int INC = 4368, INP = 4480;
constexpr int NFFN_LAT = 65536, NFFN_ALL = 73728;
constexpr float LN_EPS = 1e-5f;
constexpr float ALPHA = 1.41421356237309515f;
constexpr int SMEM_BYTES = 81920;
constexpr int NPHASE = 2 + 2 * (2 * 5 + 7);


constexpr size_t al256(size_t x) { return (x + 255) & ~(size_t)255; }
constexpr size_t U_ = (size_t)NTOK * 512 * 2;
constexpr size_t OFF_WinT = 0;
constexpr size_t OFF_WgT = OFF_WinT + al256((size_t)2 * INP * 1024 * 2);
constexpr size_t OFF_WbT = OFF_WgT + al256((size_t)2 * 4 * 1024 * 1024 * 2);
constexpr size_t OFF_WoT = OFF_WbT + al256((size_t)2 * 4 * 1024 * 512 * 2);
constexpr size_t OFF_poolT = OFF_WoT + al256((size_t)2 * 1024 * 1024 * 2);
constexpr size_t OFF_sguW = OFF_poolT + al256((size_t)2 * 4 * 128 * 128 * 2);
constexpr size_t OFF_mod = OFF_sguW + al256((size_t)2 * 4 * 128 * 128 * 2);
constexpr size_t OFF_rope = OFF_mod + al256((size_t)2 * 17 * 6144 * 4);
constexpr size_t OFF_lamv = OFF_rope + al256(64 * 16 * 2 * 4);
constexpr size_t OFF_bar = OFF_lamv + 256;
constexpr size_t OFF_aff = OFF_bar + 32768;
constexpr size_t OFF_rank = OFF_aff + al256((size_t)NTOK * 16 * 4);
constexpr size_t OFF_ssq = OFF_rank + al256((size_t)NTOK * 16 * 4);
constexpr size_t OFF_tokidx = OFF_ssq + al256((size_t)NTOK * 8 * 4);
constexpr size_t OFF_gatev = OFF_tokidx + al256((size_t)NFFN_ALL * 4);
constexpr size_t OFF_dtbuf = OFF_gatev + al256((size_t)NFFN_ALL * 4);
constexpr size_t OFF_decay = OFF_dtbuf + al256((size_t)HROWS * 16 * 4);
constexpr size_t OFF_H = OFF_decay + al256((size_t)8 * 2 * 8 * 18 * 4);
constexpr size_t OFF_Y = OFF_H + 2 * U_;
constexpr size_t OFF_xsT = OFF_Y;
constexpr size_t OFF_cstate = OFF_Y + U_ / 2;
constexpr size_t OFF_enter = OFF_Y + U_;
constexpr size_t OFF_bm = OFF_Y + U_ + U_ / 2;
constexpr size_t OFF_cm = OFF_bm + U_ / 8;
constexpr size_t OFF_bmT = OFF_cm + U_ / 8;
constexpr size_t OFF_RM = OFF_Y + 2 * U_;
constexpr size_t OFF_xp = OFF_RM;
constexpr size_t OFF_z = OFF_xp + U_ / 2;
constexpr size_t OFF_xbc = OFF_z + U_ / 2;
constexpr size_t OFF_o1 = OFF_xbc;
constexpr size_t OFF_q = OFF_xbc + (U_ / 4) * 3;
constexpr size_t OFF_k = OFF_q + U_ / 2;
constexpr size_t OFF_vT = OFF_k + U_ / 2;
constexpr size_t OFF_gvT = OFF_vT + U_ / 2;
constexpr size_t OFF_br0 = OFF_gvT + U_ / 2;
constexpr size_t OFF_br1 = OFF_br0 + U_;
constexpr size_t OFF_br2 = OFF_br1 + U_;
constexpr size_t OFF_br3 = OFF_br2 + U_;
constexpr size_t OFF_acc = OFF_RM;
constexpr size_t OFF_W13T = OFF_RM;
constexpr size_t OFF_W2T = OFF_W13T + (size_t)16 * 1024 * 1024 * 2;
constexpr size_t OFF_hid = OFF_W2T + (size_t)16 * 1024 * 512 * 2;
constexpr size_t OFF_ye = OFF_hid + (size_t)NFFN_ALL * 512 * 2;
constexpr size_t WS_MIX_END = OFF_br3 + U_;
constexpr size_t WS_FFN_END = OFF_ye + (size_t)NFFN_ALL * 1024 * 2;
constexpr size_t WS_NEED = WS_MIX_END > WS_FFN_END ? WS_MIX_END : WS_FFN_END;

struct Params {
  const float *x, *c, *ctx, *c_ctx, *w_mod, *b_mod, *w_in, *conv_w, *conv_b, *a_log, *dt_bias, *ssd_d, *ssd_norm_g,
      *diff_lambda, *diff_norm_g, *pool_w, *pool_scale, *sgu_ln_g, *sgu_ln_b, *sgu_w, *sgu_b, *w_gate, *w_branch, *w_out,
      *ln1_g, *ln1_b, *w_router, *w1, *w3, *w2, *ln2_g, *ln2_b;
  float* out;
  char* ws;
};

DI int TID() { int t = (int)__builtin_amdgcn_workitem_id_x(); asm volatile("" : "+v"(t)); return t; }
typedef __bf16 bf2_t __attribute__((ext_vector_type(2)));
typedef float f2_t __attribute__((ext_vector_type(2)));
typedef unsigned u32x2 __attribute__((ext_vector_type(2)));
DI unsigned pack2(float a, float b) { f2_t v = {a, b}; return __builtin_bit_cast(unsigned, __builtin_convertvector(v, bf2_t)); }
DI u16 f2bf(float x) { return (u16)(pack2(x, 0.f) & 0xffffu); }
DI float bf2f(u16 v) { return __uint_as_float(((unsigned)v) << 16); }
DI float bflo(unsigned p) { return __uint_as_float(p << 16); }
DI float bfhi(unsigned p) { return __uint_as_float(p & 0xffff0000u); }
DI float sigmoidf_(float x) { return __builtin_amdgcn_rcpf(1.f + __expf(-x)); }
DI float siluf_(float x) { return x * __builtin_amdgcn_rcpf(1.f + __expf(-x)); }
DI float geluf_(float x) { float y = 0.7978845608028654f * (x + 0.044715f * x * x * x); float t = 1.f - 2.f * __builtin_amdgcn_rcpf(__expf(2.f * y) + 1.f); return 0.5f * x * (1.f + t); }
DI float softplusf_(float x) { return x > 20.f ? x : log1pf(__expf(x)); }
DI bf16x4 pack4(float a, float b, float c, float d) { u32x2 r = {pack2(a, b), pack2(c, d)}; return __builtin_bit_cast(bf16x4, r); }
DI bf16x4 pack4v(f32x4 v) { return pack4(v[0], v[1], v[2], v[3]); }
DI float wave_sum(float v) { for (int o = 32; o > 0; o >>= 1) v += __shfl_xor(v, o); return v; }

template <int MI, int NI, bool SWAP, bool LOWREG = false>
DI void mma_lds(const u16* As, int lda, const u16* Bs, int ldb, int ksteps, f32x4 (&acc)[MI][NI], int fr, int fq) {
  for (int ks = 0; ks < ksteps; ++ks) {
    if (LOWREG) __builtin_amdgcn_sched_barrier(0);
    bf16x8 a[MI], b[NI];
#pragma unroll
    for (int m = 0; m < MI; ++m) a[m] = *(const bf16x8*)(As + (m * 16 + fr) * lda + ks * 32 + fq * 8);
#pragma unroll
    for (int n = 0; n < NI; ++n) b[n] = *(const bf16x8*)(Bs + (n * 16 + fr) * ldb + ks * 32 + fq * 8);
#pragma unroll
    for (int m = 0; m < MI; ++m)
#pragma unroll
      for (int n = 0; n < NI; ++n) acc[m][n] = SWAP ? MFMA16(b[n], a[m], acc[m][n]) : MFMA16(a[m], b[n], acc[m][n]);
  }
}

constexpr int LDT = 72;
template <int NI, bool SWAP, bool GATHER, bool PF2 = true>
DI void gemm_main(const u16* __restrict__ A, int lda, const int* __restrict__ aidx, int arow0, const u16* __restrict__ Bt, int ldb, int brow0,
                  int K, f32x4 (&acc)[4][NI], u16* smem) {
  constexpr int BN = NI * 32;
  constexpr int NBL = BN / 32;
  const int tid = TID(), wave = tid >> 6, lane = tid & 63, fr = lane & 15, fq = lane >> 4;
  const int wr = wave >> 1, wc = wave & 1;
  u16* As = smem;
  u16* Bs = smem + 2 * 128 * LDT;
  const int lr = tid >> 3, lc = (tid & 7) * 8;
  const u16* ap[4];
#pragma unroll
  for (int i = 0; i < 4; ++i) {
    int r = arow0 + lr + 32 * i;
    size_t rr = GATHER ? (size_t)aidx[r] : (size_t)r;
    ap[i] = A + rr * lda + lc;
  }
  const u16* bp = Bt + (size_t)(brow0 + lr) * ldb + lc;
  u32x4 ra0[4], rb0[NBL], ra1[4], rb1[NBL];
  const int nk = K / 64;
#define GLOAD(RA, RB, KO)                                                                   \
  {                                                                                         \
    _Pragma("unroll") for (int i = 0; i < 4; ++i) RA[i] = *(const u32x4*)(ap[i] + (KO));    \
    _Pragma("unroll") for (int i = 0; i < NBL; ++i) RB[i] = *(const u32x4*)(bp + (size_t)(32 * i) * ldb + (KO)); \
  }
#define SSTORE_A(RA, BUF) { _Pragma("unroll") for (int i = 0; i < 4; ++i) *(u32x4*)(As + (BUF) * 128 * LDT + (lr + 32 * i) * LDT + lc) = RA[i]; }
#define SSTORE_B(RB, BUF) { _Pragma("unroll") for (int i = 0; i < NBL; ++i) *(u32x4*)(Bs + (BUF) * BN * LDT + (lr + 32 * i) * LDT + lc) = RB[i]; }
#define SSTORE(RA, RB, BUF) { SSTORE_A(RA, BUF) SSTORE_B(RB, BUF) }
#define COMPUTE(BUF) mma_lds<4, NI, SWAP, !PF2>(As + (BUF) * 128 * LDT + wr * 64 * LDT, LDT, Bs + (BUF) * BN * LDT + wc * (NI * 16) * LDT, LDT, 2, acc, fr, fq)
#define COMPUTE_KS(BUF, KS) mma_lds<4, NI, SWAP, false>(As + (BUF) * 128 * LDT + wr * 64 * LDT + (KS) * 32, LDT, Bs + (BUF) * BN * LDT + wc * (NI * 16) * LDT + (KS) * 32, LDT, 1, acc, fr, fq)
  if (PF2) {
    GLOAD(ra0, rb0, 0);
    GLOAD(ra1, rb1, 64);
    __syncthreads();
    SSTORE(ra0, rb0, 0);
    __syncthreads();
    for (int kt = 0; kt < nk; kt += 2) {
      __builtin_amdgcn_iglp_opt(0);
      if (kt + 2 < nk) GLOAD(ra0, rb0, (kt + 2) * 64);
      COMPUTE_KS(0, 0);
      SSTORE_A(ra1, 1);
      COMPUTE_KS(0, 1);
      SSTORE_B(rb1, 1);
      __syncthreads();
      if (kt + 3 < nk) GLOAD(ra1, rb1, (kt + 3) * 64);
      COMPUTE_KS(1, 0);
      if (kt + 2 < nk) SSTORE_A(ra0, 0);
      COMPUTE_KS(1, 1);
      if (kt + 2 < nk) SSTORE_B(rb0, 0);
      __syncthreads();
    }
  } else {
    GLOAD(ra0, rb0, 0);
    __syncthreads();
    SSTORE(ra0, rb0, 0);
    __syncthreads();
    for (int kt = 0; kt < nk; kt += 2) {
      GLOAD(ra0, rb0, (kt + 1) * 64);
      COMPUTE(0);
      SSTORE(ra0, rb0, 1);
      __syncthreads();
      if (kt + 2 < nk) GLOAD(ra0, rb0, (kt + 2) * 64);
      COMPUTE(1);
      if (kt + 2 < nk) SSTORE(ra0, rb0, 0);
      __syncthreads();
    }
  }
#undef GLOAD
#undef SSTORE
#undef COMPUTE
#undef COMPUTE_KS
#undef SSTORE_A
#undef SSTORE_B
}

template <int NI> DI void zero_acc(f32x4 (&a)[4][NI]) {
#pragma unroll
  for (int m = 0; m < 4; ++m)
#pragma unroll
    for (int n = 0; n < NI; ++n) a[m][n] = f32x4{0.f, 0.f, 0.f, 0.f};
}

DI void cvt_tile(const float* __restrict__ src0, const float* __restrict__ src1, int ld, u16* __restrict__ dst, int K, int n0, int k0, int mode, u16* lds) {
  const int tid = TID();
  constexpr int LC = 66;
  __syncthreads();
  float v[16];
  if (mode == 3) {
#pragma unroll
    for (int i = 0; i < 16; ++i) { int idx = tid + 256 * i; int n = idx >> 6, kk = idx & 63; v[i] = src0[(size_t)(n0 + n) * ld + k0 + kk]; }
#pragma unroll
    for (int i = 0; i < 16; ++i) { int idx = tid + 256 * i; int n = idx >> 6, kk = idx & 63; lds[kk * LC + n] = f2bf(v[i]); }
  } else {
#pragma unroll
    for (int i = 0; i < 16; ++i) {
      int idx = tid + 256 * i;
      int kk = idx >> 6, n = idx & 63;
      int nn = n0 + n;
      float t = 0.f;
      if (mode == 0) t = src0[(size_t)(k0 + kk) * ld + nn];
      else if (mode == 1) {
        int col = nn < 1792 ? nn : (nn < 4352 ? nn + 16 : (nn < 4368 ? nn - 4352 + 1792 : -1));
        if (col >= 0) t = src0[(size_t)(k0 + kk) * ld + col];
        if (nn >= 1792 && nn < 2304) t *= 0.125f;
      } else {
        int g = nn >> 5, r = nn & 31;
        t = (r < 16) ? src0[(size_t)(k0 + kk) * ld + g * 16 + r] : src1[(size_t)(k0 + kk) * ld + g * 16 + r - 16];
      }
      v[i] = t;
    }
#pragma unroll
    for (int i = 0; i < 16; ++i) { int idx = tid + 256 * i; int kk = idx >> 6, n = idx & 63; lds[kk * LC + n] = f2bf(v[i]); }
  }
  __syncthreads();
  for (int c = tid; c < 512; c += 256) {
    int n = c & 63, kc = (c >> 6) * 8;
    bf16x8 o;
#pragma unroll
    for (int j = 0; j < 8; ++j) o[j] = (short)lds[(kc + j) * LC + n];
    *(bf16x8*)(dst + (size_t)(n0 + n) * K + k0 + kc) = o;
  }
}

DI void mod_item(const Params& P, int item, char* smem) {
  const int l = item / 96, n0 = (item % 96) * 64;
  float* sc = (float*)smem;
  const int tid = TID();
  __syncthreads();
  for (int i = tid; i < 17 * 1024; i += 256) {
    int s = i >> 10, kk = i & 1023;
    float v = s < 16 ? P.c[s * 1024 + kk] : P.c_ctx[kk];
    sc[i] = siluf_(v);
  }
  __syncthreads();
  const int col = tid & 63, kp = tid >> 6;
  float a[17];
#pragma unroll
  for (int s = 0; s < 17; ++s) a[s] = 0.f;
  const float* w = P.w_mod + (size_t)l * 1024 * 6144 + n0 + col;
  for (int k0 = kp * 256; k0 < kp * 256 + 256; k0 += 16) {
    float wv[16];
#pragma unroll
    for (int u = 0; u < 16; ++u) wv[u] = w[(size_t)(k0 + u) * 6144];
#pragma unroll
    for (int u = 0; u < 16; ++u)
#pragma unroll
      for (int s = 0; s < 17; ++s) a[s] += sc[s * 1024 + k0 + u] * wv[u];
  }
  __syncthreads();
  float* red = (float*)smem;
#pragma unroll
  for (int s = 0; s < 17; ++s) red[(kp * 17 + s) * 64 + col] = a[s];
  __syncthreads();
  for (int i = tid; i < 17 * 64; i += 256) {
    int s = i >> 6, cc = i & 63;
    float v = red[(0 * 17 + s) * 64 + cc] + red[(1 * 17 + s) * 64 + cc] + red[(2 * 17 + s) * 64 + cc] + red[(3 * 17 + s) * 64 + cc];
    ((float*)(P.ws + OFF_mod))[((size_t)l * 17 + s) * 6144 + n0 + cc] = v + P.b_mod[l * 6144 + n0 + cc];
  }
}

DI void misc_item(const Params& P) {
  const int tid = TID();
  for (int i = tid; i < 1024; i += 256) {
    int pos = i >> 4, f = i & 15;
    float inv = powf(10000.f, -(float)f / 16.f);
    float ang = (float)pos * inv;
    ((float*)(P.ws + OFF_rope))[i * 2] = cosf(ang);
    ((float*)(P.ws + OFF_rope))[i * 2 + 1] = sinf(ang);
  }
  if (tid < 2) {
    const float* dl = P.diff_lambda + tid * 256;
    float s1 = 0.f, s2 = 0.f;
    for (int i = 0; i < 64; ++i) { s1 += dl[i] * dl[64 + i]; s2 += dl[128 + i] * dl[192 + i]; }
    float lam_init = 0.8f - 0.6f * expf(-0.3f * (float)tid);
    ((float*)(P.ws + OFF_lamv))[tid * 2] = expf(s1) - expf(s2) + lam_init;
    ((float*)(P.ws + OFF_lamv))[tid * 2 + 1] = lam_init;
  }
}

DI void phase_prologue(const Params& P, char* smem) {
  const int per_layer = 1120 + 4 * 256 + 4 * 128 + 256 + 16 + 16;
  const int ncvt = 2 * per_layer;
  const int total = ncvt + 192 + 1;
  for (int it0 = blockIdx.x; it0 < total; it0 += gridDim.x) {
    const int it = it0 < 193 ? ncvt + it0 : it0 - 193;
    if (it < ncvt) {
      const int l = it / per_layer;
      int t = it % per_layer;
      const float* s0; u16* dst; int ld, K, ntk, mode;
      if (t < 1120) { s0 = P.w_in + (size_t)l * 1024 * INC; ld = INC; dst = ((u16*)(P.ws + OFF_WinT)) + (size_t)l * INP * 1024; K = 1024; ntk = 16; mode = 1; }
      else if (t < 2144) { t -= 1120; int kq = t >> 8; t &= 255; s0 = P.w_gate + ((size_t)l * 4 + kq) * 1024 * 1024; ld = 1024; dst = ((u16*)(P.ws + OFF_WgT)) + ((size_t)l * 4 + kq) * 1024 * 1024; K = 1024; ntk = 16; mode = 0; }
      else if (t < 2656) { t -= 2144; int kq = t >> 7; t &= 127; s0 = P.w_branch + ((size_t)l * 4 + kq) * 512 * 1024; ld = 1024; dst = ((u16*)(P.ws + OFF_WbT)) + ((size_t)l * 4 + kq) * 1024 * 512; K = 512; ntk = 8; mode = 0; }
      else if (t < 2912) { t -= 2656; s0 = P.w_out + (size_t)l * 1024 * 1024; ld = 1024; dst = ((u16*)(P.ws + OFF_WoT)) + (size_t)l * 1024 * 1024; K = 1024; ntk = 16; mode = 0; }
      else if (t < 2928) { t -= 2912; int g = t >> 2; t &= 3; s0 = P.pool_w + ((size_t)l * 4 + g) * 128 * 128; ld = 128; dst = ((u16*)(P.ws + OFF_poolT)) + ((size_t)l * 4 + g) * 128 * 128; K = 128; ntk = 2; mode = 0; }
      else { t -= 2928; int g = t >> 2; t &= 3; s0 = P.sgu_w + ((size_t)l * 4 + g) * 128 * 128; ld = 128; dst = ((u16*)(P.ws + OFF_sguW)) + ((size_t)l * 4 + g) * 128 * 128; K = 128; ntk = 2; mode = 3; }
      const int tn = t / ntk, tk = t % ntk;
      cvt_tile(s0, s0, ld, dst, K, tn * 64, tk * 64, mode, (u16*)smem);
    } else if (it < ncvt + 192) {
      mod_item(P, it - ncvt, smem);
    } else {
      misc_item(P);
    }
  }
}

DI void ffn_cvt_item(const Params& P, int l, int it, char* smem) {
  const int e = it / 384;
  int t = it % 384;
  if (t < 256) {
    cvt_tile(P.w1 + ((size_t)l * 16 + e) * 1024 * 512, P.w3 + ((size_t)l * 16 + e) * 1024 * 512, 512, ((u16*)(P.ws + OFF_W13T)) + (size_t)e * 1024 * 1024, 1024, (t >> 4) * 64, (t & 15) * 64, 2, (u16*)smem);
  } else {
    t -= 256;
    const float* s = P.w2 + ((size_t)l * 16 + e) * 512 * 1024;
    cvt_tile(s, s, 1024, ((u16*)(P.ws + OFF_W2T)) + (size_t)e * 1024 * 512, 512, (t >> 3) * 64, (t & 7) * 64, 0, (u16*)smem);
  }
}

DI void load_row_f32(const float* p, int lane, float (&v)[16]) {
#pragma unroll
  for (int k = 0; k < 4; ++k) { float4 t = *(const float4*)(p + lane * 4 + 256 * k); v[4 * k] = t.x; v[4 * k + 1] = t.y; v[4 * k + 2] = t.z; v[4 * k + 3] = t.w; }
}
DI void load_row_bf16(const u16* p, int lane, float (&v)[16]) {
#pragma unroll
  for (int k = 0; k < 4; ++k) { bf16x4 t = *(const bf16x4*)(p + lane * 4 + 256 * k); for (int i = 0; i < 4; ++i) v[4 * k + i] = bf2f((u16)t[i]); }
}
DI void store_row_f32(float* p, int lane, const float (&v)[16]) {
#pragma unroll
  for (int k = 0; k < 4; ++k) *(float4*)(p + lane * 4 + 256 * k) = make_float4(v[4 * k], v[4 * k + 1], v[4 * k + 2], v[4 * k + 3]);
}
DI void store_row_bf16(u16* p, int lane, const float (&v)[16]) {
#pragma unroll
  for (int k = 0; k < 4; ++k) *(bf16x4*)(p + lane * 4 + 256 * k) = pack4(v[4 * k], v[4 * k + 1], v[4 * k + 2], v[4 * k + 3]);
}
DI void ln_row(float (&v)[16], const float* g, const float* b, int lane) {
  float s = 0.f;
#pragma unroll
  for (int i = 0; i < 16; ++i) s += v[i];
  float mu = wave_sum(s) * (1.f / 1024.f);
  float q = 0.f;
#pragma unroll
  for (int i = 0; i < 16; ++i) { float d = v[i] - mu; q += d * d; }
  float rstd = rsqrtf(wave_sum(q) * (1.f / 1024.f) + LN_EPS);
  float gg[16], bb[16];
  load_row_f32(g, lane, gg); load_row_f32(b, lane, bb);
#pragma unroll
  for (int i = 0; i < 16; ++i) v[i] = (v[i] - mu) * rstd * gg[i] + bb[i];
}

DI void phase_h0(const Params& P) {
  const int lane = TID() & 63;
  const int gw = blockIdx.x * 4 + (TID() >> 6), nw = gridDim.x * 4;
  for (int row = gw; row < NTOK; row += nw) {
    int s = row / SP, p = row % SP;
    bool lat = p < SEQ;
    const float* xs = lat ? P.x + ((size_t)s * SEQ + p) * DM : P.ctx + ((size_t)s * CTXL + (p - SEQ)) * DM;
    const float* md = ((float*)(P.ws + OFF_mod)) + (size_t)(lat ? s : 16) * 6144;
    float v[16], sh[16], scl[16];
    load_row_f32(xs, lane, v); load_row_f32(md, lane, sh); load_row_f32(md + 1024, lane, scl);
#pragma unroll
    for (int i = 0; i < 16; ++i) v[i] = v[i] * (1.f + scl[i]) + sh[i];
    store_row_bf16(((u16*)(P.ws + OFF_H)) + (size_t)row * DM, lane, v);
  }
}

DI void compute_x1(const Params& P, int l, int row, int lane, float (&v)[16]) {
  int s = row / SP, p = row % SP;
  bool lat = p < SEQ;
  const float* xs;
  if (l == 0) xs = lat ? P.x + ((size_t)s * SEQ + p) * DM : P.ctx + ((size_t)s * CTXL + (p - SEQ)) * DM;
  else xs = P.out + ((size_t)s * SEQ + p) * DM;
  const float* md = ((float*)(P.ws + OFF_mod)) + ((size_t)l * 17 + (lat ? s : 16)) * 6144;
  float y[16], m2[16];
  load_row_f32(xs, lane, v); load_row_bf16(((u16*)(P.ws + OFF_Y)) + (size_t)row * DM, lane, y); load_row_f32(md + 2 * 1024, lane, m2);
#pragma unroll
  for (int i = 0; i < 16; ++i) v[i] = ALPHA * v[i] + m2[i] * y[i];
  ln_row(v, P.ln1_g + l * 1024, P.ln1_b + l * 1024, lane);
}

DI void phase_ln1(const Params& P, int l, char* smem) {
  const bool last = (l == 1);
  const int tid = TID();
  const int lane = tid & 63;
  const int gw = blockIdx.x * 4 + (tid >> 6), nw = gridDim.x * 4;
  float* wT = (float*)smem;
  __syncthreads();
  {
    const float* wr = P.w_router + (size_t)l * 1024 * 16;
    for (int i = tid; i < 4096; i += 256) {
      int c = i >> 2, e4 = (i & 3) * 4;
      float4 w = *(const float4*)(wr + (size_t)c * 16 + e4);
      wT[(e4 + 0) * 1024 + c] = w.x; wT[(e4 + 1) * 1024 + c] = w.y; wT[(e4 + 2) * 1024 + c] = w.z; wT[(e4 + 3) * 1024 + c] = w.w;
    }
  }
  __syncthreads();
  for (int row = gw; row < NTOK; row += nw) {
    int s = row / SP, p = row % SP;
    bool lat = p < SEQ;
    if (last && !lat) continue;
    float v[16];
    compute_x1(P, l, row, lane, v);
    const float* md = ((float*)(P.ws + OFF_mod)) + ((size_t)l * 17 + (lat ? s : 16)) * 6144;
    float m3[16], m4[16];
    load_row_f32(md + 3 * 1024, lane, m3); load_row_f32(md + 4 * 1024, lane, m4);
#pragma unroll
    for (int i = 0; i < 16; ++i) v[i] = v[i] * (1.f + m4[i]) + m3[i];
    store_row_bf16(((u16*)(P.ws + OFF_H)) + (size_t)row * DM, lane, v);
    float lg[16];
#pragma unroll
    for (int e = 0; e < 16; ++e) {
      float a = 0.f;
#pragma unroll
      for (int k = 0; k < 4; ++k) {
        float4 w = *(const float4*)(wT + e * 1024 + lane * 4 + 256 * k);
        a += v[4 * k] * w.x + v[4 * k + 1] * w.y + v[4 * k + 2] * w.z + v[4 * k + 3] * w.w;
      }
      lg[e] = a;
    }
#pragma unroll
    for (int e = 0; e < 16; ++e) lg[e] = wave_sum(lg[e]);
    float mx = lg[0];
#pragma unroll
    for (int e = 1; e < 16; ++e) mx = fmaxf(mx, lg[e]);
    float sum = 0.f;
#pragma unroll
    for (int e = 0; e < 16; ++e) { lg[e] = expf(lg[e] - mx); sum += lg[e]; }
    float inv = 1.f / sum;
    if (lane < 16) {
      float mine = 0.f;
#pragma unroll
      for (int e = 0; e < 16; ++e) if (lane == e) mine = lg[e];
      ((float*)(P.ws + OFF_aff))[(size_t)row * 16 + lane] = mine * inv;
    }
  }
}

DI int block_excl_scan(int v, int* red, int tid, int& total) {
  const int lane = tid & 63, wave = tid >> 6;
  int inc = v;
#pragma unroll
  for (int o = 1; o < 64; o <<= 1) { int t = __shfl_up(inc, o); if (lane >= o) inc += t; }
  __syncthreads();
  if (lane == 63) red[wave] = inc;
  __syncthreads();
  int base = 0;
#pragma unroll
  for (int w = 0; w < 4; ++w) { int t = red[w]; if (w < wave) base += t; }
  total = red[0] + red[1] + red[2] + red[3];
  return base + inc - v;
}

DI void phase_topk(const Params& P, int l, char* smem) {
  const bool last = (l == 1);
  const int tid = TID();
  unsigned* keys = (unsigned*)smem;
  int* red = (int*)(smem + 8192);
  const int nitems = last ? 256 : 512;
  for (int it = gridDim.x - 1 - blockIdx.x; it < 16 * 384; it += gridDim.x) ffn_cvt_item(P, l, it, smem);
  for (int it = blockIdx.x; it < nitems; it += gridDim.x) {
    const bool isctx = it >= 256;
    const int se = it & 255, s = se >> 4, e = se & 15;
    const int n = isctx ? CTXL : SEQ, cap = isctx ? 32 : 256;
    const int row0 = s * SP + (isctx ? SEQ : 0);
    const int per = n >> 8;
    __syncthreads();
    for (int i = tid; i < n; i += 256) keys[i] = __float_as_uint(((float*)(P.ws + OFF_aff))[(size_t)(row0 + i) * 16 + e]);
    __syncthreads();
    unsigned kv[8];
#pragma unroll
    for (int j = 0; j < 8; ++j) kv[j] = (j < per) ? keys[tid * per + j] : 0u;
    unsigned prefix = 0u;
    int krem = cap;
    for (int bit = 31; bit >= 0; --bit) {
      const unsigned himask = (bit == 31) ? 0u : (0xFFFFFFFFu << (bit + 1));
      const unsigned want = prefix | (1u << bit);
      int c = 0;
#pragma unroll
      for (int j = 0; j < 8; ++j) c += (j < per && ((kv[j] & (himask | (1u << bit))) == want)) ? 1 : 0;
      c = (int)wave_sum((float)c);
      __syncthreads();
      if ((tid & 63) == 0) red[tid >> 6] = c;
      __syncthreads();
      const int cnt = red[0] + red[1] + red[2] + red[3];
      if (cnt >= krem) prefix = want; else krem -= cnt;
    }
    const unsigned T = prefix;
    int cgt = 0, ceq = 0;
#pragma unroll
    for (int j = 0; j < 8; ++j) if (j < per) { cgt += kv[j] > T ? 1 : 0; ceq += kv[j] == T ? 1 : 0; }
    int tot_gt, tot_eq, tot_sel;
    (void)block_excl_scan(cgt, red, tid, tot_gt);
    const int eq_before = block_excl_scan(ceq, red, tid, tot_eq);
    const int need_eq = cap - tot_gt;
    int eqc = eq_before, csel = 0;
    bool sel[8];
#pragma unroll
    for (int j = 0; j < 8; ++j) {
      sel[j] = false;
      if (j < per) {
        if (kv[j] > T) sel[j] = true;
        else if (kv[j] == T) { sel[j] = eqc < need_eq; ++eqc; }
        csel += sel[j] ? 1 : 0;
      }
    }
    int slot = block_excl_scan(csel, red, tid, tot_sel);
#pragma unroll
    for (int j = 0; j < 8; ++j) if (j < per) {
      const int t = tid * per + j;
      int rk = cap;
      if (sel[j]) {
        rk = slot++;
        const int R = isctx ? NFFN_LAT + (e * 16 + s) * 32 + rk : (s * 16 + e) * 256 + rk;
        ((int*)(P.ws + OFF_tokidx))[R] = row0 + t;
        ((float*)(P.ws + OFF_gatev))[R] = __uint_as_float(kv[j]);
      }
      ((int*)(P.ws + OFF_rank))[(size_t)(row0 + t) * 16 + e] = rk;
    }
  }
}

DI void phase_ln2(const Params& P, int l) {
  const bool last = (l == 1);
  const int lane = TID() & 63;
  const int gw = blockIdx.x * 4 + (TID() >> 6), nw = gridDim.x * 4;
  for (int row = gw; row < NTOK; row += nw) {
    int s = row / SP, p = row % SP;
    bool lat = p < SEQ;
    if (last && !lat) continue;
    float v[16];
    compute_x1(P, l, row, lane, v);
    float yf[16];
#pragma unroll
    for (int i = 0; i < 16; ++i) yf[i] = 0.f;
    const int cap = lat ? 256 : 32;
    int rks[16];
    {
      const int4* rp = (const int4*)(((int*)(P.ws + OFF_rank)) + (size_t)row * 16);
      int4 r0 = rp[0], r1 = rp[1], r2 = rp[2], r3 = rp[3];
      rks[0] = r0.x; rks[1] = r0.y; rks[2] = r0.z; rks[3] = r0.w; rks[4] = r1.x; rks[5] = r1.y; rks[6] = r1.z; rks[7] = r1.w;
      rks[8] = r2.x; rks[9] = r2.y; rks[10] = r2.z; rks[11] = r2.w; rks[12] = r3.x; rks[13] = r3.y; rks[14] = r3.z; rks[15] = r3.w;
    }
#pragma unroll
    for (int e = 0; e < 16; ++e) {
      const int rk = __builtin_amdgcn_readfirstlane(rks[e]);
      if (rk < cap) {
        int R = lat ? (s * 16 + e) * 256 + rk : NFFN_LAT + (e * 16 + s) * 32 + rk;
        float t[16];
        load_row_bf16(((u16*)(P.ws + OFF_ye)) + (size_t)R * DM, lane, t);
#pragma unroll
        for (int i = 0; i < 16; ++i) yf[i] += t[i];
      }
    }
    const float* md = ((float*)(P.ws + OFF_mod)) + ((size_t)l * 17 + (lat ? s : 16)) * 6144;
    float m5[16];
    load_row_f32(md + 5 * 1024, lane, m5);
#pragma unroll
    for (int i = 0; i < 16; ++i) v[i] = ALPHA * v[i] + m5[i] * yf[i];
    ln_row(v, P.ln2_g + l * 1024, P.ln2_b + l * 1024, lane);
    if (lat) store_row_f32(P.out + ((size_t)s * SEQ + p) * DM, lane, v);
    if (!last) {
      const float* md2 = ((float*)(P.ws + OFF_mod)) + ((size_t)(l + 1) * 17 + (lat ? s : 16)) * 6144;
      float sh[16], scl[16];
      load_row_f32(md2, lane, sh); load_row_f32(md2 + 1024, lane, scl);
#pragma unroll
      for (int i = 0; i < 16; ++i) v[i] = v[i] * (1.f + scl[i]) + sh[i];
      store_row_bf16(((u16*)(P.ws + OFF_H)) + (size_t)row * DM, lane, v);
    }
  }
}

DI int wq_next(unsigned* ctr, char* smem) {
  volatile int* slot = (volatile int*)(smem + SMEM_BYTES - 32);
  __syncthreads();
  if (TID() == 0) *slot = (int)__hip_atomic_fetch_add(ctr, 1u, __ATOMIC_RELAXED, __HIP_MEMORY_SCOPE_AGENT);
  __syncthreads();
  return *slot;
}

DI unsigned* wq_ctr(const Params& P, int ph) { return (unsigned*)(P.ws + OFF_bar) + 3600 + 16 * ph; }

template <bool SWAP>
DI void proj_tile(const Params& P, int l, int hb, int mt, int nt, char* smem) {
  const int tid = TID(), wave = tid >> 6, lane = tid & 63, fr = lane & 15, fq = lane >> 4;
  const int wr = wave >> 1, wc = wave & 1;
  const int hrow0 = mt * 128, grow0 = hb * HROWS + hrow0;
  f32x4 acc[4][4];
  zero_acc<4>(acc);
  gemm_main<4, SWAP, false>(((u16*)(P.ws + OFF_H)), DM, nullptr, grow0, ((u16*)(P.ws + OFF_WinT)) + (size_t)l * INP * 1024, 1024, nt * 128, 1024, acc, (u16*)smem);
  const int jp = mt % 18;
  const int bl = mt / 18;
  const bool lat = jp < 16;
  if (SWAP) {
    u16* dst; int ldd, c0;
    if (nt < 4) { dst = ((u16*)(P.ws + OFF_xp)); ldd = 512; c0 = nt * 128; }
    else if (nt < 8) { dst = ((u16*)(P.ws + OFF_z)); ldd = 512; c0 = (nt - 4) * 128; }
    else if (nt < 14) { dst = ((u16*)(P.ws + OFF_xbc)); ldd = 768; c0 = (nt - 8) * 128; }
    else if (nt < 18) { dst = ((u16*)(P.ws + OFF_q)); ldd = 512; c0 = (nt - 14) * 128; }
    else if (nt < 22) { dst = ((u16*)(P.ws + OFF_k)); ldd = 512; c0 = (nt - 18) * 128; }
    else { dst = ((u16*)(P.ws + OFF_br3)); ldd = 512; c0 = (nt - 26) * 128; }
    const bool isu = nt >= 26;
    const bool rope = (nt >= 14 && nt < 22) && lat;
#pragma unroll
    for (int m = 0; m < 4; ++m) {
      int r = wr * 64 + m * 16 + fr;
      size_t orow = isu ? (size_t)(grow0 + r) : (size_t)(hrow0 + r);
      if (rope) {
        int t = jp * 128 + r;
        int prow = t >> 6, pcol = t & 63;
#pragma unroll
        for (int j = 0; j < 4; ++j) {
          int f = fq * 4 + j;
          float c1 = ((float*)(P.ws + OFF_rope))[(prow * 16 + f) * 2], s1 = ((float*)(P.ws + OFF_rope))[(prow * 16 + f) * 2 + 1];
          float c2 = ((float*)(P.ws + OFF_rope))[(pcol * 16 + f) * 2], s2 = ((float*)(P.ws + OFF_rope))[(pcol * 16 + f) * 2 + 1];
          float a = acc[m][0][j], b = acc[m][1][j];
          acc[m][0][j] = a * c1 - b * s1; acc[m][1][j] = a * s1 + b * c1;
          a = acc[m][2][j]; b = acc[m][3][j];
          acc[m][2][j] = a * c2 - b * s2; acc[m][3][j] = a * s2 + b * c2;
        }
      }
#pragma unroll
      for (int n = 0; n < 4; ++n) {
        f32x4 v = acc[m][n];
        if (isu) { v[0] = geluf_(v[0]); v[1] = geluf_(v[1]); v[2] = geluf_(v[2]); v[3] = geluf_(v[3]); }
        int col = c0 + wc * 64 + n * 16 + fq * 4;
        *(bf16x4*)(dst + orow * ldd + col) = pack4v(v);
      }
    }
  } else {
    if (nt == 34) {
      if (wc == 0) {
#pragma unroll
        for (int m = 0; m < 4; ++m)
#pragma unroll
          for (int j = 0; j < 4; ++j) ((float*)(P.ws + OFF_dtbuf))[(size_t)(hrow0 + wr * 64 + m * 16 + fq * 4 + j) * 16 + fr] = acc[m][0][j];
      }
    } else if (nt < 26) {
      int cb = (nt - 22) * 128 + wc * 64;
#pragma unroll
      for (int m = 0; m < 4; ++m)
#pragma unroll
        for (int n = 0; n < 4; ++n) {
          int c = cb + n * 16 + fr;
          int pos = jp * 128 + wr * 64 + m * 16 + fq * 4;
          *(bf16x4*)(((u16*)(P.ws + OFF_vT)) + ((size_t)bl * 512 + c) * SP + pos) = pack4v(acc[m][n]);
        }
    } else {
      int cb = (nt - 30) * 128 + wc * 64;
#pragma unroll
      for (int m = 0; m < 4; ++m)
#pragma unroll
        for (int n = 0; n < 4; ++n) {
          int c = cb + n * 16 + fr;
          int i0 = wr * 64 + m * 16 + fq * 4;
          f32x4 v = acc[m][n];
          *(bf16x4*)(((u16*)(P.ws + OFF_gvT)) + ((size_t)mt * 512 + c) * 128 + i0) = pack4(geluf_(v[0]), geluf_(v[1]), geluf_(v[2]), geluf_(v[3]));
        }
    }
  }
}

DI void phase_proj(const Params& P, int l, int hb, char* smem, int ph) {
  const bool last = (l == 1);
  for (;;) {
    const int it = wq_next(wq_ctr(P, ph), smem);
    if (it >= 144 * 35) break;
    int mt = it / 35, nt = it % 35;
    bool isctx = (mt % 18) >= 16;
    if (last && isctx) {
      bool need = (nt >= 8 && nt < 14) || (nt >= 18 && nt < 26) || nt == 34;
      if (!need) continue;
    }
    bool transposed = (nt >= 22 && nt < 26) || nt >= 30;
    if (transposed) proj_tile<false>(P, l, hb, mt, nt, smem);
    else proj_tile<true>(P, l, hb, mt, nt, smem);
  }
}

constexpr int LDK = 136;
DI void pool_item(const Params& P, int l, int hb, int mt, int g, char* smem) {
  const int tid = TID(), wave = tid >> 6, lane = tid & 63, fr = lane & 15, fq = lane >> 4;
  const int wr = wave >> 1, wc = wave & 1;
  u16* As = (u16*)smem;
  u16* Bs = As + 128 * LDK;
  const int jp = mt % 18, bl = mt / 18;
  const bool lat = jp < 16;
  const int n = lat ? SEQ : CTXL;
  const int p0 = lat ? jp * 128 : (jp - 16) * 128;
  const int seqbase = bl * SP + (lat ? 0 : SEQ);
  const int half = 1 << g;
  __syncthreads();
  {
    const int cch = tid & 15;
    const u16* src = ((u16*)(P.ws + OFF_xp)) + (size_t)seqbase * 512 + g * 128 + cch * 8;
    for (int ii = 0; ii < 8; ++ii) {
      int i = (tid >> 4) + 16 * ii;
      int p = p0 + i;
      int lo = max(p - half, 0), hi = min(p + half, n);
      float s[8];
#pragma unroll
      for (int e = 0; e < 8; ++e) s[e] = 0.f;
      for (int r = lo; r < hi; ++r) {
        bf16x8 t = *(const bf16x8*)(src + (size_t)r * 512);
#pragma unroll
        for (int e = 0; e < 8; ++e) s[e] += bf2f((u16)t[e]);
      }
      bf16x8 self = *(const bf16x8*)(src + (size_t)p * 512);
      float inv = 1.f / (float)(hi - lo);
      bf16x8 o;
#pragma unroll
      for (int e = 0; e < 8; ++e) o[e] = (short)f2bf(s[e] * inv - bf2f((u16)self[e]));
      *(bf16x8*)(As + i * LDK + cch * 8) = o;
    }
    const u16* wsrc = ((u16*)(P.ws + OFF_poolT)) + ((size_t)l * 4 + g) * 128 * 128;
    for (int cid = tid; cid < 2048; cid += 256) {
      int r = cid >> 4, c8 = (cid & 15) * 8;
      *(u32x4*)(Bs + r * LDK + c8) = *(const u32x4*)(wsrc + r * 128 + c8);
    }
  }
  __syncthreads();
  f32x4 acc[4][4];
  zero_acc<4>(acc);
  mma_lds<4, 4, true>(As + wr * 64 * LDK, LDK, Bs + wc * 64 * LDK, LDK, 4, acc, fr, fq);
  const float* psc = P.pool_scale + l * 512 + g * 128;
#pragma unroll
  for (int m = 0; m < 4; ++m)
#pragma unroll
    for (int nn = 0; nn < 4; ++nn) {
      int r = wr * 64 + m * 16 + fr, c = wc * 64 + nn * 16 + fq * 4;
      float4 sc = *(const float4*)(psc + c);
      f32x4 v = acc[m][nn];
      *(bf16x4*)(((u16*)(P.ws + OFF_br0)) + (size_t)(hb * HROWS + mt * 128 + r) * 512 + g * 128 + c) = pack4(v[0] * sc.x, v[1] * sc.y, v[2] * sc.z, v[3] * sc.w);
    }
}

DI void sgu_item(const Params& P, int l, int hb, int mt, int g, char* smem) {
  const int tid = TID(), wave = tid >> 6, lane = tid & 63, fr = lane & 15, fq = lane >> 4;
  const int wr = wave >> 1, wc = wave & 1;
  u16* As = (u16*)smem;
  u16* Bs = As + 128 * LDK;
  float* st = (float*)(Bs + 128 * LDK);
  const u16* gv = ((u16*)(P.ws + OFF_gvT)) + (size_t)mt * 512 * 128;
  __syncthreads();
  {
    float* ps = (float*)smem;
    float* pq = ps + 16 * 128;
    const int cg = tid >> 4, tc = tid & 15;
    float s8[8], q8[8];
#pragma unroll
    for (int e2 = 0; e2 < 8; ++e2) { s8[e2] = 0.f; q8[e2] = 0.f; }
#pragma unroll 8
    for (int c = 0; c < 32; ++c) {
      u32x4 t = *(const u32x4*)(gv + (size_t)(cg * 32 + c) * 128 + tc * 8);
#pragma unroll
      for (int e2 = 0; e2 < 4; ++e2) {
        float a = bflo(t[e2]), b = bfhi(t[e2]);
        s8[2 * e2] += a; q8[2 * e2] += a * a; s8[2 * e2 + 1] += b; q8[2 * e2 + 1] += b * b;
      }
    }
#pragma unroll
    for (int e2 = 0; e2 < 8; ++e2) { ps[cg * 128 + tc * 8 + e2] = s8[e2]; pq[cg * 128 + tc * 8 + e2] = q8[e2]; }
    __syncthreads();
    if (tid < 128) {
      float s = 0.f, q = 0.f;
#pragma unroll
      for (int g2 = 0; g2 < 16; ++g2) { s += ps[g2 * 128 + tid]; q += pq[g2 * 128 + tid]; }
      const float mu_ = s * (1.f / 512.f);
      const float var = fmaxf(q * (1.f / 512.f) - mu_ * mu_, 0.f);
      st[256 + tid] = mu_; st[384 + tid] = rsqrtf(var + LN_EPS);
    }
  }
  const float* mu = st + 256;
  const float* rs = st + 384;
  {
    __syncthreads();
    const u16* wsrc = ((u16*)(P.ws + OFF_sguW)) + ((size_t)l * 4 + g) * 128 * 128;
    for (int cid = tid; cid < 2048; cid += 256) {
      int r = cid >> 4, c8 = (cid & 15) * 8;
      *(u32x4*)(As + r * LDK + c8) = *(const u32x4*)(wsrc + r * 128 + c8);
      bf16x8 t = *(const bf16x8*)(gv + (size_t)(g * 128 + r) * 128 + c8);
      float lg = P.sgu_ln_g[l * 512 + g * 128 + r], lb = P.sgu_ln_b[l * 512 + g * 128 + r];
      bf16x8 o;
#pragma unroll
      for (int e = 0; e < 8; ++e) o[e] = (short)f2bf((bf2f((u16)t[e]) - mu[c8 + e]) * rs[c8 + e] * lg + lb);
      *(bf16x8*)(Bs + r * LDK + c8) = o;
    }
    __syncthreads();
    f32x4 acc[4][4];
    zero_acc<4>(acc);
    mma_lds<4, 4, true>(As + wr * 64 * LDK, LDK, Bs + wc * 64 * LDK, LDK, 4, acc, fr, fq);
    const float* bs = P.sgu_b + ((size_t)l * 4 + g) * 128;
#pragma unroll
    for (int m = 0; m < 4; ++m) {
      int pp = wr * 64 + m * 16 + fr;
      float bias = bs[pp];
#pragma unroll
      for (int nn = 0; nn < 4; ++nn) {
        int d = wc * 64 + nn * 16 + fq * 4;
        u16* up = ((u16*)(P.ws + OFF_br3)) + (size_t)(hb * HROWS + mt * 128 + pp) * 512 + g * 128 + d;
        bf16x4 uu = *(const bf16x4*)up;
        f32x4 v = acc[m][nn];
        *(bf16x4*)up = pack4((v[0] + bias) * bf2f((u16)uu[0]), (v[1] + bias) * bf2f((u16)uu[1]), (v[2] + bias) * bf2f((u16)uu[2]), (v[3] + bias) * bf2f((u16)uu[3]));
      }
    }
  }
}

DI void attn_item(const Params& P, int l, int hb, int item, char* smem) {
  const int tid = TID(), wave = tid >> 6, lane = tid & 63, fr = lane & 15, fq = lane >> 4;
  int qt, h, bl;
  if (item < 512) { bl = item >> 6; h = (item >> 4) & 3; qt = item & 15; }
  else { const int j = item - 512; bl = j >> 3; h = (j >> 1) & 3; qt = 16 + (j & 1); }
  const bool ctxq = qt >= 16;
  const int key0 = ctxq ? SEQ : 0, nkt = ctxq ? 4 : 36;
  const int hrow_q0 = bl * SP + qt * 128 + wave * 32;
  constexpr int KT = 64 * LDT, VT = 128 * LDT;
  u16* Ks = (u16*)smem;
  u16* Vs = Ks + 2 * KT;
  constexpr float LOG2E = 1.4426950408889634f;
  for (int sub = 0; sub < 2; ++sub) {
    const int hs = 2 * h + sub;
    bf16x8 qf[2][2];
#pragma unroll
    for (int qb = 0; qb < 2; ++qb)
#pragma unroll
      for (int ks = 0; ks < 2; ++ks) qf[qb][ks] = *(const bf16x8*)(((u16*)(P.ws + OFF_q)) + (size_t)(hrow_q0 + qb * 16 + fr) * 512 + hs * 64 + ks * 32 + fq * 8);
    f32x4 ot[8][2];
#pragma unroll
    for (int d = 0; d < 8; ++d) { ot[d][0] = f32x4{0.f, 0.f, 0.f, 0.f}; ot[d][1] = f32x4{0.f, 0.f, 0.f, 0.f}; }
    float mrow[2] = {-INFINITY, -INFINITY}, lrow[2] = {0.f, 0.f};
    const u16* Kg = ((u16*)(P.ws + OFF_k)) + ((size_t)bl * SP + key0) * 512 + hs * 64;
    const u16* Vg = ((u16*)(P.ws + OFF_vT)) + ((size_t)bl * 512 + h * 128) * SP + key0;
    u32x4 rk[2], rv[4];
    const u16* kgp = Kg + (size_t)(tid >> 2) * 512 + (tid & 3) * 16;
    const u16* vgp = Vg + (size_t)(tid >> 1) * SP + (tid & 1) * 32;
    u16* ksp = Ks + (tid >> 2) * LDT + (tid & 3) * 16;
    u16* vsp = Vs + (tid >> 1) * LDT + (tid & 1) * 32;
    auto gloadK = [&](int t) {
      const u16* kp = kgp + (size_t)t * 64 * 512;
      rk[0] = *(const u32x4*)(kp); rk[1] = *(const u32x4*)(kp + 8);
    };
    auto gloadV = [&](int t) {
      const u16* vp = vgp + t * 64;
      rv[0] = *(const u32x4*)(vp); rv[1] = *(const u32x4*)(vp + 8); rv[2] = *(const u32x4*)(vp + 16); rv[3] = *(const u32x4*)(vp + 24);
    };
    auto sstore = [&](int buf) {
      u16* kp = ksp + buf * KT;
      *(u32x4*)(kp) = rk[0]; *(u32x4*)(kp + 8) = rk[1];
      u16* vp = vsp + buf * VT;
      *(u32x4*)(vp) = rv[0]; *(u32x4*)(vp + 8) = rv[1]; *(u32x4*)(vp + 16) = rv[2]; *(u32x4*)(vp + 24) = rv[3];
    };
    gloadK(0); gloadV(0);
    __syncthreads();
    sstore(0);
    __syncthreads();
    for (int t = 0; t < nkt; ++t) {
      const int cur = t & 1;
      if (t + 1 < nkt) gloadK(t + 1);
      const u16* Kc = Ks + cur * KT;
      const u16* Vc = Vs + cur * VT;
      f32x4 st[4][2];
#pragma unroll
      for (int k4 = 0; k4 < 4; ++k4) { st[k4][0] = f32x4{0.f, 0.f, 0.f, 0.f}; st[k4][1] = f32x4{0.f, 0.f, 0.f, 0.f}; }
#pragma unroll
      for (int k4 = 0; k4 < 4; ++k4)
#pragma unroll
        for (int ks = 0; ks < 2; ++ks) {
          bf16x8 a = *(const bf16x8*)(Kc + (k4 * 16 + fr) * LDT + ks * 32 + fq * 8);
          st[k4][0] = MFMA16(a, qf[0][ks], st[k4][0]);
          st[k4][1] = MFMA16(a, qf[1][ks], st[k4][1]);
          if (ks == 1 && (k4 & 1)) __builtin_amdgcn_sched_barrier(0);
        }
      __builtin_amdgcn_sched_barrier(0);
#pragma unroll
      for (int qb = 0; qb < 2; ++qb) {
        float mx = -INFINITY;
#pragma unroll
        for (int k4 = 0; k4 < 4; ++k4)
#pragma unroll
          for (int j = 0; j < 4; ++j) mx = fmaxf(mx, st[k4][qb][j]);
        mx = fmaxf(mx, __shfl_xor(mx, 16));
        mx = fmaxf(mx, __shfl_xor(mx, 32));
        const bool upd = mx > mrow[qb] + 5.5f;
        const float mnew = upd ? mx : mrow[qb];
        const float moff = mnew * LOG2E;
        float ps = 0.f;
#pragma unroll
        for (int k4 = 0; k4 < 4; ++k4)
#pragma unroll
          for (int j = 0; j < 4; ++j) { float pv = __builtin_amdgcn_exp2f(st[k4][qb][j] * LOG2E - moff); st[k4][qb][j] = pv; ps += pv; }
        if (__builtin_amdgcn_ballot_w64(upd) != 0ull) {
          const float alpha = __builtin_amdgcn_exp2f((mrow[qb] - mnew) * LOG2E);
          lrow[qb] *= alpha;
#pragma unroll
          for (int d = 0; d < 8; ++d) { ot[d][qb][0] *= alpha; ot[d][qb][1] *= alpha; ot[d][qb][2] *= alpha; ot[d][qb][3] *= alpha; }
        }
        mrow[qb] = mnew;
        lrow[qb] += ps;
      }
      __builtin_amdgcn_sched_barrier(0);
      if (t + 1 < nkt) gloadV(t + 1);
#pragma unroll
      for (int ks2 = 0; ks2 < 2; ++ks2) {
        bf16x8 pf[2];
#pragma unroll
        for (int qb = 0; qb < 2; ++qb) {
          bf16x4 lo = pack4v(st[2 * ks2][qb]), hi = pack4v(st[2 * ks2 + 1][qb]);
          pf[qb] = __builtin_shufflevector(lo, hi, 0, 1, 2, 3, 4, 5, 6, 7);
        }
#pragma unroll
        for (int d = 0; d < 8; ++d) {
          const u16* vp = Vc + (d * 16 + fr) * LDT + ks2 * 32 + fq * 4;
          bf16x4 lo = *(const bf16x4*)vp, hi = *(const bf16x4*)(vp + 16);
          bf16x8 a = __builtin_shufflevector(lo, hi, 0, 1, 2, 3, 4, 5, 6, 7);
          ot[d][0] = MFMA16(a, pf[0], ot[d][0]);
          ot[d][1] = MFMA16(a, pf[1], ot[d][1]);
          if ((d & 3) == 3) __builtin_amdgcn_sched_barrier(0);
        }
      }
      if (t + 1 < nkt) sstore(cur ^ 1);
      __syncthreads();
    }
#pragma unroll
    for (int qb = 0; qb < 2; ++qb) {
      float lt = lrow[qb];
      lt += __shfl_xor(lt, 16);
      lt += __shfl_xor(lt, 32);
      float inv = 1.f / lt;
      size_t hrow = (size_t)(hrow_q0 + qb * 16 + fr);
      if (sub == 0) {
#pragma unroll
        for (int d = 0; d < 8; ++d) {
          f32x4 v = ot[d][qb];
          *(bf16x4*)(((u16*)(P.ws + OFF_o1)) + hrow * 512 + h * 128 + d * 16 + fq * 4) = pack4(v[0] * inv, v[1] * inv, v[2] * inv, v[3] * inv);
        }
      } else {
        const float lam = ((float*)(P.ws + OFF_lamv))[l * 2], lam_init = ((float*)(P.ws + OFF_lamv))[l * 2 + 1];
        float ss = 0.f;
#pragma unroll
        for (int d = 0; d < 8; ++d) {
          bf16x4 o1v = *(const bf16x4*)(((u16*)(P.ws + OFF_o1)) + hrow * 512 + h * 128 + d * 16 + fq * 4);
#pragma unroll
          for (int j = 0; j < 4; ++j) { float dd = bf2f((u16)o1v[j]) - lam * ot[d][qb][j] * inv; ot[d][qb][j] = dd; ss += dd * dd; }
        }
        ss += __shfl_xor(ss, 16);
        ss += __shfl_xor(ss, 32);
        float rr = rsqrtf(ss * (1.f / 128.f) + LN_EPS) * (1.f - lam_init);
        const float* gn = P.diff_norm_g + l * 128;
#pragma unroll
        for (int d = 0; d < 8; ++d) {
          int dv = d * 16 + fq * 4;
          float4 g4 = *(const float4*)(gn + dv);
          f32x4 v = ot[d][qb];
          *(bf16x4*)(((u16*)(P.ws + OFF_br2)) + ((size_t)hb * HROWS + hrow) * 512 + h * 128 + dv) = pack4(v[0] * rr * g4.x, v[1] * rr * g4.y, v[2] * rr * g4.z, v[3] * rr * g4.w);
        }
      }
    }
  }
}

template <bool TRANS>
DI void conv_stage(const Params& P, int l, const u16* xbase  , int chan0, int n, int p0, u16* dst, int ld, const float* scale) {
  const int tid = TID(), cl = tid & 63, ig = tid >> 6;
  const int ch = chan0 + cl;
  const float* cw = P.conv_w + (size_t)l * 5 * 768 + ch;
  const float w0 = cw[0], w1 = cw[768], w2 = cw[2 * 768], w3 = cw[3 * 768], w4 = cw[4 * 768];
  const float cb = P.conv_b[l * 768 + ch];
  const u16* xc = xbase + ch;
#pragma unroll 1
  for (int g8 = 0; g8 < 4; ++g8) {
    const int tok0 = ig * 32 + g8 * 8;
    const int pos0 = p0 + tok0 - 2;
    float xv[12];
#pragma unroll
    for (int i = 0; i < 12; ++i) { int pos = pos0 + i; xv[i] = (pos >= 0 && pos < n) ? bf2f(xc[(size_t)pos * 768]) : 0.f; }
#pragma unroll
    for (int ii = 0; ii < 8; ++ii) {
      float v = w0 * xv[ii] + w1 * xv[ii + 1] + w2 * xv[ii + 2] + w3 * xv[ii + 3] + w4 * xv[ii + 4] + cb;
      v = v * __builtin_amdgcn_rcpf(1.f + __expf(-v));
      const int tok = tok0 + ii;
      if (scale) v *= scale[tok];
      if (TRANS) dst[cl * ld + tok] = f2bf(v); else dst[tok * ld + cl] = f2bf(v);
    }
  }
}

DI void ssd_scalars(const Params& P, int l, int hrow0, int h, int dir, float* dts, float* S, float* tmp) {
  const int tid = TID();
  const float aneg = -expf(P.a_log[l * 16 + dir * 8 + h]);
  float a = 0.f, inc = 0.f;
  if (tid < 128) {
    float raw = ((float*)(P.ws + OFF_dtbuf))[(size_t)(hrow0 + tid) * 16 + dir * 8 + h] + P.dt_bias[l * 16 + dir * 8 + h];
    float dt = softplusf_(raw);
    dts[tid] = dt;
    a = dt * aneg;
    inc = a;
    const int lane = tid & 63;
#pragma unroll
    for (int o = 1; o < 64; o <<= 1) { float t = __shfl_up(inc, o); if (lane >= o) inc += t; }
    if (lane == 63) tmp[tid >> 6] = inc;
  }
  __syncthreads();
  if (tid < 128) {
    const float t0 = tmp[0], t1 = tmp[1];
    const float pre = inc + (tid >= 64 ? t0 : 0.f);
    S[tid] = (dir == 0) ? pre : (t0 + t1) - pre + a;
  }
  __syncthreads();
}

constexpr int SSD_STATE_STRIDE = 18 * 4096;

DI void ssd_prep_item(const Params& P, int l, int hb, int mt, int slab, char* smem) {
  const int tid = TID();
  const int jp = mt % 18, bl = mt / 18;
  const bool lat = jp < 16;
  const int n = lat ? SEQ : CTXL;
  const int p0 = lat ? jp * 128 : (jp - 16) * 128;
  const int seqbase = bl * SP + (lat ? 0 : SEQ);
  const int hrow0 = bl * SP + jp * 128;
  u16* T = (u16*)smem;
  u16* Rm = T + 64 * LDK;
  __syncthreads();
  const u16* xb = ((u16*)(P.ws + OFF_xbc)) + (size_t)seqbase * 768;
  {
    const int cg = tid & 7, tg = tid >> 3;
    const int ch0 = slab * 64 + cg * 8;
    float w[5][8], cbv[8];
#pragma unroll
    for (int d = 0; d < 5; ++d) {
      const float4 a = *(const float4*)(P.conv_w + ((size_t)l * 5 + d) * 768 + ch0), b = *(const float4*)(P.conv_w + ((size_t)l * 5 + d) * 768 + ch0 + 4);
      w[d][0] = a.x; w[d][1] = a.y; w[d][2] = a.z; w[d][3] = a.w; w[d][4] = b.x; w[d][5] = b.y; w[d][6] = b.z; w[d][7] = b.w;
    }
    {
      const float4 a = *(const float4*)(P.conv_b + l * 768 + ch0), b = *(const float4*)(P.conv_b + l * 768 + ch0 + 4);
      cbv[0] = a.x; cbv[1] = a.y; cbv[2] = a.z; cbv[3] = a.w; cbv[4] = b.x; cbv[5] = b.y; cbv[6] = b.z; cbv[7] = b.w;
    }
    const int tok0 = tg * 4;
    u32x4 xr[8];
#pragma unroll
    for (int i = 0; i < 8; ++i) {
      const int pos = p0 + tok0 - 2 + i;
      xr[i] = u32x4{0u, 0u, 0u, 0u};
      if (pos >= 0 && pos < n) xr[i] = *(const u32x4*)(xb + (size_t)pos * 768 + ch0);
    }
    float o[4][8];
#pragma unroll
    for (int t = 0; t < 4; ++t)
#pragma unroll
      for (int e2 = 0; e2 < 4; ++e2) {
        float a0 = cbv[2 * e2], a1 = cbv[2 * e2 + 1];
#pragma unroll
        for (int d = 0; d < 5; ++d) { a0 += w[d][2 * e2] * bflo(xr[t + d][e2]); a1 += w[d][2 * e2 + 1] * bfhi(xr[t + d][e2]); }
        o[t][2 * e2] = siluf_(a0); o[t][2 * e2 + 1] = siluf_(a1);
      }
    if (slab < 10) {
#pragma unroll
      for (int e2 = 0; e2 < 8; ++e2) *(bf16x4*)(T + (cg * 8 + e2) * LDK + tok0) = pack4(o[0][e2], o[1][e2], o[2][e2], o[3][e2]);
    }
    if (slab >= 8) {
#pragma unroll
      for (int t = 0; t < 4; ++t) {
        u32x4 v = {pack2(o[t][0], o[t][1]), pack2(o[t][2], o[t][3]), pack2(o[t][4], o[t][5]), pack2(o[t][6], o[t][7])};
        *(u32x4*)(Rm + (tok0 + t) * LDT + cg * 8) = v;
      }
    }
  }
  __syncthreads();
  if (slab < 10) {
    u16* dst = slab < 8 ? ((u16*)(P.ws + OFF_xsT)) + ((size_t)mt * 512 + slab * 64) * 128 : ((u16*)(P.ws + OFF_bmT)) + ((size_t)mt * 128 + (slab - 8) * 64) * 128;
#pragma unroll
    for (int i = 0; i < 4; ++i) { int cid = tid + 256 * i; int r = cid >> 4, c8 = (cid & 15) * 8; *(u32x4*)(dst + (size_t)r * 128 + c8) = *(const u32x4*)(T + r * LDK + c8); }
  }
  if (slab >= 8) {
    u16* dst = (slab < 10 ? ((u16*)(P.ws + OFF_bm)) + (slab - 8) * 64 : ((u16*)(P.ws + OFF_cm)) + (slab - 10) * 64) + (size_t)hrow0 * 128;
#pragma unroll
    for (int i = 0; i < 4; ++i) { int cid = tid + 256 * i; int r = cid >> 3, c8 = (cid & 7) * 8; *(u32x4*)(dst + (size_t)r * 128 + c8) = *(const u32x4*)(Rm + r * LDT + c8); }
  }
}

DI void phase_ssd_prep(const Params& P, int l, int hb, char* smem, int ph) {
  for (;;) {
    const int it = wq_next(wq_ctr(P, ph), smem);
    if (it >= 144 * 12) break;
    ssd_prep_item(P, l, hb, it / 12, it % 12, smem);
  }
}

DI void ssd_state_item(const Params& P, int l, int hb, int item, char* smem) {
  const int tid = TID(), wave = tid >> 6, lane = tid & 63, fr = lane & 15, fq = lane >> 4;
  const int h = item & 7, jp = (item >> 3) % 18, bl = (item >> 3) / 18;
  const int mt = bl * 18 + jp;
  const int hrow0 = bl * SP + jp * 128;
  u16* At = (u16*)smem;
  u16* Bt = At + 64 * LDK;
  float* dts = (float*)(Bt + 64 * LDK);
  float* S = dts + 128;
  float* wgt = S + 128;
  __syncthreads();
  u32x4 xr[4];
  {
    const u16* bsrc = ((u16*)(P.ws + OFF_bmT)) + ((size_t)mt * 128 + (h >> 2) * 64) * 128;
    const u16* xsrc = ((u16*)(P.ws + OFF_xsT)) + ((size_t)mt * 512 + h * 64) * 128;
#pragma unroll
    for (int i = 0; i < 4; ++i) {
      int cid = tid + 256 * i; int r = cid >> 4, c8 = (cid & 15) * 8;
      *(u32x4*)(Bt + r * LDK + c8) = *(const u32x4*)(bsrc + (size_t)r * 128 + c8);
      xr[i] = *(const u32x4*)(xsrc + (size_t)r * 128 + c8);
    }
  }
  const int wr = wave >> 1, wc = wave & 1;
#pragma unroll 1
  for (int dir = 0; dir < 2; ++dir) {
    ssd_scalars(P, l, hrow0, h, dir, dts, S, wgt);
    const float total = (dir == 0) ? S[127] : S[0];
    __syncthreads();
    if (tid < 128) wgt[tid] = dts[tid] * __expf(total - S[tid]);
    __syncthreads();
#pragma unroll
    for (int i = 0; i < 4; ++i) {
      int cid = tid + 256 * i; int r = cid >> 4, c8 = (cid & 15) * 8;
      u32x4 o;
#pragma unroll
      for (int e2 = 0; e2 < 4; ++e2) o[e2] = pack2(bflo(xr[i][e2]) * wgt[c8 + 2 * e2], bfhi(xr[i][e2]) * wgt[c8 + 2 * e2 + 1]);
      *(u32x4*)(At + r * LDK + c8) = o;
    }
    __syncthreads();
    f32x4 acc[2][2];
#pragma unroll
    for (int m = 0; m < 2; ++m) { acc[m][0] = f32x4{0.f, 0.f, 0.f, 0.f}; acc[m][1] = f32x4{0.f, 0.f, 0.f, 0.f}; }
    mma_lds<2, 2, true>(At + wr * 32 * LDK, LDK, Bt + wc * 32 * LDK, LDK, 4, acc, fr, fq);
    u16* cs = ((u16*)(P.ws + OFF_cstate)) + (((size_t)(bl * 2 + dir) * 8 + h) * 18 + jp) * 4096;
#pragma unroll
    for (int m = 0; m < 2; ++m)
#pragma unroll
      for (int nn = 0; nn < 2; ++nn) *(bf16x4*)(cs + (wr * 32 + m * 16 + fr) * 64 + wc * 32 + nn * 16 + fq * 4) = pack4v(acc[m][nn]);
    if (tid == 0) ((float*)(P.ws + OFF_decay))[((bl * 2 + dir) * 8 + h) * 18 + jp] = __expf(total);
  }
}

DI void phase_carry(const Params& P) {
  const int total = 8 * 2 * 8 * 4096;
  for (int idx = blockIdx.x * 256 + TID(); idx < total; idx += gridDim.x * 256) {
    int pn = idx & 4095, bdh = idx >> 12;
    int dir = (bdh >> 3) & 1;
    const u16* __restrict__ cs = ((const u16*)(P.ws + OFF_cstate)) + (size_t)bdh * SSD_STATE_STRIDE + pn;
    u16* __restrict__ en = ((u16*)(P.ws + OFF_enter)) + (size_t)bdh * SSD_STATE_STRIDE + pn;
    const float* __restrict__ dc = ((const float*)(P.ws + OFF_decay)) + bdh * 18;
    float cv[18], dv[18];
#pragma unroll
    for (int jp = 0; jp < 18; ++jp) { cv[jp] = bf2f(cs[(size_t)jp * 4096]); dv[jp] = dc[jp]; }
    float state = 0.f;
    if (dir == 0) {
#pragma unroll
      for (int st = 0; st < 18; ++st) {
        const int jp = st < 2 ? 16 + st : st - 2;
        en[(size_t)jp * 4096] = f2bf(state);
        state = state * dv[jp] + cv[jp];
      }
    } else {
#pragma unroll
      for (int st = 0; st < 18; ++st) {
        const int jp = 17 - st;
        en[(size_t)jp * 4096] = f2bf(state);
        state = state * dv[jp] + cv[jp];
      }
    }
  }
}

DI void ssd_out_item(const Params& P, int l, int hb, int item, char* smem) {
  const int tid = TID(), wave = tid >> 6, lane = tid & 63, fr = lane & 15, fq = lane >> 4;
  const int h = item & 7, jp = (item >> 3) % 18, bl = (item >> 3) / 18;
  const bool lat = jp < 16;
  const int n = lat ? SEQ : CTXL;
  const int p0 = lat ? jp * 128 : (jp - 16) * 128;
  const int seqbase = bl * SP + (lat ? 0 : SEQ);
  const int hrow0 = bl * SP + jp * 128;
  u16* Cs = (u16*)smem;
  u16* xT = Cs + 128 * LDT;
  u16* Et = xT + 64 * LDK;
  u16* Un = Et + 64 * LDT;
  float* fs = (float*)(Un + 128 * LDK);
  float* dts = fs;
  float* S = fs + 128;
  float* tmp = fs + 256;
  const int grp = h >> 2;
  __syncthreads();
  {
    const int mt = bl * 18 + jp;
    const u16* csrc = ((u16*)(P.ws + OFF_cm)) + (size_t)hrow0 * 128 + grp * 64;
    const u16* bsrc = ((u16*)(P.ws + OFF_bm)) + (size_t)hrow0 * 128 + grp * 64;
    const u16* xsrc = ((u16*)(P.ws + OFF_xsT)) + ((size_t)mt * 512 + h * 64) * 128;
#pragma unroll
    for (int i = 0; i < 4; ++i) {
      int cid = tid + 256 * i;
      int r = cid >> 3, c8 = (cid & 7) * 8;
      *(u32x4*)(Cs + r * LDT + c8) = *(const u32x4*)(csrc + (size_t)r * 128 + c8);
      *(u32x4*)(Un + r * LDT + c8) = *(const u32x4*)(bsrc + (size_t)r * 128 + c8);
      int r2 = cid >> 4, c82 = (cid & 15) * 8;
      *(u32x4*)(xT + r2 * LDK + c82) = *(const u32x4*)(xsrc + (size_t)r2 * 128 + c82);
    }
  }
  __syncthreads();
  f32x4 cb[2][8];
#pragma unroll
  for (int m = 0; m < 2; ++m)
#pragma unroll
    for (int nn = 0; nn < 8; ++nn) cb[m][nn] = f32x4{0.f, 0.f, 0.f, 0.f};
  mma_lds<2, 8, false>(Cs + wave * 32 * LDT, LDT, Un, LDT, 2, cb, fr, fq);
  f32x4 yacc[2][4];
#pragma unroll
  for (int m = 0; m < 2; ++m)
#pragma unroll
    for (int nn = 0; nn < 4; ++nn) yacc[m][nn] = f32x4{0.f, 0.f, 0.f, 0.f};
#pragma unroll 1
  for (int dir = 0; dir < 2; ++dir) {
    __syncthreads();
    ssd_scalars(P, l, hrow0, h, dir, dts, S, tmp);
#pragma unroll
    for (int m = 0; m < 2; ++m)
#pragma unroll
      for (int j = 0; j < 4; ++j) {
        int lrow = wave * 32 + m * 16 + fq * 4 + j;
        float Sl = S[lrow];
#pragma unroll
        for (int nn = 0; nn < 8; ++nn) {
          int s = nn * 16 + fr;
          bool ok = dir == 0 ? (s <= lrow) : (s >= lrow);
          float coef = ok ? __expf(Sl - S[s]) * dts[s] : 0.f;
          Un[lrow * LDK + s] = f2bf(cb[m][nn][j] * coef);
        }
      }
    {
      const u16* en = ((u16*)(P.ws + OFF_enter)) + (((size_t)(bl * 2 + dir) * 8 + h) * 18 + jp) * 4096;
      for (int cid = tid; cid < 512; cid += 256) {
        int pr = cid >> 3, c8 = (cid & 7) * 8;
        *(u32x4*)(Et + pr * LDT + c8) = *(const u32x4*)(en + pr * 64 + c8);
      }
    }
    __syncthreads();
    mma_lds<2, 4, true>(Un + wave * 32 * LDK, LDK, xT, LDK, 4, yacc, fr, fq);
    f32x4 yi[2][4];
#pragma unroll
    for (int m = 0; m < 2; ++m)
#pragma unroll
      for (int nn = 0; nn < 4; ++nn) yi[m][nn] = f32x4{0.f, 0.f, 0.f, 0.f};
    mma_lds<2, 4, true>(Cs + wave * 32 * LDT, LDT, Et, LDT, 2, yi, fr, fq);
#pragma unroll
    for (int m = 0; m < 2; ++m) {
      float e = __expf(S[wave * 32 + m * 16 + fr]);
#pragma unroll
      for (int nn = 0; nn < 4; ++nn)
#pragma unroll
        for (int j = 0; j < 4; ++j) yacc[m][nn][j] += e * yi[m][nn][j];
    }
  }
  const float dsk = P.ssd_d[l * 8 + h];
  const float* gn = P.ssd_norm_g + l * 512 + h * 64;
#pragma unroll
  for (int m = 0; m < 2; ++m) {
    int lrow = wave * 32 + m * 16 + fr;
    float ss = 0.f;
#pragma unroll
    for (int nn = 0; nn < 4; ++nn) {
      int pc = nn * 16 + fq * 4;
      bf16x4 zz = *(const bf16x4*)(((u16*)(P.ws + OFF_z)) + (size_t)(hrow0 + lrow) * 512 + h * 64 + pc);
      float4 g4 = *(const float4*)(gn + pc);
      float gg[4] = {g4.x, g4.y, g4.z, g4.w};
      float o[4];
#pragma unroll
      for (int j = 0; j < 4; ++j) {
        float y = yacc[m][nn][j] + dsk * bf2f(xT[(pc + j) * LDK + lrow]);
        y *= siluf_(bf2f((u16)zz[j]));
        ss += y * y;
        o[j] = y * gg[j];
      }
      *(bf16x4*)(((u16*)(P.ws + OFF_br1)) + ((size_t)hb * HROWS + hrow0 + lrow) * 512 + h * 64 + pc) = pack4(o[0], o[1], o[2], o[3]);
    }
    ss += __shfl_xor(ss, 16);
    ss += __shfl_xor(ss, 32);
    if (fq == 0) ((float*)(P.ws + OFF_ssq))[((size_t)hb * HROWS + hrow0 + lrow) * 8 + h] = ss;
  }
}


DI void merge_tile(const Params& P, int l, int mt, int nt, char* smem) {
  const int row0 = mt * 128;
#pragma unroll 1
  for (int kq = 0; kq < 4; ++kq) {
    unsigned gp[4][4][2];
    {
      f32x4 g[4][4];
      zero_acc<4>(g);
      gemm_main<4, true, false, true>(((u16*)(P.ws + OFF_H)), DM, nullptr, row0, ((u16*)(P.ws + OFF_WgT)) + ((size_t)l * 4 + kq) * 1024 * 1024, 1024, nt * 128, 1024, g, (u16*)smem);
#pragma unroll
      for (int m = 0; m < 4; ++m)
#pragma unroll
        for (int n = 0; n < 4; ++n) {
          gp[m][n][0] = pack2(sigmoidf_(g[m][n][0]), sigmoidf_(g[m][n][1]));
          gp[m][n][1] = pack2(sigmoidf_(g[m][n][2]), sigmoidf_(g[m][n][3]));
        }
    }
    f32x4 bb[4][4];
    zero_acc<4>(bb);
    const u16* br = ((u16*)(P.ws + OFF_br0)) + (size_t)kq * (U_ / 2);
    gemm_main<4, true, false, false>(br, 512, nullptr, row0, ((u16*)(P.ws + OFF_WbT)) + ((size_t)l * 4 + kq) * 1024 * 512, 512, nt * 128, 512, bb, (u16*)smem);
    const int tid = TID(), wave = tid >> 6, lane = tid & 63, fr = lane & 15, fq = lane >> 4;
    const int wr = wave >> 1, wc = wave & 1;
#pragma unroll
    for (int m = 0; m < 4; ++m) {
      const int r = row0 + wr * 64 + m * 16 + fr;
      float rs = 1.f;
      if (kq == 1) {
        const float* sq = ((float*)(P.ws + OFF_ssq)) + (size_t)r * 8;
        float4 a = *(const float4*)sq, b = *(const float4*)(sq + 4);
        rs = rsqrtf((a.x + a.y + a.z + a.w + b.x + b.y + b.z + b.w) * (1.f / 512.f) + LN_EPS);
      }
#pragma unroll
      for (int n = 0; n < 4; ++n) {
        u32x2* dst = (u32x2*)(((u16*)(P.ws + OFF_acc)) + (size_t)r * DM + nt * 128 + wc * 64 + n * 16 + fq * 4);
        u32x2 prev = {0u, 0u};
        if (kq > 0) prev = *dst;
        const unsigned g0 = gp[m][n][0], g1 = gp[m][n][1];
        u32x2 o;
        o[0] = pack2(bflo(prev[0]) + bflo(g0) * bb[m][n][0] * rs, bfhi(prev[0]) + bfhi(g0) * bb[m][n][1] * rs);
        o[1] = pack2(bflo(prev[1]) + bflo(g1) * bb[m][n][2] * rs, bfhi(prev[1]) + bfhi(g1) * bb[m][n][3] * rs);
        *dst = o;
      }
    }
  }
}

DI void phase_merge(const Params& P, int l, char* smem, int ph) {
  const bool last = (l == 1);
  for (;;) {
    const int it = wq_next(wq_ctr(P, ph), smem);
    if (it >= 288 * 8) break;
    int mt = it / 8, nt = it % 8;
    if (last && (mt % 18) >= 16) continue;
    merge_tile(P, l, mt, nt, smem);
  }
}

DI void phase_outproj(const Params& P, int l, char* smem, int ph) {
  const bool last = (l == 1);
  const int tid = TID(), wave = tid >> 6, lane = tid & 63, fr = lane & 15, fq = lane >> 4;
  const int wr = wave >> 1, wc = wave & 1;
  for (;;) {
    const int it = wq_next(wq_ctr(P, ph), smem);
    if (it >= 288 * 8) break;
    int mt = it / 8, nt = it % 8;
    if (last && (mt % 18) >= 16) continue;
    f32x4 acc[4][4];
    zero_acc<4>(acc);
    gemm_main<4, true, false>(((u16*)(P.ws + OFF_acc)), DM, nullptr, mt * 128, ((u16*)(P.ws + OFF_WoT)) + (size_t)l * 1024 * 1024, 1024, nt * 128, 1024, acc, (u16*)smem);
#pragma unroll
    for (int m = 0; m < 4; ++m)
#pragma unroll
      for (int n = 0; n < 4; ++n) {
        int r = mt * 128 + wr * 64 + m * 16 + fr, c = nt * 128 + wc * 64 + n * 16 + fq * 4;
        *(bf16x4*)(((u16*)(P.ws + OFF_Y)) + (size_t)r * DM + c) = pack4v(acc[m][n]);
      }
  }
}

DI void phase_ffn1(const Params& P, int l, char* smem, int ph) {
  const bool last = (l == 1);
  const int tid = TID(), wave = tid >> 6, lane = tid & 63, fr = lane & 15, fq = lane >> 4;
  const int wr = wave >> 1, wc = wave & 1;
  const int nmt = last ? 512 : 576;
  for (;;) {
    const int it = wq_next(wq_ctr(P, ph), smem);
    if (it >= nmt * 8) break;
    int mt = it / 8, nt = it % 8;
    int R0 = mt * 128;
    int e = R0 < NFFN_LAT ? (R0 >> 8) & 15 : (R0 - NFFN_LAT) >> 9;
    f32x4 acc[4][4];
    zero_acc<4>(acc);
    gemm_main<4, true, true>(((u16*)(P.ws + OFF_H)), DM, ((int*)(P.ws + OFF_tokidx)), R0, ((u16*)(P.ws + OFF_W13T)) + (size_t)e * 1024 * 1024, 1024, nt * 128, 1024, acc, (u16*)smem);
#pragma unroll
    for (int m = 0; m < 4; ++m)
#pragma unroll
      for (int n2 = 0; n2 < 2; ++n2) {
        int r = R0 + wr * 64 + m * 16 + fr;
        int hc = (nt * 4 + wc * 2 + n2) * 16 + fq * 4;
        f32x4 a = acc[m][2 * n2], b = acc[m][2 * n2 + 1];
        *(bf16x4*)(((u16*)(P.ws + OFF_hid)) + (size_t)r * 512 + hc) = pack4(siluf_(a[0]) * b[0], siluf_(a[1]) * b[1], siluf_(a[2]) * b[2], siluf_(a[3]) * b[3]);
      }
  }
}

DI void phase_ffn2(const Params& P, int l, char* smem, int ph) {
  const bool last = (l == 1);
  const int tid = TID(), wave = tid >> 6, lane = tid & 63, fr = lane & 15, fq = lane >> 4;
  const int wr = wave >> 1, wc = wave & 1;
  const int nmt = last ? 512 : 576;
  for (;;) {
    const int it = wq_next(wq_ctr(P, ph), smem);
    if (it >= nmt * 8) break;
    int mt = it / 8, nt = it % 8;
    int R0 = mt * 128;
    int e = R0 < NFFN_LAT ? (R0 >> 8) & 15 : (R0 - NFFN_LAT) >> 9;
    f32x4 acc[4][4];
    zero_acc<4>(acc);
    gemm_main<4, true, false>(((u16*)(P.ws + OFF_hid)), 512, nullptr, R0, ((u16*)(P.ws + OFF_W2T)) + (size_t)e * 1024 * 512, 512, nt * 128, 512, acc, (u16*)smem);
#pragma unroll
    for (int m = 0; m < 4; ++m) {
      int r = R0 + wr * 64 + m * 16 + fr;
      float gt = ((float*)(P.ws + OFF_gatev))[r];
#pragma unroll
      for (int n = 0; n < 4; ++n) {
        int c = nt * 128 + wc * 64 + n * 16 + fq * 4;
        f32x4 v = acc[m][n];
        *(bf16x4*)(((u16*)(P.ws + OFF_ye)) + (size_t)r * DM + c) = pack4(v[0] * gt, v[1] * gt, v[2] * gt, v[3] * gt);
      }
    }
  }
}

DI void phase_mix2(const Params& P, int l, int hb, char* smem, int ph) {
  const bool last = (l == 1);
  const int nG = 576, nA = 576, nS = 1152, nP = 576;
  for (;;) {
    const int it = wq_next(wq_ctr(P, ph), smem);
    if (it >= nA + nG + nS + nP) break;
    if (it < nG) {
      const int mt = it >> 2, g = it & 3;
      if (last && (mt % 18) >= 16) continue;
      sgu_item(P, l, hb, mt, g, smem);
    } else if (it < nG + nA) {
      const int ia = it - nG;
      if (last && ia >= 512) continue;
      attn_item(P, l, hb, ia, smem);
    } else if (it < nA + nG + nS) {
      ssd_state_item(P, l, hb, it - nA - nG, smem);
    } else {
      const int t = it - nA - nG - nS;
      const int mt = t >> 2, g = t & 3;
      if (last && (mt % 18) >= 16) continue;
      pool_item(P, l, hb, mt, g, smem);
    }
  }
}

DI void phase_ssd_out(const Params& P, int l, int hb, char* smem, int ph) {
  const bool last = (l == 1);
  for (;;) {
    const int it = wq_next(wq_ctr(P, ph), smem);
    if (it >= 8 * 18 * 8) break;
    int jp = (it >> 3) % 18;
    if (last && jp >= 16) continue;
    ssd_out_item(P, l, hb, it, smem);
  }
}

#define XB_TMO      128
#define XB_XCNT(j)  (256  + 64 * (j))
#define XB_XSUB(j)  (1280 + 64 * (j))
#define XB_XGEN(j)  (2304 + 64 * (j))
#define XB_TOP      3328
#define XB_TOPGEN   3392
#define XCD_BAR_WORDS 3456
#define XB_SPIN_CAP (1u << 18)
#define LAS __attribute__((address_space(3)))

__device__ __forceinline__ unsigned xb_ld(unsigned* p)              { return __hip_atomic_load(p, __ATOMIC_RELAXED, __HIP_MEMORY_SCOPE_AGENT); }
__device__ __forceinline__ unsigned xb_add(unsigned* p, unsigned v) { return __hip_atomic_fetch_add(p, v, __ATOMIC_RELAXED, __HIP_MEMORY_SCOPE_AGENT); }
__device__ __forceinline__ unsigned xb_xcc_id() { return (unsigned)__builtin_amdgcn_s_getreg((3 << 11) | 20) & 0xFu; }
#define XB_SPIN(cond, bar) do { unsigned _sp = 0; while (cond) { __builtin_amdgcn_s_sleep(1); \
    if ((++_sp & 255u) == 0u) { if (xb_ld(&(bar)[XB_TMO])) break; if (_sp > XB_SPIN_CAP) { atomicAdd(&(bar)[XB_TMO], 1u); break; } } } } while (0)

struct XcdBarrier {
    unsigned* bar; unsigned x;
    volatile LAS unsigned* st;
};

__device__ __forceinline__ XcdBarrier xcd_barrier_post(unsigned* bar, volatile LAS unsigned* st) {
    XcdBarrier b; b.bar = bar; b.x = xb_xcc_id(); b.st = st;
    if (threadIdx.x == 0) (void)xb_add(&bar[XB_XCNT(b.x)], 1u);
    return b;
}
__device__ __forceinline__ void xcd_barrier_complete(unsigned* bar, unsigned x, unsigned& nloc, unsigned& nx) {
    const unsigned G = gridDim.x * gridDim.y * gridDim.z;
    unsigned sum, cnt, mine, sp = 0u;
    for (;;) {
        sum = 0u; cnt = 0u; mine = 0u;
#pragma unroll
        for (unsigned j = 0; j < 16; ++j) { const unsigned c = xb_ld(&bar[XB_XCNT(j)]); sum += c; cnt += (c > 0u) ? 1u : 0u; mine = (j == x) ? c : mine; }
        if (sum == G) break;
        __builtin_amdgcn_s_sleep(1);
        if ((++sp & 255u) == 0u) { if (xb_ld(&bar[XB_TMO])) break; if (sp > XB_SPIN_CAP) { atomicAdd(&bar[XB_TMO], 1u); break; } }
    }
    nloc = mine > 0u ? mine : 1u; nx = cnt > 0u ? cnt : 1u;
}

__device__ __forceinline__ void xcd_barrier(const XcdBarrier& b) {
    asm volatile("s_waitcnt vmcnt(0)" ::: "memory");
    __syncthreads();
    if (threadIdx.x == 0) {
        unsigned* bar = b.bar;
        __builtin_amdgcn_s_waitcnt(0);
        unsigned nloc = b.st[0], nx = b.st[1];
        if (nloc == 0u) { xcd_barrier_complete(bar, b.x, nloc, nx); b.st[0] = nloc; b.st[1] = nx; }
        const unsigned old = xb_add(&bar[XB_XSUB(b.x)], 1u);
        const unsigned gen = old / nloc;
        if (old + 1u == (gen + 1u) * nloc) {
            __builtin_amdgcn_fence(__ATOMIC_RELEASE, "agent");
            asm volatile("s_waitcnt vmcnt(0)" ::: "memory");
            const unsigned og = xb_add(&bar[XB_TOP], 1u);
            const unsigned tg = og / nx;
            if (og + 1u == (tg + 1u) * nx) xb_add(&bar[XB_TOPGEN], 1u);
            else XB_SPIN(xb_ld(&bar[XB_TOPGEN]) == tg, bar);
            __builtin_amdgcn_fence(__ATOMIC_ACQUIRE, "agent");
            xb_add(&bar[XB_XGEN(b.x)], 1u);
            asm volatile("s_waitcnt vmcnt(0)" ::: "memory");
        } else {
            XB_SPIN(xb_ld(&bar[XB_XGEN(b.x)]) == gen, bar);
            __builtin_amdgcn_fence(__ATOMIC_ACQUIRE, "agent");
            asm volatile("s_waitcnt vmcnt(0)" ::: "memory");
        }
    }
    __syncthreads();
}


template <bool COOP>
__global__ void __launch_bounds__(256, 2) mk_forward(Params P, int ph_begin, int ph_end) {
  __shared__ __attribute__((aligned(16))) char smem[SMEM_BYTES];
  int ph = 0;
  volatile LAS unsigned* xbst = (volatile LAS unsigned*)(smem + SMEM_BYTES - 16);
  XcdBarrier xb;
  if (COOP) {
    if (__builtin_amdgcn_workitem_id_x() == 0) { xbst[0] = 0u; xbst[1] = 0u; xbst[2] = 0u; xbst[3] = 0u; }
    __syncthreads();
    xb = xcd_barrier_post((unsigned*)(P.ws + OFF_bar), xbst);
  }
#define PHASE(code)                                         \
  {                                                         \
    if (ph >= ph_begin && ph < ph_end) { code; }            \
    ++ph;                                                   \
    if (COOP && ph > ph_begin && ph < ph_end) {             \
      if (ph == 1) cg::this_grid().sync();                  \
      else xcd_barrier(xb);                                 \
    }                                                       \
  }
  PHASE(phase_prologue(P, smem));
  PHASE(phase_h0(P));
#pragma unroll 1
  for (int l = 0; l < 2; ++l) {
#pragma unroll 1
    for (int hb = 0; hb < 2; ++hb) {
      PHASE(phase_proj(P, l, hb, smem, ph));
      PHASE(phase_ssd_prep(P, l, hb, smem, ph));
      PHASE(phase_mix2(P, l, hb, smem, ph));
      PHASE(phase_carry(P));
      PHASE(phase_ssd_out(P, l, hb, smem, ph));
    }
    PHASE(phase_merge(P, l, smem, ph));
    PHASE(phase_outproj(P, l, smem, ph));
    PHASE(phase_ln1(P, l, smem));
    PHASE(phase_topk(P, l, smem));
    PHASE(phase_ffn1(P, l, smem, ph));
    PHASE(phase_ffn2(P, l, smem, ph));
    PHASE(phase_ln2(P, l));
  }
#undef PHASE
}

#ifndef MK_COOP
#define MK_COOP 1
#endif

extern "C" void kernel_launch(void* const* d_in, const int* in_sizes, int n_in, void* d_out, int out_size, void* d_ws, size_t ws_size,
                              hipStream_t stream) {
  Params p{};
  const float* const* in = (const float* const*)d_in;
  p.x = in[0]; p.c = in[1]; p.ctx = in[2]; p.c_ctx = in[3]; p.w_mod = in[4]; p.b_mod = in[5]; p.w_in = in[6]; p.conv_w = in[7];
  p.conv_b = in[8]; p.a_log = in[9]; p.dt_bias = in[10]; p.ssd_d = in[11]; p.ssd_norm_g = in[12]; p.diff_lambda = in[13];
  p.diff_norm_g = in[14]; p.pool_w = in[15]; p.pool_scale = in[16]; p.sgu_ln_g = in[17]; p.sgu_ln_b = in[18]; p.sgu_w = in[19];
  p.sgu_b = in[20]; p.w_gate = in[21]; p.w_branch = in[22]; p.w_out = in[23]; p.ln1_g = in[24]; p.ln1_b = in[25]; p.w_router = in[26];
  p.w1 = in[27]; p.w3 = in[28]; p.w2 = in[29]; p.ln2_g = in[30]; p.ln2_b = in[31];
  p.out = (float*)d_out;
  p.ws = (char*)d_ws;
  if (WS_NEED > ws_size) { fprintf(stderr, "workspace too small: need %zu have %zu\n", (size_t)WS_NEED, ws_size); return; }

  static int grid_blocks = 0;
  if (!grid_blocks) {
    int dev = 0, cus = 0, per_cu = 0;
    hipGetDevice(&dev);
    hipDeviceGetAttribute(&cus, hipDeviceAttributeMultiprocessorCount, dev);
    (void)hipOccupancyMaxActiveBlocksPerMultiprocessor(&per_cu, mk_forward<(MK_COOP != 0)>, 256, 0);
    if (per_cu < 1) per_cu = 1;
    if (per_cu > 2) per_cu = 2;
    grid_blocks = cus * per_cu;
  }
#if MK_COOP
  hipMemsetAsync((char*)d_ws + OFF_bar, 0, 32768, stream);
  int b = 0, e = NPHASE;
  void* args[] = {&p, &b, &e};
  hipError_t err = hipLaunchCooperativeKernel((void*)mk_forward<true>, dim3(grid_blocks), dim3(256), args, 0, stream);
  if (err != hipSuccess) fprintf(stderr, "cooperative launch failed: %s (grid %d)\n", hipGetErrorString(err), grid_blocks);
#else
  for (int ph = 0; ph < NPHASE; ++ph) hipLaunchKernelGGL(mk_forward<false>, dim3(grid_blocks), dim3(256), 0, stream, p, ph, ph + 1);
#endif
}
```

```cpp
#include <hip/hip_runtime.h>
#include <hip/hip_cooperative_groups.h>
#include <cstdio>
#include <cstdint>
namespace cg = cooperative_groups;

typedef unsigned short u16;
using bf16x8 = __attribute__((ext_vector_type(8))) short;
using bf16x4 = __attribute__((ext_vector_type(4))) short;
using f32x4 = __attribute__((ext_vector_type(4))) float;
using u32x4 = __attribute__((ext_vector_type(4))) unsigned;

#define DI __device__ __forceinline__
#define MFMA16(a, b, c) __builtin_amdgcn_mfma_f32_16x16x32_bf16((a), (b), (c), 0, 0, 0)

constexpr int NB = 16, SEQ = 2048, CTXL = 256, SP = 2304, NTOK = NB * SP, DM = 1024;
constexpr int HROWS = 8 * SP;
constexpr int INC = 4368, INP = 4480;
constexpr int NFFN_LAT = 65536, NFFN_ALL = 73728;
constexpr float LN_EPS = 1e-5f;
constexpr float ALPHA = 1.41421356237309515f;
constexpr int SMEM_BYTES = 81920;
constexpr int NPHASE = 2 + 2 * (2 * 5 + 7);


constexpr size_t al256(size_t x) { return (x + 255) & ~(size_t)255; }
constexpr size_t U_ = (size_t)NTOK * 512 * 2;
constexpr size_t OFF_WinT = 0;
constexpr size_t OFF_WgT = OFF_WinT + al256((size_t)2 * INP * 1024 * 2);
constexpr size_t OFF_WbT = OFF_WgT + al256((size_t)2 * 4 * 1024 * 1024 * 2);
constexpr size_t OFF_WoT = OFF_WbT + al256((size_t)2 * 4 * 1024 * 512 * 2);
constexpr size_t OFF_poolT = OFF_WoT + al256((size_t)2 * 1024 * 1024 * 2);
constexpr size_t OFF_sguW = OFF_poolT + al256((size_t)2 * 4 * 128 * 128 * 2);
constexpr size_t OFF_mod = OFF_sguW + al256((size_t)2 * 4 * 128 * 128 * 2);
constexpr size_t OFF_rope = OFF_mod + al256((size_t)2 * 17 * 6144 * 4);
constexpr size_t OFF_lamv = OFF_rope + al256(64 * 16 * 2 * 4);
constexpr size_t OFF_bar = OFF_lamv + 256;
constexpr size_t OFF_aff = OFF_bar + 32768;
constexpr size_t OFF_rank = OFF_aff + al256((size_t)NTOK * 16 * 4);
constexpr size_t OFF_ssq = OFF_rank + al256((size_t)NTOK * 16 * 4);
constexpr size_t OFF_tokidx = OFF_ssq + al256((size_t)NTOK * 8 * 4);
constexpr size_t OFF_gatev = OFF_tokidx + al256((size_t)NFFN_ALL * 4);
constexpr size_t OFF_dtbuf = OFF_gatev + al256((size_t)NFFN_ALL * 4);
constexpr size_t OFF_decay = OFF_dtbuf + al256((size_t)HROWS * 16 * 4);
constexpr size_t OFF_H = OFF_decay + al256((size_t)8 * 2 * 8 * 18 * 4);
constexpr size_t OFF_Y = OFF_H + 2 * U_;
constexpr size_t OFF_xsT = OFF_Y;
constexpr size_t OFF_cstate = OFF_Y + U_ / 2;
constexpr size_t OFF_enter = OFF_Y + U_;
constexpr size_t OFF_bm = OFF_Y + U_ + U_ / 2;
constexpr size_t OFF_cm = OFF_bm + U_ / 8;
constexpr size_t OFF_bmT = OFF_cm + U_ / 8;
constexpr size_t OFF_RM = OFF_Y + 2 * U_;
constexpr size_t OFF_xp = OFF_RM;
constexpr size_t OFF_z = OFF_xp + U_ / 2;
constexpr size_t OFF_xbc = OFF_z + U_ / 2;
constexpr size_t OFF_o1 = OFF_xbc;
constexpr size_t OFF_q = OFF_xbc + (U_ / 4) * 3;
constexpr size_t OFF_k = OFF_q + U_ / 2;
constexpr size_t OFF_vT = OFF_k + U_ / 2;
constexpr size_t OFF_gvT = OFF_vT + U_ / 2;
constexpr size_t OFF_br0 = OFF_gvT + U_ / 2;
constexpr size_t OFF_br1 = OFF_br0 + U_;
constexpr size_t OFF_br2 = OFF_br1 + U_;
constexpr size_t OFF_br3 = OFF_br2 + U_;
constexpr size_t OFF_acc = OFF_RM;
constexpr size_t OFF_W13T = OFF_RM;
constexpr size_t OFF_W2T = OFF_W13T + (size_t)16 * 1024 * 1024 * 2;
constexpr size_t OFF_hid = OFF_W2T + (size_t)16 * 1024 * 512 * 2;
constexpr size_t OFF_ye = OFF_hid + (size_t)NFFN_ALL * 512 * 2;
constexpr size_t WS_MIX_END = OFF_br3 + U_;
constexpr size_t WS_FFN_END = OFF_ye + (size_t)NFFN_ALL * 1024 * 2;
constexpr size_t WS_NEED = WS_MIX_END > WS_FFN_END ? WS_MIX_END : WS_FFN_END;

struct Params {
  const float *x, *c, *ctx, *c_ctx, *w_mod, *b_mod, *w_in, *conv_w, *conv_b, *a_log, *dt_bias, *ssd_d, *ssd_norm_g,
      *diff_lambda, *diff_norm_g, *pool_w, *pool_scale, *sgu_ln_g, *sgu_ln_b, *sgu_w, *sgu_b, *w_gate, *w_branch, *w_out,
      *ln1_g, *ln1_b, *w_router, *w1, *w3, *w2, *ln2_g, *ln2_b;
  float* out;
  char* ws;
};

DI int TID() { int t = (int)__builtin_amdgcn_workitem_id_x(); asm volatile("" : "+v"(t)); return t; }
typedef __bf16 bf2_t __attribute__((ext_vector_type(2)));
typedef float f2_t __attribute__((ext_vector_type(2)));
typedef unsigned u32x2 __attribute__((ext_vector_type(2)));
DI unsigned pack2(float a, float b) { f2_t v = {a, b}; return __builtin_bit_cast(unsigned, __builtin_convertvector(v, bf2_t)); }
DI u16 f2bf(float x) { return (u16)(pack2(x, 0.f) & 0xffffu); }
DI float bf2f(u16 v) { return __uint_as_float(((unsigned)v) << 16); }
DI float bflo(unsigned p) { return __uint_as_float(p << 16); }
DI float bfhi(unsigned p) { return __uint_as_float(p & 0xffff0000u); }
DI float sigmoidf_(float x) { return __builtin_amdgcn_rcpf(1.f + __expf(-x)); }
DI float siluf_(float x) { return x * __builtin_amdgcn_rcpf(1.f + __expf(-x)); }
DI float geluf_(float x) { float y = 0.7978845608028654f * (x + 0.044715f * x * x * x); float t = 1.f - 2.f * __builtin_amdgcn_rcpf(__expf(2.f * y) + 1.f); return 0.5f * x * (1.f + t); }
DI float softplusf_(float x) { return x > 20.f ? x : log1pf(__expf(x)); }
DI bf16x4 pack4(float a, float b, float c, float d) { u32x2 r = {pack2(a, b), pack2(c, d)}; return __builtin_bit_cast(bf16x4, r); }
DI bf16x4 pack4v(f32x4 v) { return pack4(v[0], v[1], v[2], v[3]); }
DI float wave_sum(float v) { for (int o = 32; o > 0; o >>= 1) v += __shfl_xor(v, o); return v; }

template <int MI, int NI, bool SWAP, bool LOWREG = false>
DI void mma_lds(const u16* As, int lda, const u16* Bs, int ldb, int ksteps, f32x4 (&acc)[MI][NI], int fr, int fq) {
  for (int ks = 0; ks < ksteps; ++ks) {
    if (LOWREG) __builtin_amdgcn_sched_barrier(0);
    bf16x8 a[MI], b[NI];
#pragma unroll
    for (int m = 0; m < MI; ++m) a[m] = *(const bf16x8*)(As + (m * 16 + fr) * lda + ks * 32 + fq * 8);
#pragma unroll
    for (int n = 0; n < NI; ++n) b[n] = *(const bf16x8*)(Bs + (n * 16 + fr) * ldb + ks * 32 + fq * 8);
#pragma unroll
    for (int m = 0; m < MI; ++m)
#pragma unroll
      for (int n = 0; n < NI; ++n) acc[m][n] = SWAP ? MFMA16(b[n], a[m], acc[m][n]) : MFMA16(a[m], b[n], acc[m][n]);
  }
}

constexpr int LDT = 72;
template <int NI, bool SWAP, bool GATHER, bool PF2 = true>
DI void gemm_main(const u16* __restrict__ A, int lda, const int* __restrict__ aidx, int arow0, const u16* __restrict__ Bt, int ldb, int brow0,
                  int K, f32x4 (&acc)[4][NI], u16* smem) {
  constexpr int BN = NI * 32;
  constexpr int NBL = BN / 32;
  const int tid = TID(), wave = tid >> 6, lane = tid & 63, fr = lane & 15, fq = lane >> 4;
  const int wr = wave >> 1, wc = wave & 1;
  u16* As = smem;
  u16* Bs = smem + 2 * 128 * LDT;
  const int lr = tid >> 3, lc = (tid & 7) * 8;
  const u16* ap[4];
#pragma unroll
  for (int i = 0; i < 4; ++i) {
    int r = arow0 + lr + 32 * i;
    size_t rr = GATHER ? (size_t)aidx[r] : (size_t)r;
    ap[i] = A + rr * lda + lc;
  }
  const u16* bp = Bt + (size_t)(brow0 + lr) * ldb + lc;
  u32x4 ra0[4], rb0[NBL], ra1[4], rb1[NBL];
  const int nk = K / 64;
#define GLOAD(RA, RB, KO)                                                                   \
  {                                                                                         \
    _Pragma("unroll") for (int i = 0; i < 4; ++i) RA[i] = *(const u32x4*)(ap[i] + (KO));    \
    _Pragma("unroll") for (int i = 0; i < NBL; ++i) RB[i] = *(const u32x4*)(bp + (size_t)(32 * i) * ldb + (KO)); \
  }
#define SSTORE_A(RA, BUF) { _Pragma("unroll") for (int i = 0; i < 4; ++i) *(u32x4*)(As + (BUF) * 128 * LDT + (lr + 32 * i) * LDT + lc) = RA[i]; }
#define SSTORE_B(RB, BUF) { _Pragma("unroll") for (int i = 0; i < NBL; ++i) *(u32x4*)(Bs + (BUF) * BN * LDT + (lr + 32 * i) * LDT + lc) = RB[i]; }
#define SSTORE(RA, RB, BUF) { SSTORE_A(RA, BUF) SSTORE_B(RB, BUF) }
#define COMPUTE(BUF) mma_lds<4, NI, SWAP, !PF2>(As + (BUF) * 128 * LDT + wr * 64 * LDT, LDT, Bs + (BUF) * BN * LDT + wc * (NI * 16) * LDT, LDT, 2, acc, fr, fq)
#define COMPUTE_KS(BUF, KS) mma_lds<4, NI, SWAP, false>(As + (BUF) * 128 * LDT + wr * 64 * LDT + (KS) * 32, LDT, Bs + (BUF) * BN * LDT + wc * (NI * 16) * LDT + (KS) * 32, LDT, 1, acc, fr, fq)
  if (PF2) {
    GLOAD(ra0, rb0, 0);
    GLOAD(ra1, rb1, 64);
    __syncthreads();
    SSTORE(ra0, rb0, 0);
    __syncthreads();
    for (int kt = 0; kt < nk; kt += 2) {
      __builtin_amdgcn_iglp_opt(0);
      if (kt + 2 < nk) GLOAD(ra0, rb0, (kt + 2) * 64);
      COMPUTE_KS(0, 0);
      SSTORE_A(ra1, 1);
      COMPUTE_KS(0, 1);
      SSTORE_B(rb1, 1);
      __syncthreads();
      if (kt + 3 < nk) GLOAD(ra1, rb1, (kt + 3) * 64);
      COMPUTE_KS(1, 0);
      if (kt + 2 < nk) SSTORE_A(ra0, 0);
      COMPUTE_KS(1, 1);
      if (kt + 2 < nk) SSTORE_B(rb0, 0);
      __syncthreads();
    }
  } else {
    GLOAD(ra0, rb0, 0);
    __syncthreads();
    SSTORE(ra0, rb0, 0);
    __syncthreads();
    for (int kt = 0; kt < nk; kt += 2) {
      GLOAD(ra0, rb0, (kt + 1) * 64);
      COMPUTE(0);
      SSTORE(ra0, rb0, 1);
      __syncthreads();
      if (kt + 2 < nk) GLOAD(ra0, rb0, (kt + 2) * 64);
      COMPUTE(1);
      if (kt + 2 < nk) SSTORE(ra0, rb0, 0);
      __syncthreads();
    }
  }
#undef GLOAD
#undef SSTORE
#undef COMPUTE
#undef COMPUTE_KS
#undef SSTORE_A
#undef SSTORE_B
}

template <int NI> DI void zero_acc(f32x4 (&a)[4][NI]) {
#pragma unroll
  for (int m = 0; m < 4; ++m)
#pragma unroll
    for (int n = 0; n < NI; ++n) a[m][n] = f32x4{0.f, 0.f, 0.f, 0.f};
}

DI void cvt_tile(const float* __restrict__ src0, const float* __restrict__ src1, int ld, u16* __restrict__ dst, int K, int n0, int k0, int mode, u16* lds) {
  const int tid = TID();
  constexpr int LC = 66;
  __syncthreads();
  float v[16];
  if (mode == 3) {
#pragma unroll
    for (int i = 0; i < 16; ++i) { int idx = tid + 256 * i; int n = idx >> 6, kk = idx & 63; v[i] = src0[(size_t)(n0 + n) * ld + k0 + kk]; }
#pragma unroll
    for (int i = 0; i < 16; ++i) { int idx = tid + 256 * i; int n = idx >> 6, kk = idx & 63; lds[kk * LC + n] = f2bf(v[i]); }
  } else {
#pragma unroll
    for (int i = 0; i < 16; ++i) {
      int idx = tid + 256 * i;
      int kk = idx >> 6, n = idx & 63;
      int nn = n0 + n;
      float t = 0.f;
      if (mode == 0) t = src0[(size_t)(k0 + kk) * ld + nn];
      else if (mode == 1) {
        int col = nn < 1792 ? nn : (nn < 4352 ? nn + 16 : (nn < 4368 ? nn - 4352 + 1792 : -1));
        if (col >= 0) t = src0[(size_t)(k0 + kk) * ld + col];
        if (nn >= 1792 && nn < 2304) t *= 0.125f;
      } else {
        int g = nn >> 5, r = nn & 31;
        t = (r < 16) ? src0[(size_t)(k0 + kk) * ld + g * 16 + r] : src1[(size_t)(k0 + kk) * ld + g * 16 + r - 16];
      }
      v[i] = t;
    }
#pragma unroll
    for (int i = 0; i < 16; ++i) { int idx = tid + 256 * i; int kk = idx >> 6, n = idx & 63; lds[kk * LC + n] = f2bf(v[i]); }
  }
  __syncthreads();
  for (int c = tid; c < 512; c += 256) {
    int n = c & 63, kc = (c >> 6) * 8;
    bf16x8 o;
#pragma unroll
    for (int j = 0; j < 8; ++j) o[j] = (short)lds[(kc + j) * LC + n];
    *(bf16x8*)(dst + (size_t)(n0 + n) * K + k0 + kc) = o;
  }
}

DI void mod_item(const Params& P, int item, char* smem) {
  const int l = item / 96, n0 = (item % 96) * 64;
  float* sc = (float*)smem;
  const int tid = TID();
  __syncthreads();
  for (int i = tid; i < 17 * 1024; i += 256) {
    int s = i >> 10, kk = i & 1023;
    float v = s < 16 ? P.c[s * 1024 + kk] : P.c_ctx[kk];
    sc[i] = siluf_(v);
  }
  __syncthreads();
  const int col = tid & 63, kp = tid >> 6;
  float a[17];
#pragma unroll
  for (int s = 0; s < 17; ++s) a[s] = 0.f;
  const float* w = P.w_mod + (size_t)l * 1024 * 6144 + n0 + col;
  for (int k0 = kp * 256; k0 < kp * 256 + 256; k0 += 16) {
    float wv[16];
#pragma unroll
    for (int u = 0; u < 16; ++u) wv[u] = w[(size_t)(k0 + u) * 6144];
#pragma unroll
    for (int u = 0; u < 16; ++u)
#pragma unroll
      for (int s = 0; s < 17; ++s) a[s] += sc[s * 1024 + k0 + u] * wv[u];
  }
  __syncthreads();
  float* red = (float*)smem;
#pragma unroll
  for (int s = 0; s < 17; ++s) red[(kp * 17 + s) * 64 + col] = a[s];
  __syncthreads();
  for (int i = tid; i < 17 * 64; i += 256) {
    int s = i >> 6, cc = i & 63;
    float v = red[(0 * 17 + s) * 64 + cc] + red[(1 * 17 + s) * 64 + cc] + red[(2 * 17 + s) * 64 + cc] + red[(3 * 17 + s) * 64 + cc];
    ((float*)(P.ws + OFF_mod))[((size_t)l * 17 + s) * 6144 + n0 + cc] = v + P.b_mod[l * 6144 + n0 + cc];
  }
}

DI void misc_item(const Params& P) {
  const int tid = TID();
  for (int i = tid; i < 1024; i += 256) {
    int pos = i >> 4, f = i & 15;
    float inv = powf(10000.f, -(float)f / 16.f);
    float ang = (float)pos * inv;
    ((float*)(P.ws + OFF_rope))[i * 2] = cosf(ang);
    ((float*)(P.ws + OFF_rope))[i * 2 + 1] = sinf(ang);
  }
  if (tid < 2) {
    const float* dl = P.diff_lambda + tid * 256;
    float s1 = 0.f, s2 = 0.f;
    for (int i = 0; i < 64; ++i) { s1 += dl[i] * dl[64 + i]; s2 += dl[128 + i] * dl[192 + i]; }
    float lam_init = 0.8f - 0.6f * expf(-0.3f * (float)tid);
    ((float*)(P.ws + OFF_lamv))[tid * 2] = expf(s1) - expf(s2) + lam_init;
    ((float*)(P.ws + OFF_lamv))[tid * 2 + 1] = lam_init;
  }
}

DI void phase_prologue(const Params& P, char* smem) {
  const int per_layer = 1120 + 4 * 256 + 4 * 128 + 256 + 16 + 16;
  const int ncvt = 2 * per_layer;
  const int total = ncvt + 192 + 1;
  for (int it0 = blockIdx.x; it0 < total; it0 += gridDim.x) {
    const int it = it0 < 193 ? ncvt + it0 : it0 - 193;
    if (it < ncvt) {
      const int l = it / per_layer;
      int t = it % per_layer;
      const float* s0; u16* dst; int ld, K, ntk, mode;
      if (t < 1120) { s0 = P.w_in + (size_t)l * 1024 * INC; ld = INC; dst = ((u16*)(P.ws + OFF_WinT)) + (size_t)l * INP * 1024; K = 1024; ntk = 16; mode = 1; }
      else if (t < 2144) { t -= 1120; int kq = t >> 8; t &= 255; s0 = P.w_gate + ((size_t)l * 4 + kq) * 1024 * 1024; ld = 1024; dst = ((u16*)(P.ws + OFF_WgT)) + ((size_t)l * 4 + kq) * 1024 * 1024; K = 1024; ntk = 16; mode = 0; }
      else if (t < 2656) { t -= 2144; int kq = t >> 7; t &= 127; s0 = P.w_branch + ((size_t)l * 4 + kq) * 512 * 1024; ld = 1024; dst = ((u16*)(P.ws + OFF_WbT)) + ((size_t)l * 4 + kq) * 1024 * 512; K = 512; ntk = 8; mode = 0; }
      else if (t < 2912) { t -= 2656; s0 = P.w_out + (size_t)l * 1024 * 1024; ld = 1024; dst = ((u16*)(P.ws + OFF_WoT)) + (size_t)l * 1024 * 1024; K = 1024; ntk = 16; mode = 0; }
      else if (t < 2928) { t -= 2912; int g = t >> 2; t &= 3; s0 = P.pool_w + ((size_t)l * 4 + g) * 128 * 128; ld = 128; dst = ((u16*)(P.ws + OFF_poolT)) + ((size_t)l * 4 + g) * 128 * 128; K = 128; ntk = 2; mode = 0; }
      else { t -= 2928; int g = t >> 2; t &= 3; s0 = P.sgu_w + ((size_t)l * 4 + g) * 128 * 128; ld = 128; dst = ((u16*)(P.ws + OFF_sguW)) + ((size_t)l * 4 + g) * 128 * 128; K = 128; ntk = 2; mode = 3; }
      const int tn = t / ntk, tk = t % ntk;
      cvt_tile(s0, s0, ld, dst, K, tn * 64, tk * 64, mode, (u16*)smem);
    } else if (it < ncvt + 192) {
      mod_item(P, it - ncvt, smem);
    } else {
      misc_item(P);
    }
  }
}

DI void ffn_cvt_item(const Params& P, int l, int it, char* smem) {
  const int e = it / 384;
  int t = it % 384;
  if (t < 256) {
    cvt_tile(P.w1 + ((size_t)l * 16 + e) * 1024 * 512, P.w3 + ((size_t)l * 16 + e) * 1024 * 512, 512, ((u16*)(P.ws + OFF_W13T)) + (size_t)e * 1024 * 1024, 1024, (t >> 4) * 64, (t & 15) * 64, 2, (u16*)smem);
  } else {
    t -= 256;
    const float* s = P.w2 + ((size_t)l * 16 + e) * 512 * 1024;
    cvt_tile(s, s, 1024, ((u16*)(P.ws + OFF_W2T)) + (size_t)e * 1024 * 512, 512, (t >> 3) * 64, (t & 7) * 64, 0, (u16*)smem);
  }
}

DI void load_row_f32(const float* p, int lane, float (&v)[16]) {
#pragma unroll
  for (int k = 0; k < 4; ++k) { float4 t = *(const float4*)(p + lane * 4 + 256 * k); v[4 * k] = t.x; v[4 * k + 1] = t.y; v[4 * k + 2] = t.z; v[4 * k + 3] = t.w; }
}
DI void load_row_bf16(const u16* p, int lane, float (&v)[16]) {
#pragma unroll
  for (int k = 0; k < 4; ++k) { bf16x4 t = *(const bf16x4*)(p + lane * 4 + 256 * k); for (int i = 0; i < 4; ++i) v[4 * k + i] = bf2f((u16)t[i]); }
}
DI void store_row_f32(float* p, int lane, const float (&v)[16]) {
#pragma unroll
  for (int k = 0; k < 4; ++k) *(float4*)(p + lane * 4 + 256 * k) = make_float4(v[4 * k], v[4 * k + 1], v[4 * k + 2], v[4 * k + 3]);
}
DI void store_row_bf16(u16* p, int lane, const float (&v)[16]) {
#pragma unroll
  for (int k = 0; k < 4; ++k) *(bf16x4*)(p + lane * 4 + 256 * k) = pack4(v[4 * k], v[4 * k + 1], v[4 * k + 2], v[4 * k + 3]);
}
DI void ln_row(float (&v)[16], const float* g, const float* b, int lane) {
  float s = 0.f;
#pragma unroll
  for (int i = 0; i < 16; ++i) s += v[i];
  float mu = wave_sum(s) * (1.f / 1024.f);
  float q = 0.f;
#pragma unroll
  for (int i = 0; i < 16; ++i) { float d = v[i] - mu; q += d * d; }
  float rstd = rsqrtf(wave_sum(q) * (1.f / 1024.f) + LN_EPS);
  float gg[16], bb[16];
  load_row_f32(g, lane, gg); load_row_f32(b, lane, bb);
#pragma unroll
  for (int i = 0; i < 16; ++i) v[i] = (v[i] - mu) * rstd * gg[i] + bb[i];
}

DI void phase_h0(const Params& P) {
  const int lane = TID() & 63;
  const int gw = blockIdx.x * 4 + (TID() >> 6), nw = gridDim.x * 4;
  for (int row = gw; row < NTOK; row += nw) {
    int s = row / SP, p = row % SP;
    bool lat = p < SEQ;
    const float* xs = lat ? P.x + ((size_t)s * SEQ + p) * DM : P.ctx + ((size_t)s * CTXL + (p - SEQ)) * DM;
    const float* md = ((float*)(P.ws + OFF_mod)) + (size_t)(lat ? s : 16) * 6144;
    float v[16], sh[16], scl[16];
    load_row_f32(xs, lane, v); load_row_f32(md, lane, sh); load_row_f32(md + 1024, lane, scl);
#pragma unroll
    for (int i = 0; i < 16; ++i) v[i] = v[i] * (1.f + scl[i]) + sh[i];
    store_row_bf16(((u16*)(P.ws + OFF_H)) + (size_t)row * DM, lane, v);
  }
}

DI void compute_x1(const Params& P, int l, int row, int lane, float (&v)[16]) {
  int s = row / SP, p = row % SP;
  bool lat = p < SEQ;
  const float* xs;
  if (l == 0) xs = lat ? P.x + ((size_t)s * SEQ + p) * DM : P.ctx + ((size_t)s * CTXL + (p - SEQ)) * DM;
  else xs = P.out + ((size_t)s * SEQ + p) * DM;
  const float* md = ((float*)(P.ws + OFF_mod)) + ((size_t)l * 17 + (lat ? s : 16)) * 6144;
  float y[16], m2[16];
  load_row_f32(xs, lane, v); load_row_bf16(((u16*)(P.ws + OFF_Y)) + (size_t)row * DM, lane, y); load_row_f32(md + 2 * 1024, lane, m2);
#pragma unroll
  for (int i = 0; i < 16; ++i) v[i] = ALPHA * v[i] + m2[i] * y[i];
  ln_row(v, P.ln1_g + l * 1024, P.ln1_b + l * 1024, lane);
}

DI void phase_ln1(const Params& P, int l, char* smem) {
  const bool last = (l == 1);
  const int tid = TID();
  const int lane = tid & 63;
  const int gw = blockIdx.x * 4 + (tid >> 6), nw = gridDim.x * 4;
  float* wT = (float*)smem;
  __syncthreads();
  {
    const float* wr = P.w_router + (size_t)l * 1024 * 16;
    for (int i = tid; i < 4096; i += 256) {
      int c = i >> 2, e4 = (i & 3) * 4;
      float4 w = *(const float4*)(wr + (size_t)c * 16 + e4);
      wT[(e4 + 0) * 1024 + c] = w.x; wT[(e4 + 1) * 1024 + c] = w.y; wT[(e4 + 2) * 1024 + c] = w.z; wT[(e4 + 3) * 1024 + c] = w.w;
    }
  }
  __syncthreads();
  for (int row = gw; row < NTOK; row += nw) {
    int s = row / SP, p = row % SP;
    bool lat = p < SEQ;
    if (last && !lat) continue;
    float v[16];
    compute_x1(P, l, row, lane, v);
    const float* md = ((float*)(P.ws + OFF_mod)) + ((size_t)l * 17 + (lat ? s : 16)) * 6144;
    float m3[16], m4[16];
    load_row_f32(md + 3 * 1024, lane, m3); load_row_f32(md + 4 * 1024, lane, m4);
#pragma unroll
    for (int i = 0; i < 16; ++i) v[i] = v[i] * (1.f + m4[i]) + m3[i];
    store_row_bf16(((u16*)(P.ws + OFF_H)) + (size_t)row * DM, lane, v);
    float lg[16];
#pragma unroll
    for (int e = 0; e < 16; ++e) {
      float a = 0.f;
#pragma unroll
      for (int k = 0; k < 4; ++k) {
        float4 w = *(const float4*)(wT + e * 1024 + lane * 4 + 256 * k);
        a += v[4 * k] * w.x + v[4 * k + 1] * w.y + v[4 * k + 2] * w.z + v[4 * k + 3] * w.w;
      }
      lg[e] = a;
    }
#pragma unroll
    for (int e = 0; e < 16; ++e) lg[e] = wave_sum(lg[e]);
    float mx = lg[0];
#pragma unroll
    for (int e = 1; e < 16; ++e) mx = fmaxf(mx, lg[e]);
    float sum = 0.f;
#pragma unroll
    for (int e = 0; e < 16; ++e) { lg[e] = expf(lg[e] - mx); sum += lg[e]; }
    float inv = 1.f / sum;
    if (lane < 16) {
      float mine = 0.f;
#pragma unroll
      for (int e = 0; e < 16; ++e) if (lane == e) mine = lg[e];
      ((float*)(P.ws + OFF_aff))[(size_t)row * 16 + lane] = mine * inv;
    }
  }
}

DI int block_excl_scan(int v, int* red, int tid, int& total) {
  const int lane = tid & 63, wave = tid >> 6;
  int inc = v;
#pragma unroll
  for (int o = 1; o < 64; o <<= 1) { int t = __shfl_up(inc, o); if (lane >= o) inc += t; }
  __syncthreads();
  if (lane == 63) red[wave] = inc;
  __syncthreads();
  int base = 0;
#pragma unroll
  for (int w = 0; w < 4; ++w) { int t = red[w]; if (w < wave) base += t; }
  total = red[0] + red[1] + red[2] + red[3];
  return base + inc - v;
}

DI void phase_topk(const Params& P, int l, char* smem) {
  const bool last = (l == 1);
  const int tid = TID();
  unsigned* keys = (unsigned*)smem;
  int* red = (int*)(smem + 8192);
  const int nitems = last ? 256 : 512;
  for (int it = gridDim.x - 1 - blockIdx.x; it < 16 * 384; it += gridDim.x) ffn_cvt_item(P, l, it, smem);
  for (int it = blockIdx.x; it < nitems; it += gridDim.x) {
    const bool isctx = it >= 256;
    const int se = it & 255, s = se >> 4, e = se & 15;
    const int n = isctx ? CTXL : SEQ, cap = isctx ? 32 : 256;
    const int row0 = s * SP + (isctx ? SEQ : 0);
    const int per = n >> 8;
    __syncthreads();
    for (int i = tid; i < n; i += 256) keys[i] = __float_as_uint(((float*)(P.ws + OFF_aff))[(size_t)(row0 + i) * 16 + e]);
    __syncthreads();
    unsigned kv[8];
#pragma unroll
    for (int j = 0; j < 8; ++j) kv[j] = (j < per) ? keys[tid * per + j] : 0u;
    unsigned prefix = 0u;
    int krem = cap;
    for (int bit = 31; bit >= 0; --bit) {
      const unsigned himask = (bit == 31) ? 0u : (0xFFFFFFFFu << (bit + 1));
      const unsigned want = prefix | (1u << bit);
      int c = 0;
#pragma unroll
      for (int j = 0; j < 8; ++j) c += (j < per && ((kv[j] & (himask | (1u << bit))) == want)) ? 1 : 0;
      c = (int)wave_sum((float)c);
      __syncthreads();
      if ((tid & 63) == 0) red[tid >> 6] = c;
      __syncthreads();
      const int cnt = red[0] + red[1] + red[2] + red[3];
      if (cnt >= krem) prefix = want; else krem -= cnt;
    }
    const unsigned T = prefix;
    int cgt = 0, ceq = 0;
#pragma unroll
    for (int j = 0; j < 8; ++j) if (j < per) { cgt += kv[j] > T ? 1 : 0; ceq += kv[j] == T ? 1 : 0; }
    int tot_gt, tot_eq, tot_sel;
    (void)block_excl_scan(cgt, red, tid, tot_gt);
    const int eq_before = block_excl_scan(ceq, red, tid, tot_eq);
    const int need_eq = cap - tot_gt;
    int eqc = eq_before, csel = 0;
    bool sel[8];
#pragma unroll
    for (int j = 0; j < 8; ++j) {
      sel[j] = false;
      if (j < per) {
        if (kv[j] > T) sel[j] = true;
        else if (kv[j] == T) { sel[j] = eqc < need_eq; ++eqc; }
        csel += sel[j] ? 1 : 0;
      }
    }
    int slot = block_excl_scan(csel, red, tid, tot_sel);
#pragma unroll
    for (int j = 0; j < 8; ++j) if (j < per) {
      const int t = tid * per + j;
      int rk = cap;
      if (sel[j]) {
        rk = slot++;
        const int R = isctx ? NFFN_LAT + (e * 16 + s) * 32 + rk : (s * 16 + e) * 256 + rk;
        ((int*)(P.ws + OFF_tokidx))[R] = row0 + t;
        ((float*)(P.ws + OFF_gatev))[R] = __uint_as_float(kv[j]);
      }
      ((int*)(P.ws + OFF_rank))[(size_t)(row0 + t) * 16 + e] = rk;
    }
  }
}

DI void phase_ln2(const Params& P, int l) {
  const bool last = (l == 1);
  const int lane = TID() & 63;
  const int gw = blockIdx.x * 4 + (TID() >> 6), nw = gridDim.x * 4;
  for (int row = gw; row < NTOK; row += nw) {
    int s = row / SP, p = row % SP;
    bool lat = p < SEQ;
    if (last && !lat) continue;
    float v[16];
    compute_x1(P, l, row, lane, v);
    float yf[16];
#pragma unroll
    for (int i = 0; i < 16; ++i) yf[i] = 0.f;
    const int cap = lat ? 256 : 32;
    int rks[16];
    {
      const int4* rp = (const int4*)(((int*)(P.ws + OFF_rank)) + (size_t)row * 16);
      int4 r0 = rp[0], r1 = rp[1], r2 = rp[2], r3 = rp[3];
      rks[0] = r0.x; rks[1] = r0.y; rks[2] = r0.z; rks[3] = r0.w; rks[4] = r1.x; rks[5] = r1.y; rks[6] = r1.z; rks[7] = r1.w;
      rks[8] = r2.x; rks[9] = r2.y; rks[10] = r2.z; rks[11] = r2.w; rks[12] = r3.x; rks[13] = r3.y; rks[14] = r3.z; rks[15] = r3.w;
    }
#pragma unroll
    for (int e = 0; e < 16; ++e) {
      const int rk = __builtin_amdgcn_readfirstlane(rks[e]);
      if (rk < cap) {
        int R = lat ? (s * 16 + e) * 256 + rk : NFFN_LAT + (e * 16 + s) * 32 + rk;
        float t[16];
        load_row_bf16(((u16*)(P.ws + OFF_ye)) + (size_t)R * DM, lane, t);
#pragma unroll
        for (int i = 0; i < 16; ++i) yf[i] += t[i];
      }
    }
    const float* md = ((float*)(P.ws + OFF_mod)) + ((size_t)l * 17 + (lat ? s : 16)) * 6144;
    float m5[16];
    load_row_f32(md + 5 * 1024, lane, m5);
#pragma unroll
    for (int i = 0; i < 16; ++i) v[i] = ALPHA * v[i] + m5[i] * yf[i];
    ln_row(v, P.ln2_g + l * 1024, P.ln2_b + l * 1024, lane);
    if (lat) store_row_f32(P.out + ((size_t)s * SEQ + p) * DM, lane, v);
    if (!last) {
      const float* md2 = ((float*)(P.ws + OFF_mod)) + ((size_t)(l + 1) * 17 + (lat ? s : 16)) * 6144;
      float sh[16], scl[16];
      load_row_f32(md2, lane, sh); load_row_f32(md2 + 1024, lane, scl);
#pragma unroll
      for (int i = 0; i < 16; ++i) v[i] = v[i] * (1.f + scl[i]) + sh[i];
      store_row_bf16(((u16*)(P.ws + OFF_H)) + (size_t)row * DM, lane, v);
    }
  }
}

DI int wq_next(unsigned* ctr, char* smem) {
  volatile int* slot = (volatile int*)(smem + SMEM_BYTES - 32);
  __syncthreads();
  if (TID() == 0) *slot = (int)__hip_atomic_fetch_add(ctr, 1u, __ATOMIC_RELAXED, __HIP_MEMORY_SCOPE_AGENT);
  __syncthreads();
  return *slot;
}

DI unsigned* wq_ctr(const Params& P, int ph) { return (unsigned*)(P.ws + OFF_bar) + 3600 + 16 * ph; }

template <bool SWAP>
DI void proj_tile(const Params& P, int l, int hb, int mt, int nt, char* smem) {
  const int tid = TID(), wave = tid >> 6, lane = tid & 63, fr = lane & 15, fq = lane >> 4;
  const int wr = wave >> 1, wc = wave & 1;
  const int hrow0 = mt * 128, grow0 = hb * HROWS + hrow0;
  f32x4 acc[4][4];
  zero_acc<4>(acc);
  gemm_main<4, SWAP, false>(((u16*)(P.ws + OFF_H)), DM, nullptr, grow0, ((u16*)(P.ws + OFF_WinT)) + (size_t)l * INP * 1024, 1024, nt * 128, 1024, acc, (u16*)smem);
  const int jp = mt % 18;
  const int bl = mt / 18;
  const bool lat = jp < 16;
  if (SWAP) {
    u16* dst; int ldd, c0;
    if (nt < 4) { dst = ((u16*)(P.ws + OFF_xp)); ldd = 512; c0 = nt * 128; }
    else if (nt < 8) { dst = ((u16*)(P.ws + OFF_z)); ldd = 512; c0 = (nt - 4) * 128; }
    else if (nt < 14) { dst = ((u16*)(P.ws + OFF_xbc)); ldd = 768; c0 = (nt - 8) * 128; }
    else if (nt < 18) { dst = ((u16*)(P.ws + OFF_q)); ldd = 512; c0 = (nt - 14) * 128; }
    else if (nt < 22) { dst = ((u16*)(P.ws + OFF_k)); ldd = 512; c0 = (nt - 18) * 128; }
    else { dst = ((u16*)(P.ws + OFF_br3)); ldd = 512; c0 = (nt - 26) * 128; }
    const bool isu = nt >= 26;
    const bool rope = (nt >= 14 && nt < 22) && lat;
#pragma unroll
    for (int m = 0; m < 4; ++m) {
      int r = wr * 64 + m * 16 + fr;
      size_t orow = isu ? (size_t)(grow0 + r) : (size_t)(hrow0 + r);
      if (rope) {
        int t = jp * 128 + r;
        int prow = t >> 6, pcol = t & 63;
#pragma unroll
        for (int j = 0; j < 4; ++j) {
          int f = fq * 4 + j;
          float c1 = ((float*)(P.ws + OFF_rope))[(prow * 16 + f) * 2], s1 = ((float*)(P.ws + OFF_rope))[(prow * 16 + f) * 2 + 1];
          float c2 = ((float*)(P.ws + OFF_rope))[(pcol * 16 + f) * 2], s2 = ((float*)(P.ws + OFF_rope))[(pcol * 16 + f) * 2 + 1];
          float a = acc[m][0][j], b = acc[m][1][j];
          acc[m][0][j] = a * c1 - b * s1; acc[m][1][j] = a * s1 + b * c1;
          a = acc[m][2][j]; b = acc[m][3][j];
          acc[m][2][j] = a * c2 - b * s2; acc[m][3][j] = a * s2 + b * c2;
        }
      }
#pragma unroll
      for (int n = 0; n < 4; ++n) {
        f32x4 v = acc[m][n];
        if (isu) { v[0] = geluf_(v[0]); v[1] = geluf_(v[1]); v[2] = geluf_(v[2]); v[3] = geluf_(v[3]); }
        int col = c0 + wc * 64 + n * 16 + fq * 4;
        *(bf16x4*)(dst + orow * ldd + col) = pack4v(v);
      }
    }
  } else {
    if (nt == 34) {
      if (wc == 0) {
#pragma unroll
        for (int m = 0; m < 4; ++m)
#pragma unroll
          for (int j = 0; j < 4; ++j) ((float*)(P.ws + OFF_dtbuf))[(size_t)(hrow0 + wr * 64 + m * 16 + fq * 4 + j) * 16 + fr] = acc[m][0][j];
      }
    } else if (nt < 26) {
      int cb = (nt - 22) * 128 + wc * 64;
#pragma unroll
      for (int m = 0; m < 4; ++m)
#pragma unroll
        for (int n = 0; n < 4; ++n) {
          int c = cb + n * 16 + fr;
          int pos = jp * 128 + wr * 64 + m * 16 + fq * 4;
          *(bf16x4*)(((u16*)(P.ws + OFF_vT)) + ((size_t)bl * 512 + c) * SP + pos) = pack4v(acc[m][n]);
        }
    } else {
      int cb = (nt - 30) * 128 + wc * 64;
#pragma unroll
      for (int m = 0; m < 4; ++m)
#pragma unroll
        for (int n = 0; n < 4; ++n) {
          int c = cb + n * 16 + fr;
          int i0 = wr * 64 + m * 16 + fq * 4;
          f32x4 v = acc[m][n];
          *(bf16x4*)(((u16*)(P.ws + OFF_gvT)) + ((size_t)mt * 512 + c) * 128 + i0) = pack4(geluf_(v[0]), geluf_(v[1]), geluf_(v[2]), geluf_(v[3]));
        }
    }
  }
}

DI void phase_proj(const Params& P, int l, int hb, char* smem, int ph) {
  const bool last = (l == 1);
  for (;;) {
    const int it = wq_next(wq_ctr(P, ph), smem);
    if (it >= 144 * 35) break;
    int mt = it / 35, nt = it % 35;
    bool isctx = (mt % 18) >= 16;
    if (last && isctx) {
      bool need = (nt >= 8 && nt < 14) || (nt >= 18 && nt < 26) || nt == 34;
      if (!need) continue;
    }
    bool transposed = (nt >= 22 && nt < 26) || nt >= 30;
    if (transposed) proj_tile<false>(P, l, hb, mt, nt, smem);
    else proj_tile<true>(P, l, hb, mt, nt, smem);
  }
}

constexpr int LDK = 136;
DI void pool_item(const Params& P, int l, int hb, int mt, int g, char* smem) {
  const int tid = TID(), wave = tid >> 6, lane = tid & 63, fr = lane & 15, fq = lane >> 4;
  const int wr = wave >> 1, wc = wave & 1;
  u16* As = (u16*)smem;
  u16* Bs = As + 128 * LDK;
  const int jp = mt % 18, bl = mt / 18;
  const bool lat = jp < 16;
  const int n = lat ? SEQ : CTXL;
  const int p0 = lat ? jp * 128 : (jp - 16) * 128;
  const int seqbase = bl * SP + (lat ? 0 : SEQ);
  const int half = 1 << g;
  __syncthreads();
  {
    const int cch = tid & 15;
    const u16* src = ((u16*)(P.ws + OFF_xp)) + (size_t)seqbase * 512 + g * 128 + cch * 8;
    for (int ii = 0; ii < 8; ++ii) {
      int i = (tid >> 4) + 16 * ii;
      int p = p0 + i;
      int lo = max(p - half, 0), hi = min(p + half, n);
      float s[8];
#pragma unroll
      for (int e = 0; e < 8; ++e) s[e] = 0.f;
      for (int r = lo; r < hi; ++r) {
        bf16x8 t = *(const bf16x8*)(src + (size_t)r * 512);
#pragma unroll
        for (int e = 0; e < 8; ++e) s[e] += bf2f((u16)t[e]);
      }
      bf16x8 self = *(const bf16x8*)(src + (size_t)p * 512);
      float inv = 1.f / (float)(hi - lo);
      bf16x8 o;
#pragma unroll
      for (int e = 0; e < 8; ++e) o[e] = (short)f2bf(s[e] * inv - bf2f((u16)self[e]));
      *(bf16x8*)(As + i * LDK + cch * 8) = o;
    }
    const u16* wsrc = ((u16*)(P.ws + OFF_poolT)) + ((size_t)l * 4 + g) * 128 * 128;
    for (int cid = tid; cid < 2048; cid += 256) {
      int r = cid >> 4, c8 = (cid & 15) * 8;
      *(u32x4*)(Bs + r * LDK + c8) = *(const u32x4*)(wsrc + r * 128 + c8);
    }
  }
  __syncthreads();
  f32x4 acc[4][4];
  zero_acc<4>(acc);
  mma_lds<4, 4, true>(As + wr * 64 * LDK, LDK, Bs + wc * 64 * LDK, LDK, 4, acc, fr, fq);
  const float* psc = P.pool_scale + l * 512 + g * 128;
#pragma unroll
  for (int m = 0; m < 4; ++m)
#pragma unroll
    for (int nn = 0; nn < 4; ++nn) {
      int r = wr * 64 + m * 16 + fr, c = wc * 64 + nn * 16 + fq * 4;
      float4 sc = *(const float4*)(psc + c);
      f32x4 v = acc[m][nn];
      *(bf16x4*)(((u16*)(P.ws + OFF_br0)) + (size_t)(hb * HROWS + mt * 128 + r) * 512 + g * 128 + c) = pack4(v[0] * sc.x, v[1] * sc.y, v[2] * sc.z, v[3] * sc.w);
    }
}

DI void sgu_item(const Params& P, int l, int hb, int mt, int g, char* smem) {
  const int tid = TID(), wave = tid >> 6, lane = tid & 63, fr = lane & 15, fq = lane >> 4;
  const int wr = wave >> 1, wc = wave & 1;
  u16* As = (u16*)smem;
  u16* Bs = As + 128 * LDK;
  float* st = (float*)(Bs + 128 * LDK);
  const u16* gv = ((u16*)(P.ws + OFF_gvT)) + (size_t)mt * 512 * 128;
  __syncthreads();
  {
    float* ps = (float*)smem;
    float* pq = ps + 16 * 128;
    const int cg = tid >> 4, tc = tid & 15;
    float s8[8], q8[8];
#pragma unroll
    for (int e2 = 0; e2 < 8; ++e2) { s8[e2] = 0.f; q8[e2] = 0.f; }
#pragma unroll 8
    for (int c = 0; c < 32; ++c) {
      u32x4 t = *(const u32x4*)(gv + (size_t)(cg * 32 + c) * 128 + tc * 8);
#pragma unroll
      for (int e2 = 0; e2 < 4; ++e2) {
        float a = bflo(t[e2]), b = bfhi(t[e2]);
        s8[2 * e2] += a; q8[2 * e2] += a * a; s8[2 * e2 + 1] += b; q8[2 * e2 + 1] += b * b;
      }
    }
#pragma unroll
    for (int e2 = 0; e2 < 8; ++e2) { ps[cg * 128 + tc * 8 + e2] = s8[e2]; pq[cg * 128 + tc * 8 + e2] = q8[e2]; }
    __syncthreads();
    if (tid < 128) {
      float s = 0.f, q = 0.f;
#pragma unroll
      for (int g2 = 0; g2 < 16; ++g2) { s += ps[g2 * 128 + tid]; q += pq[g2 * 128 + tid]; }
      const float mu_ = s * (1.f / 512.f);
      const float var = fmaxf(q * (1.f / 512.f) - mu_ * mu_, 0.f);
      st[256 + tid] = mu_; st[384 + tid] = rsqrtf(var + LN_EPS);
    }
  }
  const float* mu = st + 256;
  const float* rs = st + 384;
  {
    __syncthreads();
    const u16* wsrc = ((u16*)(P.ws + OFF_sguW)) + ((size_t)l * 4 + g) * 128 * 128;
    for (int cid = tid; cid < 2048; cid += 256) {
      int r = cid >> 4, c8 = (cid & 15) * 8;
      *(u32x4*)(As + r * LDK + c8) = *(const u32x4*)(wsrc + r * 128 + c8);
      bf16x8 t = *(const bf16x8*)(gv + (size_t)(g * 128 + r) * 128 + c8);
      float lg = P.sgu_ln_g[l * 512 + g * 128 + r], lb = P.sgu_ln_b[l * 512 + g * 128 + r];
      bf16x8 o;
#pragma unroll
      for (int e = 0; e < 8; ++e) o[e] = (short)f2bf((bf2f((u16)t[e]) - mu[c8 + e]) * rs[c8 + e] * lg + lb);
      *(bf16x8*)(Bs + r * LDK + c8) = o;
    }
    __syncthreads();
    f32x4 acc[4][4];
    zero_acc<4>(acc);
    mma_lds<4, 4, true>(As + wr * 64 * LDK, LDK, Bs + wc * 64 * LDK, LDK, 4, acc, fr, fq);
    const float* bs = P.sgu_b + ((size_t)l * 4 + g) * 128;
#pragma unroll
    for (int m = 0; m < 4; ++m) {
      int pp = wr * 64 + m * 16 + fr;
      float bias = bs[pp];
#pragma unroll
      for (int nn = 0; nn < 4; ++nn) {
        int d = wc * 64 + nn * 16 + fq * 4;
        u16* up = ((u16*)(P.ws + OFF_br3)) + (size_t)(hb * HROWS + mt * 128 + pp) * 512 + g * 128 + d;
        bf16x4 uu = *(const bf16x4*)up;
        f32x4 v = acc[m][nn];
        *(bf16x4*)up = pack4((v[0] + bias) * bf2f((u16)uu[0]), (v[1] + bias) * bf2f((u16)uu[1]), (v[2] + bias) * bf2f((u16)uu[2]), (v[3] + bias) * bf2f((u16)uu[3]));
      }
    }
  }
}

DI void attn_item(const Params& P, int l, int hb, int item, char* smem) {
  const int tid = TID(), wave = tid >> 6, lane = tid & 63, fr = lane & 15, fq = lane >> 4;
  int qt, h, bl;
  if (item < 512) { bl = item >> 6; h = (item >> 4) & 3; qt = item & 15; }
  else { const int j = item - 512; bl = j >> 3; h = (j >> 1) & 3; qt = 16 + (j & 1); }
  const bool ctxq = qt >= 16;
  const int key0 = ctxq ? SEQ : 0, nkt = ctxq ? 4 : 36;
  const int hrow_q0 = bl * SP + qt * 128 + wave * 32;
  constexpr int KT = 64 * LDT, VT = 128 * LDT;
  u16* Ks = (u16*)smem;
  u16* Vs = Ks + 2 * KT;
  constexpr float LOG2E = 1.4426950408889634f;
  for (int sub = 0; sub < 2; ++sub) {
    const int hs = 2 * h + sub;
    bf16x8 qf[2][2];
#pragma unroll
    for (int qb = 0; qb < 2; ++qb)
#pragma unroll
      for (int ks = 0; ks < 2; ++ks) qf[qb][ks] = *(const bf16x8*)(((u16*)(P.ws + OFF_q)) + (size_t)(hrow_q0 + qb * 16 + fr) * 512 + hs * 64 + ks * 32 + fq * 8);
    f32x4 ot[8][2];
#pragma unroll
    for (int d = 0; d < 8; ++d) { ot[d][0] = f32x4{0.f, 0.f, 0.f, 0.f}; ot[d][1] = f32x4{0.f, 0.f, 0.f, 0.f}; }
    float mrow[2] = {-INFINITY, -INFINITY}, lrow[2] = {0.f, 0.f};
    const u16* Kg = ((u16*)(P.ws + OFF_k)) + ((size_t)bl * SP + key0) * 512 + hs * 64;
    const u16* Vg = ((u16*)(P.ws + OFF_vT)) + ((size_t)bl * 512 + h * 128) * SP + key0;
    u32x4 rk[2], rv[4];
    const u16* kgp = Kg + (size_t)(tid >> 2) * 512 + (tid & 3) * 16;
    const u16* vgp = Vg + (size_t)(tid >> 1) * SP + (tid & 1) * 32;
    u16* ksp = Ks + (tid >> 2) * LDT + (tid & 3) * 16;
    u16* vsp = Vs + (tid >> 1) * LDT + (tid & 1) * 32;
    auto gloadK = [&](int t) {
      const u16* kp = kgp + (size_t)t * 64 * 512;
      rk[0] = *(const u32x4*)(kp); rk[1] = *(const u32x4*)(kp + 8);
    };
    auto gloadV = [&](int t) {
      const u16* vp = vgp + t * 64;
      rv[0] = *(const u32x4*)(vp); rv[1] = *(const u32x4*)(vp + 8); rv[2] = *(const u32x4*)(vp + 16); rv[3] = *(const u32x4*)(vp + 24);
    };
    auto sstore = [&](int buf) {
      u16* kp = ksp + buf * KT;
      *(u32x4*)(kp) = rk[0]; *(u32x4*)(kp + 8) = rk[1];
      u16* vp = vsp + buf * VT;
      *(u32x4*)(vp) = rv[0]; *(u32x4*)(vp + 8) = rv[1]; *(u32x4*)(vp + 16) = rv[2]; *(u32x4*)(vp + 24) = rv[3];
    };
    gloadK(0); gloadV(0);
    __syncthreads();
    sstore(0);
    __syncthreads();
    for (int t = 0; t < nkt; ++t) {
      const int cur = t & 1;
      __builtin_amdgcn_iglp_opt(0);
      if (t + 1 < nkt) gloadK(t + 1);
      const u16* Kc = Ks + cur * KT;
      const u16* Vc = Vs + cur * VT;
      f32x4 st[4][2];
#pragma unroll
      for (int k4 = 0; k4 < 4; ++k4) { st[k4][0] = f32x4{0.f, 0.f, 0.f, 0.f}; st[k4][1] = f32x4{0.f, 0.f, 0.f, 0.f}; }
#pragma unroll
      for (int k4 = 0; k4 < 4; ++k4)
#pragma unroll
        for (int ks = 0; ks < 2; ++ks) {
          bf16x8 a = *(const bf16x8*)(Kc + (k4 * 16 + fr) * LDT + ks * 32 + fq * 8);
          st[k4][0] = MFMA16(a, qf[0][ks], st[k4][0]);
          st[k4][1] = MFMA16(a, qf[1][ks], st[k4][1]);
          if (ks == 1 && (k4 & 1)) __builtin_amdgcn_sched_barrier(0);
        }
      __builtin_amdgcn_sched_barrier(0);
#pragma unroll
      for (int qb = 0; qb < 2; ++qb) {
        float mx = -INFINITY;
#pragma unroll
        for (int k4 = 0; k4 < 4; ++k4)
#pragma unroll
          for (int j = 0; j < 4; ++j) mx = fmaxf(mx, st[k4][qb][j]);
        mx = fmaxf(mx, __shfl_xor(mx, 16));
        mx = fmaxf(mx, __shfl_xor(mx, 32));
        const bool upd = mx > mrow[qb] + 5.5f;
        const float mnew = upd ? mx : mrow[qb];
        const float moff = mnew * LOG2E;
        float ps = 0.f;
#pragma unroll
        for (int k4 = 0; k4 < 4; ++k4)
#pragma unroll
          for (int j = 0; j < 4; ++j) { float pv = __builtin_amdgcn_exp2f(st[k4][qb][j] * LOG2E - moff); st[k4][qb][j] = pv; ps += pv; }
        if (__builtin_amdgcn_ballot_w64(upd) != 0ull) {
          const float alpha = __builtin_amdgcn_exp2f((mrow[qb] - mnew) * LOG2E);
          lrow[qb] *= alpha;
#pragma unroll
          for (int d = 0; d < 8; ++d) { ot[d][qb][0] *= alpha; ot[d][qb][1] *= alpha; ot[d][qb][2] *= alpha; ot[d][qb][3] *= alpha; }
        }
        mrow[qb] = mnew;
        lrow[qb] += ps;
      }
      __builtin_amdgcn_sched_barrier(0);
      if (t + 1 < nkt) gloadV(t + 1);
#pragma unroll
      for (int ks2 = 0; ks2 < 2; ++ks2) {
        bf16x8 pf[2];
#pragma unroll
        for (int qb = 0; qb < 2; ++qb) {
          bf16x4 lo = pack4v(st[2 * ks2][qb]), hi = pack4v(st[2 * ks2 + 1][qb]);
          pf[qb] = __builtin_shufflevector(lo, hi, 0, 1, 2, 3, 4, 5, 6, 7);
        }
#pragma unroll
        for (int d = 0; d < 8; ++d) {
          const u16* vp = Vc + (d * 16 + fr) * LDT + ks2 * 32 + fq * 4;
          bf16x4 lo = *(const bf16x4*)vp, hi = *(const bf16x4*)(vp + 16);
          bf16x8 a = __builtin_shufflevector(lo, hi, 0, 1, 2, 3, 4, 5, 6, 7);
          ot[d][0] = MFMA16(a, pf[0], ot[d][0]);
          ot[d][1] = MFMA16(a, pf[1], ot[d][1]);
          if ((d & 3) == 3) __builtin_amdgcn_sched_barrier(0);
        }
      }
      if (t + 1 < nkt) sstore(cur ^ 1);
      __syncthreads();
    }
#pragma unroll
    for (int qb = 0; qb < 2; ++qb) {
      float lt = lrow[qb];
      lt += __shfl_xor(lt, 16);
      lt += __shfl_xor(lt, 32);
      float inv = 1.f / lt;
      size_t hrow = (size_t)(hrow_q0 + qb * 16 + fr);
      if (sub == 0) {
#pragma unroll
        for (int d = 0; d < 8; ++d) {
          f32x4 v = ot[d][qb];
          *(bf16x4*)(((u16*)(P.ws + OFF_o1)) + hrow * 512 + h * 128 + d * 16 + fq * 4) = pack4(v[0] * inv, v[1] * inv, v[2] * inv, v[3] * inv);
        }
      } else {
        const float lam = ((float*)(P.ws + OFF_lamv))[l * 2], lam_init = ((float*)(P.ws + OFF_lamv))[l * 2 + 1];
        float ss = 0.f;
#pragma unroll
        for (int d = 0; d < 8; ++d) {
          bf16x4 o1v = *(const bf16x4*)(((u16*)(P.ws + OFF_o1)) + hrow * 512 + h * 128 + d * 16 + fq * 4);
#pragma unroll
          for (int j = 0; j < 4; ++j) { float dd = bf2f((u16)o1v[j]) - lam * ot[d][qb][j] * inv; ot[d][qb][j] = dd; ss += dd * dd; }
        }
        ss += __shfl_xor(ss, 16);
        ss += __shfl_xor(ss, 32);
        float rr = rsqrtf(ss * (1.f / 128.f) + LN_EPS) * (1.f - lam_init);
        const float* gn = P.diff_norm_g + l * 128;
#pragma unroll
        for (int d = 0; d < 8; ++d) {
          int dv = d * 16 + fq * 4;
          float4 g4 = *(const float4*)(gn + dv);
          f32x4 v = ot[d][qb];
          *(bf16x4*)(((u16*)(P.ws + OFF_br2)) + ((size_t)hb * HROWS + hrow) * 512 + h * 128 + dv) = pack4(v[0] * rr * g4.x, v[1] * rr * g4.y, v[2] * rr * g4.z, v[3] * rr * g4.w);
        }
      }
    }
  }
}

template <bool TRANS>
DI void conv_stage(const Params& P, int l, const u16* xbase  , int chan0, int n, int p0, u16* dst, int ld, const float* scale) {
  const int tid = TID(), cl = tid & 63, ig = tid >> 6;
  const int ch = chan0 + cl;
  const float* cw = P.conv_w + (size_t)l * 5 * 768 + ch;
  const float w0 = cw[0], w1 = cw[768], w2 = cw[2 * 768], w3 = cw[3 * 768], w4 = cw[4 * 768];
  const float cb = P.conv_b[l * 768 + ch];
  const u16* xc = xbase + ch;
#pragma unroll 1
  for (int g8 = 0; g8 < 4; ++g8) {
    const int tok0 = ig * 32 + g8 * 8;
    const int pos0 = p0 + tok0 - 2;
    float xv[12];
#pragma unroll
    for (int i = 0; i < 12; ++i) { int pos = pos0 + i; xv[i] = (pos >= 0 && pos < n) ? bf2f(xc[(size_t)pos * 768]) : 0.f; }
#pragma unroll
    for (int ii = 0; ii < 8; ++ii) {
      float v = w0 * xv[ii] + w1 * xv[ii + 1] + w2 * xv[ii + 2] + w3 * xv[ii + 3] + w4 * xv[ii + 4] + cb;
      v = v * __builtin_amdgcn_rcpf(1.f + __expf(-v));
      const int tok = tok0 + ii;
      if (scale) v *= scale[tok];
      if (TRANS) dst[cl * ld + tok] = f2bf(v); else dst[tok * ld + cl] = f2bf(v);
    }
  }
}

DI void ssd_scalars(const Params& P, int l, int hrow0, int h, int dir, float* dts, float* S, float* tmp) {
  const int tid = TID();
  const float aneg = -expf(P.a_log[l * 16 + dir * 8 + h]);
  float a = 0.f, inc = 0.f;
  if (tid < 128) {
    float raw = ((float*)(P.ws + OFF_dtbuf))[(size_t)(hrow0 + tid) * 16 + dir * 8 + h] + P.dt_bias[l * 16 + dir * 8 + h];
    float dt = softplusf_(raw);
    dts[tid] = dt;
    a = dt * aneg;
    inc = a;
    const int lane = tid & 63;
#pragma unroll
    for (int o = 1; o < 64; o <<= 1) { float t = __shfl_up(inc, o); if (lane >= o) inc += t; }
    if (lane == 63) tmp[tid >> 6] = inc;
  }
  __syncthreads();
  if (tid < 128) {
    const float t0 = tmp[0], t1 = tmp[1];
    const float pre = inc + (tid >= 64 ? t0 : 0.f);
    S[tid] = (dir == 0) ? pre : (t0 + t1) - pre + a;
  }
  __syncthreads();
}

constexpr int SSD_STATE_STRIDE = 18 * 4096;

DI void ssd_prep_item(const Params& P, int l, int hb, int mt, int slab, char* smem) {
  const int tid = TID();
  const int jp = mt % 18, bl = mt / 18;
  const bool lat = jp < 16;
  const int n = lat ? SEQ : CTXL;
  const int p0 = lat ? jp * 128 : (jp - 16) * 128;
  const int seqbase = bl * SP + (lat ? 0 : SEQ);
  const int hrow0 = bl * SP + jp * 128;
  u16* T = (u16*)smem;
  u16* Rm = T + 64 * LDK;
  __syncthreads();
  const u16* xb = ((u16*)(P.ws + OFF_xbc)) + (size_t)seqbase * 768;
  {
    const int cg = tid & 7, tg = tid >> 3;
    const int ch0 = slab * 64 + cg * 8;
    float w[5][8], cbv[8];
#pragma unroll
    for (int d = 0; d < 5; ++d) {
      const float4 a = *(const float4*)(P.conv_w + ((size_t)l * 5 + d) * 768 + ch0), b = *(const float4*)(P.conv_w + ((size_t)l * 5 + d) * 768 + ch0 + 4);
      w[d][0] = a.x; w[d][1] = a.y; w[d][2] = a.z; w[d][3] = a.w; w[d][4] = b.x; w[d][5] = b.y; w[d][6] = b.z; w[d][7] = b.w;
    }
    {
      const float4 a = *(const float4*)(P.conv_b + l * 768 + ch0), b = *(const float4*)(P.conv_b + l * 768 + ch0 + 4);
      cbv[0] = a.x; cbv[1] = a.y; cbv[2] = a.z; cbv[3] = a.w; cbv[4] = b.x; cbv[5] = b.y; cbv[6] = b.z; cbv[7] = b.w;
    }
    const int tok0 = tg * 4;
    u32x4 xr[8];
#pragma unroll
    for (int i = 0; i < 8; ++i) {
      const int pos = p0 + tok0 - 2 + i;
      xr[i] = u32x4{0u, 0u, 0u, 0u};
      if (pos >= 0 && pos < n) xr[i] = *(const u32x4*)(xb + (size_t)pos * 768 + ch0);
    }
    float o[4][8];
#pragma unroll
    for (int t = 0; t < 4; ++t)
#pragma unroll
      for (int e2 = 0; e2 < 4; ++e2) {
        float a0 = cbv[2 * e2], a1 = cbv[2 * e2 + 1];
#pragma unroll
        for (int d = 0; d < 5; ++d) { a0 += w[d][2 * e2] * bflo(xr[t + d][e2]); a1 += w[d][2 * e2 + 1] * bfhi(xr[t + d][e2]); }
        o[t][2 * e2] = siluf_(a0); o[t][2 * e2 + 1] = siluf_(a1);
      }
    if (slab < 10) {
#pragma unroll
      for (int e2 = 0; e2 < 8; ++e2) *(bf16x4*)(T + (cg * 8 + e2) * LDK + tok0) = pack4(o[0][e2], o[1][e2], o[2][e2], o[3][e2]);
    }
    if (slab >= 8) {
#pragma unroll
      for (int t = 0; t < 4; ++t) {
        u32x4 v = {pack2(o[t][0], o[t][1]), pack2(o[t][2], o[t][3]), pack2(o[t][4], o[t][5]), pack2(o[t][6], o[t][7])};
        *(u32x4*)(Rm + (tok0 + t) * LDT + cg * 8) = v;
      }
    }
  }
  __syncthreads();
  if (slab < 10) {
    u16* dst = slab < 8 ? ((u16*)(P.ws + OFF_xsT)) + ((size_t)mt * 512 + slab * 64) * 128 : ((u16*)(P.ws + OFF_bmT)) + ((size_t)mt * 128 + (slab - 8) * 64) * 128;
#pragma unroll
    for (int i = 0; i < 4; ++i) { int cid = tid + 256 * i; int r = cid >> 4, c8 = (cid & 15) * 8; *(u32x4*)(dst + (size_t)r * 128 + c8) = *(const u32x4*)(T + r * LDK + c8); }
  }
  if (slab >= 8) {
    u16* dst = (slab < 10 ? ((u16*)(P.ws + OFF_bm)) + (slab - 8) * 64 : ((u16*)(P.ws + OFF_cm)) + (slab - 10) * 64) + (size_t)hrow0 * 128;
#pragma unroll
    for (int i = 0; i < 4; ++i) { int cid = tid + 256 * i; int r = cid >> 3, c8 = (cid & 7) * 8; *(u32x4*)(dst + (size_t)r * 128 + c8) = *(const u32x4*)(Rm + r * LDT + c8); }
  }
}

DI void phase_ssd_prep(const Params& P, int l, int hb, char* smem, int ph) {
  for (;;) {
    const int it = wq_next(wq_ctr(P, ph), smem);
    if (it >= 144 * 12) break;
    ssd_prep_item(P, l, hb, it / 12, it % 12, smem);
  }
}

DI void ssd_state_item(const Params& P, int l, int hb, int item, char* smem) {
  const int tid = TID(), wave = tid >> 6, lane = tid & 63, fr = lane & 15, fq = lane >> 4;
  const int h = item & 7, jp = (item >> 3) % 18, bl = (item >> 3) / 18;
  const int mt = bl * 18 + jp;
  const int hrow0 = bl * SP + jp * 128;
  u16* At = (u16*)smem;
  u16* Bt = At + 64 * LDK;
  float* dts = (float*)(Bt + 64 * LDK);
  float* S = dts + 128;
  float* wgt = S + 128;
  __syncthreads();
  u32x4 xr[4];
  {
    const u16* bsrc = ((u16*)(P.ws + OFF_bmT)) + ((size_t)mt * 128 + (h >> 2) * 64) * 128;
    const u16* xsrc = ((u16*)(P.ws + OFF_xsT)) + ((size_t)mt * 512 + h * 64) * 128;
#pragma unroll
    for (int i = 0; i < 4; ++i) {
      int cid = tid + 256 * i; int r = cid >> 4, c8 = (cid & 15) * 8;
      *(u32x4*)(Bt + r * LDK + c8) = *(const u32x4*)(bsrc + (size_t)r * 128 + c8);
      xr[i] = *(const u32x4*)(xsrc + (size_t)r * 128 + c8);
    }
  }
  const int wr = wave >> 1, wc = wave & 1;
#pragma unroll 1
  for (int dir = 0; dir < 2; ++dir) {
    ssd_scalars(P, l, hrow0, h, dir, dts, S, wgt);
    const float total = (dir == 0) ? S[127] : S[0];
    __syncthreads();
    if (tid < 128) wgt[tid] = dts[tid] * __expf(total - S[tid]);
    __syncthreads();
#pragma unroll
    for (int i = 0; i < 4; ++i) {
      int cid = tid + 256 * i; int r = cid >> 4, c8 = (cid & 15) * 8;
      u32x4 o;
#pragma unroll
      for (int e2 = 0; e2 < 4; ++e2) o[e2] = pack2(bflo(xr[i][e2]) * wgt[c8 + 2 * e2], bfhi(xr[i][e2]) * wgt[c8 + 2 * e2 + 1]);
      *(u32x4*)(At + r * LDK + c8) = o;
    }
    __syncthreads();
    f32x4 acc[2][2];
#pragma unroll
    for (int m = 0; m < 2; ++m) { acc[m][0] = f32x4{0.f, 0.f, 0.f, 0.f}; acc[m][1] = f32x4{0.f, 0.f, 0.f, 0.f}; }
    mma_lds<2, 2, true>(At + wr * 32 * LDK, LDK, Bt + wc * 32 * LDK, LDK, 4, acc, fr, fq);
    u16* cs = ((u16*)(P.ws + OFF_cstate)) + (((size_t)(bl * 2 + dir) * 8 + h) * 18 + jp) * 4096;
#pragma unroll
    for (int m = 0; m < 2; ++m)
#pragma unroll
      for (int nn = 0; nn < 2; ++nn) *(bf16x4*)(cs + (wr * 32 + m * 16 + fr) * 64 + wc * 32 + nn * 16 + fq * 4) = pack4v(acc[m][nn]);
    if (tid == 0) ((float*)(P.ws + OFF_decay))[((bl * 2 + dir) * 8 + h) * 18 + jp] = __expf(total);
  }
}

DI void phase_carry(const Params& P) {
  const int total = 8 * 2 * 8 * 4096;
  for (int idx = blockIdx.x * 256 + TID(); idx < total; idx += gridDim.x * 256) {
    int pn = idx & 4095, bdh = idx >> 12;
    int dir = (bdh >> 3) & 1;
    const u16* __restrict__ cs = ((const u16*)(P.ws + OFF_cstate)) + (size_t)bdh * SSD_STATE_STRIDE + pn;
    u16* __restrict__ en = ((u16*)(P.ws + OFF_enter)) + (size_t)bdh * SSD_STATE_STRIDE + pn;
    const float* __restrict__ dc = ((const float*)(P.ws + OFF_decay)) + bdh * 18;
    float cv[18], dv[18];
#pragma unroll
    for (int jp = 0; jp < 18; ++jp) { cv[jp] = bf2f(cs[(size_t)jp * 4096]); dv[jp] = dc[jp]; }
    float state = 0.f;
    if (dir == 0) {
#pragma unroll
      for (int st = 0; st < 18; ++st) {
        const int jp = st < 2 ? 16 + st : st - 2;
        en[(size_t)jp * 4096] = f2bf(state);
        state = state * dv[jp] + cv[jp];
      }
    } else {
#pragma unroll
      for (int st = 0; st < 18; ++st) {
        const int jp = 17 - st;
        en[(size_t)jp * 4096] = f2bf(state);
        state = state * dv[jp] + cv[jp];
      }
    }
  }
}

DI void ssd_out_item(const Params& P, int l, int hb, int item, char* smem) {
  const int tid = TID(), wave = tid >> 6, lane = tid & 63, fr = lane & 15, fq = lane >> 4;
  const int h = item & 7, jp = (item >> 3) % 18, bl = (item >> 3) / 18;
  const bool lat = jp < 16;
  const int n = lat ? SEQ : CTXL;
  const int p0 = lat ? jp * 128 : (jp - 16) * 128;
  const int seqbase = bl * SP + (lat ? 0 : SEQ);
  const int hrow0 = bl * SP + jp * 128;
  u16* Cs = (u16*)smem;
  u16* xT = Cs + 128 * LDT;
  u16* Et = xT + 64 * LDK;
  u16* Un = Et + 64 * LDT;
  float* fs = (float*)(Un + 128 * LDK);
  float* dts = fs;
  float* S = fs + 128;
  float* tmp = fs + 256;
  const int grp = h >> 2;
  __syncthreads();
  {
    const int mt = bl * 18 + jp;
    const u16* csrc = ((u16*)(P.ws + OFF_cm)) + (size_t)hrow0 * 128 + grp * 64;
    const u16* bsrc = ((u16*)(P.ws + OFF_bm)) + (size_t)hrow0 * 128 + grp * 64;
    const u16* xsrc = ((u16*)(P.ws + OFF_xsT)) + ((size_t)mt * 512 + h * 64) * 128;
#pragma unroll
    for (int i = 0; i < 4; ++i) {
      int cid = tid + 256 * i;
      int r = cid >> 3, c8 = (cid & 7) * 8;
      *(u32x4*)(Cs + r * LDT + c8) = *(const u32x4*)(csrc + (size_t)r * 128 + c8);
      *(u32x4*)(Un + r * LDT + c8) = *(const u32x4*)(bsrc + (size_t)r * 128 + c8);
      int r2 = cid >> 4, c82 = (cid & 15) * 8;
      *(u32x4*)(xT + r2 * LDK + c82) = *(const u32x4*)(xsrc + (size_t)r2 * 128 + c82);
    }
  }
  __syncthreads();
  f32x4 cb[2][8];
#pragma unroll
  for (int m = 0; m < 2; ++m)
#pragma unroll
    for (int nn = 0; nn < 8; ++nn) cb[m][nn] = f32x4{0.f, 0.f, 0.f, 0.f};
  mma_lds<2, 8, false>(Cs + wave * 32 * LDT, LDT, Un, LDT, 2, cb, fr, fq);
  f32x4 yacc[2][4];
#pragma unroll
  for (int m = 0; m < 2; ++m)
#pragma unroll
    for (int nn = 0; nn < 4; ++nn) yacc[m][nn] = f32x4{0.f, 0.f, 0.f, 0.f};
#pragma unroll 1
  for (int dir = 0; dir < 2; ++dir) {
    __syncthreads();
    ssd_scalars(P, l, hrow0, h, dir, dts, S, tmp);
#pragma unroll
    for (int m = 0; m < 2; ++m)
#pragma unroll
      for (int j = 0; j < 4; ++j) {
        int lrow = wave * 32 + m * 16 + fq * 4 + j;
        float Sl = S[lrow];
#pragma unroll
        for (int nn = 0; nn < 8; ++nn) {
          int s = nn * 16 + fr;
          bool ok = dir == 0 ? (s <= lrow) : (s >= lrow);
          float coef = ok ? __expf(Sl - S[s]) * dts[s] : 0.f;
          Un[lrow * LDK + s] = f2bf(cb[m][nn][j] * coef);
        }
      }
    {
      const u16* en = ((u16*)(P.ws + OFF_enter)) + (((size_t)(bl * 2 + dir) * 8 + h) * 18 + jp) * 4096;
      for (int cid = tid; cid < 512; cid += 256) {
        int pr = cid >> 3, c8 = (cid & 7) * 8;
        *(u32x4*)(Et + pr * LDT + c8) = *(const u32x4*)(en + pr * 64 + c8);
      }
    }
    __syncthreads();
    mma_lds<2, 4, true>(Un + wave * 32 * LDK, LDK, xT, LDK, 4, yacc, fr, fq);
    f32x4 yi[2][4];
#pragma unroll
    for (int m = 0; m < 2; ++m)
#pragma unroll
      for (int nn = 0; nn < 4; ++nn) yi[m][nn] = f32x4{0.f, 0.f, 0.f, 0.f};
    mma_lds<2, 4, true>(Cs + wave * 32 * LDT, LDT, Et, LDT, 2, yi, fr, fq);
#pragma unroll
    for (int m = 0; m < 2; ++m) {
      float e = __expf(S[wave * 32 + m * 16 + fr]);
#pragma unroll
      for (int nn = 0; nn < 4; ++nn)
#pragma unroll
        for (int j = 0; j < 4; ++j) yacc[m][nn][j] += e * yi[m][nn][j];
    }
  }
  const float dsk = P.ssd_d[l * 8 + h];
  const float* gn = P.ssd_norm_g + l * 512 + h * 64;
#pragma unroll
  for (int m = 0; m < 2; ++m) {
    int lrow = wave * 32 + m * 16 + fr;
    float ss = 0.f;
#pragma unroll
    for (int nn = 0; nn < 4; ++nn) {
      int pc = nn * 16 + fq * 4;
      bf16x4 zz = *(const bf16x4*)(((u16*)(P.ws + OFF_z)) + (size_t)(hrow0 + lrow) * 512 + h * 64 + pc);
      float4 g4 = *(const float4*)(gn + pc);
      float gg[4] = {g4.x, g4.y, g4.z, g4.w};
      float o[4];
#pragma unroll
      for (int j = 0; j < 4; ++j) {
        float y = yacc[m][nn][j] + dsk * bf2f(xT[(pc + j) * LDK + lrow]);
        y *= siluf_(bf2f((u16)zz[j]));
        ss += y * y;
        o[j] = y * gg[j];
      }
      *(bf16x4*)(((u16*)(P.ws + OFF_br1)) + ((size_t)hb * HROWS + hrow0 + lrow) * 512 + h * 64 + pc) = pack4(o[0], o[1], o[2], o[3]);
    }
    ss += __shfl_xor(ss, 16);
    ss += __shfl_xor(ss, 32);
    if (fq == 0) ((float*)(P.ws + OFF_ssq))[((size_t)hb * HROWS + hrow0 + lrow) * 8 + h] = ss;
  }
}


DI void merge_tile(const Params& P, int l, int mt, int nt, char* smem) {
  const int row0 = mt * 128;
#pragma unroll 1
  for (int kq = 0; kq < 4; ++kq) {
    unsigned gp[4][4][2];
    {
      f32x4 g[4][4];
      zero_acc<4>(g);
      gemm_main<4, true, false, true>(((u16*)(P.ws + OFF_H)), DM, nullptr, row0, ((u16*)(P.ws + OFF_WgT)) + ((size_t)l * 4 + kq) * 1024 * 1024, 1024, nt * 128, 1024, g, (u16*)smem);
#pragma unroll
      for (int m = 0; m < 4; ++m)
#pragma unroll
        for (int n = 0; n < 4; ++n) {
          gp[m][n][0] = pack2(sigmoidf_(g[m][n][0]), sigmoidf_(g[m][n][1]));
          gp[m][n][1] = pack2(sigmoidf_(g[m][n][2]), sigmoidf_(g[m][n][3]));
        }
    }
    f32x4 bb[4][4];
    zero_acc<4>(bb);
    const u16* br = ((u16*)(P.ws + OFF_br0)) + (size_t)kq * (U_ / 2);
    gemm_main<4, true, false, false>(br, 512, nullptr, row0, ((u16*)(P.ws + OFF_WbT)) + ((size_t)l * 4 + kq) * 1024 * 512, 512, nt * 128, 512, bb, (u16*)smem);
    const int tid = TID(), wave = tid >> 6, lane = tid & 63, fr = lane & 15, fq = lane >> 4;
    const int wr = wave >> 1, wc = wave & 1;
#pragma unroll
    for (int m = 0; m < 4; ++m) {
      const int r = row0 + wr * 64 + m * 16 + fr;
      float rs = 1.f;
      if (kq == 1) {
        const float* sq = ((float*)(P.ws + OFF_ssq)) + (size_t)r * 8;
        float4 a = *(const float4*)sq, b = *(const float4*)(sq + 4);
        rs = rsqrtf((a.x + a.y + a.z + a.w + b.x + b.y + b.z + b.w) * (1.f / 512.f) + LN_EPS);
      }
#pragma unroll
      for (int n = 0; n < 4; ++n) {
        u32x2* dst = (u32x2*)(((u16*)(P.ws + OFF_acc)) + (size_t)r * DM + nt * 128 + wc * 64 + n * 16 + fq * 4);
        u32x2 prev = {0u, 0u};
        if (kq > 0) prev = *dst;
        const unsigned g0 = gp[m][n][0], g1 = gp[m][n][1];
        u32x2 o;
        o[0] = pack2(bflo(prev[0]) + bflo(g0) * bb[m][n][0] * rs, bfhi(prev[0]) + bfhi(g0) * bb[m][n][1] * rs);
        o[1] = pack2(bflo(prev[1]) + bflo(g1) * bb[m][n][2] * rs, bfhi(prev[1]) + bfhi(g1) * bb[m][n][3] * rs);
        *dst = o;
      }
    }
  }
}

DI void phase_merge(const Params& P, int l, char* smem, int ph) {
  const bool last = (l == 1);
  for (;;) {
    const int it = wq_next(wq_ctr(P, ph), smem);
    if (it >= 288 * 8) break;
    int mt = it / 8, nt = it % 8;
    if (last && (mt % 18) >= 16) continue;
    merge_tile(P, l, mt, nt, smem);
  }
}

DI void phase_outproj(const Params& P, int l, char* smem, int ph) {
  const bool last = (l == 1);
  const int tid = TID(), wave = tid >> 6, lane = tid & 63, fr = lane & 15, fq = lane >> 4;
  const int wr = wave >> 1, wc = wave & 1;
  for (;;) {
    const int it = wq_next(wq_ctr(P, ph), smem);
    if (it >= 288 * 8) break;
    int mt = it / 8, nt = it % 8;
    if (last && (mt % 18) >= 16) continue;
    f32x4 acc[4][4];
    zero_acc<4>(acc);
    gemm_main<4, true, false>(((u16*)(P.ws + OFF_acc)), DM, nullptr, mt * 128, ((u16*)(P.ws + OFF_WoT)) + (size_t)l * 1024 * 1024, 1024, nt * 128, 1024, acc, (u16*)smem);
#pragma unroll
    for (int m = 0; m < 4; ++m)
#pragma unroll
      for (int n = 0; n < 4; ++n) {
        int r = mt * 128 + wr * 64 + m * 16 + fr, c = nt * 128 + wc * 64 + n * 16 + fq * 4;
        *(bf16x4*)(((u16*)(P.ws + OFF_Y)) + (size_t)r * DM + c) = pack4v(acc[m][n]);
      }
  }
}

DI void phase_ffn1(const Params& P, int l, char* smem, int ph) {
  const bool last = (l == 1);
  const int tid = TID(), wave = tid >> 6, lane = tid & 63, fr = lane & 15, fq = lane >> 4;
  const int wr = wave >> 1, wc = wave & 1;
  const int nmt = last ? 512 : 576;
  for (;;) {
    const int it = wq_next(wq_ctr(P, ph), smem);
    if (it >= nmt * 8) break;
    int mt = it / 8, nt = it % 8;
    int R0 = mt * 128;
    int e = R0 < NFFN_LAT ? (R0 >> 8) & 15 : (R0 - NFFN_LAT) >> 9;
    f32x4 acc[4][4];
    zero_acc<4>(acc);
    gemm_main<4, true, true>(((u16*)(P.ws + OFF_H)), DM, ((int*)(P.ws + OFF_tokidx)), R0, ((u16*)(P.ws + OFF_W13T)) + (size_t)e * 1024 * 1024, 1024, nt * 128, 1024, acc, (u16*)smem);
#pragma unroll
    for (int m = 0; m < 4; ++m)
#pragma unroll
      for (int n2 = 0; n2 < 2; ++n2) {
        int r = R0 + wr * 64 + m * 16 + fr;
        int hc = (nt * 4 + wc * 2 + n2) * 16 + fq * 4;
        f32x4 a = acc[m][2 * n2], b = acc[m][2 * n2 + 1];
        *(bf16x4*)(((u16*)(P.ws + OFF_hid)) + (size_t)r * 512 + hc) = pack4(siluf_(a[0]) * b[0], siluf_(a[1]) * b[1], siluf_(a[2]) * b[2], siluf_(a[3]) * b[3]);
      }
  }
}

DI void phase_ffn2(const Params& P, int l, char* smem, int ph) {
  const bool last = (l == 1);
  const int tid = TID(), wave = tid >> 6, lane = tid & 63, fr = lane & 15, fq = lane >> 4;
  const int wr = wave >> 1, wc = wave & 1;
  const int nmt = last ? 512 : 576;
  for (;;) {
    const int it = wq_next(wq_ctr(P, ph), smem);
    if (it >= nmt * 8) break;
    int mt = it / 8, nt = it % 8;
    int R0 = mt * 128;
    int e = R0 < NFFN_LAT ? (R0 >> 8) & 15 : (R0 - NFFN_LAT) >> 9;
    f32x4 acc[4][4];
    zero_acc<4>(acc);
    gemm_main<4, true, false>(((u16*)(P.ws + OFF_hid)), 512, nullptr, R0, ((u16*)(P.ws + OFF_W2T)) + (size_t)e * 1024 * 512, 512, nt * 128, 512, acc, (u16*)smem);
#pragma unroll
    for (int m = 0; m < 4; ++m) {
      int r = R0 + wr * 64 + m * 16 + fr;
      float gt = ((float*)(P.ws + OFF_gatev))[r];
#pragma unroll
      for (int n = 0; n < 4; ++n) {
        int c = nt * 128 + wc * 64 + n * 16 + fq * 4;
        f32x4 v = acc[m][n];
        *(bf16x4*)(((u16*)(P.ws + OFF_ye)) + (size_t)r * DM + c) = pack4(v[0] * gt, v[1] * gt, v[2] * gt, v[3] * gt);
      }
    }
  }
}

DI void phase_mix2(const Params& P, int l, int hb, char* smem, int ph) {
  const bool last = (l == 1);
  const int nG = 576, nA = 576, nS = 1152, nP = 576;
  for (;;) {
    const int it = wq_next(wq_ctr(P, ph), smem);
    if (it >= nA + nG + nS + nP) break;
    if (it < nG) {
      const int mt = it >> 2, g = it & 3;
      if (last && (mt % 18) >= 16) continue;
      sgu_item(P, l, hb, mt, g, smem);
    } else if (it < nG + nA) {
      const int ia = it - nG;
      if (last && ia >= 512) continue;
      attn_item(P, l, hb, ia, smem);
    } else if (it < nA + nG + nS) {
      ssd_state_item(P, l, hb, it - nA - nG, smem);
    } else {
      const int t = it - nA - nG - nS;
      const int mt = t >> 2, g = t & 3;
      if (last && (mt % 18) >= 16) continue;
      pool_item(P, l, hb, mt, g, smem);
    }
  }
}

DI void phase_ssd_out(const Params& P, int l, int hb, char* smem, int ph) {
  const bool last = (l == 1);
  for (;;) {
    const int it = wq_next(wq_ctr(P, ph), smem);
    if (it >= 8 * 18 * 8) break;
    int jp = (it >> 3) % 18;
    if (last && jp >= 16) continue;
    ssd_out_item(P, l, hb, it, smem);
  }
}

#define XB_TMO      128
#define XB_XCNT(j)  (256  + 64 * (j))
#define XB_XSUB(j)  (1280 + 64 * (j))
#define XB_XGEN(j)  (2304 + 64 * (j))
#define XB_TOP      3328
#define XB_TOPGEN   3392
#define XCD_BAR_WORDS 3456
#define XB_SPIN_CAP (1u << 18)
#define LAS __attribute__((address_space(3)))

__device__ __forceinline__ unsigned xb_ld(unsigned* p)              { return __hip_atomic_load(p, __ATOMIC_RELAXED, __HIP_MEMORY_SCOPE_AGENT); }
__device__ __forceinline__ unsigned xb_add(unsigned* p, unsigned v) { return __hip_atomic_fetch_add(p, v, __ATOMIC_RELAXED, __HIP_MEMORY_SCOPE_AGENT); }
__device__ __forceinline__ unsigned xb_xcc_id() { return (unsigned)__builtin_amdgcn_s_getreg((3 << 11) | 20) & 0xFu; }
#define XB_SPIN(cond, bar) do { unsigned _sp = 0; while (cond) { __builtin_amdgcn_s_sleep(1); \
    if ((++_sp & 255u) == 0u) { if (xb_ld(&(bar)[XB_TMO])) break; if (_sp > XB_SPIN_CAP) { atomicAdd(&(bar)[XB_TMO], 1u); break; } } } } while (0)

struct XcdBarrier {
    unsigned* bar; unsigned x;
    volatile LAS unsigned* st;
};

__device__ __forceinline__ XcdBarrier xcd_barrier_post(unsigned* bar, volatile LAS unsigned* st) {
    XcdBarrier b; b.bar = bar; b.x = xb_xcc_id(); b.st = st;
    if (threadIdx.x == 0) (void)xb_add(&bar[XB_XCNT(b.x)], 1u);
    return b;
}
__device__ __forceinline__ void xcd_barrier_complete(unsigned* bar, unsigned x, unsigned& nloc, unsigned& nx) {
    const unsigned G = gridDim.x * gridDim.y * gridDim.z;
    unsigned sum, cnt, mine, sp = 0u;
    for (;;) {
        sum = 0u; cnt = 0u; mine = 0u;
#pragma unroll
        for (unsigned j = 0; j < 16; ++j) { const unsigned c = xb_ld(&bar[XB_XCNT(j)]); sum += c; cnt += (c > 0u) ? 1u : 0u; mine = (j == x) ? c : mine; }
        if (sum == G) break;
        __builtin_amdgcn_s_sleep(1);
        if ((++sp & 255u) == 0u) { if (xb_ld(&bar[XB_TMO])) break; if (sp > XB_SPIN_CAP) { atomicAdd(&bar[XB_TMO], 1u); break; } }
    }
    nloc = mine > 0u ? mine : 1u; nx = cnt > 0u ? cnt : 1u;
}

__device__ __forceinline__ void xcd_barrier(const XcdBarrier& b) {
    asm volatile("s_waitcnt vmcnt(0)" ::: "memory");
    __syncthreads();
    if (threadIdx.x == 0) {
        unsigned* bar = b.bar;
        __builtin_amdgcn_s_waitcnt(0);
        unsigned nloc = b.st[0], nx = b.st[1];
        if (nloc == 0u) { xcd_barrier_complete(bar, b.x, nloc, nx); b.st[0] = nloc; b.st[1] = nx; }
        const unsigned old = xb_add(&bar[XB_XSUB(b.x)], 1u);
        const unsigned gen = old / nloc;
        if (old + 1u == (gen + 1u) * nloc) {
            __builtin_amdgcn_fence(__ATOMIC_RELEASE, "agent");
            asm volatile("s_waitcnt vmcnt(0)" ::: "memory");
            const unsigned og = xb_add(&bar[XB_TOP], 1u);
            const unsigned tg = og / nx;
            if (og + 1u == (tg + 1u) * nx) xb_add(&bar[XB_TOPGEN], 1u);
            else XB_SPIN(xb_ld(&bar[XB_TOPGEN]) == tg, bar);
            __builtin_amdgcn_fence(__ATOMIC_ACQUIRE, "agent");
            xb_add(&bar[XB_XGEN(b.x)], 1u);
            asm volatile("s_waitcnt vmcnt(0)" ::: "memory");
        } else {
            XB_SPIN(xb_ld(&bar[XB_XGEN(b.x)]) == gen, bar);
            __builtin_amdgcn_fence(__ATOMIC_ACQUIRE, "agent");
            asm volatile("s_waitcnt vmcnt(0)" ::: "memory");
        }
    }
    __syncthreads();
}


template <bool COOP>
__global__ void __launch_bounds__(256, 2) mk_forward(Params P, int ph_begin, int ph_end) {
  __shared__ __attribute__((aligned(16))) char smem[SMEM_BYTES];
  int ph = 0;
  volatile LAS unsigned* xbst = (volatile LAS unsigned*)(smem + SMEM_BYTES - 16);
  XcdBarrier xb;
  if (COOP) {
    if (__builtin_amdgcn_workitem_id_x() == 0) { xbst[0] = 0u; xbst[1] = 0u; xbst[2] = 0u; xbst[3] = 0u; }
    __syncthreads();
    xb = xcd_barrier_post((unsigned*)(P.ws + OFF_bar), xbst);
  }
#define PHASE(code)                                         \
  {                                                         \
    if (ph >= ph_begin && ph < ph_end) { code; }            \
    ++ph;                                                   \
    if (COOP && ph > ph_begin && ph < ph_end) {             \
      if (ph == 1) cg::this_grid().sync();                  \
      else xcd_barrier(xb);                                 \
    }                                                       \
  }
  PHASE(phase_prologue(P, smem));
  PHASE(phase_h0(P));
#pragma unroll 1
  for (int l = 0; l < 2; ++l) {
#pragma unroll 1
    for (int hb = 0; hb < 2; ++hb) {
      PHASE(phase_proj(P, l, hb, smem, ph));
      PHASE(phase_ssd_prep(P, l, hb, smem, ph));
      PHASE(phase_mix2(P, l, hb, smem, ph));
      PHASE(phase_carry(P));
      PHASE(phase_ssd_out(P, l, hb, smem, ph));
    }
    PHASE(phase_merge(P, l, smem, ph));
    PHASE(phase_outproj(P, l, smem, ph));
    PHASE(phase_ln1(P, l, smem));
    PHASE(phase_topk(P, l, smem));
    PHASE(phase_ffn1(P, l, smem, ph));
    PHASE(phase_ffn2(P, l, smem, ph));
    PHASE(phase_ln2(P, l));
  }
#undef PHASE
}

#ifndef MK_COOP
#define MK_COOP 1
#endif

extern "C" void kernel_launch(void* const* d_in, const int* in_sizes, int n_in, void* d_out, int out_size, void* d_ws, size_t ws_size,
                              hipStream_t stream) {
  Params p{};
  const float* const* in = (const float* const*)d_in;
  p.x = in[0]; p.c = in[1]; p.ctx = in[2]; p.c_ctx = in[3]; p.w_mod = in[4]; p.b_mod = in[5]; p.w_in = in[6]; p.conv_w = in[7];
  p.conv_b = in[8]; p.a_log = in[9]; p.dt_bias = in[10]; p.ssd_d = in[11]; p.ssd_norm_g = in[12]; p.diff_lambda = in[13];
  p.diff_norm_g = in[14]; p.pool_w = in[15]; p.pool_scale = in[16]; p.sgu_ln_g = in[17]; p.sgu_ln_b = in[18]; p.sgu_w = in[19];
  p.sgu_b = in[20]; p.w_gate = in[21]; p.w_branch = in[22]; p.w_out = in[23]; p.ln1_g = in[24]; p.ln1_b = in[25]; p.w_router = in[26];
  p.w1 = in[27]; p.w3 = in[28]; p.w2 = in[29]; p.ln2_g = in[30]; p.ln2_b = in[31];
  p.out = (float*)d_out;
  p.ws = (char*)d_ws;
  if (WS_NEED > ws_size) { fprintf(stderr, "workspace too small: need %zu have %zu\n", (size_t)WS_NEED, ws_size); return; }

  static int grid_blocks = 0;
  if (!grid_blocks) {
    int dev = 0, cus = 0, per_cu = 0;
    hipGetDevice(&dev);
    hipDeviceGetAttribute(&cus, hipDeviceAttributeMultiprocessorCount, dev);
    (void)hipOccupancyMaxActiveBlocksPerMultiprocessor(&per_cu, mk_forward<(MK_COOP != 0)>, 256, 0);
    if (per_cu < 1) per_cu = 1;
    if (per_cu > 2) per_cu = 2;
    grid_blocks = cus * per_cu;
  }
#if MK_COOP
  hipMemsetAsync((char*)d_ws + OFF_bar, 0, 32768, stream);
  int b = 0, e = NPHASE;
  void* args[] = {&p, &b, &e};
  hipError_t err = hipLaunchCooperativeKernel((void*)mk_forward<true>, dim3(grid_blocks), dim3(256), args, 0, stream);
  if (err != hipSuccess) fprintf(stderr, "cooperative launch failed: %s (grid %d)\n", hipGetErrorString(err), grid_blocks);
#else
  for (int ph = 0; ph < NPHASE; ++ph) hipLaunchKernelGGL(mk_forward<false>, dim3(grid_blocks), dim3(256), 0, stream, p, ph, ph + 1);
#endif
}
```

```cpp
#include <hip/hip_runtime.h>
#include <hip/hip_cooperative_groups.h>
#include <cstdio>
#include <cstdint>
namespace cg = cooperative_groups;

typedef unsigned short u16;
using bf16x8 = __attribute__((ext_vector_type(8))) short;
using bf16x4 = __attribute__((ext_vector_type(4))) short;
using f32x4 = __attribute__((ext_vector_type(4))) float;
using u32x4 = __attribute__((ext_vector_type(4))) unsigned;

#define DI __device__ __forceinline__
#define MFMA16(a, b, c) __builtin_amdgcn_mfma_f32_16x16x32_bf16((a), (b), (c), 0, 0, 0)

constexpr int NB = 16, SEQ = 2048, CTXL = 256, SP = 2304, NTOK = NB * SP, DM = 1024;
constexpr int HROWS = 8 * SP;
constexpr int INC = 4368, INP = 4480;
constexpr int NFFN_LAT = 65536, NFFN_ALL = 73728;
constexpr float LN_EPS = 1e-5f;
constexpr float ALPHA = 1.41421356237309515f;
constexpr int SMEM_BYTES = 81920;
constexpr int NPHASE = 2 + 2 * (2 * 4 + 7);


constexpr size_t al256(size_t x) { return (x + 255) & ~(size_t)255; }
constexpr size_t U_ = (size_t)NTOK * 512 * 2;
constexpr size_t OFF_WinT = 0;
constexpr size_t OFF_WgT = OFF_WinT + al256((size_t)2 * INP * 1024 * 2);
constexpr size_t OFF_WbT = OFF_WgT + al256((size_t)2 * 4 * 1024 * 1024 * 2);
constexpr size_t OFF_WoT = OFF_WbT + al256((size_t)2 * 4 * 1024 * 512 * 2);
constexpr size_t OFF_poolT = OFF_WoT + al256((size_t)2 * 1024 * 1024 * 2);
constexpr size_t OFF_sguW = OFF_poolT + al256((size_t)2 * 4 * 128 * 128 * 2);
constexpr size_t OFF_mod = OFF_sguW + al256((size_t)2 * 4 * 128 * 128 * 2);
constexpr size_t OFF_rope = OFF_mod + al256((size_t)2 * 17 * 6144 * 4);
constexpr size_t OFF_lamv = OFF_rope + al256(64 * 16 * 2 * 4);
constexpr size_t OFF_bar = OFF_lamv + 256;
constexpr size_t OFF_aff = OFF_bar + 32768;
constexpr size_t OFF_rank = OFF_aff + al256((size_t)NTOK * 16 * 4);
constexpr size_t OFF_ssq = OFF_rank + al256((size_t)NTOK * 16 * 4);
constexpr size_t OFF_tokidx = OFF_ssq + al256((size_t)NTOK * 8 * 4);
constexpr size_t OFF_gatev = OFF_tokidx + al256((size_t)NFFN_ALL * 4);
constexpr size_t OFF_dtbuf = OFF_gatev + al256((size_t)NFFN_ALL * 4);
constexpr size_t OFF_decay = OFF_dtbuf + al256((size_t)HROWS * 16 * 4);
constexpr size_t OFF_H = OFF_decay + al256((size_t)8 * 2 * 8 * 18 * 4);
constexpr size_t OFF_Y = OFF_H + 2 * U_;
constexpr size_t OFF_xsT = OFF_Y;
constexpr size_t OFF_cstate = OFF_Y + U_ / 2;
constexpr size_t OFF_enter = OFF_Y + U_;
constexpr size_t OFF_bm = OFF_Y + U_ + U_ / 2;
constexpr size_t OFF_cm = OFF_bm + U_ / 8;
constexpr size_t OFF_bmT = OFF_cm + U_ / 8;
constexpr size_t OFF_RM = OFF_Y + 2 * U_;
constexpr size_t OFF_xp = OFF_RM;
constexpr size_t OFF_z = OFF_xp + U_ / 2;
constexpr size_t OFF_xbc = OFF_z + U_ / 2;
constexpr size_t OFF_o1 = OFF_xbc;
constexpr size_t OFF_q = OFF_xbc + (U_ / 4) * 3;
constexpr size_t OFF_k = OFF_q + U_ / 2;
constexpr size_t OFF_vT = OFF_k + U_ / 2;
constexpr size_t OFF_gvT = OFF_vT + U_ / 2;
constexpr size_t OFF_br0 = OFF_gvT + U_ / 2;
constexpr size_t OFF_br1 = OFF_br0 + U_;
constexpr size_t OFF_br2 = OFF_br1 + U_;
constexpr size_t OFF_br3 = OFF_br2 + U_;
constexpr size_t OFF_acc = OFF_RM;
constexpr size_t OFF_W13T = OFF_RM;
constexpr size_t OFF_W2T = OFF_W13T + (size_t)16 * 1024 * 1024 * 2;
constexpr size_t OFF_hid = OFF_W2T + (size_t)16 * 1024 * 512 * 2;
constexpr size_t OFF_ye = OFF_hid + (size_t)NFFN_ALL * 512 * 2;
constexpr size_t WS_MIX_END = OFF_br3 + U_;
constexpr size_t WS_FFN_END = OFF_ye + (size_t)NFFN_ALL * 1024 * 2;
constexpr size_t WS_NEED = WS_MIX_END > WS_FFN_END ? WS_MIX_END : WS_FFN_END;

struct Params {
  const float *x, *c, *ctx, *c_ctx, *w_mod, *b_mod, *w_in, *conv_w, *conv_b, *a_log, *dt_bias, *ssd_d, *ssd_norm_g,
      *diff_lambda, *diff_norm_g, *pool_w, *pool_scale, *sgu_ln_g, *sgu_ln_b, *sgu_w, *sgu_b, *w_gate, *w_branch, *w_out,
      *ln1_g, *ln1_b, *w_router, *w1, *w3, *w2, *ln2_g, *ln2_b;
  float* out;
  char* ws;
};

DI int TID() { int t = (int)__builtin_amdgcn_workitem_id_x(); asm volatile("" : "+v"(t)); return t; }
typedef __bf16 bf2_t __attribute__((ext_vector_type(2)));
typedef float f2_t __attribute__((ext_vector_type(2)));
typedef unsigned u32x2 __attribute__((ext_vector_type(2)));
DI unsigned pack2(float a, float b) { f2_t v = {a, b}; return __builtin_bit_cast(unsigned, __builtin_convertvector(v, bf2_t)); }
DI u16 f2bf(float x) { return (u16)(pack2(x, 0.f) & 0xffffu); }
DI float bf2f(u16 v) { return __uint_as_float(((unsigned)v) << 16); }
DI float bflo(unsigned p) { return __uint_as_float(p << 16); }
DI float bfhi(unsigned p) { return __uint_as_float(p & 0xffff0000u); }
DI float sigmoidf_(float x) { return __builtin_amdgcn_rcpf(1.f + __expf(-x)); }
DI float siluf_(float x) { return x * __builtin_amdgcn_rcpf(1.f + __expf(-x)); }
DI float geluf_(float x) { float y = 0.7978845608028654f * (x + 0.044715f * x * x * x); float t = 1.f - 2.f * __builtin_amdgcn_rcpf(__expf(2.f * y) + 1.f); return 0.5f * x * (1.f + t); }
DI float softplusf_(float x) { return x > 20.f ? x : log1pf(__expf(x)); }
DI bf16x4 pack4(float a, float b, float c, float d) { u32x2 r = {pack2(a, b), pack2(c, d)}; return __builtin_bit_cast(bf16x4, r); }
DI bf16x4 pack4v(f32x4 v) { return pack4(v[0], v[1], v[2], v[3]); }
DI float wave_sum(float v) { for (int o = 32; o > 0; o >>= 1) v += __shfl_xor(v, o); return v; }

template <int MI, int NI, bool SWAP, bool LOWREG = false>
DI void mma_lds(const u16* As, int lda, const u16* Bs, int ldb, int ksteps, f32x4 (&acc)[MI][NI], int fr, int fq) {
  for (int ks = 0; ks < ksteps; ++ks) {
    if (LOWREG) __builtin_amdgcn_sched_barrier(0);
    bf16x8 a[MI], b[NI];
#pragma unroll
    for (int m = 0; m < MI; ++m) a[m] = *(const bf16x8*)(As + (m * 16 + fr) * lda + ks * 32 + fq * 8);
#pragma unroll
    for (int n = 0; n < NI; ++n) b[n] = *(const bf16x8*)(Bs + (n * 16 + fr) * ldb + ks * 32 + fq * 8);
#pragma unroll
    for (int m = 0; m < MI; ++m)
#pragma unroll
      for (int n = 0; n < NI; ++n) acc[m][n] = SWAP ? MFMA16(b[n], a[m], acc[m][n]) : MFMA16(a[m], b[n], acc[m][n]);
  }
}

constexpr int LDT = 72;
template <int NI, bool SWAP, bool GATHER, bool PF2 = true>
DI void gemm_main(const u16* __restrict__ A, int lda, const int* __restrict__ aidx, int arow0, const u16* __restrict__ Bt, int ldb, int brow0,
                  int K, f32x4 (&acc)[4][NI], u16* smem) {
  constexpr int BN = NI * 32;
  constexpr int NBL = BN / 32;
  const int tid = TID(), wave = tid >> 6, lane = tid & 63, fr = lane & 15, fq = lane >> 4;
  const int wr = wave >> 1, wc = wave & 1;
  u16* As = smem;
  u16* Bs = smem + 2 * 128 * LDT;
  const int lr = tid >> 3, lc = (tid & 7) * 8;
  const u16* ap[4];
#pragma unroll
  for (int i = 0; i < 4; ++i) {
    int r = arow0 + lr + 32 * i;
    size_t rr = GATHER ? (size_t)aidx[r] : (size_t)r;
    ap[i] = A + rr * lda + lc;
  }
  const u16* bp = Bt + (size_t)(brow0 + lr) * ldb + lc;
  u32x4 ra0[4], rb0[NBL], ra1[4], rb1[NBL];
  const int nk = K / 64;
#define GLOAD(RA, RB, KO)                                                                   \
  {                                                                                         \
    _Pragma("unroll") for (int i = 0; i < 4; ++i) RA[i] = *(const u32x4*)(ap[i] + (KO));    \
    _Pragma("unroll") for (int i = 0; i < NBL; ++i) RB[i] = *(const u32x4*)(bp + (size_t)(32 * i) * ldb + (KO)); \
  }
#define SSTORE_A(RA, BUF) { _Pragma("unroll") for (int i = 0; i < 4; ++i) *(u32x4*)(As + (BUF) * 128 * LDT + (lr + 32 * i) * LDT + lc) = RA[i]; }
#define SSTORE_B(RB, BUF) { _Pragma("unroll") for (int i = 0; i < NBL; ++i) *(u32x4*)(Bs + (BUF) * BN * LDT + (lr + 32 * i) * LDT + lc) = RB[i]; }
#define SSTORE(RA, RB, BUF) { SSTORE_A(RA, BUF) SSTORE_B(RB, BUF) }
#define COMPUTE(BUF) mma_lds<4, NI, SWAP, !PF2>(As + (BUF) * 128 * LDT + wr * 64 * LDT, LDT, Bs + (BUF) * BN * LDT + wc * (NI * 16) * LDT, LDT, 2, acc, fr, fq)
#define COMPUTE_KS(BUF, KS) mma_lds<4, NI, SWAP, false>(As + (BUF) * 128 * LDT + wr * 64 * LDT + (KS) * 32, LDT, Bs + (BUF) * BN * LDT + wc * (NI * 16) * LDT + (KS) * 32, LDT, 1, acc, fr, fq)
  if (PF2) {
    GLOAD(ra0, rb0, 0);
    GLOAD(ra1, rb1, 64);
    __syncthreads();
    SSTORE(ra0, rb0, 0);
    __syncthreads();
    for (int kt = 0; kt < nk; kt += 2) {
      __builtin_amdgcn_iglp_opt(0);
      if (kt + 2 < nk) GLOAD(ra0, rb0, (kt + 2) * 64);
      COMPUTE_KS(0, 0);
      SSTORE_A(ra1, 1);
      COMPUTE_KS(0, 1);
      SSTORE_B(rb1, 1);
      __syncthreads();
      if (kt + 3 < nk) GLOAD(ra1, rb1, (kt + 3) * 64);
      COMPUTE_KS(1, 0);
      if (kt + 2 < nk) SSTORE_A(ra0, 0);
      COMPUTE_KS(1, 1);
      if (kt + 2 < nk) SSTORE_B(rb0, 0);
      __syncthreads();
    }
  } else {
    GLOAD(ra0, rb0, 0);
    __syncthreads();
    SSTORE(ra0, rb0, 0);
    __syncthreads();
    for (int kt = 0; kt < nk; kt += 2) {
      GLOAD(ra0, rb0, (kt + 1) * 64);
      COMPUTE(0);
      SSTORE(ra0, rb0, 1);
      __syncthreads();
      if (kt + 2 < nk) GLOAD(ra0, rb0, (kt + 2) * 64);
      COMPUTE(1);
      if (kt + 2 < nk) SSTORE(ra0, rb0, 0);
      __syncthreads();
    }
  }
#undef GLOAD
#undef SSTORE
#undef COMPUTE
#undef COMPUTE_KS
#undef SSTORE_A
#undef SSTORE_B
}

template <int NI> DI void zero_acc(f32x4 (&a)[4][NI]) {
#pragma unroll
  for (int m = 0; m < 4; ++m)
#pragma unroll
    for (int n = 0; n < NI; ++n) a[m][n] = f32x4{0.f, 0.f, 0.f, 0.f};
}

DI void cvt_tile(const float* __restrict__ src0, const float* __restrict__ src1, int ld, u16* __restrict__ dst, int K, int n0, int k0, int mode, u16* lds) {
  const int tid = TID();
  constexpr int LC = 66;
  __syncthreads();
  float v[16];
  if (mode == 3) {
#pragma unroll
    for (int i = 0; i < 16; ++i) { int idx = tid + 256 * i; int n = idx >> 6, kk = idx & 63; v[i] = src0[(size_t)(n0 + n) * ld + k0 + kk]; }
#pragma unroll
    for (int i = 0; i < 16; ++i) { int idx = tid + 256 * i; int n = idx >> 6, kk = idx & 63; lds[kk * LC + n] = f2bf(v[i]); }
  } else {
#pragma unroll
    for (int i = 0; i < 16; ++i) {
      int idx = tid + 256 * i;
      int kk = idx >> 6, n = idx & 63;
      int nn = n0 + n;
      float t = 0.f;
      if (mode == 0) t = src0[(size_t)(k0 + kk) * ld + nn];
      else if (mode == 1) {
        int col = nn < 1792 ? nn : (nn < 4352 ? nn + 16 : (nn < 4368 ? nn - 4352 + 1792 : -1));
        if (col >= 0) t = src0[(size_t)(k0 + kk) * ld + col];
        if (nn >= 1792 && nn < 2304) t *= 0.125f;
      } else {
        int g = nn >> 5, r = nn & 31;
        t = (r < 16) ? src0[(size_t)(k0 + kk) * ld + g * 16 + r] : src1[(size_t)(k0 + kk) * ld + g * 16 + r - 16];
      }
      v[i] = t;
    }
#pragma unroll
    for (int i = 0; i < 16; ++i) { int idx = tid + 256 * i; int kk = idx >> 6, n = idx & 63; lds[kk * LC + n] = f2bf(v[i]); }
  }
  __syncthreads();
  for (int c = tid; c < 512; c += 256) {
    int n = c & 63, kc = (c >> 6) * 8;
    bf16x8 o;
#pragma unroll
    for (int j = 0; j < 8; ++j) o[j] = (short)lds[(kc + j) * LC + n];
    *(bf16x8*)(dst + (size_t)(n0 + n) * K + k0 + kc) = o;
  }
}

DI void mod_item(const Params& P, int item, char* smem) {
  const int l = item / 96, n0 = (item % 96) * 64;
  float* sc = (float*)smem;
  const int tid = TID();
  __syncthreads();
  for (int i = tid; i < 17 * 1024; i += 256) {
    int s = i >> 10, kk = i & 1023;
    float v = s < 16 ? P.c[s * 1024 + kk] : P.c_ctx[kk];
    sc[i] = siluf_(v);
  }
  __syncthreads();
  const int col = tid & 63, kp = tid >> 6;
  float a[17];
#pragma unroll
  for (int s = 0; s < 17; ++s) a[s] = 0.f;
  const float* w = P.w_mod + (size_t)l * 1024 * 6144 + n0 + col;
  for (int k0 = kp * 256; k0 < kp * 256 + 256; k0 += 16) {
    float wv[16];
#pragma unroll
    for (int u = 0; u < 16; ++u) wv[u] = w[(size_t)(k0 + u) * 6144];
#pragma unroll
    for (int u = 0; u < 16; ++u)
#pragma unroll
      for (int s = 0; s < 17; ++s) a[s] += sc[s * 1024 + k0 + u] * wv[u];
  }
  __syncthreads();
  float* red = (float*)smem;
#pragma unroll
  for (int s = 0; s < 17; ++s) red[(kp * 17 + s) * 64 + col] = a[s];
  __syncthreads();
  for (int i = tid; i < 17 * 64; i += 256) {
    int s = i >> 6, cc = i & 63;
    float v = red[(0 * 17 + s) * 64 + cc] + red[(1 * 17 + s) * 64 + cc] + red[(2 * 17 + s) * 64 + cc] + red[(3 * 17 + s) * 64 + cc];
    ((float*)(P.ws + OFF_mod))[((size_t)l * 17 + s) * 6144 + n0 + cc] = v + P.b_mod[l * 6144 + n0 + cc];
  }
}

DI void misc_item(const Params& P) {
  const int tid = TID();
  for (int i = tid; i < 1024; i += 256) {
    int pos = i >> 4, f = i & 15;
    float inv = powf(10000.f, -(float)f / 16.f);
    float ang = (float)pos * inv;
    ((float*)(P.ws + OFF_rope))[i * 2] = cosf(ang);
    ((float*)(P.ws + OFF_rope))[i * 2 + 1] = sinf(ang);
  }
  if (tid < 2) {
    const float* dl = P.diff_lambda + tid * 256;
    float s1 = 0.f, s2 = 0.f;
    for (int i = 0; i < 64; ++i) { s1 += dl[i] * dl[64 + i]; s2 += dl[128 + i] * dl[192 + i]; }
    float lam_init = 0.8f - 0.6f * expf(-0.3f * (float)tid);
    ((float*)(P.ws + OFF_lamv))[tid * 2] = expf(s1) - expf(s2) + lam_init;
    ((float*)(P.ws + OFF_lamv))[tid * 2 + 1] = lam_init;
  }
}

DI void phase_prologue(const Params& P, char* smem) {
  const int per_layer = 1120 + 4 * 256 + 4 * 128 + 256 + 16 + 16;
  const int ncvt = 2 * per_layer;
  const int total = ncvt + 192 + 1;
  for (int it0 = blockIdx.x; it0 < total; it0 += gridDim.x) {
    const int it = it0 < 193 ? ncvt + it0 : it0 - 193;
    if (it < ncvt) {
      const int l = it / per_layer;
      int t = it % per_layer;
      const float* s0; u16* dst; int ld, K, ntk, mode;
      if (t < 1120) { s0 = P.w_in + (size_t)l * 1024 * INC; ld = INC; dst = ((u16*)(P.ws + OFF_WinT)) + (size_t)l * INP * 1024; K = 1024; ntk = 16; mode = 1; }
      else if (t < 2144) { t -= 1120; int kq = t >> 8; t &= 255; s0 = P.w_gate + ((size_t)l * 4 + kq) * 1024 * 1024; ld = 1024; dst = ((u16*)(P.ws + OFF_WgT)) + ((size_t)l * 4 + kq) * 1024 * 1024; K = 1024; ntk = 16; mode = 0; }
      else if (t < 2656) { t -= 2144; int kq = t >> 7; t &= 127; s0 = P.w_branch + ((size_t)l * 4 + kq) * 512 * 1024; ld = 1024; dst = ((u16*)(P.ws + OFF_WbT)) + ((size_t)l * 4 + kq) * 1024 * 512; K = 512; ntk = 8; mode = 0; }
      else if (t < 2912) { t -= 2656; s0 = P.w_out + (size_t)l * 1024 * 1024; ld = 1024; dst = ((u16*)(P.ws + OFF_WoT)) + (size_t)l * 1024 * 1024; K = 1024; ntk = 16; mode = 0; }
      else if (t < 2928) { t -= 2912; int g = t >> 2; t &= 3; s0 = P.pool_w + ((size_t)l * 4 + g) * 128 * 128; ld = 128; dst = ((u16*)(P.ws + OFF_poolT)) + ((size_t)l * 4 + g) * 128 * 128; K = 128; ntk = 2; mode = 0; }
      else { t -= 2928; int g = t >> 2; t &= 3; s0 = P.sgu_w + ((size_t)l * 4 + g) * 128 * 128; ld = 128; dst = ((u16*)(P.ws + OFF_sguW)) + ((size_t)l * 4 + g) * 128 * 128; K = 128; ntk = 2; mode = 3; }
      const int tn = t / ntk, tk = t % ntk;
      cvt_tile(s0, s0, ld, dst, K, tn * 64, tk * 64, mode, (u16*)smem);
    } else if (it < ncvt + 192) {
      mod_item(P, it - ncvt, smem);
    } else {
      misc_item(P);
    }
  }
}

DI void ffn_cvt_item(const Params& P, int l, int it, char* smem) {
  const int e = it / 384;
  int t = it % 384;
  if (t < 256) {
    cvt_tile(P.w1 + ((size_t)l * 16 + e) * 1024 * 512, P.w3 + ((size_t)l * 16 + e) * 1024 * 512, 512, ((u16*)(P.ws + OFF_W13T)) + (size_t)e * 1024 * 1024, 1024, (t >> 4) * 64, (t & 15) * 64, 2, (u16*)smem);
  } else {
    t -= 256;
    const float* s = P.w2 + ((size_t)l * 16 + e) * 512 * 1024;
    cvt_tile(s, s, 1024, ((u16*)(P.ws + OFF_W2T)) + (size_t)e * 1024 * 512, 512, (t >> 3) * 64, (t & 7) * 64, 0, (u16*)smem);
  }
}

DI void load_row_f32(const float* p, int lane, float (&v)[16]) {
#pragma unroll
  for (int k = 0; k < 4; ++k) { float4 t = *(const float4*)(p + lane * 4 + 256 * k); v[4 * k] = t.x; v[4 * k + 1] = t.y; v[4 * k + 2] = t.z; v[4 * k + 3] = t.w; }
}
DI void load_row_bf16(const u16* p, int lane, float (&v)[16]) {
#pragma unroll
  for (int k = 0; k < 4; ++k) { bf16x4 t = *(const bf16x4*)(p + lane * 4 + 256 * k); for (int i = 0; i < 4; ++i) v[4 * k + i] = bf2f((u16)t[i]); }
}
DI void store_row_f32(float* p, int lane, const float (&v)[16]) {
#pragma unroll
  for (int k = 0; k < 4; ++k) *(float4*)(p + lane * 4 + 256 * k) = make_float4(v[4 * k], v[4 * k + 1], v[4 * k + 2], v[4 * k + 3]);
}
DI void store_row_bf16(u16* p, int lane, const float (&v)[16]) {
#pragma unroll
  for (int k = 0; k < 4; ++k) *(bf16x4*)(p + lane * 4 + 256 * k) = pack4(v[4 * k], v[4 * k + 1], v[4 * k + 2], v[4 * k + 3]);
}
DI void ln_row(float (&v)[16], const float* g, const float* b, int lane) {
  float s = 0.f;
#pragma unroll
  for (int i = 0; i < 16; ++i) s += v[i];
  float mu = wave_sum(s) * (1.f / 1024.f);
  float q = 0.f;
#pragma unroll
  for (int i = 0; i < 16; ++i) { float d = v[i] - mu; q += d * d; }
  float rstd = rsqrtf(wave_sum(q) * (1.f / 1024.f) + LN_EPS);
  float gg[16], bb[16];
  load_row_f32(g, lane, gg); load_row_f32(b, lane, bb);
#pragma unroll
  for (int i = 0; i < 16; ++i) v[i] = (v[i] - mu) * rstd * gg[i] + bb[i];
}

DI void phase_h0(const Params& P) {
  const int lane = TID() & 63;
  const int gw = blockIdx.x * 4 + (TID() >> 6), nw = gridDim.x * 4;
  for (int row = gw; row < NTOK; row += nw) {
    int s = row / SP, p = row % SP;
    bool lat = p < SEQ;
    const float* xs = lat ? P.x + ((size_t)s * SEQ + p) * DM : P.ctx + ((size_t)s * CTXL + (p - SEQ)) * DM;
    const float* md = ((float*)(P.ws + OFF_mod)) + (size_t)(lat ? s : 16) * 6144;
    float v[16], sh[16], scl[16];
    load_row_f32(xs, lane, v); load_row_f32(md, lane, sh); load_row_f32(md + 1024, lane, scl);
#pragma unroll
    for (int i = 0; i < 16; ++i) v[i] = v[i] * (1.f + scl[i]) + sh[i];
    store_row_bf16(((u16*)(P.ws + OFF_H)) + (size_t)row * DM, lane, v);
  }
}

DI void compute_x1(const Params& P, int l, int row, int lane, float (&v)[16]) {
  int s = row / SP, p = row % SP;
  bool lat = p < SEQ;
  const float* xs;
  if (l == 0) xs = lat ? P.x + ((size_t)s * SEQ + p) * DM : P.ctx + ((size_t)s * CTXL + (p - SEQ)) * DM;
  else xs = P.out + ((size_t)s * SEQ + p) * DM;
  const float* md = ((float*)(P.ws + OFF_mod)) + ((size_t)l * 17 + (lat ? s : 16)) * 6144;
  float y[16], m2[16];
  load_row_f32(xs, lane, v); load_row_bf16(((u16*)(P.ws + OFF_Y)) + (size_t)row * DM, lane, y); load_row_f32(md + 2 * 1024, lane, m2);
#pragma unroll
  for (int i = 0; i < 16; ++i) v[i] = ALPHA * v[i] + m2[i] * y[i];
  ln_row(v, P.ln1_g + l * 1024, P.ln1_b + l * 1024, lane);
}

DI void phase_ln1(const Params& P, int l, char* smem) {
  const bool last = (l == 1);
  const int tid = TID();
  const int lane = tid & 63;
  const int gw = blockIdx.x * 4 + (tid >> 6), nw = gridDim.x * 4;
  float* wT = (float*)smem;
  __syncthreads();
  {
    const float* wr = P.w_router + (size_t)l * 1024 * 16;
    for (int i = tid; i < 4096; i += 256) {
      int c = i >> 2, e4 = (i & 3) * 4;
      float4 w = *(const float4*)(wr + (size_t)c * 16 + e4);
      wT[(e4 + 0) * 1024 + c] = w.x; wT[(e4 + 1) * 1024 + c] = w.y; wT[(e4 + 2) * 1024 + c] = w.z; wT[(e4 + 3) * 1024 + c] = w.w;
    }
  }
  __syncthreads();
  for (int row = gw; row < NTOK; row += nw) {
    int s = row / SP, p = row % SP;
    bool lat = p < SEQ;
    if (last && !lat) continue;
    float v[16];
    compute_x1(P, l, row, lane, v);
    const float* md = ((float*)(P.ws + OFF_mod)) + ((size_t)l * 17 + (lat ? s : 16)) * 6144;
    float m3[16], m4[16];
    load_row_f32(md + 3 * 1024, lane, m3); load_row_f32(md + 4 * 1024, lane, m4);
#pragma unroll
    for (int i = 0; i < 16; ++i) v[i] = v[i] * (1.f + m4[i]) + m3[i];
    store_row_bf16(((u16*)(P.ws + OFF_H)) + (size_t)row * DM, lane, v);
    float lg[16];
#pragma unroll
    for (int e = 0; e < 16; ++e) {
      float a = 0.f;
#pragma unroll
      for (int k = 0; k < 4; ++k) {
        float4 w = *(const float4*)(wT + e * 1024 + lane * 4 + 256 * k);
        a += v[4 * k] * w.x + v[4 * k + 1] * w.y + v[4 * k + 2] * w.z + v[4 * k + 3] * w.w;
      }
      lg[e] = a;
    }
#pragma unroll
    for (int e = 0; e < 16; ++e) lg[e] = wave_sum(lg[e]);
    float mx = lg[0];
#pragma unroll
    for (int e = 1; e < 16; ++e) mx = fmaxf(mx, lg[e]);
    float sum = 0.f;
#pragma unroll
    for (int e = 0; e < 16; ++e) { lg[e] = expf(lg[e] - mx); sum += lg[e]; }
    float inv = 1.f / sum;
    if (lane < 16) {
      float mine = 0.f;
#pragma unroll
      for (int e = 0; e < 16; ++e) if (lane == e) mine = lg[e];
      ((float*)(P.ws + OFF_aff))[(size_t)row * 16 + lane] = mine * inv;
    }
  }
}

DI int block_excl_scan(int v, int* red, int tid, int& total) {
  const int lane = tid & 63, wave = tid >> 6;
  int inc = v;
#pragma unroll
  for (int o = 1; o < 64; o <<= 1) { int t = __shfl_up(inc, o); if (lane >= o) inc += t; }
  __syncthreads();
  if (lane == 63) red[wave] = inc;
  __syncthreads();
  int base = 0;
#pragma unroll
  for (int w = 0; w < 4; ++w) { int t = red[w]; if (w < wave) base += t; }
  total = red[0] + red[1] + red[2] + red[3];
  return base + inc - v;
}

DI void phase_topk(const Params& P, int l, char* smem) {
  const bool last = (l == 1);
  const int tid = TID();
  unsigned* keys = (unsigned*)smem;
  int* red = (int*)(smem + 8192);
  const int nitems = last ? 256 : 512;
  for (int it = gridDim.x - 1 - blockIdx.x; it < 16 * 384; it += gridDim.x) ffn_cvt_item(P, l, it, smem);
  for (int it = blockIdx.x; it < nitems; it += gridDim.x) {
    const bool isctx = it >= 256;
    const int se = it & 255, s = se >> 4, e = se & 15;
    const int n = isctx ? CTXL : SEQ, cap = isctx ? 32 : 256;
    const int row0 = s * SP + (isctx ? SEQ : 0);
    const int per = n >> 8;
    __syncthreads();
    for (int i = tid; i < n; i += 256) keys[i] = __float_as_uint(((float*)(P.ws + OFF_aff))[(size_t)(row0 + i) * 16 + e]);
    __syncthreads();
    unsigned kv[8];
#pragma unroll
    for (int j = 0; j < 8; ++j) kv[j] = (j < per) ? keys[tid * per + j] : 0u;
    unsigned prefix = 0u;
    int krem = cap;
    for (int bit = 31; bit >= 0; --bit) {
      const unsigned himask = (bit == 31) ? 0u : (0xFFFFFFFFu << (bit + 1));
      const unsigned want = prefix | (1u << bit);
      int c = 0;
#pragma unroll
      for (int j = 0; j < 8; ++j) c += (j < per && ((kv[j] & (himask | (1u << bit))) == want)) ? 1 : 0;
      c = (int)wave_sum((float)c);
      __syncthreads();
      if ((tid & 63) == 0) red[tid >> 6] = c;
      __syncthreads();
      const int cnt = red[0] + red[1] + red[2] + red[3];
      if (cnt >= krem) prefix = want; else krem -= cnt;
    }
    const unsigned T = prefix;
    int cgt = 0, ceq = 0;
#pragma unroll
    for (int j = 0; j < 8; ++j) if (j < per) { cgt += kv[j] > T ? 1 : 0; ceq += kv[j] == T ? 1 : 0; }
    int tot_gt, tot_eq, tot_sel;
    (void)block_excl_scan(cgt, red, tid, tot_gt);
    const int eq_before = block_excl_scan(ceq, red, tid, tot_eq);
    const int need_eq = cap - tot_gt;
    int eqc = eq_before, csel = 0;
    bool sel[8];
#pragma unroll
    for (int j = 0; j < 8; ++j) {
      sel[j] = false;
      if (j < per) {
        if (kv[j] > T) sel[j] = true;
        else if (kv[j] == T) { sel[j] = eqc < need_eq; ++eqc; }
        csel += sel[j] ? 1 : 0;
      }
    }
    int slot = block_excl_scan(csel, red, tid, tot_sel);
#pragma unroll
    for (int j = 0; j < 8; ++j) if (j < per) {
      const int t = tid * per + j;
      int rk = cap;
      if (sel[j]) {
        rk = slot++;
        const int R = isctx ? NFFN_LAT + (e * 16 + s) * 32 + rk : (s * 16 + e) * 256 + rk;
        ((int*)(P.ws + OFF_tokidx))[R] = row0 + t;
        ((float*)(P.ws + OFF_gatev))[R] = __uint_as_float(kv[j]);
      }
      ((int*)(P.ws + OFF_rank))[(size_t)(row0 + t) * 16 + e] = rk;
    }
  }
}

DI void phase_ln2(const Params& P, int l) {
  const bool last = (l == 1);
  const int lane = TID() & 63;
  const int gw = blockIdx.x * 4 + (TID() >> 6), nw = gridDim.x * 4;
  for (int row = gw; row < NTOK; row += nw) {
    int s = row / SP, p = row % SP;
    bool lat = p < SEQ;
    if (last && !lat) continue;
    float v[16];
    compute_x1(P, l, row, lane, v);
    float yf[16];
#pragma unroll
    for (int i = 0; i < 16; ++i) yf[i] = 0.f;
    const int cap = lat ? 256 : 32;
    int rks[16];
    {
      const int4* rp = (const int4*)(((int*)(P.ws + OFF_rank)) + (size_t)row * 16);
      int4 r0 = rp[0], r1 = rp[1], r2 = rp[2], r3 = rp[3];
      rks[0] = r0.x; rks[1] = r0.y; rks[2] = r0.z; rks[3] = r0.w; rks[4] = r1.x; rks[5] = r1.y; rks[6] = r1.z; rks[7] = r1.w;
      rks[8] = r2.x; rks[9] = r2.y; rks[10] = r2.z; rks[11] = r2.w; rks[12] = r3.x; rks[13] = r3.y; rks[14] = r3.z; rks[15] = r3.w;
    }
#pragma unroll
    for (int e = 0; e < 16; ++e) {
      const int rk = __builtin_amdgcn_readfirstlane(rks[e]);
      if (rk < cap) {
        int R = lat ? (s * 16 + e) * 256 + rk : NFFN_LAT + (e * 16 + s) * 32 + rk;
        float t[16];
        load_row_bf16(((u16*)(P.ws + OFF_ye)) + (size_t)R * DM, lane, t);
#pragma unroll
        for (int i = 0; i < 16; ++i) yf[i] += t[i];
      }
    }
    const float* md = ((float*)(P.ws + OFF_mod)) + ((size_t)l * 17 + (lat ? s : 16)) * 6144;
    float m5[16];
    load_row_f32(md + 5 * 1024, lane, m5);
#pragma unroll
    for (int i = 0; i < 16; ++i) v[i] = ALPHA * v[i] + m5[i] * yf[i];
    ln_row(v, P.ln2_g + l * 1024, P.ln2_b + l * 1024, lane);
    if (lat) store_row_f32(P.out + ((size_t)s * SEQ + p) * DM, lane, v);
    if (!last) {
      const float* md2 = ((float*)(P.ws + OFF_mod)) + ((size_t)(l + 1) * 17 + (lat ? s : 16)) * 6144;
      float sh[16], scl[16];
      load_row_f32(md2, lane, sh); load_row_f32(md2 + 1024, lane, scl);
#pragma unroll
      for (int i = 0; i < 16; ++i) v[i] = v[i] * (1.f + scl[i]) + sh[i];
      store_row_bf16(((u16*)(P.ws + OFF_H)) + (size_t)row * DM, lane, v);
    }
  }
}

DI int wq_next(unsigned* ctr, char* smem) {
  volatile int* slot = (volatile int*)(smem + SMEM_BYTES - 32);
  __syncthreads();
  if (TID() == 0) *slot = (int)__hip_atomic_fetch_add(ctr, 1u, __ATOMIC_RELAXED, __HIP_MEMORY_SCOPE_AGENT);
  __syncthreads();
  return *slot;
}

DI unsigned* wq_ctr(const Params& P, int ph) { return (unsigned*)(P.ws + OFF_bar) + 3600 + 16 * ph; }

template <bool SWAP>
DI void proj_tile(const Params& P, int l, int hb, int mt, int nt, char* smem) {
  const int tid = TID(), wave = tid >> 6, lane = tid & 63, fr = lane & 15, fq = lane >> 4;
  const int wr = wave >> 1, wc = wave & 1;
  const int hrow0 = mt * 128, grow0 = hb * HROWS + hrow0;
  f32x4 acc[4][4];
  zero_acc<4>(acc);
  gemm_main<4, SWAP, false>(((u16*)(P.ws + OFF_H)), DM, nullptr, grow0, ((u16*)(P.ws + OFF_WinT)) + (size_t)l * INP * 1024, 1024, nt * 128, 1024, acc, (u16*)smem);
  const int jp = mt % 18;
  const int bl = mt / 18;
  const bool lat = jp < 16;
  if (SWAP) {
    u16* dst; int ldd, c0;
    if (nt < 4) { dst = ((u16*)(P.ws + OFF_xp)); ldd = 512; c0 = nt * 128; }
    else if (nt < 8) { dst = ((u16*)(P.ws + OFF_z)); ldd = 512; c0 = (nt - 4) * 128; }
    else if (nt < 14) { dst = ((u16*)(P.ws + OFF_xbc)); ldd = 768; c0 = (nt - 8) * 128; }
    else if (nt < 18) { dst = ((u16*)(P.ws + OFF_q)); ldd = 512; c0 = (nt - 14) * 128; }
    else if (nt < 22) { dst = ((u16*)(P.ws + OFF_k)); ldd = 512; c0 = (nt - 18) * 128; }
    else { dst = ((u16*)(P.ws + OFF_br3)); ldd = 512; c0 = (nt - 26) * 128; }
    const bool isu = nt >= 26;
    const bool rope = (nt >= 14 && nt < 22) && lat;
#pragma unroll
    for (int m = 0; m < 4; ++m) {
      int r = wr * 64 + m * 16 + fr;
      size_t orow = isu ? (size_t)(grow0 + r) : (size_t)(hrow0 + r);
      if (rope) {
        int t = jp * 128 + r;
        int prow = t >> 6, pcol = t & 63;
#pragma unroll
        for (int j = 0; j < 4; ++j) {
          int f = fq * 4 + j;
          float c1 = ((float*)(P.ws + OFF_rope))[(prow * 16 + f) * 2], s1 = ((float*)(P.ws + OFF_rope))[(prow * 16 + f) * 2 + 1];
          float c2 = ((float*)(P.ws + OFF_rope))[(pcol * 16 + f) * 2], s2 = ((float*)(P.ws + OFF_rope))[(pcol * 16 + f) * 2 + 1];
          float a = acc[m][0][j], b = acc[m][1][j];
          acc[m][0][j] = a * c1 - b * s1; acc[m][1][j] = a * s1 + b * c1;
          a = acc[m][2][j]; b = acc[m][3][j];
          acc[m][2][j] = a * c2 - b * s2; acc[m][3][j] = a * s2 + b * c2;
        }
      }
#pragma unroll
      for (int n = 0; n < 4; ++n) {
        f32x4 v = acc[m][n];
        if (isu) { v[0] = geluf_(v[0]); v[1] = geluf_(v[1]); v[2] = geluf_(v[2]); v[3] = geluf_(v[3]); }
        int col = c0 + wc * 64 + n * 16 + fq * 4;
        *(bf16x4*)(dst + orow * ldd + col) = pack4v(v);
      }
    }
  } else {
    if (nt == 34) {
      if (wc == 0) {
#pragma unroll
        for (int m = 0; m < 4; ++m)
#pragma unroll
          for (int j = 0; j < 4; ++j) ((float*)(P.ws + OFF_dtbuf))[(size_t)(hrow0 + wr * 64 + m * 16 + fq * 4 + j) * 16 + fr] = acc[m][0][j];
      }
    } else if (nt < 26) {
      int cb = (nt - 22) * 128 + wc * 64;
#pragma unroll
      for (int m = 0; m < 4; ++m)
#pragma unroll
        for (int n = 0; n < 4; ++n) {
          int c = cb + n * 16 + fr;
          int pos = jp * 128 + wr * 64 + m * 16 + fq * 4;
          *(bf16x4*)(((u16*)(P.ws + OFF_vT)) + ((size_t)bl * 512 + c) * SP + pos) = pack4v(acc[m][n]);
        }
    } else {
      int cb = (nt - 30) * 128 + wc * 64;
#pragma unroll
      for (int m = 0; m < 4; ++m)
#pragma unroll
        for (int n = 0; n < 4; ++n) {
          int c = cb + n * 16 + fr;
          int i0 = wr * 64 + m * 16 + fq * 4;
          f32x4 v = acc[m][n];
          *(bf16x4*)(((u16*)(P.ws + OFF_gvT)) + ((size_t)mt * 512 + c) * 128 + i0) = pack4(geluf_(v[0]), geluf_(v[1]), geluf_(v[2]), geluf_(v[3]));
        }
    }
  }
}

DI void phase_proj(const Params& P, int l, int hb, char* smem, int ph) {
  const bool last = (l == 1);
  for (;;) {
    const int it = wq_next(wq_ctr(P, ph), smem);
    if (it >= 144 * 35) break;
    int mt = it / 35, nt = it % 35;
    bool isctx = (mt % 18) >= 16;
    if (last && isctx) {
      bool need = (nt >= 8 && nt < 14) || (nt >= 18 && nt < 26) || nt == 34;
      if (!need) continue;
    }
    bool transposed = (nt >= 22 && nt < 26) || nt >= 30;
    if (transposed) proj_tile<false>(P, l, hb, mt, nt, smem);
    else proj_tile<true>(P, l, hb, mt, nt, smem);
  }
}

constexpr int LDK = 136;
DI void pool_item(const Params& P, int l, int hb, int mt, int g, char* smem) {
  const int tid = TID(), wave = tid >> 6, lane = tid & 63, fr = lane & 15, fq = lane >> 4;
  const int wr = wave >> 1, wc = wave & 1;
  u16* As = (u16*)smem;
  u16* Bs = As + 128 * LDK;
  const int jp = mt % 18, bl = mt / 18;
  const bool lat = jp < 16;
  const int n = lat ? SEQ : CTXL;
  const int p0 = lat ? jp * 128 : (jp - 16) * 128;
  const int seqbase = bl * SP + (lat ? 0 : SEQ);
  const int half = 1 << g;
  __syncthreads();
  {
    const int cch = tid & 15;
    const u16* src = ((u16*)(P.ws + OFF_xp)) + (size_t)seqbase * 512 + g * 128 + cch * 8;
    for (int ii = 0; ii < 8; ++ii) {
      int i = (tid >> 4) + 16 * ii;
      int p = p0 + i;
      int lo = max(p - half, 0), hi = min(p + half, n);
      float s[8];
#pragma unroll
      for (int e = 0; e < 8; ++e) s[e] = 0.f;
      for (int r = lo; r < hi; ++r) {
        bf16x8 t = *(const bf16x8*)(src + (size_t)r * 512);
#pragma unroll
        for (int e = 0; e < 8; ++e) s[e] += bf2f((u16)t[e]);
      }
      bf16x8 self = *(const bf16x8*)(src + (size_t)p * 512);
      float inv = 1.f / (float)(hi - lo);
      bf16x8 o;
#pragma unroll
      for (int e = 0; e < 8; ++e) o[e] = (short)f2bf(s[e] * inv - bf2f((u16)self[e]));
      *(bf16x8*)(As + i * LDK + cch * 8) = o;
    }
    const u16* wsrc = ((u16*)(P.ws + OFF_poolT)) + ((size_t)l * 4 + g) * 128 * 128;
    for (int cid = tid; cid < 2048; cid += 256) {
      int r = cid >> 4, c8 = (cid & 15) * 8;
      *(u32x4*)(Bs + r * LDK + c8) = *(const u32x4*)(wsrc + r * 128 + c8);
    }
  }
  __syncthreads();
  f32x4 acc[4][4];
  zero_acc<4>(acc);
  mma_lds<4, 4, true>(As + wr * 64 * LDK, LDK, Bs + wc * 64 * LDK, LDK, 4, acc, fr, fq);
  const float* psc = P.pool_scale + l * 512 + g * 128;
#pragma unroll
  for (int m = 0; m < 4; ++m)
#pragma unroll
    for (int nn = 0; nn < 4; ++nn) {
      int r = wr * 64 + m * 16 + fr, c = wc * 64 + nn * 16 + fq * 4;
      float4 sc = *(const float4*)(psc + c);
      f32x4 v = acc[m][nn];
      *(bf16x4*)(((u16*)(P.ws + OFF_br0)) + (size_t)(hb * HROWS + mt * 128 + r) * 512 + g * 128 + c) = pack4(v[0] * sc.x, v[1] * sc.y, v[2] * sc.z, v[3] * sc.w);
    }
}

DI void sgu_item(const Params& P, int l, int hb, int mt, int g, char* smem) {
  const int tid = TID(), wave = tid >> 6, lane = tid & 63, fr = lane & 15, fq = lane >> 4;
  const int wr = wave >> 1, wc = wave & 1;
  u16* As = (u16*)smem;
  u16* Bs = As + 128 * LDK;
  float* st = (float*)(Bs + 128 * LDK);
  const u16* gv = ((u16*)(P.ws + OFF_gvT)) + (size_t)mt * 512 * 128;
  __syncthreads();
  {
    float* ps = (float*)smem;
    float* pq = ps + 16 * 128;
    const int cg = tid >> 4, tc = tid & 15;
    float s8[8], q8[8];
#pragma unroll
    for (int e2 = 0; e2 < 8; ++e2) { s8[e2] = 0.f; q8[e2] = 0.f; }
#pragma unroll 8
    for (int c = 0; c < 32; ++c) {
      u32x4 t = *(const u32x4*)(gv + (size_t)(cg * 32 + c) * 128 + tc * 8);
#pragma unroll
      for (int e2 = 0; e2 < 4; ++e2) {
        float a = bflo(t[e2]), b = bfhi(t[e2]);
        s8[2 * e2] += a; q8[2 * e2] += a * a; s8[2 * e2 + 1] += b; q8[2 * e2 + 1] += b * b;
      }
    }
#pragma unroll
    for (int e2 = 0; e2 < 8; ++e2) { ps[cg * 128 + tc * 8 + e2] = s8[e2]; pq[cg * 128 + tc * 8 + e2] = q8[e2]; }
    __syncthreads();
    if (tid < 128) {
      float s = 0.f, q = 0.f;
#pragma unroll
      for (int g2 = 0; g2 < 16; ++g2) { s += ps[g2 * 128 + tid]; q += pq[g2 * 128 + tid]; }
      const float mu_ = s * (1.f / 512.f);
      const float var = fmaxf(q * (1.f / 512.f) - mu_ * mu_, 0.f);
      st[256 + tid] = mu_; st[384 + tid] = rsqrtf(var + LN_EPS);
    }
  }
  const float* mu = st + 256;
  const float* rs = st + 384;
  {
    __syncthreads();
    const u16* wsrc = ((u16*)(P.ws + OFF_sguW)) + ((size_t)l * 4 + g) * 128 * 128;
    for (int cid = tid; cid < 2048; cid += 256) {
      int r = cid >> 4, c8 = (cid & 15) * 8;
      *(u32x4*)(As + r * LDK + c8) = *(const u32x4*)(wsrc + r * 128 + c8);
      bf16x8 t = *(const bf16x8*)(gv + (size_t)(g * 128 + r) * 128 + c8);
      float lg = P.sgu_ln_g[l * 512 + g * 128 + r], lb = P.sgu_ln_b[l * 512 + g * 128 + r];
      bf16x8 o;
#pragma unroll
      for (int e = 0; e < 8; ++e) o[e] = (short)f2bf((bf2f((u16)t[e]) - mu[c8 + e]) * rs[c8 + e] * lg + lb);
      *(bf16x8*)(Bs + r * LDK + c8) = o;
    }
    __syncthreads();
    f32x4 acc[4][4];
    zero_acc<4>(acc);
    mma_lds<4, 4, true>(As + wr * 64 * LDK, LDK, Bs + wc * 64 * LDK, LDK, 4, acc, fr, fq);
    const float* bs = P.sgu_b + ((size_t)l * 4 + g) * 128;
#pragma unroll
    for (int m = 0; m < 4; ++m) {
      int pp = wr * 64 + m * 16 + fr;
      float bias = bs[pp];
#pragma unroll
      for (int nn = 0; nn < 4; ++nn) {
        int d = wc * 64 + nn * 16 + fq * 4;
        u16* up = ((u16*)(P.ws + OFF_br3)) + (size_t)(hb * HROWS + mt * 128 + pp) * 512 + g * 128 + d;
        bf16x4 uu = *(const bf16x4*)up;
        f32x4 v = acc[m][nn];
        *(bf16x4*)up = pack4((v[0] + bias) * bf2f((u16)uu[0]), (v[1] + bias) * bf2f((u16)uu[1]), (v[2] + bias) * bf2f((u16)uu[2]), (v[3] + bias) * bf2f((u16)uu[3]));
      }
    }
  }
}

DI void attn_item(const Params& P, int l, int hb, int item, char* smem) {
  const int tid = TID(), wave = tid >> 6, lane = tid & 63, fr = lane & 15, fq = lane >> 4;
  int qt, h, bl;
  if (item < 512) { bl = item >> 6; h = (item >> 4) & 3; qt = item & 15; }
  else { const int j = item - 512; bl = j >> 3; h = (j >> 1) & 3; qt = 16 + (j & 1); }
  const bool ctxq = qt >= 16;
  const int key0 = ctxq ? SEQ : 0, nkt = ctxq ? 4 : 36;
  const int hrow_q0 = bl * SP + qt * 128 + wave * 32;
  constexpr int KT = 64 * LDT, VT = 128 * LDT;
  u16* Ks = (u16*)smem;
  u16* Vs = Ks + 2 * KT;
  constexpr float LOG2E = 1.4426950408889634f;
  for (int sub = 0; sub < 2; ++sub) {
    const int hs = 2 * h + sub;
    bf16x8 qf[2][2];
#pragma unroll
    for (int qb = 0; qb < 2; ++qb)
#pragma unroll
      for (int ks = 0; ks < 2; ++ks) qf[qb][ks] = *(const bf16x8*)(((u16*)(P.ws + OFF_q)) + (size_t)(hrow_q0 + qb * 16 + fr) * 512 + hs * 64 + ks * 32 + fq * 8);
    f32x4 ot[8][2];
#pragma unroll
    for (int d = 0; d < 8; ++d) { ot[d][0] = f32x4{0.f, 0.f, 0.f, 0.f}; ot[d][1] = f32x4{0.f, 0.f, 0.f, 0.f}; }
    float mrow[2] = {-INFINITY, -INFINITY}, lrow[2] = {0.f, 0.f};
    const u16* Kg = ((u16*)(P.ws + OFF_k)) + ((size_t)bl * SP + key0) * 512 + hs * 64;
    const u16* Vg = ((u16*)(P.ws + OFF_vT)) + ((size_t)bl * 512 + h * 128) * SP + key0;
    u32x4 rk[2], rv[4];
    const u16* kgp = Kg + (size_t)(tid >> 2) * 512 + (tid & 3) * 16;
    const u16* vgp = Vg + (size_t)(tid >> 1) * SP + (tid & 1) * 32;
    u16* ksp = Ks + (tid >> 2) * LDT + (tid & 3) * 16;
    u16* vsp = Vs + (tid >> 1) * LDT + (tid & 1) * 32;
    auto gloadK = [&](int t) {
      const u16* kp = kgp + (size_t)t * 64 * 512;
      rk[0] = *(const u32x4*)(kp); rk[1] = *(const u32x4*)(kp + 8);
    };
    auto gloadV = [&](int t) {
      const u16* vp = vgp + t * 64;
      rv[0] = *(const u32x4*)(vp); rv[1] = *(const u32x4*)(vp + 8); rv[2] = *(const u32x4*)(vp + 16); rv[3] = *(const u32x4*)(vp + 24);
    };
    auto sstore = [&](int buf) {
      u16* kp = ksp + buf * KT;
      *(u32x4*)(kp) = rk[0]; *(u32x4*)(kp + 8) = rk[1];
      u16* vp = vsp + buf * VT;
      *(u32x4*)(vp) = rv[0]; *(u32x4*)(vp + 8) = rv[1]; *(u32x4*)(vp + 16) = rv[2]; *(u32x4*)(vp + 24) = rv[3];
    };
    gloadK(0); gloadV(0);
    __syncthreads();
    sstore(0);
    __syncthreads();
    for (int t = 0; t < nkt; ++t) {
      const int cur = t & 1;
      __builtin_amdgcn_iglp_opt(0);
      if (t + 1 < nkt) gloadK(t + 1);
      const u16* Kc = Ks + cur * KT;
      const u16* Vc = Vs + cur * VT;
      f32x4 st[4][2];
#pragma unroll
      for (int k4 = 0; k4 < 4; ++k4) { st[k4][0] = f32x4{0.f, 0.f, 0.f, 0.f}; st[k4][1] = f32x4{0.f, 0.f, 0.f, 0.f}; }
#pragma unroll
      for (int k4 = 0; k4 < 4; ++k4)
#pragma unroll
        for (int ks = 0; ks < 2; ++ks) {
          bf16x8 a = *(const bf16x8*)(Kc + (k4 * 16 + fr) * LDT + ks * 32 + fq * 8);
          st[k4][0] = MFMA16(a, qf[0][ks], st[k4][0]);
          st[k4][1] = MFMA16(a, qf[1][ks], st[k4][1]);
          if (ks == 1 && (k4 & 1)) __builtin_amdgcn_sched_barrier(0);
        }
      __builtin_amdgcn_sched_barrier(0);
#pragma unroll
      for (int qb = 0; qb < 2; ++qb) {
        float mx = -INFINITY;
#pragma unroll
        for (int k4 = 0; k4 < 4; ++k4)
#pragma unroll
          for (int j = 0; j < 4; ++j) mx = fmaxf(mx, st[k4][qb][j]);
        mx = fmaxf(mx, __shfl_xor(mx, 16));
        mx = fmaxf(mx, __shfl_xor(mx, 32));
        const bool upd = mx > mrow[qb] + 5.5f;
        const float mnew = upd ? mx : mrow[qb];
        const float moff = mnew * LOG2E;
        float ps = 0.f;
#pragma unroll
        for (int k4 = 0; k4 < 4; ++k4)
#pragma unroll
          for (int j = 0; j < 4; ++j) { float pv = __builtin_amdgcn_exp2f(st[k4][qb][j] * LOG2E - moff); st[k4][qb][j] = pv; ps += pv; }
        if (__builtin_amdgcn_ballot_w64(upd) != 0ull) {
          const float alpha = __builtin_amdgcn_exp2f((mrow[qb] - mnew) * LOG2E);
          lrow[qb] *= alpha;
#pragma unroll
          for (int d = 0; d < 8; ++d) { ot[d][qb][0] *= alpha; ot[d][qb][1] *= alpha; ot[d][qb][2] *= alpha; ot[d][qb][3] *= alpha; }
        }
        mrow[qb] = mnew;
        lrow[qb] += ps;
      }
      __builtin_amdgcn_sched_barrier(0);
      if (t + 1 < nkt) gloadV(t + 1);
#pragma unroll
      for (int ks2 = 0; ks2 < 2; ++ks2) {
        bf16x8 pf[2];
#pragma unroll
        for (int qb = 0; qb < 2; ++qb) {
          bf16x4 lo = pack4v(st[2 * ks2][qb]), hi = pack4v(st[2 * ks2 + 1][qb]);
          pf[qb] = __builtin_shufflevector(lo, hi, 0, 1, 2, 3, 4, 5, 6, 7);
        }
#pragma unroll
        for (int d = 0; d < 8; ++d) {
          const u16* vp = Vc + (d * 16 + fr) * LDT + ks2 * 32 + fq * 4;
          bf16x4 lo = *(const bf16x4*)vp, hi = *(const bf16x4*)(vp + 16);
          bf16x8 a = __builtin_shufflevector(lo, hi, 0, 1, 2, 3, 4, 5, 6, 7);
          ot[d][0] = MFMA16(a, pf[0], ot[d][0]);
          ot[d][1] = MFMA16(a, pf[1], ot[d][1]);
          if ((d & 3) == 3) __builtin_amdgcn_sched_barrier(0);
        }
      }
      if (t + 1 < nkt) sstore(cur ^ 1);
      __syncthreads();
    }
#pragma unroll
    for (int qb = 0; qb < 2; ++qb) {
      float lt = lrow[qb];
      lt += __shfl_xor(lt, 16);
      lt += __shfl_xor(lt, 32);
      float inv = 1.f / lt;
      size_t hrow = (size_t)(hrow_q0 + qb * 16 + fr);
      if (sub == 0) {
#pragma unroll
        for (int d = 0; d < 8; ++d) {
          f32x4 v = ot[d][qb];
          *(bf16x4*)(((u16*)(P.ws + OFF_o1)) + hrow * 512 + h * 128 + d * 16 + fq * 4) = pack4(v[0] * inv, v[1] * inv, v[2] * inv, v[3] * inv);
        }
      } else {
        const float lam = ((float*)(P.ws + OFF_lamv))[l * 2], lam_init = ((float*)(P.ws + OFF_lamv))[l * 2 + 1];
        float ss = 0.f;
#pragma unroll
        for (int d = 0; d < 8; ++d) {
          bf16x4 o1v = *(const bf16x4*)(((u16*)(P.ws + OFF_o1)) + hrow * 512 + h * 128 + d * 16 + fq * 4);
#pragma unroll
          for (int j = 0; j < 4; ++j) { float dd = bf2f((u16)o1v[j]) - lam * ot[d][qb][j] * inv; ot[d][qb][j] = dd; ss += dd * dd; }
        }
        ss += __shfl_xor(ss, 16);
        ss += __shfl_xor(ss, 32);
        float rr = rsqrtf(ss * (1.f / 128.f) + LN_EPS) * (1.f - lam_init);
        const float* gn = P.diff_norm_g + l * 128;
#pragma unroll
        for (int d = 0; d < 8; ++d) {
          int dv = d * 16 + fq * 4;
          float4 g4 = *(const float4*)(gn + dv);
          f32x4 v = ot[d][qb];
          *(bf16x4*)(((u16*)(P.ws + OFF_br2)) + ((size_t)hb * HROWS + hrow) * 512 + h * 128 + dv) = pack4(v[0] * rr * g4.x, v[1] * rr * g4.y, v[2] * rr * g4.z, v[3] * rr * g4.w);
        }
      }
    }
  }
}

template <bool TRANS>
DI void conv_stage(const Params& P, int l, const u16* xbase  , int chan0, int n, int p0, u16* dst, int ld, const float* scale) {
  const int tid = TID(), cl = tid & 63, ig = tid >> 6;
  const int ch = chan0 + cl;
  const float* cw = P.conv_w + (size_t)l * 5 * 768 + ch;
  const float w0 = cw[0], w1 = cw[768], w2 = cw[2 * 768], w3 = cw[3 * 768], w4 = cw[4 * 768];
  const float cb = P.conv_b[l * 768 + ch];
  const u16* xc = xbase + ch;
#pragma unroll 1
  for (int g8 = 0; g8 < 4; ++g8) {
    const int tok0 = ig * 32 + g8 * 8;
    const int pos0 = p0 + tok0 - 2;
    float xv[12];
#pragma unroll
    for (int i = 0; i < 12; ++i) { int pos = pos0 + i; xv[i] = (pos >= 0 && pos < n) ? bf2f(xc[(size_t)pos * 768]) : 0.f; }
#pragma unroll
    for (int ii = 0; ii < 8; ++ii) {
      float v = w0 * xv[ii] + w1 * xv[ii + 1] + w2 * xv[ii + 2] + w3 * xv[ii + 3] + w4 * xv[ii + 4] + cb;
      v = v * __builtin_amdgcn_rcpf(1.f + __expf(-v));
      const int tok = tok0 + ii;
      if (scale) v *= scale[tok];
      if (TRANS) dst[cl * ld + tok] = f2bf(v); else dst[tok * ld + cl] = f2bf(v);
    }
  }
}

DI void ssd_scalars(const Params& P, int l, int hrow0, int h, int dir, float* dts, float* S, float* tmp) {
  const int tid = TID();
  const float aneg = -expf(P.a_log[l * 16 + dir * 8 + h]);
  float a = 0.f, inc = 0.f;
  if (tid < 128) {
    float raw = ((float*)(P.ws + OFF_dtbuf))[(size_t)(hrow0 + tid) * 16 + dir * 8 + h] + P.dt_bias[l * 16 + dir * 8 + h];
    float dt = softplusf_(raw);
    dts[tid] = dt;
    a = dt * aneg;
    inc = a;
    const int lane = tid & 63;
#pragma unroll
    for (int o = 1; o < 64; o <<= 1) { float t = __shfl_up(inc, o); if (lane >= o) inc += t; }
    if (lane == 63) tmp[tid >> 6] = inc;
  }
  __syncthreads();
  if (tid < 128) {
    const float t0 = tmp[0], t1 = tmp[1];
    const float pre = inc + (tid >= 64 ? t0 : 0.f);
    S[tid] = (dir == 0) ? pre : (t0 + t1) - pre + a;
  }
  __syncthreads();
}

constexpr int SSD_STATE_STRIDE = 18 * 4096;

DI void ssd_prep_item(const Params& P, int l, int hb, int mt, int slab, char* smem) {
  const int tid = TID();
  const int jp = mt % 18, bl = mt / 18;
  const bool lat = jp < 16;
  const int n = lat ? SEQ : CTXL;
  const int p0 = lat ? jp * 128 : (jp - 16) * 128;
  const int seqbase = bl * SP + (lat ? 0 : SEQ);
  const int hrow0 = bl * SP + jp * 128;
  u16* T = (u16*)smem;
  u16* Rm = T + 64 * LDK;
  __syncthreads();
  const u16* xb = ((u16*)(P.ws + OFF_xbc)) + (size_t)seqbase * 768;
  {
    const int cg = tid & 7, tg = tid >> 3;
    const int ch0 = slab * 64 + cg * 8;
    float w[5][8], cbv[8];
#pragma unroll
    for (int d = 0; d < 5; ++d) {
      const float4 a = *(const float4*)(P.conv_w + ((size_t)l * 5 + d) * 768 + ch0), b = *(const float4*)(P.conv_w + ((size_t)l * 5 + d) * 768 + ch0 + 4);
      w[d][0] = a.x; w[d][1] = a.y; w[d][2] = a.z; w[d][3] = a.w; w[d][4] = b.x; w[d][5] = b.y; w[d][6] = b.z; w[d][7] = b.w;
    }
    {
      const float4 a = *(const float4*)(P.conv_b + l * 768 + ch0), b = *(const float4*)(P.conv_b + l * 768 + ch0 + 4);
      cbv[0] = a.x; cbv[1] = a.y; cbv[2] = a.z; cbv[3] = a.w; cbv[4] = b.x; cbv[5] = b.y; cbv[6] = b.z; cbv[7] = b.w;
    }
    const int tok0 = tg * 4;
    u32x4 xr[8];
#pragma unroll
    for (int i = 0; i < 8; ++i) {
      const int pos = p0 + tok0 - 2 + i;
      xr[i] = u32x4{0u, 0u, 0u, 0u};
      if (pos >= 0 && pos < n) xr[i] = *(const u32x4*)(xb + (size_t)pos * 768 + ch0);
    }
    float o[4][8];
#pragma unroll
    for (int t = 0; t < 4; ++t)
#pragma unroll
      for (int e2 = 0; e2 < 4; ++e2) {
        float a0 = cbv[2 * e2], a1 = cbv[2 * e2 + 1];
#pragma unroll
        for (int d = 0; d < 5; ++d) { a0 += w[d][2 * e2] * bflo(xr[t + d][e2]); a1 += w[d][2 * e2 + 1] * bfhi(xr[t + d][e2]); }
        o[t][2 * e2] = siluf_(a0); o[t][2 * e2 + 1] = siluf_(a1);
      }
    if (slab < 10) {
#pragma unroll
      for (int e2 = 0; e2 < 8; ++e2) *(bf16x4*)(T + (cg * 8 + e2) * LDK + tok0) = pack4(o[0][e2], o[1][e2], o[2][e2], o[3][e2]);
    }
    if (slab >= 8) {
#pragma unroll
      for (int t = 0; t < 4; ++t) {
        u32x4 v = {pack2(o[t][0], o[t][1]), pack2(o[t][2], o[t][3]), pack2(o[t][4], o[t][5]), pack2(o[t][6], o[t][7])};
        *(u32x4*)(Rm + (tok0 + t) * LDT + cg * 8) = v;
      }
    }
  }
  __syncthreads();
  if (slab < 10) {
    u16* dst = slab < 8 ? ((u16*)(P.ws + OFF_xsT)) + ((size_t)mt * 512 + slab * 64) * 128 : ((u16*)(P.ws + OFF_bmT)) + ((size_t)mt * 128 + (slab - 8) * 64) * 128;
#pragma unroll
    for (int i = 0; i < 4; ++i) { int cid = tid + 256 * i; int r = cid >> 4, c8 = (cid & 15) * 8; *(u32x4*)(dst + (size_t)r * 128 + c8) = *(const u32x4*)(T + r * LDK + c8); }
  }
  if (slab >= 8) {
    u16* dst = (slab < 10 ? ((u16*)(P.ws + OFF_bm)) + (slab - 8) * 64 : ((u16*)(P.ws + OFF_cm)) + (slab - 10) * 64) + (size_t)hrow0 * 128;
#pragma unroll
    for (int i = 0; i < 4; ++i) { int cid = tid + 256 * i; int r = cid >> 3, c8 = (cid & 7) * 8; *(u32x4*)(dst + (size_t)r * 128 + c8) = *(const u32x4*)(Rm + r * LDT + c8); }
  }
}

DI void phase_ssd_prep(const Params& P, int l, int hb, char* smem, int ph) {
  for (;;) {
    const int it = wq_next(wq_ctr(P, ph), smem);
    if (it >= 144 * 12) break;
    ssd_prep_item(P, l, hb, it / 12, it % 12, smem);
  }
}

DI void ssd_state_item(const Params& P, int l, int hb, int item, char* smem) {
  const int tid = TID(), wave = tid >> 6, lane = tid & 63, fr = lane & 15, fq = lane >> 4;
  const int h = item & 7, jp = (item >> 3) % 18, bl = (item >> 3) / 18;
  const int mt = bl * 18 + jp;
  const int hrow0 = bl * SP + jp * 128;
  u16* At = (u16*)smem;
  u16* Bt = At + 64 * LDK;
  float* dts = (float*)(Bt + 64 * LDK);
  float* S = dts + 128;
  float* wgt = S + 128;
  __syncthreads();
  u32x4 xr[4];
  {
    const u16* bsrc = ((u16*)(P.ws + OFF_bmT)) + ((size_t)mt * 128 + (h >> 2) * 64) * 128;
    const u16* xsrc = ((u16*)(P.ws + OFF_xsT)) + ((size_t)mt * 512 + h * 64) * 128;
#pragma unroll
    for (int i = 0; i < 4; ++i) {
      int cid = tid + 256 * i; int r = cid >> 4, c8 = (cid & 15) * 8;
      *(u32x4*)(Bt + r * LDK + c8) = *(const u32x4*)(bsrc + (size_t)r * 128 + c8);
      xr[i] = *(const u32x4*)(xsrc + (size_t)r * 128 + c8);
    }
  }
  const int wr = wave >> 1, wc = wave & 1;
#pragma unroll 1
  for (int dir = 0; dir < 2; ++dir) {
    ssd_scalars(P, l, hrow0, h, dir, dts, S, wgt);
    const float total = (dir == 0) ? S[127] : S[0];
    __syncthreads();
    if (tid < 128) wgt[tid] = dts[tid] * __expf(total - S[tid]);
    __syncthreads();
#pragma unroll
    for (int i = 0; i < 4; ++i) {
      int cid = tid + 256 * i; int r = cid >> 4, c8 = (cid & 15) * 8;
      u32x4 o;
#pragma unroll
      for (int e2 = 0; e2 < 4; ++e2) o[e2] = pack2(bflo(xr[i][e2]) * wgt[c8 + 2 * e2], bfhi(xr[i][e2]) * wgt[c8 + 2 * e2 + 1]);
      *(u32x4*)(At + r * LDK + c8) = o;
    }
    __syncthreads();
    f32x4 acc[2][2];
#pragma unroll
    for (int m = 0; m < 2; ++m) { acc[m][0] = f32x4{0.f, 0.f, 0.f, 0.f}; acc[m][1] = f32x4{0.f, 0.f, 0.f, 0.f}; }
    mma_lds<2, 2, true>(At + wr * 32 * LDK, LDK, Bt + wc * 32 * LDK, LDK, 4, acc, fr, fq);
    u16* cs = ((u16*)(P.ws + OFF_cstate)) + (((size_t)(bl * 2 + dir) * 8 + h) * 18 + jp) * 4096;
#pragma unroll
    for (int m = 0; m < 2; ++m)
#pragma unroll
      for (int nn = 0; nn < 2; ++nn) *(bf16x4*)(cs + (wr * 32 + m * 16 + fr) * 64 + wc * 32 + nn * 16 + fq * 4) = pack4v(acc[m][nn]);
    if (tid == 0) ((float*)(P.ws + OFF_decay))[((bl * 2 + dir) * 8 + h) * 18 + jp] = __expf(total);
  }
}

DI void phase_carry(const Params& P) {
  const int total = 8 * 2 * 8 * 4096;
  for (int idx = blockIdx.x * 256 + TID(); idx < total; idx += gridDim.x * 256) {
    int pn = idx & 4095, bdh = idx >> 12;
    int dir = (bdh >> 3) & 1;
    const u16* __restrict__ cs = ((const u16*)(P.ws + OFF_cstate)) + (size_t)bdh * SSD_STATE_STRIDE + pn;
    u16* __restrict__ en = ((u16*)(P.ws + OFF_enter)) + (size_t)bdh * SSD_STATE_STRIDE + pn;
    const float* __restrict__ dc = ((const float*)(P.ws + OFF_decay)) + bdh * 18;
    float cv[18], dv[18];
#pragma unroll
    for (int jp = 0; jp < 18; ++jp) { cv[jp] = bf2f(cs[(size_t)jp * 4096]); dv[jp] = dc[jp]; }
    float state = 0.f;
    if (dir == 0) {
#pragma unroll
      for (int st = 0; st < 18; ++st) {
        const int jp = st < 2 ? 16 + st : st - 2;
        en[(size_t)jp * 4096] = f2bf(state);
        state = state * dv[jp] + cv[jp];
      }
    } else {
#pragma unroll
      for (int st = 0; st < 18; ++st) {
        const int jp = 17 - st;
        en[(size_t)jp * 4096] = f2bf(state);
        state = state * dv[jp] + cv[jp];
      }
    }
  }
}

DI void ssd_out_item(const Params& P, int l, int hb, int item, char* smem) {
  const int tid = TID(), wave = tid >> 6, lane = tid & 63, fr = lane & 15, fq = lane >> 4;
  const int h = item & 7, jp = (item >> 3) % 18, bl = (item >> 3) / 18;
  const bool lat = jp < 16;
  const int n = lat ? SEQ : CTXL;
  const int p0 = lat ? jp * 128 : (jp - 16) * 128;
  const int seqbase = bl * SP + (lat ? 0 : SEQ);
  const int hrow0 = bl * SP + jp * 128;
  u16* Cs = (u16*)smem;
  u16* xT = Cs + 128 * LDT;
  u16* Et = xT + 64 * LDK;
  u16* Un = Et + 64 * LDT;
  float* fs = (float*)(Un + 128 * LDK);
  float* dts = fs;
  float* S = fs + 128;
  float* tmp = fs + 256;
  const int grp = h >> 2;
  __syncthreads();
  {
    const int mt = bl * 18 + jp;
    const u16* csrc = ((u16*)(P.ws + OFF_cm)) + (size_t)hrow0 * 128 + grp * 64;
    const u16* bsrc = ((u16*)(P.ws + OFF_bm)) + (size_t)hrow0 * 128 + grp * 64;
    const u16* xsrc = ((u16*)(P.ws + OFF_xsT)) + ((size_t)mt * 512 + h * 64) * 128;
#pragma unroll
    for (int i = 0; i < 4; ++i) {
      int cid = tid + 256 * i;
      int r = cid >> 3, c8 = (cid & 7) * 8;
      *(u32x4*)(Cs + r * LDT + c8) = *(const u32x4*)(csrc + (size_t)r * 128 + c8);
      *(u32x4*)(Un + r * LDT + c8) = *(const u32x4*)(bsrc + (size_t)r * 128 + c8);
      int r2 = cid >> 4, c82 = (cid & 15) * 8;
      *(u32x4*)(xT + r2 * LDK + c82) = *(const u32x4*)(xsrc + (size_t)r2 * 128 + c82);
    }
  }
  __syncthreads();
  f32x4 cb[2][8];
#pragma unroll
  for (int m = 0; m < 2; ++m)
#pragma unroll
    for (int nn = 0; nn < 8; ++nn) cb[m][nn] = f32x4{0.f, 0.f, 0.f, 0.f};
  mma_lds<2, 8, false>(Cs + wave * 32 * LDT, LDT, Un, LDT, 2, cb, fr, fq);
  f32x4 yacc[2][4];
#pragma unroll
  for (int m = 0; m < 2; ++m)
#pragma unroll
    for (int nn = 0; nn < 4; ++nn) yacc[m][nn] = f32x4{0.f, 0.f, 0.f, 0.f};
#pragma unroll 1
  for (int dir = 0; dir < 2; ++dir) {
    __syncthreads();
    ssd_scalars(P, l, hrow0, h, dir, dts, S, tmp);
#pragma unroll
    for (int m = 0; m < 2; ++m)
#pragma unroll
      for (int j = 0; j < 4; ++j) {
        int lrow = wave * 32 + m * 16 + fq * 4 + j;
        float Sl = S[lrow];
#pragma unroll
        for (int nn = 0; nn < 8; ++nn) {
          int s = nn * 16 + fr;
          bool ok = dir == 0 ? (s <= lrow) : (s >= lrow);
          float coef = ok ? __expf(Sl - S[s]) * dts[s] : 0.f;
          Un[lrow * LDK + s] = f2bf(cb[m][nn][j] * coef);
        }
      }
    {
      const u16* csb = ((u16*)(P.ws + OFF_cstate)) + ((size_t)(bl * 2 + dir) * 8 + h) * SSD_STATE_STRIDE;
      const float* dcb = ((float*)(P.ws + OFF_decay)) + ((bl * 2 + dir) * 8 + h) * 18;
      const int pos = dir == 0 ? (jp < 16 ? jp + 2 : jp - 16) : 17 - jp;
#pragma unroll 1
      for (int cid = tid; cid < 512; cid += 256) {
        const int pr = cid >> 3, c8 = (cid & 7) * 8;
        float st8[8];
#pragma unroll
        for (int e2 = 0; e2 < 8; ++e2) st8[e2] = 0.f;
#pragma unroll 1
        for (int s0 = 0; s0 < 18; s0 += 6) {
          if (s0 >= pos) break;
          u32x4 cv[6];
          float dv[6];
#pragma unroll
          for (int u = 0; u < 6; ++u) {
            const int s = s0 + u;
            const int c = dir == 0 ? (s < 2 ? 16 + s : s - 2) : 17 - s;
            cv[u] = u32x4{0u, 0u, 0u, 0u}; dv[u] = 1.f;
            if (s < pos) { cv[u] = *(const u32x4*)(csb + (size_t)c * 4096 + pr * 64 + c8); dv[u] = dcb[c]; }
          }
#pragma unroll
          for (int u = 0; u < 6; ++u)
#pragma unroll
            for (int e2 = 0; e2 < 4; ++e2) {
              st8[2 * e2] = st8[2 * e2] * dv[u] + bflo(cv[u][e2]);
              st8[2 * e2 + 1] = st8[2 * e2 + 1] * dv[u] + bfhi(cv[u][e2]);
            }
        }
        u32x4 o = {pack2(st8[0], st8[1]), pack2(st8[2], st8[3]), pack2(st8[4], st8[5]), pack2(st8[6], st8[7])};
        *(u32x4*)(Et + pr * LDT + c8) = o;
      }
    }
    __syncthreads();
    mma_lds<2, 4, true>(Un + wave * 32 * LDK, LDK, xT, LDK, 4, yacc, fr, fq);
    f32x4 yi[2][4];
#pragma unroll
    for (int m = 0; m < 2; ++m)
#pragma unroll
      for (int nn = 0; nn < 4; ++nn) yi[m][nn] = f32x4{0.f, 0.f, 0.f, 0.f};
    mma_lds<2, 4, true>(Cs + wave * 32 * LDT, LDT, Et, LDT, 2, yi, fr, fq);
#pragma unroll
    for (int m = 0; m < 2; ++m) {
      float e = __expf(S[wave * 32 + m * 16 + fr]);
#pragma unroll
      for (int nn = 0; nn < 4; ++nn)
#pragma unroll
        for (int j = 0; j < 4; ++j) yacc[m][nn][j] += e * yi[m][nn][j];
    }
  }
  const float dsk = P.ssd_d[l * 8 + h];
  const float* gn = P.ssd_norm_g + l * 512 + h * 64;
#pragma unroll
  for (int m = 0; m < 2; ++m) {
    int lrow = wave * 32 + m * 16 + fr;
    float ss = 0.f;
#pragma unroll
    for (int nn = 0; nn < 4; ++nn) {
      int pc = nn * 16 + fq * 4;
      bf16x4 zz = *(const bf16x4*)(((u16*)(P.ws + OFF_z)) + (size_t)(hrow0 + lrow) * 512 + h * 64 + pc);
      float4 g4 = *(const float4*)(gn + pc);
      float gg[4] = {g4.x, g4.y, g4.z, g4.w};
      float o[4];
#pragma unroll
      for (int j = 0; j < 4; ++j) {
        float y = yacc[m][nn][j] + dsk * bf2f(xT[(pc + j) * LDK + lrow]);
        y *= siluf_(bf2f((u16)zz[j]));
        ss += y * y;
        o[j] = y * gg[j];
      }
      *(bf16x4*)(((u16*)(P.ws + OFF_br1)) + ((size_t)hb * HROWS + hrow0 + lrow) * 512 + h * 64 + pc) = pack4(o[0], o[1], o[2], o[3]);
    }
    ss += __shfl_xor(ss, 16);
    ss += __shfl_xor(ss, 32);
    if (fq == 0) ((float*)(P.ws + OFF_ssq))[((size_t)hb * HROWS + hrow0 + lrow) * 8 + h] = ss;
  }
}


DI void merge_tile(const Params& P, int l, int mt, int nt, char* smem) {
  const int row0 = mt * 128;
#pragma unroll 1
  for (int kq = 0; kq < 4; ++kq) {
    unsigned gp[4][4][2];
    {
      f32x4 g[4][4];
      zero_acc<4>(g);
      gemm_main<4, true, false, true>(((u16*)(P.ws + OFF_H)), DM, nullptr, row0, ((u16*)(P.ws + OFF_WgT)) + ((size_t)l * 4 + kq) * 1024 * 1024, 1024, nt * 128, 1024, g, (u16*)smem);
#pragma unroll
      for (int m = 0; m < 4; ++m)
#pragma unroll
        for (int n = 0; n < 4; ++n) {
          gp[m][n][0] = pack2(sigmoidf_(g[m][n][0]), sigmoidf_(g[m][n][1]));
          gp[m][n][1] = pack2(sigmoidf_(g[m][n][2]), sigmoidf_(g[m][n][3]));
        }
    }
    f32x4 bb[4][4];
    zero_acc<4>(bb);
    const u16* br = ((u16*)(P.ws + OFF_br0)) + (size_t)kq * (U_ / 2);
    gemm_main<4, true, false, false>(br, 512, nullptr, row0, ((u16*)(P.ws + OFF_WbT)) + ((size_t)l * 4 + kq) * 1024 * 512, 512, nt * 128, 512, bb, (u16*)smem);
    const int tid = TID(), wave = tid >> 6, lane = tid & 63, fr = lane & 15, fq = lane >> 4;
    const int wr = wave >> 1, wc = wave & 1;
#pragma unroll
    for (int m = 0; m < 4; ++m) {
      const int r = row0 + wr * 64 + m * 16 + fr;
      float rs = 1.f;
      if (kq == 1) {
        const float* sq = ((float*)(P.ws + OFF_ssq)) + (size_t)r * 8;
        float4 a = *(const float4*)sq, b = *(const float4*)(sq + 4);
        rs = rsqrtf((a.x + a.y + a.z + a.w + b.x + b.y + b.z + b.w) * (1.f / 512.f) + LN_EPS);
      }
#pragma unroll
      for (int n = 0; n < 4; ++n) {
        u32x2* dst = (u32x2*)(((u16*)(P.ws + OFF_acc)) + (size_t)r * DM + nt * 128 + wc * 64 + n * 16 + fq * 4);
        u32x2 prev = {0u, 0u};
        if (kq > 0) prev = *dst;
        const unsigned g0 = gp[m][n][0], g1 = gp[m][n][1];
        u32x2 o;
        o[0] = pack2(bflo(prev[0]) + bflo(g0) * bb[m][n][0] * rs, bfhi(prev[0]) + bfhi(g0) * bb[m][n][1] * rs);
        o[1] = pack2(bflo(prev[1]) + bflo(g1) * bb[m][n][2] * rs, bfhi(prev[1]) + bfhi(g1) * bb[m][n][3] * rs);
        *dst = o;
      }
    }
  }
}

DI void phase_merge(const Params& P, int l, char* smem, int ph) {
  const bool last = (l == 1);
  for (;;) {
    const int it = wq_next(wq_ctr(P, ph), smem);
    if (it >= 288 * 8) break;
    int mt = it / 8, nt = it % 8;
    if (last && (mt % 18) >= 16) continue;
    merge_tile(P, l, mt, nt, smem);
  }
}

DI void phase_outproj(const Params& P, int l, char* smem, int ph) {
  const bool last = (l == 1);
  const int tid = TID(), wave = tid >> 6, lane = tid & 63, fr = lane & 15, fq = lane >> 4;
  const int wr = wave >> 1, wc = wave & 1;
  for (;;) {
    const int it = wq_next(wq_ctr(P, ph), smem);
    if (it >= 288 * 8) break;
    int mt = it / 8, nt = it % 8;
    if (last && (mt % 18) >= 16) continue;
    f32x4 acc[4][4];
    zero_acc<4>(acc);
    gemm_main<4, true, false>(((u16*)(P.ws + OFF_acc)), DM, nullptr, mt * 128, ((u16*)(P.ws + OFF_WoT)) + (size_t)l * 1024 * 1024, 1024, nt * 128, 1024, acc, (u16*)smem);
#pragma unroll
    for (int m = 0; m < 4; ++m)
#pragma unroll
      for (int n = 0; n < 4; ++n) {
        int r = mt * 128 + wr * 64 + m * 16 + fr, c = nt * 128 + wc * 64 + n * 16 + fq * 4;
        *(bf16x4*)(((u16*)(P.ws + OFF_Y)) + (size_t)r * DM + c) = pack4v(acc[m][n]);
      }
  }
}

DI void phase_ffn1(const Params& P, int l, char* smem, int ph) {
  const bool last = (l == 1);
  const int tid = TID(), wave = tid >> 6, lane = tid & 63, fr = lane & 15, fq = lane >> 4;
  const int wr = wave >> 1, wc = wave & 1;
  const int nmt = last ? 512 : 576;
  for (;;) {
    const int it = wq_next(wq_ctr(P, ph), smem);
    if (it >= nmt * 8) break;
    int mt = it / 8, nt = it % 8;
    int R0 = mt * 128;
    int e = R0 < NFFN_LAT ? (R0 >> 8) & 15 : (R0 - NFFN_LAT) >> 9;
    f32x4 acc[4][4];
    zero_acc<4>(acc);
    gemm_main<4, true, true>(((u16*)(P.ws + OFF_H)), DM, ((int*)(P.ws + OFF_tokidx)), R0, ((u16*)(P.ws + OFF_W13T)) + (size_t)e * 1024 * 1024, 1024, nt * 128, 1024, acc, (u16*)smem);
#pragma unroll
    for (int m = 0; m < 4; ++m)
#pragma unroll
      for (int n2 = 0; n2 < 2; ++n2) {
        int r = R0 + wr * 64 + m * 16 + fr;
        int hc = (nt * 4 + wc * 2 + n2) * 16 + fq * 4;
        f32x4 a = acc[m][2 * n2], b = acc[m][2 * n2 + 1];
        *(bf16x4*)(((u16*)(P.ws + OFF_hid)) + (size_t)r * 512 + hc) = pack4(siluf_(a[0]) * b[0], siluf_(a[1]) * b[1], siluf_(a[2]) * b[2], siluf_(a[3]) * b[3]);
      }
  }
}

DI void phase_ffn2(const Params& P, int l, char* smem, int ph) {
  const bool last = (l == 1);
  const int tid = TID(), wave = tid >> 6, lane = tid & 63, fr = lane & 15, fq = lane >> 4;
  const int wr = wave >> 1, wc = wave & 1;
  const int nmt = last ? 512 : 576;
  for (;;) {
    const int it = wq_next(wq_ctr(P, ph), smem);
    if (it >= nmt * 8) break;
    int mt = it / 8, nt = it % 8;
    int R0 = mt * 128;
    int e = R0 < NFFN_LAT ? (R0 >> 8) & 15 : (R0 - NFFN_LAT) >> 9;
    f32x4 acc[4][4];
    zero_acc<4>(acc);
    gemm_main<4, true, false>(((u16*)(P.ws + OFF_hid)), 512, nullptr, R0, ((u16*)(P.ws + OFF_W2T)) + (size_t)e * 1024 * 512, 512, nt * 128, 512, acc, (u16*)smem);
#pragma unroll
    for (int m = 0; m < 4; ++m) {
      int r = R0 + wr * 64 + m * 16 + fr;
      float gt = ((float*)(P.ws + OFF_gatev))[r];
#pragma unroll
      for (int n = 0; n < 4; ++n) {
        int c = nt * 128 + wc * 64 + n * 16 + fq * 4;
        f32x4 v = acc[m][n];
        *(bf16x4*)(((u16*)(P.ws + OFF_ye)) + (size_t)r * DM + c) = pack4(v[0] * gt, v[1] * gt, v[2] * gt, v[3] * gt);
      }
    }
  }
}

DI void phase_mix2(const Params& P, int l, int hb, char* smem, int ph) {
  const bool last = (l == 1);
  const int nG = 576, nA = 576, nS = 1152, nP = 576;
  for (;;) {
    const int it = wq_next(wq_ctr(P, ph), smem);
    if (it >= nA + nG + nS + nP) break;
    if (it < nG) {
      const int mt = it >> 2, g = it & 3;
      if (last && (mt % 18) >= 16) continue;
      sgu_item(P, l, hb, mt, g, smem);
    } else if (it < nG + nA) {
      const int ia = it - nG;
      if (last && ia >= 512) continue;
      attn_item(P, l, hb, ia, smem);
    } else if (it < nA + nG + nS) {
      ssd_state_item(P, l, hb, it - nA - nG, smem);
    } else {
      const int t = it - nA - nG - nS;
      const int mt = t >> 2, g = t & 3;
      if (last && (mt % 18) >= 16) continue;
      pool_item(P, l, hb, mt, g, smem);
    }
  }
}

DI void phase_ssd_out(const Params& P, int l, int hb, char* smem, int ph) {
  const bool last = (l == 1);
  for (;;) {
    const int it = wq_next(wq_ctr(P, ph), smem);
    if (it >= 8 * 18 * 8) break;
    int jp = (it >> 3) % 18;
    if (last && jp >= 16) continue;
    ssd_out_item(P, l, hb, it, smem);
  }
}

#define XB_TMO      128
#define XB_XCNT(j)  (256  + 64 * (j))
#define XB_XSUB(j)  (1280 + 64 * (j))
#define XB_XGEN(j)  (2304 + 64 * (j))
#define XB_TOP      3328
#define XB_TOPGEN   3392
#define XCD_BAR_WORDS 3456
#define XB_SPIN_CAP (1u << 18)
#define LAS __attribute__((address_space(3)))

__device__ __forceinline__ unsigned xb_ld(unsigned* p)              { return __hip_atomic_load(p, __ATOMIC_RELAXED, __HIP_MEMORY_SCOPE_AGENT); }
__device__ __forceinline__ unsigned xb_add(unsigned* p, unsigned v) { return __hip_atomic_fetch_add(p, v, __ATOMIC_RELAXED, __HIP_MEMORY_SCOPE_AGENT); }
__device__ __forceinline__ unsigned xb_xcc_id() { return (unsigned)__builtin_amdgcn_s_getreg((3 << 11) | 20) & 0xFu; }
#define XB_SPIN(cond, bar) do { unsigned _sp = 0; while (cond) { __builtin_amdgcn_s_sleep(1); \
    if ((++_sp & 255u) == 0u) { if (xb_ld(&(bar)[XB_TMO])) break; if (_sp > XB_SPIN_CAP) { atomicAdd(&(bar)[XB_TMO], 1u); break; } } } } while (0)

struct XcdBarrier {
    unsigned* bar; unsigned x;
    volatile LAS unsigned* st;
};

__device__ __forceinline__ XcdBarrier xcd_barrier_post(unsigned* bar, volatile LAS unsigned* st) {
    XcdBarrier b; b.bar = bar; b.x = xb_xcc_id(); b.st = st;
    if (threadIdx.x == 0) (void)xb_add(&bar[XB_XCNT(b.x)], 1u);
    return b;
}
__device__ __forceinline__ void xcd_barrier_complete(unsigned* bar, unsigned x, unsigned& nloc, unsigned& nx) {
    const unsigned G = gridDim.x * gridDim.y * gridDim.z;
    unsigned sum, cnt, mine, sp = 0u;
    for (;;) {
        sum = 0u; cnt = 0u; mine = 0u;
#pragma unroll
        for (unsigned j = 0; j < 16; ++j) { const unsigned c = xb_ld(&bar[XB_XCNT(j)]); sum += c; cnt += (c > 0u) ? 1u : 0u; mine = (j == x) ? c : mine; }
        if (sum == G) break;
        __builtin_amdgcn_s_sleep(1);
        if ((++sp & 255u) == 0u) { if (xb_ld(&bar[XB_TMO])) break; if (sp > XB_SPIN_CAP) { atomicAdd(&bar[XB_TMO], 1u); break; } }
    }
    nloc = mine > 0u ? mine : 1u; nx = cnt > 0u ? cnt : 1u;
}

__device__ __forceinline__ void xcd_barrier(const XcdBarrier& b) {
    asm volatile("s_waitcnt vmcnt(0)" ::: "memory");
    __syncthreads();
    if (threadIdx.x == 0) {
        unsigned* bar = b.bar;
        __builtin_amdgcn_s_waitcnt(0);
        unsigned nloc = b.st[0], nx = b.st[1];
        if (nloc == 0u) { xcd_barrier_complete(bar, b.x, nloc, nx); b.st[0] = nloc; b.st[1] = nx; }
        const unsigned old = xb_add(&bar[XB_XSUB(b.x)], 1u);
        const unsigned gen = old / nloc;
        if (old + 1u == (gen + 1u) * nloc) {
            __builtin_amdgcn_fence(__ATOMIC_RELEASE, "agent");
            asm volatile("s_waitcnt vmcnt(0)" ::: "memory");
            const unsigned og = xb_add(&bar[XB_TOP], 1u);
            const unsigned tg = og / nx;
            if (og + 1u == (tg + 1u) * nx) xb_add(&bar[XB_TOPGEN], 1u);
            else XB_SPIN(xb_ld(&bar[XB_TOPGEN]) == tg, bar);
            __builtin_amdgcn_fence(__ATOMIC_ACQUIRE, "agent");
            xb_add(&bar[XB_XGEN(b.x)], 1u);
            asm volatile("s_waitcnt vmcnt(0)" ::: "memory");
        } else {
            XB_SPIN(xb_ld(&bar[XB_XGEN(b.x)]) == gen, bar);
            __builtin_amdgcn_fence(__ATOMIC_ACQUIRE, "agent");
            asm volatile("s_waitcnt vmcnt(0)" ::: "memory");
        }
    }
    __syncthreads();
}


template <bool COOP>
__global__ void __launch_bounds__(256, 2) mk_forward(Params P, int ph_begin, int ph_end) {
  __shared__ __attribute__((aligned(16))) char smem[SMEM_BYTES];
  int ph = 0;
  volatile LAS unsigned* xbst = (volatile LAS unsigned*)(smem + SMEM_BYTES - 16);
  XcdBarrier xb;
  if (COOP) {
    if (__builtin_amdgcn_workitem_id_x() == 0) { xbst[0] = 0u; xbst[1] = 0u; xbst[2] = 0u; xbst[3] = 0u; }
    __syncthreads();
    xb = xcd_barrier_post((unsigned*)(P.ws + OFF_bar), xbst);
  }
#define PHASE(code)                                         \
  {                                                         \
    if (ph >= ph_begin && ph < ph_end) { code; }            \
    ++ph;                                                   \
    if (COOP && ph > ph_begin && ph < ph_end) {             \
      if (ph == 1) cg::this_grid().sync();                  \
      else xcd_barrier(xb);                                 \
    }                                                       \
  }
  PHASE(phase_prologue(P, smem));
  PHASE(phase_h0(P));
#pragma unroll 1
  for (int l = 0; l < 2; ++l) {
#pragma unroll 1
    for (int hb = 0; hb < 2; ++hb) {
      PHASE(phase_proj(P, l, hb, smem, ph));
      PHASE(phase_ssd_prep(P, l, hb, smem, ph));
      PHASE(phase_mix2(P, l, hb, smem, ph));
      PHASE(phase_ssd_out(P, l, hb, smem, ph));
    }
    PHASE(phase_merge(P, l, smem, ph));
    PHASE(phase_outproj(P, l, smem, ph));
    PHASE(phase_ln1(P, l, smem));
    PHASE(phase_topk(P, l, smem));
    PHASE(phase_ffn1(P, l, smem, ph));
    PHASE(phase_ffn2(P, l, smem, ph));
    PHASE(phase_ln2(P, l));
  }
#undef PHASE
}

#ifndef MK_COOP
#define MK_COOP 1
#endif

extern "C" void kernel_launch(void* const* d_in, const int* in_sizes, int n_in, void* d_out, int out_size, void* d_ws, size_t ws_size,
                              hipStream_t stream) {
  Params p{};
  const float* const* in = (const float* const*)d_in;
  p.x = in[0]; p.c = in[1]; p.ctx = in[2]; p.c_ctx = in[3]; p.w_mod = in[4]; p.b_mod = in[5]; p.w_in = in[6]; p.conv_w = in[7];
  p.conv_b = in[8]; p.a_log = in[9]; p.dt_bias = in[10]; p.ssd_d = in[11]; p.ssd_norm_g = in[12]; p.diff_lambda = in[13];
  p.diff_norm_g = in[14]; p.pool_w = in[15]; p.pool_scale = in[16]; p.sgu_ln_g = in[17]; p.sgu_ln_b = in[18]; p.sgu_w = in[19];
  p.sgu_b = in[20]; p.w_gate = in[21]; p.w_branch = in[22]; p.w_out = in[23]; p.ln1_g = in[24]; p.ln1_b = in[25]; p.w_router = in[26];
  p.w1 = in[27]; p.w3 = in[28]; p.w2 = in[29]; p.ln2_g = in[30]; p.ln2_b = in[31];
  p.out = (float*)d_out;
  p.ws = (char*)d_ws;
  if (WS_NEED > ws_size) { fprintf(stderr, "workspace too small: need %zu have %zu\n", (size_t)WS_NEED, ws_size); return; }

  static int grid_blocks = 0;
  if (!grid_blocks) {
    int dev = 0, cus = 0, per_cu = 0;
    hipGetDevice(&dev);
    hipDeviceGetAttribute(&cus, hipDeviceAttributeMultiprocessorCount, dev);
    (void)hipOccupancyMaxActiveBlocksPerMultiprocessor(&per_cu, mk_forward<(MK_COOP != 0)>, 256, 0);
    if (per_cu < 1) per_cu = 1;
    if (per_cu > 2) per_cu = 2;
    grid_blocks = cus * per_cu;
  }
#if MK_COOP
  hipMemsetAsync((char*)d_ws + OFF_bar, 0, 32768, stream);
  int b = 0, e = NPHASE;
  void* args[] = {&p, &b, &e};
  hipError_t err = hipLaunchCooperativeKernel((void*)mk_forward<true>, dim3(grid_blocks), dim3(256), args, 0, stream);
  if (err != hipSuccess) fprintf(stderr, "cooperative launch failed: %s (grid %d)\n", hipGetErrorString(err), grid_blocks);
#else
  for (int ph = 0; ph < NPHASE; ++ph) hipLaunchKernelGGL(mk_forward<false>, dim3(grid_blocks), dim3(256), 0, stream, p, ph, ph + 1);
#endif
}
```
